# Optimizing an MI355X kernel written in HIP

```python
import math
import jax
import jax.numpy as jnp
from jax import lax
import numpy as np

D_MODEL = 2048
BATCH = 1
SEQ = 8192
DEPTH = 4
DEC_BATCH = 1
DEC_SEQ = 16384
PAST_LEN = 128

N_EVEN = (DEPTH + 1) // 2
N_ODD = DEPTH // 2
EPS = 1e-6
Q_BLOCK = 128
GRID_W = 64
N_MEM = 256
D_FF = 5632

S5_WIDTH = D_MODEL // 2
S5_GROUP = 16
S5_GROUPS = S5_WIDTH // S5_GROUP
S5_STATE = 64
S5_DT_MIN = 1e-3
S5_DT_MAX = 1e-1
S5_LAMBDA_RE_MAX = -1e-4

DIFF_WIDTH = D_MODEL - S5_WIDTH
DIFF_HEAD = 64
DIFF_HEADS = DIFF_WIDTH // (2 * DIFF_HEAD)
DIFF_VHEAD = 2 * DIFF_HEAD
DIFF_SUBLN_EPS = 1e-5
EVEN_IN = S5_WIDTH + 3 * DIFF_WIDTH

GQA_HEAD = 128
GQA_HEADS = D_MODEL // GQA_HEAD
GQA_KV_HEADS = 4
GQA_GROUP = GQA_HEADS // GQA_KV_HEADS
ODD_IN = (GQA_HEADS + 2 * GQA_KV_HEADS) * GQA_HEAD
ROPE_AXIS = GQA_HEAD // 2
ROPE_THETA = 10000.0

X_HEADS = 4
X_HEAD = D_MODEL // X_HEADS

kernel_name = "hybrid_s5_diffattn_axial_gqa_encoder"


def rmsnorm(x, g, eps=EPS):
    xf = x.astype(jnp.float32)
    y = xf * lax.rsqrt(jnp.mean(xf * xf, axis=-1, keepdims=True) + eps)
    return (y * g.astype(jnp.float32)).astype(x.dtype)


def swiglu(h, w_gu, w_down):
    g, u = jnp.split(h @ w_gu, 2, axis=-1)
    return (jax.nn.silu(g) * u) @ w_down


def alibi_slopes(n):
    return jnp.asarray([2.0 ** (-8.0 * (i + 1) / n) for i in range(n)], dtype=jnp.float32)


def s5_combine(e1, e2):
    a1r, a1i, b1r, b1i = e1
    a2r, a2i, b2r, b2i = e2
    ar = a2r * a1r - a2i * a1i
    ai = a2r * a1i + a2i * a1r
    br = a2r * b1r - a2i * b1i + b2r
    bi = a2r * b1i + a2i * b1r + b2i
    return (ar, ai, br, bi)


def s5_mixer(u, lam_re, lam_im, log_dt, b_re, b_im, c_re, c_im, d_skip, glu_w, glu_b):
    bsz, L, _ = u.shape
    uf = u.astype(jnp.float32).reshape(bsz, L, S5_GROUPS, S5_GROUP)
    y = d_skip.astype(jnp.float32).reshape(S5_GROUPS, S5_GROUP) * uf
    for direction in range(2):
        lr = jnp.minimum(lam_re[direction].astype(jnp.float32), S5_LAMBDA_RE_MAX)
        li = lam_im[direction].astype(jnp.float32)
        dt = jnp.exp(log_dt[direction].astype(jnp.float32))[:, None]
        mag = jnp.exp(lr * dt)
        ab_re = mag * jnp.cos(li * dt)
        ab_im = mag * jnp.sin(li * dt)
        nr = ab_re - 1.0
        den = lr * lr + li * li
        f_re = ((nr * lr + ab_im * li) / den)[..., None]
        f_im = ((ab_im * lr - nr * li) / den)[..., None]
        br = b_re[direction].astype(jnp.float32)
        bi = b_im[direction].astype(jnp.float32)
        bb_re = f_re * br - f_im * bi
        bb_im = f_re * bi + f_im * br
        bu_re = jnp.einsum('blgh,gph->blgp', uf, bb_re)
        bu_im = jnp.einsum('blgh,gph->blgp', uf, bb_im)
        a_re = jnp.broadcast_to(ab_re, bu_re.shape)
        a_im = jnp.broadcast_to(ab_im, bu_im.shape)
        _, _, x_re, x_im = lax.associative_scan(
            s5_combine, (a_re, a_im, bu_re, bu_im), reverse=(direction == 1), axis=1)
        cr = c_re[direction].astype(jnp.float32)
        ci = c_im[direction].astype(jnp.float32)
        y = y + jnp.einsum('blgp,ghp->blgh', x_re, cr) - jnp.einsum('blgp,ghp->blgh', x_im, ci)
    y = y.reshape(bsz, L, S5_WIDTH).astype(u.dtype)
    g = jax.nn.gelu(y)
    return g * jax.nn.sigmoid(g @ glu_w + glu_b)


def diff_attention(q, k, v, lam, lambda_init, subln_g):
    bsz, H, _, L, d = q.shape
    nb = L // Q_BLOCK
    slopes = alibi_slopes(H)
    kpos = jnp.arange(L, dtype=jnp.int32)
    scale = d ** -0.5
    qb = q.reshape(bsz, H, 2, nb, Q_BLOCK, d).transpose(3, 0, 1, 2, 4, 5)
    starts = jnp.arange(nb, dtype=jnp.int32) * Q_BLOCK

    def block(args):
        qi, s0 = args
        qpos = s0 + jnp.arange(Q_BLOCK, dtype=jnp.int32)
        dist = jnp.abs(qpos[:, None] - kpos[None, :]).astype(jnp.float32)
        bias = -slopes[:, None, None] * dist
        s = jnp.einsum('bhmqd,bhmkd->bhmqk', qi, k,
                       preferred_element_type=jnp.float32) * scale + bias[None, :, None]
        p = jax.nn.softmax(s, axis=-1)
        a = p[:, :, 0] - lam * p[:, :, 1]
        return jnp.einsum('bhqk,bhke->bhqe', a.astype(v.dtype), v)

    o = lax.map(block, (qb, starts))
    o = o.transpose(1, 2, 0, 3, 4).reshape(bsz, H, L, 2 * d)
    return rmsnorm(o, subln_g, eps=DIFF_SUBLN_EPS) * (1.0 - lambda_init)


def even_mixer(h, w_in, w_out, lam_re, lam_im, log_dt, b_re, b_im, c_re, c_im, d_skip,
               glu_w, glu_b, lq1, lk1, lq2, lk2, subln_g, layer_idx):
    bsz, L, _ = h.shape
    z = h @ w_in
    u, q, k, v = jnp.split(z, [S5_WIDTH, S5_WIDTH + DIFF_WIDTH, S5_WIDTH + 2 * DIFF_WIDTH], axis=-1)
    ya = s5_mixer(u, lam_re, lam_im, log_dt, b_re, b_im, c_re, c_im, d_skip, glu_w, glu_b)
    q = q.reshape(bsz, L, DIFF_HEADS, 2, DIFF_HEAD).transpose(0, 2, 3, 1, 4)
    k = k.reshape(bsz, L, DIFF_HEADS, 2, DIFF_HEAD).transpose(0, 2, 3, 1, 4)
    v = v.reshape(bsz, L, DIFF_HEADS, DIFF_VHEAD).transpose(0, 2, 1, 3)
    lambda_init = 0.8 - 0.6 * math.exp(-0.3 * layer_idx)
    lam = (jnp.exp(jnp.sum(lq1.astype(jnp.float32) * lk1.astype(jnp.float32)))
           - jnp.exp(jnp.sum(lq2.astype(jnp.float32) * lk2.astype(jnp.float32))) + lambda_init)
    yb = diff_attention(q, k, v, lam, lambda_init, subln_g)
    yb = yb.transpose(0, 2, 1, 3).reshape(bsz, L, DIFF_WIDTH)
    return jnp.concatenate([ya, yb.astype(ya.dtype)], axis=-1) @ w_out


def axial_rope_tables(L):
    rows = L // GRID_W
    r = jnp.repeat(jnp.arange(rows, dtype=jnp.float32), GRID_W)
    c = jnp.tile(jnp.arange(GRID_W, dtype=jnp.float32), rows)
    inv = ROPE_THETA ** (-jnp.arange(0, ROPE_AXIS, 2, dtype=jnp.float32) / ROPE_AXIS)
    ang = jnp.stack([r[:, None] * inv, c[:, None] * inv], axis=1)
    return jnp.cos(ang), jnp.sin(ang)


def apply_axial_rope(x, cos, sin):
    xs = x.astype(jnp.float32).reshape(x.shape[:-1] + (2, 2, ROPE_AXIS // 2))
    x1 = xs[..., 0, :]
    x2 = xs[..., 1, :]
    o1 = x1 * cos - x2 * sin
    o2 = x2 * cos + x1 * sin
    return jnp.stack([o1, o2], axis=-2).reshape(x.shape).astype(x.dtype)


def gqa_attention(q, k, v):
    bsz, hk, g, L, d = q.shape
    nb = L // Q_BLOCK
    scale = d ** -0.5
    qb = q.reshape(bsz, hk, g, nb, Q_BLOCK, d).transpose(3, 0, 1, 2, 4, 5)

    def block(qi):
        s = jnp.einsum('bhgqd,bhkd->bhgqk', qi, k, preferred_element_type=jnp.float32) * scale
        p = jax.nn.softmax(s, axis=-1)
        return jnp.einsum('bhgqk,bhkd->bhgqd', p.astype(v.dtype), v)

    o = lax.map(block, qb)
    return o.transpose(1, 2, 3, 0, 4, 5).reshape(bsz, hk, g, L, d)


def odd_mixer(h, w_in, w_out, q_g, k_g, cos, sin):
    bsz, L, _ = h.shape
    z = h @ w_in
    q, k, v = jnp.split(z, [GQA_HEADS * GQA_HEAD, (GQA_HEADS + GQA_KV_HEADS) * GQA_HEAD], axis=-1)
    q = rmsnorm(q.reshape(bsz, L, GQA_HEADS, GQA_HEAD), q_g).transpose(0, 2, 1, 3)
    k = rmsnorm(k.reshape(bsz, L, GQA_KV_HEADS, GQA_HEAD), k_g).transpose(0, 2, 1, 3)
    v = v.reshape(bsz, L, GQA_KV_HEADS, GQA_HEAD).transpose(0, 2, 1, 3)
    q = apply_axial_rope(q, cos, sin).reshape(bsz, GQA_KV_HEADS, GQA_GROUP, L, GQA_HEAD)
    k = apply_axial_rope(k, cos, sin)
    o = gqa_attention(q, k, v)
    o = o.transpose(0, 3, 1, 2, 4).reshape(bsz, L, D_MODEL)
    return o @ w_out


def cross_attention(h, m, w_q, w_kv, w_o):
    bsz, L, _ = h.shape
    n = m.shape[1]
    q = (h @ w_q).reshape(bsz, L, X_HEADS, X_HEAD)
    k, v = jnp.split(m @ w_kv, 2, axis=-1)
    k = k.reshape(bsz, n, X_HEADS, X_HEAD)
    v = v.reshape(bsz, n, X_HEADS, X_HEAD)
    s = jnp.einsum('blhd,bnhd->bhln', q, k, preferred_element_type=jnp.float32) * (X_HEAD ** -0.5)
    p = jax.nn.softmax(s, axis=-1)
    o = jnp.einsum('bhln,bnhd->blhd', p.astype(v.dtype), v).reshape(bsz, L, D_MODEL)
    return o @ w_o


def encoder(x, mem, p):
    L = x.shape[1]
    cos, sin = axial_rope_tables(L)
    for l in range(DEPTH):
        x = x + 0.5 * swiglu(rmsnorm(x, p['ffn1_norm'][l]), p['ffn1_w_gu'][l], p['ffn1_w_down'][l])
        h = rmsnorm(x, p['mix_norm'][l])
        if l % 2 == 0:
            e = l // 2
            x = x + even_mixer(h, p['even_w_in'][e], p['even_w_out'][e],
                               p['s5_lambda_re'][e], p['s5_lambda_im'][e], p['s5_log_dt'][e],
                               p['s5_b_re'][e], p['s5_b_im'][e], p['s5_c_re'][e], p['s5_c_im'][e],
                               p['s5_d'][e], p['s5_glu_w'][e], p['s5_glu_b'][e],
                               p['diff_lambda_q1'][e], p['diff_lambda_k1'][e],
                               p['diff_lambda_q2'][e], p['diff_lambda_k2'][e],
                               p['diff_subln'][e], l)
        else:
            o = l // 2
            x = x + odd_mixer(h, p['odd_w_in'][o], p['odd_w_out'][o],
                              p['gqa_q_norm'][o], p['gqa_k_norm'][o], cos, sin)
        x = x + cross_attention(rmsnorm(x, p['cross_norm'][l]), rmsnorm(mem, p['mem_norm'][l]),
                                p['cross_w_q'][l], p['cross_w_kv'][l], p['cross_w_o'][l])
        x = x + 0.5 * swiglu(rmsnorm(x, p['ffn2_norm'][l]), p['ffn2_w_gu'][l], p['ffn2_w_down'][l])
    return rmsnorm(x, p['final_norm'])


def _dense(k, shape, fan_in):
    return jax.random.normal(k, shape, jnp.float32) * (fan_in ** -0.5)


def _gain(k, shape):
    return 1.0 + 0.02 * jax.random.normal(k, shape, jnp.float32)


def setup_inputs(seed: int = 0) -> dict:
    key = jax.random.key(seed)
    ks = list(jax.random.split(key, 48))
    G, P, H = S5_GROUPS, S5_STATE, S5_GROUP
    n_idx = jnp.arange(P, dtype=jnp.float32)
    d = {}
    d['x_prompt'] = jax.random.normal(ks[0], (BATCH, SEQ, D_MODEL), jnp.float32)
    d['x_sample'] = jax.random.normal(ks[1], (DEC_BATCH, DEC_SEQ, D_MODEL), jnp.float32)
    d['mem_prompt'] = jax.random.normal(ks[2], (BATCH, N_MEM, D_MODEL), jnp.float32)
    d['mem_sample'] = jax.random.normal(ks[3], (DEC_BATCH, N_MEM, D_MODEL), jnp.float32)
    d['ffn1_norm'] = _gain(ks[4], (DEPTH, D_MODEL))
    d['ffn1_w_gu'] = _dense(ks[5], (DEPTH, D_MODEL, 2 * D_FF), D_MODEL)
    d['ffn1_w_down'] = _dense(ks[6], (DEPTH, D_FF, D_MODEL), D_FF)
    d['mix_norm'] = _gain(ks[7], (DEPTH, D_MODEL))
    d['even_w_in'] = _dense(ks[8], (N_EVEN, D_MODEL, EVEN_IN), D_MODEL)
    d['even_w_out'] = _dense(ks[9], (N_EVEN, D_MODEL, D_MODEL), D_MODEL)
    d['s5_lambda_re'] = -0.5 + 0.01 * jax.random.normal(ks[10], (N_EVEN, 2, G, P), jnp.float32)
    d['s5_lambda_im'] = math.pi * n_idx + 0.01 * jax.random.normal(ks[11], (N_EVEN, 2, G, P), jnp.float32)
    d['s5_log_dt'] = jax.random.uniform(ks[12], (N_EVEN, 2, G), jnp.float32,
                                        math.log(S5_DT_MIN), math.log(S5_DT_MAX))
    d['s5_b_re'] = _dense(ks[13], (N_EVEN, 2, G, P, H), 2 * H)
    d['s5_b_im'] = _dense(ks[14], (N_EVEN, 2, G, P, H), 2 * H)
    d['s5_c_re'] = _dense(ks[15], (N_EVEN, 2, G, H, P), 2 * P)
    d['s5_c_im'] = _dense(ks[16], (N_EVEN, 2, G, H, P), 2 * P)
    d['s5_d'] = jax.random.normal(ks[17], (N_EVEN, S5_WIDTH), jnp.float32)
    d['s5_glu_w'] = _dense(ks[18], (N_EVEN, S5_WIDTH, S5_WIDTH), S5_WIDTH)
    d['s5_glu_b'] = 0.01 * jax.random.normal(ks[19], (N_EVEN, S5_WIDTH), jnp.float32)
    d['diff_lambda_q1'] = 0.1 * jax.random.normal(ks[20], (N_EVEN, DIFF_HEAD), jnp.float32)
    d['diff_lambda_k1'] = 0.1 * jax.random.normal(ks[21], (N_EVEN, DIFF_HEAD), jnp.float32)
    d['diff_lambda_q2'] = 0.1 * jax.random.normal(ks[22], (N_EVEN, DIFF_HEAD), jnp.float32)
    d['diff_lambda_k2'] = 0.1 * jax.random.normal(ks[23], (N_EVEN, DIFF_HEAD), jnp.float32)
    d['diff_subln'] = _gain(ks[24], (N_EVEN, DIFF_VHEAD))
    d['odd_w_in'] = _dense(ks[25], (N_ODD, D_MODEL, ODD_IN), D_MODEL)
    d['odd_w_out'] = _dense(ks[26], (N_ODD, D_MODEL, D_MODEL), D_MODEL)
    d['gqa_q_norm'] = _gain(ks[27], (N_ODD, GQA_HEAD))
    d['gqa_k_norm'] = _gain(ks[28], (N_ODD, GQA_HEAD))
    d['cross_norm'] = _gain(ks[29], (DEPTH, D_MODEL))
    d['mem_norm'] = _gain(ks[30], (DEPTH, D_MODEL))
    d['cross_w_q'] = _dense(ks[31], (DEPTH, D_MODEL, D_MODEL), D_MODEL)
    d['cross_w_kv'] = _dense(ks[32], (DEPTH, D_MODEL, 2 * D_MODEL), D_MODEL)
    d['cross_w_o'] = _dense(ks[33], (DEPTH, D_MODEL, D_MODEL), D_MODEL)
    d['ffn2_norm'] = _gain(ks[34], (DEPTH, D_MODEL))
    d['ffn2_w_gu'] = _dense(ks[35], (DEPTH, D_MODEL, 2 * D_FF), D_MODEL)
    d['ffn2_w_down'] = _dense(ks[36], (DEPTH, D_FF, D_MODEL), D_FF)
    d['final_norm'] = _gain(ks[37], (D_MODEL,))
    return d


def reference(x_prompt, x_sample, mem_prompt, mem_sample,
              ffn1_norm, ffn1_w_gu, ffn1_w_down, mix_norm,
              even_w_in, even_w_out, s5_lambda_re, s5_lambda_im, s5_log_dt,
              s5_b_re, s5_b_im, s5_c_re, s5_c_im, s5_d, s5_glu_w, s5_glu_b,
              diff_lambda_q1, diff_lambda_k1, diff_lambda_q2, diff_lambda_k2, diff_subln,
              odd_w_in, odd_w_out, gqa_q_norm, gqa_k_norm,
              cross_norm, mem_norm, cross_w_q, cross_w_kv, cross_w_o,
              ffn2_norm, ffn2_w_gu, ffn2_w_down, final_norm):
    p = dict(ffn1_norm=ffn1_norm, ffn1_w_gu=ffn1_w_gu, ffn1_w_down=ffn1_w_down, mix_norm=mix_norm,
             even_w_in=even_w_in, even_w_out=even_w_out, s5_lambda_re=s5_lambda_re,
             s5_lambda_im=s5_lambda_im, s5_log_dt=s5_log_dt, s5_b_re=s5_b_re, s5_b_im=s5_b_im,
             s5_c_re=s5_c_re, s5_c_im=s5_c_im, s5_d=s5_d, s5_glu_w=s5_glu_w, s5_glu_b=s5_glu_b,
             diff_lambda_q1=diff_lambda_q1, diff_lambda_k1=diff_lambda_k1,
             diff_lambda_q2=diff_lambda_q2, diff_lambda_k2=diff_lambda_k2, diff_subln=diff_subln,
             odd_w_in=odd_w_in, odd_w_out=odd_w_out, gqa_q_norm=gqa_q_norm, gqa_k_norm=gqa_k_norm,
             cross_norm=cross_norm, mem_norm=mem_norm, cross_w_q=cross_w_q, cross_w_kv=cross_w_kv,
             cross_w_o=cross_w_o, ffn2_norm=ffn2_norm, ffn2_w_gu=ffn2_w_gu, ffn2_w_down=ffn2_w_down,
             final_norm=final_norm)
    y_prompt = encoder(x_prompt, mem_prompt, p)
    y_sample = encoder(x_sample, mem_sample, p)
    return (y_prompt, y_sample)
```

```cpp
#include <hip/hip_runtime.h>
#include <cstdio>
#include <cstdint>

#define GAS __attribute__((address_space(1)))
#define LAS __attribute__((address_space(3)))
typedef unsigned short bf16_t;
typedef short bf16x8 __attribute__((ext_vector_type(8)));
typedef short s16x4 __attribute__((ext_vector_type(4)));
typedef float f32x2 __attribute__((ext_vector_type(2)));
typedef float f32x4 __attribute__((ext_vector_type(4)));
typedef float f32x8 __attribute__((ext_vector_type(8)));
typedef float f32x16 __attribute__((ext_vector_type(16)));
typedef unsigned u32x2 __attribute__((ext_vector_type(2)));
typedef unsigned u32x4 __attribute__((ext_vector_type(4)));
typedef GAS unsigned gu32;
#define RLX_AGENT __ATOMIC_RELAXED, __HIP_MEMORY_SCOPE_AGENT
#define LDS_WAIT() asm volatile("s_waitcnt lgkmcnt(0)" ::: "memory")
#define VM_WAIT() asm volatile("s_waitcnt vmcnt(0)" ::: "memory")
#define SBAR() __builtin_amdgcn_sched_barrier(0)

__device__ __forceinline__ unsigned cvt_pk_bf16(float lo, float hi) { unsigned r; asm volatile("v_cvt_pk_bf16_f32 %0, %1, %2" : "=v"(r) : "v"(lo), "v"(hi)); return r; }
__device__ __forceinline__ float bf2f(unsigned short b) { return __uint_as_float(((unsigned)b) << 16); }
__device__ __forceinline__ float bflo(unsigned w) { return __uint_as_float(w << 16); }
__device__ __forceinline__ float bfhi(unsigned w) { return __uint_as_float(w & 0xffff0000u); }
__device__ __forceinline__ unsigned short f2bf(float f) { unsigned u = __float_as_uint(f); return (unsigned short)((u + 0x7fffu + ((u >> 16) & 1u)) >> 16); }
__device__ __forceinline__ float fast_rcp(float x) { return __builtin_amdgcn_rcpf(x); }
__device__ __forceinline__ float fast_exp2(float x) { return __builtin_amdgcn_exp2f(x); }
__device__ __forceinline__ float sigmoidf_fast(float x) { return fast_rcp(1.0f + fast_exp2(-1.4426950408889634f * x)); }
__device__ __forceinline__ float silu_f(float x) { return x * sigmoidf_fast(x); }
__device__ __forceinline__ float gelu_tanh_f(float y) { const float z = y + 0.044715f * y * y * y; return y * fast_rcp(1.0f + fast_exp2(-2.3022081982f * z)); }
__device__ __forceinline__ float wave_sum(float v) {
#pragma unroll
    for (int o = 1; o < 64; o <<= 1) v += __shfl_xor(v, o);
    return v;
}

#define XB_TMO      128
#define XB_XCNT(j)  (256  + 64 * (j))
#define XB_XSUB(j)  (1280 + 64 * (j))
#define XB_XGEN(j)  (2304 + 64 * (j))
#define XB_TOP      3328
#define XB_TOPGEN   3392
#define XCD_BAR_WORDS 3456
#define XB_SPIN_CAP (1u << 22)

__device__ __forceinline__ unsigned xb_ld(unsigned* p)              { return __hip_atomic_load(p, __ATOMIC_RELAXED, __HIP_MEMORY_SCOPE_AGENT); }
__device__ __forceinline__ unsigned xb_add(unsigned* p, unsigned v) { return __hip_atomic_fetch_add(p, v, __ATOMIC_RELAXED, __HIP_MEMORY_SCOPE_AGENT); }
__device__ __forceinline__ unsigned xb_xcc_id() { return (unsigned)__builtin_amdgcn_s_getreg((3 << 11) | 20) & 0xFu; }
#define XB_SPIN(cond, bar) do { unsigned _sp = 0; while (cond) { __builtin_amdgcn_s_sleep(1); \
    if ((++_sp & 255u) == 0u) { if (xb_ld(&(bar)[XB_TMO])) break; if (_sp > XB_SPIN_CAP) { atomicAdd(&(bar)[XB_TMO], 1u); break; } } } } while (0)

struct XcdBarrier { unsigned* bar; unsigned x; volatile LAS unsigned* st; };

__device__ __forceinline__ XcdBarrier xcd_barrier_post(unsigned* bar, volatile LAS unsigned* st) {
    XcdBarrier b; b.bar = bar; b.x = xb_xcc_id(); b.st = st;
    if (threadIdx.x == 0) (void)xb_add(&bar[XB_XCNT(b.x)], 1u);
    return b;
}
__device__ __forceinline__ void xcd_barrier_complete(unsigned* bar, unsigned x, unsigned& nloc, unsigned& nx) {
    const unsigned G = gridDim.x * gridDim.y * gridDim.z;
    unsigned sum, cnt, mine, sp = 0u;
    for (;;) {
        sum = 0u; cnt = 0u; mine = 0u;
#pragma unroll
        for (unsigned j = 0; j < 16; ++j) { const unsigned c = xb_ld(&bar[XB_XCNT(j)]); sum += c; cnt += (c > 0u) ? 1u : 0u; mine = (j == x) ? c : mine; }
        if (sum == G) break;
        __builtin_amdgcn_s_sleep(1);
        if ((++sp & 255u) == 0u) { if (xb_ld(&bar[XB_TMO])) break; if (sp > XB_SPIN_CAP) { atomicAdd(&bar[XB_TMO], 1u); break; } }
    }
    nloc = mine > 0u ? mine : 1u; nx = cnt > 0u ? cnt : 1u;
}
__device__ __forceinline__ void xcd_barrier(const XcdBarrier& b) {
    asm volatile("s_waitcnt vmcnt(0)" ::: "memory");
    __syncthreads();
    if (threadIdx.x == 0) {
        unsigned* bar = b.bar;
        __builtin_amdgcn_s_waitcnt(0);
        unsigned nloc = b.st[0], nx = b.st[1];
        if (nloc == 0u) { xcd_barrier_complete(bar, b.x, nloc, nx); b.st[0] = nloc; b.st[1] = nx; }
        const unsigned old = xb_add(&bar[XB_XSUB(b.x)], 1u);
        const unsigned gen = old / nloc;
        if (old + 1u == (gen + 1u) * nloc) {
            __builtin_amdgcn_fence(__ATOMIC_RELEASE, "agent");
            asm volatile("s_waitcnt vmcnt(0)" ::: "memory");
            const unsigned og = xb_add(&bar[XB_TOP], 1u);
            const unsigned tg = og / nx;
            if (og + 1u == (tg + 1u) * nx) xb_add(&bar[XB_TOPGEN], 1u);
            else XB_SPIN(xb_ld(&bar[XB_TOPGEN]) == tg, bar);
            __builtin_amdgcn_fence(__ATOMIC_ACQUIRE, "agent");
            xb_add(&bar[XB_XGEN(b.x)], 1u);
            asm volatile("s_waitcnt vmcnt(0)" ::: "memory");
        } else {
            XB_SPIN(xb_ld(&bar[XB_XGEN(b.x)]) == gen, bar);
            __builtin_amdgcn_fence(__ATOMIC_ACQUIRE, "agent");
            asm volatile("s_waitcnt vmcnt(0)" ::: "memory");
        }
    }
    __syncthreads();
}

namespace pg8 {
constexpr int BM = 256, BK = 64, HALF = 128, HTB = HALF * BK * 2, STAGE_BYTES = 8 * HTB, NXCD = 8, WGM = 8;
__host__ __device__ __forceinline__ int lds_byte(int r, int c) { const int st = (r >> 4) * 2 + (c >> 5), rr = r & 15, cc = c & 31, ob = rr * 64 + cc * 2; return st * 1024 + (ob ^ (((ob >> 9) & 1) << 5)); }
__host__ __device__ __forceinline__ void stage_rc(int b, int& R, int& C) { const int st = b / 1024, sb = b % 1024, swz = sb ^ (((sb >> 9) & 1) << 5); R = (st >> 1) * 16 + swz / 64; C = (st & 1) * 32 + (swz % 64) / 2; }
__host__ __device__ __forceinline__ int perm32(int rho) { const int n = rho >> 4, i = rho & 15; return 8 * (i >> 2) + 4 * n + (i & 3); }

struct Unit { int pm, pn, z; };
struct Enum {
    int nM, nN, nZ, nwg, G, c;
    __device__ __forceinline__ void init(int nM_, int nN_, int nZ_, int G_, int c_) { nM = nM_; nN = nN_; nZ = nZ_; nwg = nM * nN * nZ; G = G_; c = c_; }
    __device__ __forceinline__ bool next(int i, Unit& u) const {
        const long L = (long)i * G + c; if (L >= nwg) return false;
        int wgid = (int)L; { const int q = nwg / NXCD, r = nwg % NXCD, xcd = wgid % NXCD, off = wgid / NXCD; wgid = (xcd < r ? xcd * (q + 1) : r * (q + 1) + (xcd - r) * q) + off; }
        const int per = nM * nN; u.z = wgid / per; wgid -= u.z * per;
        const int nig = WGM * nN, gid = wgid / nig, fm = gid * WGM, gsz = (nM - fm) < WGM ? (nM - fm) : WGM;
        u.pm = fm + ((wgid % nig) % gsz); u.pn = (wgid % nig) / gsz; return true;
    }
};

template <class Epi, class Sched>
__device__ __forceinline__ void gemm_phase(LAS unsigned char* lds, const int lda, const int ldb, const int K, const Sched& S, const Epi& E, const int tid) {
    const int wid = __builtin_amdgcn_readfirstlane(tid >> 6), lane = tid & 63, wr = wid >> 2, wc = wid & 3, fr = lane & 15, fq = lane >> 4;
    const int nt = K / BK;
    unsigned voffA[2], voffB[2];
#pragma unroll
    for (int i = 0; i < 2; ++i) { int R, C; stage_rc(tid * 16 + i * 8192, R, C); const int Rb = Epi::PERM ? ((R & ~31) + perm32(R & 31)) : R;
        voffA[i] = (unsigned)(R * lda + C) * 2u; voffB[i] = (unsigned)(Rb * ldb + C) * 2u; }
    const size_t kstep = (size_t)(BK * 2);
    const size_t hstepA = (size_t)HALF * lda * 2, hstepB = (size_t)HALF * ldb * 2;
    const unsigned ldsw = (unsigned)wid * 1024u;
    const int aoff = lds_byte(wr * 64 + fr, fq * 8), boff = lds_byte(wc * 32 + fr, fq * 8);
#define PG8_SA(b, h) (((b) * 2 + (h)) * HTB)
#define PG8_SB(b, h) ((4 + (b) * 2 + (h)) * HTB)
#define PG8_STAGE(bufoff, gbase, voff) do { _Pragma("unroll") for (int _i = 0; _i < 2; ++_i) \
        __builtin_amdgcn_global_load_lds((const unsigned*)((const char*)(gbase) + (voff)[_i]), (LAS unsigned*)(lds + (bufoff) + ldsw + _i * 8192), 16, 0, 0); } while (0)
#define PG8_LDA(dst, b, h) do { _Pragma("unroll") for (int m = 0; m < 4; ++m) _Pragma("unroll") for (int k = 0; k < 2; ++k) dst[m][k] = *(const LAS bf16x8*)(lds + PG8_SA(b, h) + aoff + m * 2048 + k * 1024); } while (0)
#define PG8_LDB(dst, b, h) do { _Pragma("unroll") for (int n = 0; n < 2; ++n) _Pragma("unroll") for (int k = 0; k < 2; ++k) dst[n][k] = *(const LAS bf16x8*)(lds + PG8_SB(b, h) + boff + n * 2048 + k * 1024); } while (0)
#define PG8_MMA(ai, bj, At, Bt) do { __builtin_amdgcn_s_setprio(1); _Pragma("unroll") for (int m = 0; m < 4; ++m) _Pragma("unroll") for (int n = 0; n < 2; ++n) _Pragma("unroll") for (int k = 0; k < 2; ++k) \
        acc[ai][bj][m][n] = __builtin_amdgcn_mfma_f32_16x16x32_bf16(Bt[n][k], At[m][k], acc[ai][bj][m][n], 0, 0, 0); __builtin_amdgcn_s_setprio(0); } while (0)
#define PG8_WAIT_V(n) asm volatile("s_waitcnt vmcnt(" #n ")" ::: "memory")
#define PG8_WAIT_L(n) asm volatile("s_waitcnt lgkmcnt(" #n ")" ::: "memory")
#define PG8_BAR __builtin_amdgcn_s_barrier()
#define PG8_SCHED __builtin_amdgcn_sched_barrier(0)
    Unit cur, nxt; int ui = 0;
    if (!S.next(0, cur)) return;
    f32x4 acc[2][2][4][2];
#pragma unroll
    for (int a = 0; a < 2; ++a)
#pragma unroll
        for (int b = 0; b < 2; ++b)
#pragma unroll
            for (int m = 0; m < 4; ++m)
#pragma unroll
                for (int n = 0; n < 2; ++n) acc[a][b][m][n] = (f32x4){0.f, 0.f, 0.f, 0.f};
    bf16x8 At[4][2], B0[2][2], B1[2][2];
    const char* cA = S.a_base(cur); const char* cB = S.b_base(cur);
    {
        PG8_STAGE(PG8_SB(0, 0), cB, voffB); PG8_STAGE(PG8_SB(0, 1), cB + hstepB, voffB); PG8_STAGE(PG8_SA(0, 0), cA, voffA); PG8_STAGE(PG8_SA(0, 1), cA + hstepA, voffA);
        if (wr == 1) PG8_BAR;
        PG8_WAIT_V(2); PG8_BAR;
        PG8_STAGE(PG8_SB(1, 0), cB + kstep, voffB); PG8_STAGE(PG8_SA(1, 0), cA + kstep, voffA); PG8_STAGE(PG8_SB(1, 1), cB + hstepB + kstep, voffB);
        PG8_WAIT_V(6); PG8_BAR;
    }
    for (;;) {
        const bool has_next = S.next(ui + 1, nxt);
        const char* nA = has_next ? S.a_base(nxt) : cA; const char* nB = has_next ? S.b_base(nxt) : cB;
        for (int t = 0; t < nt; t += 2) {
            const bool last = (t == nt - 2);
            const char* a1 = cA + (size_t)(t + 1) * kstep;
            const char* a2 = last ? nA : cA + (size_t)(t + 2) * kstep; const char* b2 = last ? nB : cB + (size_t)(t + 2) * kstep;
            const char* a3 = a2 + kstep; const char* b3 = b2 + kstep;
            PG8_LDB(B0, 0, 0); PG8_LDB(B1, 0, 1); PG8_SCHED; PG8_LDA(At, 0, 0); PG8_STAGE(PG8_SA(1, 1), a1 + hstepA, voffA);
            PG8_WAIT_V(8); PG8_WAIT_L(0); PG8_BAR; PG8_MMA(0, 0, At, B0); PG8_MMA(0, 1, At, B1); PG8_BAR; PG8_SCHED;
            PG8_LDA(At, 0, 1); PG8_STAGE(PG8_SB(0, 0), b2, voffB); PG8_STAGE(PG8_SB(0, 1), b2 + hstepB, voffB); PG8_STAGE(PG8_SA(0, 0), a2, voffA);
            PG8_WAIT_V(8); PG8_WAIT_L(0); PG8_BAR; PG8_MMA(1, 0, At, B0); PG8_MMA(1, 1, At, B1); PG8_BAR; PG8_SCHED;
            PG8_LDB(B0, 1, 0); PG8_LDB(B1, 1, 1); PG8_SCHED; PG8_LDA(At, 1, 0); PG8_STAGE(PG8_SA(0, 1), a2 + hstepA, voffA);
            PG8_WAIT_V(8); PG8_WAIT_L(0); PG8_BAR; PG8_MMA(0, 0, At, B0); PG8_MMA(0, 1, At, B1); PG8_BAR; PG8_SCHED;
            PG8_LDA(At, 1, 1); PG8_STAGE(PG8_SB(1, 0), b3, voffB); PG8_STAGE(PG8_SB(1, 1), b3 + hstepB, voffB); PG8_STAGE(PG8_SA(1, 0), a3, voffA);
            PG8_WAIT_V(8); PG8_WAIT_L(0); PG8_BAR; PG8_MMA(1, 0, At, B0); PG8_MMA(1, 1, At, B1); PG8_BAR; PG8_SCHED;
        }
        if (wr == 0) PG8_BAR;
        E(acc, cur, wr, wc, fr, fq);
        if (!has_next) break;
#pragma unroll
        for (int a = 0; a < 2; ++a)
#pragma unroll
            for (int b = 0; b < 2; ++b)
#pragma unroll
                for (int m = 0; m < 4; ++m)
#pragma unroll
                    for (int n = 0; n < 2; ++n) acc[a][b][m][n] = (f32x4){0.f, 0.f, 0.f, 0.f};
        cur = nxt; cA = nA; cB = nB; ++ui;
        if (wr == 1) PG8_BAR;
    }
    PG8_WAIT_V(0);
    PG8_BAR;
#undef PG8_SA
#undef PG8_SB
#undef PG8_STAGE
#undef PG8_LDA
#undef PG8_LDB
#undef PG8_MMA
#undef PG8_WAIT_V
#undef PG8_WAIT_L
#undef PG8_BAR
#undef PG8_SCHED
}
}

constexpr int DM = 2048, T_P = 8192, T_S = 16384, TT = T_P + T_S, DEPTH = 4, NMEM = 256, DFF = 5632;
constexpr int S5W = 1024, S5G = 64, S5H = 16, S5P = 64, LC = 32, NCH = TT / LC, NCH_P = T_P / LC;
constexpr int S5K1 = LC * S5H  , S5NS = 4 * S5P  , S5K2 = S5K1 + S5NS  ;
constexpr int EVEN_IN = 4096, ODD_IN = 3072, ZLD = 3072;
constexpr float EPS = 1e-6f, SUBLN_EPS = 1e-5f;
constexpr int NWAVES = 8, NTHREADS = 512;

enum { I_XP = 0, I_XS, I_MP, I_MS, I_F1N, I_F1GU, I_F1D, I_MIXN, I_EWIN, I_EWOUT, I_LRE, I_LIM, I_LDT, I_BRE, I_BIM, I_CRE, I_CIM, I_S5D, I_GLUW, I_GLUB,
       I_LQ1, I_LK1, I_LQ2, I_LK2, I_SUBLN, I_OWIN, I_OWOUT, I_QN, I_KN, I_CN, I_MN, I_CWQ, I_CWKV, I_CWO, I_F2N, I_F2GU, I_F2D, I_FINN, N_IN };

constexpr size_t MiB = 1u << 20;
constexpr size_t WS_CTL = 0, CTL_BYTES = 2 * MiB;
constexpr size_t WS_WGU = 2 * MiB;
constexpr size_t SZ_WGU = (size_t)2 * DFF * DM * 2;
constexpr size_t WS_WD = WS_WGU + 8 * SZ_WGU;
constexpr size_t SZ_WD = (size_t)DM * DFF * 2;
constexpr size_t WS_WINE = WS_WD + 8 * SZ_WD;
constexpr size_t SZ_WINE = (size_t)EVEN_IN * DM * 2;
constexpr size_t WS_WOUTE = WS_WINE + 2 * SZ_WINE;
constexpr size_t SZ_SQ = (size_t)DM * DM * 2;
constexpr size_t WS_GLU = WS_WOUTE + 2 * SZ_SQ;
constexpr size_t SZ_GLU = (size_t)S5W * S5W * 2;
constexpr size_t WS_WINO = WS_GLU + 2 * SZ_GLU;
constexpr size_t SZ_WINO = (size_t)ODD_IN * DM * 2;
constexpr size_t WS_WOUTO = WS_WINO + 2 * SZ_WINO;
constexpr size_t WS_KF = WS_WOUTO + 2 * SZ_SQ;
constexpr size_t SZ_KF = (size_t)1024 * DM * 2;
constexpr size_t WS_VWT = WS_KF + 8 * SZ_KF;
constexpr size_t WS_WST = WS_VWT + 8 * SZ_KF;
constexpr size_t SZ_WST = (size_t)S5NS * S5K1 * 2;
constexpr size_t WS_TG = WS_WST + 2 * 64 * SZ_WST;
constexpr size_t SZ_TG = (size_t)S5K1 * S5K2 * 2;
constexpr size_t WS_HB = WS_TG + 2 * 64 * SZ_TG;
constexpr size_t SZ_HB = (size_t)TT * DM * 2;
constexpr size_t WS_MISC = WS_HB + SZ_HB;
constexpr size_t MISC_ROPE = 0, MISC_AL = 65536  , MISC_LAM = 65536 + 131072  ;
constexpr size_t WS_POOL = WS_MISC + MiB;
constexpr size_t PL_ACT = 0;
constexpr size_t PL_Z = 0;
constexpr size_t PL_UX = 144 * MiB;
constexpr size_t PL_SST = 216 * MiB;
constexpr size_t PL_GB = 264 * MiB;
constexpr size_t PL_CAT = 312 * MiB;
constexpr size_t PL_STASH = 408 * MiB;
constexpr size_t PL_CS = 0;
constexpr size_t PL_CP = 96 * MiB;
constexpr size_t PL_WQB = 0;
constexpr size_t PL_WKVT = 32 * MiB;
constexpr size_t PL_WOT = 96 * MiB;
constexpr size_t PL_MEMN = 128 * MiB;
constexpr size_t PL_KVB = 136 * MiB;
constexpr size_t POOL_BYTES = 440 * MiB;
constexpr size_t WS_END = WS_POOL + POOL_BYTES;

constexpr int CW_BAR = 4096;
constexpr int CW_DBG = 1024;

constexpr int RING_BYTES = 143360, MISC_OFF = RING_BYTES + 320, LDS_BYTES = 147456;

struct Args { const float* in[N_IN]; float* out; unsigned char* ws; int ph_lo, ph_hi, li, pad; };
struct Frame {
    LAS unsigned char* lds; char* ldsg;
    volatile LAS unsigned* MISC;
    int tid, lane, wave, G, bid;
    const float* const* in; float* x; unsigned char* ws;
};
#define WSP(off) (F.ws + (off))
#define POOLP(off) (F.ws + WS_POOL + (off))

struct ZNone { __device__ __forceinline__ size_t aoff(int) const { return 0; } __device__ __forceinline__ size_t boff(int) const { return 0; } };
struct ZLin { size_t as, bs; __device__ __forceinline__ size_t aoff(int z) const { return (size_t)z * as; } __device__ __forceinline__ size_t boff(int z) const { return (size_t)z * bs; } };
struct ZKv { __device__ __forceinline__ size_t aoff(int z) const { return (size_t)z * (256 * 2048 * 2); } __device__ __forceinline__ size_t boff(int z) const { return (size_t)(z >> 1) * ((size_t)4096 * 2048 * 2); } };
struct ZKf { __device__ __forceinline__ size_t aoff(int z) const { return (size_t)(z >> 2) * ((size_t)256 * 4096 * 2) + (size_t)(z & 3) * 1024; }
             __device__ __forceinline__ size_t boff(int z) const { return (size_t)(z >> 3) * ((size_t)2048 * 2048 * 2) + (size_t)(z & 3) * 1024; } };
struct ZVw { __device__ __forceinline__ size_t aoff(int z) const { return (size_t)(z >> 3) * ((size_t)2048 * 2048 * 2) + (size_t)(z & 3) * 1024; }
             __device__ __forceinline__ size_t boff(int z) const { return (size_t)(z >> 2) * ((size_t)256 * 4096 * 2) + 4096 + (size_t)(z & 3) * 1024; } };
template <class ZM>
struct Sched : pg8::Enum {
    const char* A; const char* B; size_t atile, btile; int split; size_t bseq; ZM zm;
    __device__ __forceinline__ const char* a_base(const pg8::Unit& u) const { return A + (size_t)u.pm * atile + zm.aoff(u.z); }
    __device__ __forceinline__ const char* b_base(const pg8::Unit& u) const { return B + (size_t)u.pn * btile + zm.boff(u.z) + (u.pm >= split ? bseq : 0); }
};
template <class ZM>
__device__ __forceinline__ Sched<ZM> make_sched(const Frame& F, const void* A, int lda, const void* B, int ldb, int M, int N, int nZ, ZM zm) {
    Sched<ZM> S; S.init(M / 256, N / 256, nZ, F.G, F.bid); S.A = (const char*)A; S.B = (const char*)B; S.atile = (size_t)256 * lda * 2; S.btile = (size_t)256 * ldb * 2;
    S.split = 1 << 30; S.bseq = 0; S.zm = zm; return S;
}

typedef f32x4 Acc[2][2][4][2];
struct EpiSwiglu { static constexpr bool PERM = true; bf16_t* O; int ldc;
    __device__ __forceinline__ void operator()(const Acc& acc, const pg8::Unit& u, int wr, int wc, int fr, int fq) const {
        const int row0 = u.pm * 256 + wr * 64 + fr, col0 = u.pn * 128 + wc * 32 + 8 * fq;
#pragma unroll
        for (int ai = 0; ai < 2; ++ai)
#pragma unroll
            for (int m = 0; m < 4; ++m) { const f32x4 g0 = acc[ai][0][m][0], g1 = acc[ai][0][m][1], u0 = acc[ai][1][m][0], u1 = acc[ai][1][m][1];
                u32x4 w; w.x = cvt_pk_bf16(silu_f(g0[0]) * u0[0], silu_f(g0[1]) * u0[1]); w.y = cvt_pk_bf16(silu_f(g0[2]) * u0[2], silu_f(g0[3]) * u0[3]);
                w.z = cvt_pk_bf16(silu_f(g1[0]) * u1[0], silu_f(g1[1]) * u1[1]); w.w = cvt_pk_bf16(silu_f(g1[2]) * u1[2], silu_f(g1[3]) * u1[3]);
                *(u32x4*)(O + (size_t)(row0 + ai * 128 + m * 16) * ldc + col0) = w; }
    }
};
struct EpiResid { static constexpr bool PERM = false; float* X; float scale;
    __device__ __forceinline__ void operator()(const Acc& acc, const pg8::Unit& u, int wr, int wc, int fr, int fq) const {
        const int row0 = u.pm * 256 + wr * 64 + fr, col0 = u.pn * 256 + wc * 32 + 4 * fq;
#pragma unroll
        for (int ai = 0; ai < 2; ++ai)
#pragma unroll
            for (int m = 0; m < 4; ++m) { float* rp = X + (size_t)(row0 + ai * 128 + m * 16) * DM + col0;
#pragma unroll
                for (int bj = 0; bj < 2; ++bj)
#pragma unroll
                    for (int n = 0; n < 2; ++n) { f32x4 v = *(const f32x4*)(rp + bj * 128 + n * 16); v = v + acc[ai][bj][m][n] * scale; *(f32x4*)(rp + bj * 128 + n * 16) = v; }
                if (m & 1) asm volatile("" ::: "memory"); }
    }
};
struct EpiBf16 { static constexpr bool PERM = true; bf16_t* O; int ldc; size_t zhi, zlo; int zshift;
    __device__ __forceinline__ void operator()(const Acc& acc, const pg8::Unit& u, int wr, int wc, int fr, int fq) const {
        bf16_t* base = O + (size_t)(u.z >> zshift) * zhi + (size_t)(u.z & ((1 << zshift) - 1)) * zlo;
        const int row0 = u.pm * 256 + wr * 64 + fr, col0 = u.pn * 256 + wc * 32 + 8 * fq;
#pragma unroll
        for (int ai = 0; ai < 2; ++ai)
#pragma unroll
            for (int m = 0; m < 4; ++m) { bf16_t* rp = base + (size_t)(row0 + ai * 128 + m * 16) * ldc + col0;
#pragma unroll
                for (int bj = 0; bj < 2; ++bj) { const f32x4 v0 = acc[ai][bj][m][0], v1 = acc[ai][bj][m][1];
                    u32x4 w; w.x = cvt_pk_bf16(v0[0], v0[1]); w.y = cvt_pk_bf16(v0[2], v0[3]); w.z = cvt_pk_bf16(v1[0], v1[1]); w.w = cvt_pk_bf16(v1[2], v1[3]);
                    *(u32x4*)(rp + bj * 128) = w; } }
    }
};
struct EpiWinEven { static constexpr bool PERM = true; bf16_t* UX; bf16_t* Z;
    __device__ __forceinline__ void operator()(const Acc& acc, const pg8::Unit& u, int wr, int wc, int fr, int fq) const {
        const int row0 = u.pm * 256 + wr * 64 + fr, col0 = u.pn * 256 + wc * 32 + 8 * fq;
#pragma unroll
        for (int ai = 0; ai < 2; ++ai)
#pragma unroll
            for (int m = 0; m < 4; ++m) { const int row = row0 + ai * 128 + m * 16;
#pragma unroll
                for (int bj = 0; bj < 2; ++bj) { const f32x4 v0 = acc[ai][bj][m][0], v1 = acc[ai][bj][m][1]; const int col = col0 + bj * 128;
                    u32x4 w; w.x = cvt_pk_bf16(v0[0], v0[1]); w.y = cvt_pk_bf16(v0[2], v0[3]); w.z = cvt_pk_bf16(v1[0], v1[1]); w.w = cvt_pk_bf16(v1[2], v1[3]);
                    bf16_t* p;
                    if (u.pn < 4) { const int g = col >> 4, h0 = col & 15, c = row >> 5, i = row & 31; p = UX + ((size_t)(g * NCH + c) * S5K2 + i * 16 + h0); }
                    else p = Z + (size_t)row * ZLD + (col - 1024);
                    *(u32x4*)p = w; } }
    }
};
struct EpiF32 { static constexpr bool PERM = false; float* O; int ldc; size_t zs;
    __device__ __forceinline__ void operator()(const Acc& acc, const pg8::Unit& u, int wr, int wc, int fr, int fq) const {
        float* base = O + (size_t)u.z * zs; const int row0 = u.pm * 256 + wr * 64 + fr, col0 = u.pn * 256 + wc * 32 + 4 * fq;
#pragma unroll
        for (int ai = 0; ai < 2; ++ai)
#pragma unroll
            for (int m = 0; m < 4; ++m) { float* rp = base + (size_t)(row0 + ai * 128 + m * 16) * ldc + col0;
#pragma unroll
                for (int bj = 0; bj < 2; ++bj)
#pragma unroll
                    for (int n = 0; n < 2; ++n) *(f32x4*)(rp + bj * 128 + n * 16) = acc[ai][bj][m][n]; }
    }
};
struct EpiS5Out { static constexpr bool PERM = true; bf16_t* GB;
    __device__ __forceinline__ void operator()(const Acc& acc, const pg8::Unit& u, int wr, int wc, int fr, int fq) const {
        const int row0 = u.pm * 256 + wr * 64 + fr, col0 = u.pn * 256 + wc * 32 + 8 * fq;
#pragma unroll
        for (int ai = 0; ai < 2; ++ai)
#pragma unroll
            for (int m = 0; m < 4; ++m) { const int c = row0 + ai * 128 + m * 16;
#pragma unroll
                for (int bj = 0; bj < 2; ++bj) { const f32x4 v0 = acc[ai][bj][m][0], v1 = acc[ai][bj][m][1]; const int col = col0 + bj * 128, i = col >> 4, h0 = col & 15;
                    u32x4 w; w.x = cvt_pk_bf16(gelu_tanh_f(v0[0]), gelu_tanh_f(v0[1])); w.y = cvt_pk_bf16(gelu_tanh_f(v0[2]), gelu_tanh_f(v0[3]));
                    w.z = cvt_pk_bf16(gelu_tanh_f(v1[0]), gelu_tanh_f(v1[1])); w.w = cvt_pk_bf16(gelu_tanh_f(v1[2]), gelu_tanh_f(v1[3]));
                    *(u32x4*)(GB + (size_t)(c * LC + i) * S5W + u.z * 16 + h0) = w; } }
    }
};
struct EpiGlu { static constexpr bool PERM = true; const bf16_t* GB; const float* bias; bf16_t* O;
    __device__ __forceinline__ void operator()(const Acc& acc, const pg8::Unit& u, int wr, int wc, int fr, int fq) const {
        const int row0 = u.pm * 256 + wr * 64 + fr, col0 = u.pn * 256 + wc * 32 + 8 * fq;
        f32x4 bv[2][2];
#pragma unroll
        for (int bj = 0; bj < 2; ++bj)
#pragma unroll
            for (int n = 0; n < 2; ++n) bv[bj][n] = *(const f32x4*)(bias + col0 + bj * 128 + 4 * n);
#pragma unroll
        for (int ai = 0; ai < 2; ++ai)
#pragma unroll
            for (int m = 0; m < 4; ++m) { const int row = row0 + ai * 128 + m * 16;
#pragma unroll
                for (int bj = 0; bj < 2; ++bj) { const f32x4 v0 = acc[ai][bj][m][0] + bv[bj][0], v1 = acc[ai][bj][m][1] + bv[bj][1]; const int col = col0 + bj * 128;
                    const u32x4 g = *(const u32x4*)(GB + (size_t)row * S5W + col);
                    u32x4 w; w.x = cvt_pk_bf16(bflo(g.x) * sigmoidf_fast(v0[0]), bfhi(g.x) * sigmoidf_fast(v0[1])); w.y = cvt_pk_bf16(bflo(g.y) * sigmoidf_fast(v0[2]), bfhi(g.y) * sigmoidf_fast(v0[3]));
                    w.z = cvt_pk_bf16(bflo(g.z) * sigmoidf_fast(v1[0]), bfhi(g.z) * sigmoidf_fast(v1[1])); w.w = cvt_pk_bf16(bflo(g.w) * sigmoidf_fast(v1[2]), bfhi(g.w) * sigmoidf_fast(v1[3]));
                    *(u32x4*)(O + (size_t)row * DM + col) = w; } }
    }
};

template <int MODE>
__device__ __forceinline__ void transpose_item(const float* W, int K, int N, bf16_t* WT, LAS float* scr, int item, int lane) {
    const int nblk = N / 32, kb = item / nblk, nb = item % nblk, k0 = 64 * kb, n0 = 32 * nb;
#pragma unroll 8
    for (int i = 0; i < 32; ++i) { const int kk = 2 * i + (lane >> 5); scr[kk * 33 + (lane & 31)] = W[(size_t)(k0 + kk) * N + n0 + (lane & 31)]; }
    LDS_WAIT(); asm volatile("" ::: "memory");
    const int c = lane & 7;
    int r0;
    if (MODE == 1) { r0 = (n0 < DFF) ? (256 * (n0 / 128) + (n0 % 128)) : (256 * ((n0 - DFF) / 128) + 128 + ((n0 - DFF) % 128)); } else r0 = n0;
#pragma unroll
    for (int j = 0; j < 4; ++j) { const int n = (lane >> 3) + 8 * j; const LAS float* s = scr + (8 * c) * 33 + n;
        u32x4 o; o.x = cvt_pk_bf16(s[0 * 33], s[1 * 33]); o.y = cvt_pk_bf16(s[2 * 33], s[3 * 33]); o.z = cvt_pk_bf16(s[4 * 33], s[5 * 33]); o.w = cvt_pk_bf16(s[6 * 33], s[7 * 33]);
        *(u32x4*)(WT + (size_t)(r0 + n) * K + k0 + 8 * c) = o; }
    LDS_WAIT(); asm volatile("" ::: "memory");
}
__device__ __forceinline__ void convert_rows(const float* src, bf16_t* dst, size_t n8, size_t gtid, size_t gthreads) {
    for (size_t i = gtid; i < n8; i += gthreads) { const f32x4 a = *(const f32x4*)(src + i * 8), b = *(const f32x4*)(src + i * 8 + 4);
        u32x4 o; o.x = cvt_pk_bf16(a[0], a[1]); o.y = cvt_pk_bf16(a[2], a[3]); o.z = cvt_pk_bf16(b[0], b[1]); o.w = cvt_pk_bf16(b[2], b[3]); *(u32x4*)(dst + i * 8) = o; }
}

__device__ __forceinline__ void rms_row_to_bf16(const float* xrow, const float* g, bf16_t* orow, float* xcopy, int lane) {
    const f32x4* xr = (const f32x4*)xrow + lane;
    f32x4 v[8]; float s = 0.f;
#pragma unroll
    for (int j = 0; j < 8; ++j) { v[j] = xr[64 * j]; s += (v[j].x * v[j].x + v[j].y * v[j].y) + (v[j].z * v[j].z + v[j].w * v[j].w); }
    if (xcopy) {
#pragma unroll
        for (int j = 0; j < 8; ++j) ((f32x4*)xcopy + lane)[64 * j] = v[j]; }
    const float rstd = 1.0f / sqrtf(wave_sum(s) * (1.f / DM) + EPS);
    const f32x4* gr = (const f32x4*)g + lane;
    u32x2* o8 = (u32x2*)orow + lane;
#pragma unroll
    for (int j = 0; j < 8; ++j) { const f32x4 gg = gr[64 * j]; u32x2 w; w.x = cvt_pk_bf16(v[j].x * rstd * gg.x, v[j].y * rstd * gg.y); w.y = cvt_pk_bf16(v[j].z * rstd * gg.z, v[j].w * rstd * gg.w); o8[64 * j] = w; }
}
__device__ __forceinline__ void norm_phase(const Frame& F, const float* g) {
    const int gw = F.bid * NWAVES + F.wave, NGW = F.G * NWAVES; bf16_t* HB = (bf16_t*)WSP(WS_HB);
    for (int m = gw; m < TT; m += NGW) rms_row_to_bf16(F.x + (size_t)m * DM, g, HB + (size_t)m * DM, nullptr, F.lane);
}
__device__ __forceinline__ void final_norm_phase(const Frame& F, const float* g) {
    const int gw = F.bid * NWAVES + F.wave, NGW = F.G * NWAVES;
    for (int m = gw; m < TT; m += NGW) {
        f32x4* xr = (f32x4*)(F.x + (size_t)m * DM) + F.lane; f32x4 v[8]; float s = 0.f;
#pragma unroll
        for (int j = 0; j < 8; ++j) { v[j] = xr[64 * j]; s += (v[j].x * v[j].x + v[j].y * v[j].y) + (v[j].z * v[j].z + v[j].w * v[j].w); }
        const float rstd = 1.0f / sqrtf(wave_sum(s) * (1.f / DM) + EPS); const f32x4* gr = (const f32x4*)g + F.lane;
#pragma unroll
        for (int j = 0; j < 8; ++j) { const f32x4 gg = gr[64 * j]; xr[64 * j] = v[j] * rstd * gg; }
    }
}

__device__ __forceinline__ void s5_precompute_group(const Frame& F, int e, int g) {
    LAS float* L = (LAS float*)F.lds;
    LAS float* apow = L;
    LAS float* bb = apow + 8448;
    LAS float* cc = bb + 4096;
    LAS float* km = cc + 4096;
    LAS float* dsk = km + 16384;
    const float* lre = F.in[I_LRE], *lim = F.in[I_LIM], *ldt = F.in[I_LDT], *bre = F.in[I_BRE], *bim = F.in[I_BIM], *cre = F.in[I_CRE], *cim = F.in[I_CIM], *dsk_g = F.in[I_S5D];
    const int tid = F.tid;
    for (int idx = tid; idx < 2 * 64 * 33; idx += NTHREADS) { const int k = idx % 33, p = (idx / 33) % 64, dir = idx / (33 * 64);
        const size_t pi = ((size_t)(e * 2 + dir) * S5G + g) * S5P + p; const float lr = fminf(lre[pi], -1e-4f), li = lim[pi], dt = expf(ldt[(e * 2 + dir) * S5G + g]);
        const float mag = expf(lr * dt * (float)k); float sn, cs; sincosf(li * dt * (float)k, &sn, &cs); apow[idx * 2] = mag * cs; apow[idx * 2 + 1] = mag * sn; }
    for (int idx = tid; idx < 2 * 64 * 16; idx += NTHREADS) { const int h = idx % 16, p = (idx / 16) % 64, dir = idx / 1024;
        const size_t pi = ((size_t)(e * 2 + dir) * S5G + g) * S5P + p; const float lr = fminf(lre[pi], -1e-4f), li = lim[pi], dt = expf(ldt[(e * 2 + dir) * S5G + g]);
        const float mag = expf(lr * dt); float sn, cs; sincosf(li * dt, &sn, &cs); const float ar = mag * cs, ai = mag * sn, nr = ar - 1.0f, den = lr * lr + li * li;
        const float fr = (nr * lr + ai * li) / den, fi = (ai * lr - nr * li) / den; const float br = bre[pi * 16 + h], bi = bim[pi * 16 + h];
        bb[idx * 2] = fr * br - fi * bi; bb[idx * 2 + 1] = fr * bi + fi * br; }
    for (int idx = tid; idx < 2 * 16 * 64; idx += NTHREADS) { const int p = idx % 64, h = (idx / 64) % 16, dir = idx / 1024;
        const size_t ci = (((size_t)(e * 2 + dir) * S5G + g) * S5H + h) * S5P + p; cc[idx * 2] = cre[ci]; cc[idx * 2 + 1] = cim[ci]; }
    if (tid < 16) dsk[tid] = dsk_g[e * S5W + g * 16 + tid];
    LDS_WAIT(); __syncthreads();
    for (int idx = tid; idx < 2 * 32 * 256; idx += NTHREADS) { const int hp = idx & 15, h = (idx >> 4) & 15, k = (idx >> 8) & 31, dir = idx >> 13; float s = 0.f;
        for (int p = 0; p < 64; ++p) { const float cr = cc[((dir * 16 + h) * 64 + p) * 2], ci = cc[((dir * 16 + h) * 64 + p) * 2 + 1], ar = apow[((dir * 64 + p) * 33 + k) * 2], ai = apow[((dir * 64 + p) * 33 + k) * 2 + 1];
            const float br = bb[((dir * 64 + p) * 16 + hp) * 2], bi = bb[((dir * 64 + p) * 16 + hp) * 2 + 1]; const float wr = cr * ar - ci * ai, wi = cr * ai + ci * ar; s += wr * br - wi * bi; }
        km[idx] = s; }
    LDS_WAIT(); __syncthreads();
    bf16_t* WST = (bf16_t*)WSP(WS_WST) + (size_t)(e * 64 + g) * (S5NS * S5K1);
    bf16_t* TG = (bf16_t*)WSP(WS_TG) + (size_t)(e * 64 + g) * (S5K1 * S5K2);
    for (int idx = tid; idx < S5NS * S5K1 / 2; idx += NTHREADS) { const int k2 = (idx % (S5K1 / 2)) * 2, n = idx / (S5K1 / 2); const int dir = n >> 7, p = (n >> 1) & 63, ri = n & 1; const int j = k2 >> 4, hp = k2 & 15;
        const int ex = dir == 0 ? (LC - 1 - j) : j; const float ar = apow[((dir * 64 + p) * 33 + ex) * 2], ai = apow[((dir * 64 + p) * 33 + ex) * 2 + 1];
        float v[2];
#pragma unroll
        for (int q = 0; q < 2; ++q) { const float br = bb[((dir * 64 + p) * 16 + hp + q) * 2], bi = bb[((dir * 64 + p) * 16 + hp + q) * 2 + 1]; v[q] = ri == 0 ? (ar * br - ai * bi) : (ar * bi + ai * br); }
        *(unsigned*)(WST + (size_t)n * S5K1 + k2) = cvt_pk_bf16(v[0], v[1]); }
    for (int idx = tid; idx < S5K1 * S5K2 / 2; idx += NTHREADS) { const int k2 = (idx % (S5K2 / 2)) * 2, n = idx / (S5K2 / 2); const int i = n >> 4, h = n & 15; float v[2];
        if (k2 < S5K1) { const int j = k2 >> 4, hp = k2 & 15;
#pragma unroll
            for (int q = 0; q < 2; ++q) { float s = 0.f; if (j <= i) s += km[((0 * 32 + (i - j)) * 16 + h) * 16 + hp + q]; if (j >= i) s += km[((1 * 32 + (j - i)) * 16 + h) * 16 + hp + q]; if (i == j && h == hp + q) s += dsk[h]; v[q] = s; }
        } else { const int nn = k2 - S5K1, dir = nn >> 7, p = (nn >> 1) & 63; const int ex = dir == 0 ? (i + 1) : (LC - i);
            const float ar = apow[((dir * 64 + p) * 33 + ex) * 2], ai = apow[((dir * 64 + p) * 33 + ex) * 2 + 1], cr = cc[((dir * 16 + h) * 64 + p) * 2], ci = cc[((dir * 16 + h) * 64 + p) * 2 + 1];
            v[0] = cr * ar - ci * ai; v[1] = -(cr * ai + ci * ar); }
        *(unsigned*)(TG + (size_t)n * S5K2 + k2) = cvt_pk_bf16(v[0], v[1]); }
    f32x2* AL = (f32x2*)(WSP(WS_MISC) + MISC_AL);
    if (tid < 128) { const int dir = tid >> 6, p = tid & 63; AL[((e * 2 + dir) * 64 + g) * 64 + p] = (f32x2){apow[((dir * 64 + p) * 33 + LC) * 2], apow[((dir * 64 + p) * 33 + LC) * 2 + 1]}; }
    __syncthreads();
}

__device__ __forceinline__ void s5_scan_phase(const Frame& F, int e) {
    const int gt = F.bid * NTHREADS + F.tid;
    if (gt >= 2 * 2 * 64 * 64) return;
    const int p = gt & 63, g = (gt >> 6) & 63, dir = (gt >> 12) & 1, seq = gt >> 13;
    const float* SST = (const float*)POOLP(PL_SST); bf16_t* UX = (bf16_t*)POOLP(PL_UX);
    const f32x2 aL = ((const f32x2*)(WSP(WS_MISC) + MISC_AL))[((e * 2 + dir) * 64 + g) * 64 + p];
    const int c0 = seq ? NCH_P : 0, c1 = seq ? NCH : NCH_P, n = c1 - c0;
    float xr = 0.f, xi = 0.f;
    const int step = dir == 0 ? 1 : -1; int c = dir == 0 ? c0 : c1 - 1;
    for (int it = 0; it < n; it += 8) {
        f32x2 s[8];
#pragma unroll
        for (int q = 0; q < 8; ++q) s[q] = *(const f32x2*)(SST + ((size_t)(c + q * step) * 64 + g) * 256 + dir * 128 + 2 * p);
#pragma unroll
        for (int q = 0; q < 8; ++q) { *(unsigned*)(UX + ((size_t)g * NCH + (c + q * step)) * S5K2 + S5K1 + dir * 128 + 2 * p) = cvt_pk_bf16(xr, xi);
            const float nr = aL.x * xr - aL.y * xi + s[q].x, ni = aL.x * xi + aL.y * xr + s[q].y; xr = nr; xi = ni; }
        c += 8 * step;
    }
}

__device__ __forceinline__ void qk_prep_phase(const Frame& F, int o) {
    bf16_t* Z = (bf16_t*)POOLP(PL_Z); const float* rope = (const float*)(WSP(WS_MISC) + MISC_ROPE);
    const float* qg = F.in[I_QN] + o * 128, *kg = F.in[I_KN] + o * 128;
    const int sub = F.lane >> 4, j = F.lane & 15;
    const long nrows = (long)TT * 20, gq = ((long)F.bid * NWAVES + F.wave) * 4 + sub, nq = (long)F.G * NWAVES * 4;
    for (long r = gq; r < nrows; r += nq) {
        const int t = (int)(r / 20), hh = (int)(r % 20);
        bf16_t* p = Z + (size_t)t * ZLD + (hh < 16 ? hh * 128 : 2048 + (hh - 16) * 128) + j * 8;
        const u32x4 w = *(const u32x4*)p; float v[8] = {bflo(w.x), bfhi(w.x), bflo(w.y), bfhi(w.y), bflo(w.z), bfhi(w.z), bflo(w.w), bfhi(w.w)};
        float s = 0.f;
#pragma unroll
        for (int q = 0; q < 8; ++q) s += v[q] * v[q];
        s += __shfl_xor(s, 1); s += __shfl_xor(s, 2); s += __shfl_xor(s, 4); s += __shfl_xor(s, 8);
        const float rstd = 1.0f / sqrtf(s * (1.f / 128.f) + EPS); const float* gg = (hh < 16 ? qg : kg) + j * 8;
        const int tl = t < T_P ? t : t - T_P; const int pos = (j < 8) ? (tl >> 6) : (tl & 63);
        const float* rp = rope + ((size_t)pos * 32 + 8 * (j & 3)) * 2;
        float o[8];
#pragma unroll
        for (int q = 0; q < 8; ++q) { const float x = v[q] * rstd * gg[q]; const float y = __shfl_xor(x, 4); const float cs = rp[2 * q], sn = rp[2 * q + 1];
            o[q] = (j & 4) ? (x * cs + y * sn) : (x * cs - y * sn); }
        u32x4 ow; ow.x = cvt_pk_bf16(o[0], o[1]); ow.y = cvt_pk_bf16(o[2], o[3]); ow.z = cvt_pk_bf16(o[4], o[5]); ow.w = cvt_pk_bf16(o[6], o[7]);
        *(u32x4*)p = ow;
    }
}

__device__ __forceinline__ void cross_softmax_phase(const Frame& F) {
    const float* CS = (const float*)POOLP(PL_CS); bf16_t* CP = (bf16_t*)POOLP(PL_CP);
    const long nrows = (long)TT * 4, gw = (long)F.bid * NWAVES + F.wave, NGW = (long)F.G * NWAVES;
    constexpr float C = 0.04419417382415922f * 1.4426950408889634f;
    for (long r = gw; r < nrows; r += NGW) {
        const f32x4 v = *((const f32x4*)(CS + r * 256) + F.lane);
        float m = fmaxf(fmaxf(v.x, v.y), fmaxf(v.z, v.w));
#pragma unroll
        for (int o = 1; o < 64; o <<= 1) m = fmaxf(m, __shfl_xor(m, o));
        const float e0 = fast_exp2((v.x - m) * C), e1 = fast_exp2((v.y - m) * C), e2 = fast_exp2((v.z - m) * C), e3 = fast_exp2((v.w - m) * C);
        const float inv = fast_rcp(wave_sum((e0 + e1) + (e2 + e3)));
        u32x2 w; w.x = cvt_pk_bf16(e0 * inv, e1 * inv); w.y = cvt_pk_bf16(e2 * inv, e3 * inv);
        *((u32x2*)(CP + r * 256) + F.lane) = w;
    }
}

__device__ __forceinline__ void prologue_phase(const Frame& F) {
    LAS float* scr = (LAS float*)(F.lds + F.wave * 16384);
    const int gw = F.bid * NWAVES + F.wave, NGW = F.G * NWAVES;
    constexpr int IT_GU = (DM / 64) * (2 * DFF / 32), IT_D = (DFF / 64) * (DM / 32), IT_WINE = (DM / 64) * (EVEN_IN / 32), IT_SQ = (DM / 64) * (DM / 32), IT_GLU = (S5W / 64) * (S5W / 32),
                  IT_WINO = (DM / 64) * (ODD_IN / 32), IT_KV = (DM / 64) * (2 * DM / 32);
    constexpr int N_GU = 8 * IT_GU, N_D = 8 * IT_D, N_WINE = 2 * IT_WINE, N_WOUTE = 2 * IT_SQ, N_GLU = 2 * IT_GLU, N_WINO = 2 * IT_WINO, N_WOUTO = 2 * IT_SQ, N_KV = 4 * IT_KV, N_WO = 4 * IT_SQ;
    constexpr int NITEMS = N_GU + N_D + N_WINE + N_WOUTE + N_GLU + N_WINO + N_WOUTO + N_KV + N_WO;
    for (int it = gw; it < NITEMS; it += NGW) {
        int r = it;
        if (r < N_GU) { const int w = r / IT_GU, l = w >> 1, f = w & 1; transpose_item<1>(F.in[f ? I_F2GU : I_F1GU] + (size_t)l * DM * 2 * DFF, DM, 2 * DFF, (bf16_t*)WSP(WS_WGU + w * SZ_WGU), scr, r % IT_GU, F.lane); continue; } r -= N_GU;
        if (r < N_D) { const int w = r / IT_D, l = w >> 1, f = w & 1; transpose_item<0>(F.in[f ? I_F2D : I_F1D] + (size_t)l * DFF * DM, DFF, DM, (bf16_t*)WSP(WS_WD + w * SZ_WD), scr, r % IT_D, F.lane); continue; } r -= N_D;
        if (r < N_WINE) { const int e = r / IT_WINE; transpose_item<0>(F.in[I_EWIN] + (size_t)e * DM * EVEN_IN, DM, EVEN_IN, (bf16_t*)WSP(WS_WINE + e * SZ_WINE), scr, r % IT_WINE, F.lane); continue; } r -= N_WINE;
        if (r < N_WOUTE) { const int e = r / IT_SQ; transpose_item<0>(F.in[I_EWOUT] + (size_t)e * DM * DM, DM, DM, (bf16_t*)WSP(WS_WOUTE + e * SZ_SQ), scr, r % IT_SQ, F.lane); continue; } r -= N_WOUTE;
        if (r < N_GLU) { const int e = r / IT_GLU; transpose_item<0>(F.in[I_GLUW] + (size_t)e * S5W * S5W, S5W, S5W, (bf16_t*)WSP(WS_GLU + e * SZ_GLU), scr, r % IT_GLU, F.lane); continue; } r -= N_GLU;
        if (r < N_WINO) { const int o = r / IT_WINO; transpose_item<0>(F.in[I_OWIN] + (size_t)o * DM * ODD_IN, DM, ODD_IN, (bf16_t*)WSP(WS_WINO + o * SZ_WINO), scr, r % IT_WINO, F.lane); continue; } r -= N_WINO;
        if (r < N_WOUTO) { const int o = r / IT_SQ; transpose_item<0>(F.in[I_OWOUT] + (size_t)o * DM * DM, DM, DM, (bf16_t*)WSP(WS_WOUTO + o * SZ_SQ), scr, r % IT_SQ, F.lane); continue; } r -= N_WOUTO;
        if (r < N_KV) { const int l = r / IT_KV; transpose_item<0>(F.in[I_CWKV] + (size_t)l * DM * 2 * DM, DM, 2 * DM, (bf16_t*)POOLP(PL_WKVT) + (size_t)l * 2 * DM * DM, scr, r % IT_KV, F.lane); continue; } r -= N_KV;
        { const int l = r / IT_SQ; transpose_item<0>(F.in[I_CWO] + (size_t)l * DM * DM, DM, DM, (bf16_t*)POOLP(PL_WOT) + (size_t)l * DM * DM, scr, r % IT_SQ, F.lane); }
    }
    convert_rows(F.in[I_CWQ], (bf16_t*)POOLP(PL_WQB), (size_t)4 * DM * DM / 8, (size_t)F.bid * NTHREADS + F.tid, (size_t)F.G * NTHREADS);
    for (int m = gw; m < 4 * 2 * NMEM; m += NGW) { const int l = m / (2 * NMEM), s = (m / NMEM) & 1, j = m % NMEM;
        rms_row_to_bf16(F.in[s ? I_MS : I_MP] + (size_t)j * DM, F.in[I_MN] + l * DM, (bf16_t*)POOLP(PL_MEMN) + (size_t)m * DM, nullptr, F.lane); }
    for (int m = gw; m < TT; m += NGW) { const float* src = m < T_P ? F.in[I_XP] + (size_t)m * DM : F.in[I_XS] + (size_t)(m - T_P) * DM;
        rms_row_to_bf16(src, F.in[I_F1N], (bf16_t*)WSP(WS_HB) + (size_t)m * DM, F.x + (size_t)m * DM, F.lane); }
    { float* rope = (float*)(WSP(WS_MISC) + MISC_ROPE); const int gt = F.bid * NTHREADS + F.tid;
      if (gt < 256 * 32) { const int pos = gt >> 5, i = gt & 31; const float inv = powf(10000.0f, -(float)(2 * i) / 64.0f); float sn, cs; sincosf((float)pos * inv, &sn, &cs); rope[gt * 2] = cs; rope[gt * 2 + 1] = sn; }
      if (gt < 2) { float s1 = 0.f, s2 = 0.f; for (int q = 0; q < 64; ++q) { s1 += F.in[I_LQ1][gt * 64 + q] * F.in[I_LK1][gt * 64 + q]; s2 += F.in[I_LQ2][gt * 64 + q] * F.in[I_LK2][gt * 64 + q]; }
          const float linit = 0.8f - 0.6f * expf(-0.3f * (float)(2 * gt)); ((float*)(WSP(WS_MISC) + MISC_LAM))[gt * 2] = expf(s1) - expf(s2) + linit; ((float*)(WSP(WS_MISC) + MISC_LAM))[gt * 2 + 1] = linit; } }
    __syncthreads();
    for (int w = F.bid; w < 2 * S5G; w += F.G) s5_precompute_group(F, w / S5G, w % S5G);
}

#ifndef GQA_SDEPTH
#define GQA_SDEPTH 1
#endif
#ifndef DIFF_SDEPTH
#define DIFF_SDEPTH 1
#endif
namespace att {
constexpr int NW = 8, QBLK = 32, KVBLK = 64, DV = 128;
constexpr float THR = 8.f;
__device__ __forceinline__ int crow(int r, int hi) { return (r & 3) + 8 * (r >> 2) + 4 * hi; }
template <int DQK> __device__ __forceinline__ int kswz(int row, int colB) { if (DQK == 128) return row * 256 + (colB ^ ((row & 7) << 4)); else return row * 128 + (colB ^ (((row >> 1) & 7) << 4)); }
__device__ __forceinline__ int v_st(int k, int c) { const int kk = (k & ~0xC) | ((k & 4) << 1) | ((k & 8) >> 1); return ((kk >> 3) * 4 + (c >> 5)) * 512 + ((kk & 7) * 32 + (c & 31)) * 2; }
__device__ __forceinline__ int v_rd_base(int lane) { return ((lane & 3) << 3) | (((lane >> 2) & 3) << 6) | (((lane >> 4) & 1) << 5) | (((lane >> 5) & 1) << 8); }
constexpr int v_rd_off(int d0, int ks, int half) { return d0 * 512 + ks * 4096 + half * 2048; }
template <int OFF> __device__ __forceinline__ s16x4 tr_read(int vb) { s16x4 r; asm volatile("ds_read_b64_tr_b16 %0, %1 offset:%2" : "=&v"(r) : "v"(vb), "i"(OFF) : "memory"); return r; }
template <int D0> __device__ __forceinline__ void pv_one(f32x16& od, int vb, bf16x8 pa0, bf16x8 pa1, bf16x8 pa2, bf16x8 pa3) {
  const s16x4 l0 = tr_read<v_rd_off(D0, 0, 0)>(vb), h0 = tr_read<v_rd_off(D0, 0, 1)>(vb), l1 = tr_read<v_rd_off(D0, 1, 0)>(vb), h1 = tr_read<v_rd_off(D0, 1, 1)>(vb);
  const s16x4 l2 = tr_read<v_rd_off(D0, 2, 0)>(vb), h2 = tr_read<v_rd_off(D0, 2, 1)>(vb), l3 = tr_read<v_rd_off(D0, 3, 0)>(vb), h3 = tr_read<v_rd_off(D0, 3, 1)>(vb);
  asm volatile("s_waitcnt lgkmcnt(0)" ::: "memory"); SBAR();
#define PK(L, H) (bf16x8){L[0], L[1], L[2], L[3], H[0], H[1], H[2], H[3]}
  od = __builtin_amdgcn_mfma_f32_32x32x16_bf16(pa0, PK(l0, h0), od, 0, 0, 0);
  od = __builtin_amdgcn_mfma_f32_32x32x16_bf16(pa1, PK(l1, h1), od, 0, 0, 0);
  od = __builtin_amdgcn_mfma_f32_32x32x16_bf16(pa2, PK(l2, h2), od, 0, 0, 0);
  od = __builtin_amdgcn_mfma_f32_32x32x16_bf16(pa3, PK(l3, h3), od, 0, 0, 0);
#undef PK
}
__device__ __forceinline__ void pv_d0(f32x16* o, int vb, bf16x8 pa0, bf16x8 pa1, bf16x8 pa2, bf16x8 pa3) {
  pv_one<0>(o[0], vb, pa0, pa1, pa2, pa3); pv_one<1>(o[1], vb, pa0, pa1, pa2, pa3); pv_one<2>(o[2], vb, pa0, pa1, pa2, pa3); pv_one<3>(o[3], vb, pa0, pa1, pa2, pa3);
}
template <int DQK> struct Cst { static constexpr float SCALE = DQK == 128 ? 0.088388347648318440f : 0.125f; static constexpr float C = SCALE * 1.4426950408889634f; };

template <int DQK>
__device__ __forceinline__ void partialSM(f32x16& p0, f32x16& p1, float& m_reg, float& mn, float& alpha) {
  constexpr float C = Cst<DQK>::C, SCALE = Cst<DQK>::SCALE;
  float pmax = p0[0];
#pragma unroll
  for (int r = 1; r < 16; ++r) pmax = fmaxf(pmax, p0[r]);
#pragma unroll
  for (int r = 0; r < 16; ++r) pmax = fmaxf(pmax, p1[r]);
  { auto rr = __builtin_amdgcn_permlane32_swap(__float_as_uint(pmax), __float_as_uint(pmax), false, false);
    pmax = fmaxf(__uint_as_float(rr[0]), __uint_as_float(rr[1])); }
  if (__builtin_expect(__all(pmax - m_reg <= THR / SCALE), 1)) { mn = m_reg; alpha = 1.f; }
  else { mn = fmaxf(m_reg, pmax); alpha = __builtin_amdgcn_exp2f((m_reg - mn) * C); m_reg = mn; }
  const float mnC = -mn * C;
#pragma unroll
  for (int r = 0; r < 16; ++r) p0[r] = fmaf(p0[r], C, mnC);
#pragma unroll
  for (int r = 0; r < 16; ++r) p1[r] = fmaf(p1[r], C, mnC);
#pragma unroll
  for (int r = 0; r < 16; ++r) p0[r] = __builtin_amdgcn_exp2f(p0[r]);
}
__device__ __forceinline__ void finishSM(f32x16& p0, f32x16& p1, float alpha, float& l_reg, bf16x8& pa0, bf16x8& pa1, bf16x8& pa2, bf16x8& pa3) {
#pragma unroll
  for (int r = 0; r < 16; ++r) p1[r] = __builtin_amdgcn_exp2f(p1[r]);
  float ps = 0;
#pragma unroll
  for (int r = 0; r < 16; ++r) ps += p0[r];
#pragma unroll
  for (int r = 0; r < 16; ++r) ps += p1[r];
  { auto rr = __builtin_amdgcn_permlane32_swap(__float_as_uint(ps), __float_as_uint(ps), false, false);
    ps = __uint_as_float(rr[0]) + __uint_as_float(rr[1]); }
  l_reg = l_reg * alpha + ps;
#define PK4(P, BASE, OUT) do { unsigned a0 = cvt_pk_bf16(P[BASE + 0], P[BASE + 1]), a1 = cvt_pk_bf16(P[BASE + 2], P[BASE + 3]);   \
    unsigned b0 = cvt_pk_bf16(P[BASE + 4], P[BASE + 5]), b1 = cvt_pk_bf16(P[BASE + 6], P[BASE + 7]);                              \
    auto r0 = __builtin_amdgcn_permlane32_swap(a0, b0, false, false); auto r1 = __builtin_amdgcn_permlane32_swap(a1, b1, false, false); \
    u32x4 w = {r0[0], r1[0], r0[1], r1[1]}; OUT = *reinterpret_cast<bf16x8*>(&w); } while (0)
  PK4(p0, 0, pa0); PK4(p0, 8, pa1); PK4(p1, 0, pa2); PK4(p1, 8, pa3);
#undef PK4
}
template <int DQK, bool ALIBI>
__device__ __forceinline__ void qkt(f32x16& p0, f32x16& p1, const char* Ks, const bf16x8* qr, int r32, int hi, float dq, float sl) {
  if (ALIBI) {
    float dh = dq - (float)(4 * hi); asm volatile("" : "+v"(dh));
#pragma unroll
    for (int r = 0; r < 16; ++r) { const float c = (float)((r & 3) + 8 * (r >> 2)); p0[r] = -sl * fabsf(dh - c); p1[r] = -sl * fabsf(dh - (c + 32.f)); }
  } else { p0 = f32x16{}; p1 = f32x16{}; }
#pragma unroll
  for (int d0 = 0; d0 < DQK / 16; ++d0) { const int cb = (d0 * 16 + hi * 8) * 2;
    const bf16x8 b0 = *reinterpret_cast<const bf16x8*>(Ks + kswz<DQK>(r32, cb));
    const bf16x8 b1 = *reinterpret_cast<const bf16x8*>(Ks + kswz<DQK>(32 + r32, cb));
    p0 = __builtin_amdgcn_mfma_f32_32x32x16_bf16(b0, qr[d0], p0, 0, 0, 0);
    p1 = __builtin_amdgcn_mfma_f32_32x32x16_bf16(b1, qr[d0], p1, 0, 0, 0); }
}

template <int DQK, bool ALIBI, int SDEPTH>
__device__ __forceinline__ void attn_pass(const bf16_t* __restrict__ Qw, const bf16_t* __restrict__ Kh, const bf16_t* __restrict__ Vh, int seq, char* lds, f32x16 (&o)[4], float qpos, float sl, int tid) {
  constexpr int SHM_V = KVBLK * DV * 2, SHM_K = KVBLK * DQK * 2;
  const int wid = tid >> 6, lane = tid & 63, r32 = lane & 31, hi = lane >> 5;
  char* V_lds = lds; char* K_lds = lds + 2 * SHM_V;
  float* ws = (float*)(lds + 2 * SHM_V + 2 * SHM_K) + wid * 64; float* li_l = ws; float* al_l = ws + 32;
  float m_reg = -1e30f, l_reg = 0; bf16x8 qr[DQK / 16];
#pragma unroll
  for (int d0 = 0; d0 < 4; ++d0) o[d0] = f32x16{};
#pragma unroll
  for (int d0 = 0; d0 < DQK / 16; ++d0) qr[d0] = *reinterpret_cast<const bf16x8*>(Qw + d0 * 16);
  const int sr = tid >> 4, sc = (tid & 15) * 8, vst0 = v_st(sr, sc), vst1 = v_st(32 + sr, sc);
  const int kr = DQK == 128 ? sr : (tid >> 3), kc = DQK == 128 ? sc : (tid & 7) * 8;
  const int vb0 = (int)(uintptr_t)V_lds + v_rd_base(lane);
  struct { bf16x8 vs0, vs1, ks0, ks1; } sr_[SDEPTH];
#define SLOAD(i, k0) do { sr_[i].vs0 = *(const bf16x8*)(Vh + (size_t)((k0) + sr) * ZLD + sc); sr_[i].vs1 = *(const bf16x8*)(Vh + (size_t)((k0) + 32 + sr) * ZLD + sc); \
    sr_[i].ks0 = *(const bf16x8*)(Kh + (size_t)((k0) + kr) * ZLD + kc); if (DQK == 128) sr_[i].ks1 = *(const bf16x8*)(Kh + (size_t)((k0) + 32 + kr) * ZLD + kc); } while (0)
#define SWRITE(b, i) do { *(bf16x8*)(V_lds + (b) * SHM_V + vst0) = sr_[i].vs0; *(bf16x8*)(V_lds + (b) * SHM_V + vst1) = sr_[i].vs1; \
    *(bf16x8*)(K_lds + (b) * SHM_K + kswz<DQK>(kr, kc * 2)) = sr_[i].ks0; if (DQK == 128) *(bf16x8*)(K_lds + (b) * SHM_K + kswz<DQK>(32 + kr, kc * 2)) = sr_[i].ks1; } while (0)
#define SWAIT() do { if (SDEPTH == 1) asm volatile("s_waitcnt vmcnt(0)" ::: "memory"); else if (DQK == 128) asm volatile("s_waitcnt vmcnt(4)" ::: "memory"); else asm volatile("s_waitcnt vmcnt(3)" ::: "memory"); } while (0)
#define RESC(a) do { if (__any((a) < 1.f)) { if (hi == 0) al_l[r32] = (a); asm volatile("s_waitcnt lgkmcnt(0)" ::: "memory"); \
    _Pragma("unroll") for (int d = 0; d < 4; ++d) _Pragma("unroll") for (int r = 0; r < 16; ++r) o[d][r] *= al_l[crow(r, hi)]; } } while (0)
  f32x16 pA0, pA1, pB0, pB1; float mnA, mnB, alA, alB; bf16x8 pa0, pa1, pa2, pa3; const int NT = seq / KVBLK;
  constexpr int SE = 0, SO = SDEPTH - 1;
  SLOAD(SE, 0); asm volatile("s_waitcnt vmcnt(0)" ::: "memory"); SWRITE(0, SE); __syncthreads();
  qkt<DQK, ALIBI>(pA0, pA1, K_lds, qr, r32, hi, qpos, sl); partialSM<DQK>(pA0, pA1, m_reg, mnA, alA);
  SLOAD(SO, KVBLK); if (SDEPTH == 2) { if (2 < NT) SLOAD(SE, 2 * KVBLK); }
  SWAIT(); SWRITE(1, SO); __syncthreads();
  _Pragma("unroll 1") for (int j = 1; j + 1 < NT; j += 2) {
    SBAR(); qkt<DQK, ALIBI>(pB0, pB1, K_lds + SHM_K, qr, r32, hi, qpos - (float)(j * KVBLK), sl);
    finishSM(pA0, pA1, alA, l_reg, pa0, pa1, pa2, pa3); SBAR();
    SLOAD(SO, (j + SDEPTH) * KVBLK); SBAR();
    pv_d0(o, vb0, pa0, pa1, pa2, pa3); partialSM<DQK>(pB0, pB1, m_reg, mnB, alB);
    __syncthreads(); SWAIT(); SWRITE(0, SE);
    RESC(alB); __syncthreads();
    SBAR(); qkt<DQK, ALIBI>(pA0, pA1, K_lds, qr, r32, hi, qpos - (float)((j + 1) * KVBLK), sl);
    finishSM(pB0, pB1, alB, l_reg, pa0, pa1, pa2, pa3); SBAR();
    if (SDEPTH == 1 || j + 3 < NT) SLOAD(SE, (j + 1 + SDEPTH) * KVBLK); SBAR();
    pv_d0(o, vb0 + SHM_V, pa0, pa1, pa2, pa3); partialSM<DQK>(pA0, pA1, m_reg, mnA, alA);
    __syncthreads(); SWAIT(); SWRITE(1, SO);
    RESC(alA); __syncthreads();
  }
  SBAR(); qkt<DQK, ALIBI>(pB0, pB1, K_lds + SHM_K, qr, r32, hi, qpos - (float)((NT - 1) * KVBLK), sl);
  finishSM(pA0, pA1, alA, l_reg, pa0, pa1, pa2, pa3); SBAR();
  pv_d0(o, vb0, pa0, pa1, pa2, pa3); partialSM<DQK>(pB0, pB1, m_reg, mnB, alB);
  __syncthreads(); RESC(alB);
  finishSM(pB0, pB1, alB, l_reg, pa0, pa1, pa2, pa3); SBAR();
  pv_d0(o, vb0 + SHM_V, pa0, pa1, pa2, pa3);
  if (hi == 0) li_l[r32] = l_reg; asm volatile("s_waitcnt lgkmcnt(0)" ::: "memory");
#pragma unroll
  for (int r = 0; r < 16; ++r) { const float rl = __builtin_amdgcn_rcpf(li_l[crow(r, hi)]);
#pragma unroll
    for (int d0 = 0; d0 < 4; ++d0) o[d0][r] *= rl; }
#undef SLOAD
#undef SWRITE
#undef SWAIT
#undef RESC
}
}

__device__ __forceinline__ void gqa_attn_phase(const Frame& F) {
    const bf16_t* Z = (const bf16_t*)POOLP(PL_Z); bf16_t* CAT = (bf16_t*)POOLP(PL_CAT);
    constexpr int NU_S = 16 * (T_S / 256), NU = NU_S + 16 * (T_P / 256);
    for (int L = F.bid; L < NU; L += F.G) {
        int tid = threadIdx.x; asm volatile("" : "+v"(tid));
        const int lane = tid & 63, r32 = lane & 31, hi = lane >> 5, wid = tid >> 6;
        int seq, head, qb;
        if (L < NU_S) { const int x = L & 7, r = L >> 3, kvh = x & 3, half = x >> 2; seq = 1; head = kvh * 4 + (r & 3); qb = half * 32 + (r >> 2); }
        else { const int Lp = L - NU_S, x = Lp & 7, r = Lp >> 3, kvh = x & 3, half = x >> 2; seq = 0; head = kvh * 4 + (r & 3); qb = half * 16 + (r >> 2); }
        const int t0 = seq ? T_P : 0, slen = seq ? T_S : T_P, kvh = head >> 2;
        const bf16_t* Qw = Z + (size_t)(t0 + qb * 256 + wid * 32 + r32) * ZLD + head * 128 + hi * 8;
        const bf16_t* Kh = Z + (size_t)t0 * ZLD + 2048 + kvh * 128; const bf16_t* Vh = Z + (size_t)t0 * ZLD + 2560 + kvh * 128;
        f32x16 o[4];
        att::attn_pass<128, false, GQA_SDEPTH>(Qw, Kh, Vh, slen, F.ldsg, o, 0.f, 0.f, tid);
        bf16_t* Ow = CAT + (size_t)(t0 + qb * 256 + wid * 32) * DM + head * 128;
#pragma unroll
        for (int r = 0; r < 16; ++r) { const int orow = att::crow(r, hi);
#pragma unroll
            for (int d0 = 0; d0 < 4; ++d0) Ow[(size_t)orow * DM + d0 * 32 + r32] = f2bf(o[d0][r]); }
    }
}

__device__ __forceinline__ void diff_attn_phase(const Frame& F, int e) {
    const bf16_t* Z = (const bf16_t*)POOLP(PL_Z); bf16_t* CAT = (bf16_t*)POOLP(PL_CAT); float* ST = (float*)POOLP(PL_STASH);
    const float lam = ((const float*)(WSP(WS_MISC) + MISC_LAM))[e * 2], linit = ((const float*)(WSP(WS_MISC) + MISC_LAM))[e * 2 + 1];
    const float* sg = F.in[I_SUBLN] + e * 128;
    constexpr int NU_S = 8 * (T_S / 256), NU = NU_S + 8 * (T_P / 256);
    for (int L = F.bid; L < NU; L += F.G) {
        int tid = threadIdx.x; asm volatile("" : "+v"(tid));
        const int lane = tid & 63, r32 = lane & 31, hi = lane >> 5, wid = tid >> 6;
        f32x4* st = (f32x4*)ST + ((size_t)F.bid * NTHREADS + tid) * 16;
        int seq, head, qb;
        if (L < NU_S) { seq = 1; head = L & 7; qb = L >> 3; } else { const int Lp = L - NU_S; seq = 0; head = Lp & 7; qb = Lp >> 3; }
        const int t0 = seq ? T_P : 0, slen = seq ? T_S : T_P;
        const float slope = exp2f(-(float)(head + 1)), sl = slope * 8.0f;
        const float qpos = (float)(qb * 256 + wid * 32 + r32);
        const bf16_t* Vh = Z + (size_t)t0 * ZLD + 2048 + head * 128;
        f32x16 o[4];
        for (int m = 0; m < 2; ++m) {
            const bf16_t* Qw = Z + (size_t)(t0 + qb * 256 + wid * 32 + r32) * ZLD + head * 128 + m * 64 + hi * 8;
            const bf16_t* Kh = Z + (size_t)t0 * ZLD + 1024 + head * 128 + m * 64;
            att::attn_pass<64, true, DIFF_SDEPTH>(Qw, Kh, Vh, slen, F.ldsg, o, qpos, sl, tid);
            if (m == 0) {
#pragma unroll
                for (int d0 = 0; d0 < 4; ++d0)
#pragma unroll
                    for (int q = 0; q < 4; ++q) st[d0 * 4 + q] = (f32x4){o[d0][4 * q], o[d0][4 * q + 1], o[d0][4 * q + 2], o[d0][4 * q + 3]};
            }
        }
        float ss[16];
#pragma unroll
        for (int r = 0; r < 16; ++r) ss[r] = 0.f;
#pragma unroll
        for (int d0 = 0; d0 < 4; ++d0) {
#pragma unroll
            for (int q = 0; q < 4; ++q) { const f32x4 s4 = st[d0 * 4 + q];
#pragma unroll
                for (int i = 0; i < 4; ++i) { const int r = 4 * q + i; const float a = s4[i] - lam * o[d0][r]; o[d0][r] = a; ss[r] += a * a; } }
            asm volatile("" ::: "memory"); }
#pragma unroll
        for (int r = 0; r < 16; ++r) { float s = ss[r]; s += __shfl_xor(s, 1); s += __shfl_xor(s, 2); s += __shfl_xor(s, 4); s += __shfl_xor(s, 8); s += __shfl_xor(s, 16);
            ss[r] = (1.0f - linit) / sqrtf(s * (1.f / 128.f) + SUBLN_EPS); }
        bf16_t* Ow = CAT + (size_t)(t0 + qb * 256 + wid * 32) * DM + 1024 + head * 128;
#pragma unroll
        for (int d0 = 0; d0 < 4; ++d0) { const float gcol = sg[d0 * 32 + r32];
#pragma unroll
            for (int r = 0; r < 16; ++r) Ow[(size_t)att::crow(r, hi) * DM + d0 * 32 + r32] = f2bf(o[d0][r] * ss[r] * gcol); }
    }
}

constexpr int PH_BASE = 3, PH_PER = 16, PH_END = PH_BASE + 8 * PH_PER - 1;
__host__ __device__ inline bool phase_exists(int pid) {
    if (pid < PH_BASE) return true;
    const int hl = (pid - PH_BASE) / PH_PER, k = (pid - PH_BASE) % PH_PER, f = hl & 1, l = hl >> 1;
    if (k <= 1 || k == 14) return true;
    if (k == 15 || f == 1) return false;
    if ((l & 1) && (k == 6 || k == 7 || k == 8)) return false;
    return true;
}

__device__ __forceinline__ bool fresh_frame(Frame& F) { int t = threadIdx.x; asm volatile("" : "+v"(t)); F.tid = t; F.lane = t & 63; F.wave = __builtin_amdgcn_readfirstlane(t >> 6); return true; }
__global__ void __launch_bounds__(NTHREADS, 2) fwd_kernel(Args args) {
    extern __shared__ __attribute__((aligned(16))) unsigned char lds[];
    Frame F;
    F.lds = (LAS unsigned char*)lds; F.ldsg = (char*)lds;
    F.MISC = (volatile LAS unsigned*)(F.lds + MISC_OFF);
    F.tid = threadIdx.x; F.lane = F.tid & 63; F.wave = __builtin_amdgcn_readfirstlane(F.tid >> 6);
    F.G = gridDim.x; F.bid = blockIdx.x; F.in = args.in; F.x = args.out; F.ws = args.ws;
    for (int u = F.tid; u < (LDS_BYTES - RING_BYTES) / 4; u += NTHREADS) ((LAS unsigned*)(F.lds + RING_BYTES))[u] = 0u;
    __syncthreads();
    XcdBarrier bar = xcd_barrier_post((unsigned*)(F.ws + WS_CTL) + CW_BAR + args.li * XCD_BAR_WORDS, F.MISC + 8);
    const int lo = args.ph_lo, hi = args.ph_hi;
#define PH(p) (lo <= (p) && (p) < hi && fresh_frame(F))
#define ENDPH(p) do { if ((p) + 1 < hi) xcd_barrier(bar); } while (0)

    if (PH(0)) { prologue_phase(F); ENDPH(0); }
    if (PH(1)) {
        auto S = make_sched(F, POOLP(PL_MEMN), DM, POOLP(PL_WKVT), DM, 256, 2 * DM, 8, ZKv{});
        EpiBf16 E{(bf16_t*)POOLP(PL_KVB), 2 * DM, (size_t)256 * 2 * DM, 0, 0};
        pg8::gemm_phase(F.lds, DM, DM, DM, S, E, F.tid); ENDPH(1);
    }
    if (PH(2)) {
        { auto S = make_sched(F, POOLP(PL_KVB), 2 * DM, POOLP(PL_WQB), DM, 256, DM, 32, ZKf{});
          EpiBf16 E{(bf16_t*)WSP(WS_KF), DM, (size_t)256 * DM, 0, 0};
          pg8::gemm_phase(F.lds, 2 * DM, DM, 512, S, E, F.tid); }
        { auto S = make_sched(F, POOLP(PL_WOT), DM, POOLP(PL_KVB), 2 * DM, DM, 256, 32, ZVw{});
          EpiBf16 E{(bf16_t*)WSP(WS_VWT), 1024, (size_t)DM * 1024, 256, 2};
          pg8::gemm_phase(F.lds, DM, 2 * DM, 512, S, E, F.tid); }
        ENDPH(2);
    }
    for (int hl = 0; hl < 8; ++hl) {
        const int l = hl >> 1, f = hl & 1, pb = PH_BASE + hl * PH_PER, eo = l >> 1;
        const bool even = (l & 1) == 0;
        if (PH(pb + 0)) {
            auto S = make_sched(F, WSP(WS_HB), DM, WSP(WS_WGU + (size_t)hl * SZ_WGU), DM, TT, 2 * DFF, 1, ZNone{});
            EpiSwiglu E{(bf16_t*)POOLP(PL_ACT), DFF};
            pg8::gemm_phase(F.lds, DM, DM, DM, S, E, F.tid); ENDPH(pb + 0);
        }
        if (PH(pb + 1)) {
            auto S = make_sched(F, POOLP(PL_ACT), DFF, WSP(WS_WD + (size_t)hl * SZ_WD), DFF, TT, DM, 1, ZNone{});
            EpiResid E{F.x, 0.5f};
            pg8::gemm_phase(F.lds, DFF, DFF, DFF, S, E, F.tid); ENDPH(pb + 1);
        }
        if (f == 0) {
            if (PH(pb + 2)) { norm_phase(F, F.in[I_MIXN] + l * DM); ENDPH(pb + 2); }
            if (even) {
                if (PH(pb + 3)) {
                    auto S = make_sched(F, WSP(WS_HB), DM, WSP(WS_WINE + (size_t)eo * SZ_WINE), DM, TT, EVEN_IN, 1, ZNone{});
                    EpiWinEven E{(bf16_t*)POOLP(PL_UX), (bf16_t*)POOLP(PL_Z)};
                    pg8::gemm_phase(F.lds, DM, DM, DM, S, E, F.tid); ENDPH(pb + 3);
                }
                if (PH(pb + 4)) {
                    auto S = make_sched(F, POOLP(PL_UX), S5K2, WSP(WS_WST + (size_t)eo * 64 * SZ_WST), S5K1, NCH, S5NS, S5G, ZLin{(size_t)NCH * S5K2 * 2, SZ_WST});
                    EpiF32 E{(float*)POOLP(PL_SST), S5G * S5NS, (size_t)S5NS};
                    pg8::gemm_phase(F.lds, S5K2, S5K1, S5K1, S, E, F.tid); ENDPH(pb + 4);
                }
                if (PH(pb + 5)) { s5_scan_phase(F, eo); ENDPH(pb + 5); }
                if (PH(pb + 6)) {
                    auto S = make_sched(F, POOLP(PL_UX), S5K2, WSP(WS_TG + (size_t)eo * 64 * SZ_TG), S5K2, NCH, S5K1, S5G, ZLin{(size_t)NCH * S5K2 * 2, SZ_TG});
                    EpiS5Out E{(bf16_t*)POOLP(PL_GB)};
                    pg8::gemm_phase(F.lds, S5K2, S5K2, S5K2, S, E, F.tid); ENDPH(pb + 6);
                }
                if (PH(pb + 7)) {
                    auto S = make_sched(F, POOLP(PL_GB), S5W, WSP(WS_GLU + (size_t)eo * SZ_GLU), S5W, TT, S5W, 1, ZNone{});
                    EpiGlu E{(const bf16_t*)POOLP(PL_GB), F.in[I_GLUB] + eo * S5W, (bf16_t*)POOLP(PL_CAT)};
                    pg8::gemm_phase(F.lds, S5W, S5W, S5W, S, E, F.tid); ENDPH(pb + 7);
                }
                if (PH(pb + 8)) { diff_attn_phase(F, eo); ENDPH(pb + 8); }
            } else {
                if (PH(pb + 3)) {
                    auto S = make_sched(F, WSP(WS_HB), DM, WSP(WS_WINO + (size_t)eo * SZ_WINO), DM, TT, ODD_IN, 1, ZNone{});
                    EpiBf16 E{(bf16_t*)POOLP(PL_Z), ZLD, 0, 0, 0};
                    pg8::gemm_phase(F.lds, DM, DM, DM, S, E, F.tid); ENDPH(pb + 3);
                }
                if (PH(pb + 4)) { qk_prep_phase(F, eo); ENDPH(pb + 4); }
                if (PH(pb + 5)) { gqa_attn_phase(F); ENDPH(pb + 5); }
            }
            if (PH(pb + 9)) {
                auto S = make_sched(F, POOLP(PL_CAT), DM, even ? WSP(WS_WOUTE + (size_t)eo * SZ_SQ) : WSP(WS_WOUTO + (size_t)eo * SZ_SQ), DM, TT, DM, 1, ZNone{});
                EpiResid E{F.x, 1.0f};
                pg8::gemm_phase(F.lds, DM, DM, DM, S, E, F.tid); ENDPH(pb + 9);
            }
            if (PH(pb + 10)) { norm_phase(F, F.in[I_CN] + l * DM); ENDPH(pb + 10); }
            if (PH(pb + 11)) {
                auto S = make_sched(F, WSP(WS_HB), DM, WSP(WS_KF + (size_t)l * 2 * SZ_KF), DM, TT, 1024, 1, ZNone{}); S.split = T_P / 256; S.bseq = SZ_KF;
                EpiF32 E{(float*)POOLP(PL_CS), 1024, 0};
                pg8::gemm_phase(F.lds, DM, DM, DM, S, E, F.tid); ENDPH(pb + 11);
            }
            if (PH(pb + 12)) { cross_softmax_phase(F); ENDPH(pb + 12); }
            if (PH(pb + 13)) {
                auto S = make_sched(F, POOLP(PL_CP), 1024, WSP(WS_VWT + (size_t)l * 2 * SZ_KF), 1024, TT, DM, 1, ZNone{}); S.split = T_P / 256; S.bseq = SZ_KF;
                EpiResid E{F.x, 1.0f};
                pg8::gemm_phase(F.lds, 1024, 1024, 1024, S, E, F.tid); ENDPH(pb + 13);
            }
        }
        if (PH(pb + 14)) {
            if (f == 0) norm_phase(F, F.in[I_F2N] + l * DM);
            else if (l < DEPTH - 1) norm_phase(F, F.in[I_F1N] + (l + 1) * DM);
            else final_norm_phase(F, F.in[I_FINN]);
            ENDPH(pb + 14);
        }
    }
#undef PH
#undef ENDPH
}

#ifndef MK_PER_PHASE
#define MK_PER_PHASE 0
#endif
extern "C" void kernel_launch(void* const* d_in, const int* in_sizes, int n_in, void* d_out, int out_size, void* d_ws, size_t ws_size, hipStream_t stream) {
    static int grid = 0;
    if (grid == 0) {
        if (n_in != N_IN || out_size != TT * DM || ws_size < WS_END) { fprintf(stderr, "kernel_launch: unexpected shapes: n_in %d out %d ws %zu (need %zu)\n", n_in, out_size, ws_size, (size_t)WS_END); grid = -1; return; }
        int dev = 0, cus = 0, per_cu = 0;
        if (hipGetDevice(&dev) != hipSuccess || hipDeviceGetAttribute(&cus, hipDeviceAttributeMultiprocessorCount, dev) != hipSuccess) { grid = -1; return; }
        if (hipFuncSetAttribute((const void*)fwd_kernel, hipFuncAttributeMaxDynamicSharedMemorySize, LDS_BYTES) != hipSuccess) { fprintf(stderr, "kernel_launch: hipFuncSetAttribute failed\n"); grid = -1; return; }
        if (hipOccupancyMaxActiveBlocksPerMultiprocessor(&per_cu, (const void*)fwd_kernel, NTHREADS, LDS_BYTES) != hipSuccess || per_cu < 1) { fprintf(stderr, "kernel_launch: occupancy query says %d\n", per_cu); (void)hipGetLastError(); grid = -1; return; }
        grid = cus;
    }
    if (grid < 0) return;
    (void)hipMemsetAsync((char*)d_ws + WS_CTL, 0, CTL_BYTES, stream);
    Args a{};
    for (int i = 0; i < N_IN; ++i) a.in[i] = (const float*)d_in[i];
    a.out = (float*)d_out; a.ws = (unsigned char*)d_ws; a.pad = 0;
#if MK_PER_PHASE
    int li = 0;
    for (int p = 0; p < PH_END; ++p) { if (!phase_exists(p)) continue; a.ph_lo = p; a.ph_hi = p + 1; a.li = li++;
        hipLaunchKernelGGL(fwd_kernel, dim3(grid), dim3(NTHREADS), LDS_BYTES, stream, a); }
#else
    a.ph_lo = 0; a.ph_hi = PH_END; a.li = 0;
    hipLaunchKernelGGL(fwd_kernel, dim3(grid), dim3(NTHREADS), LDS_BYTES, stream, a);
#endif
    const hipError_t le = hipPeekAtLastError();
    if (le != hipSuccess) fprintf(stderr, "kernel_launch: launch failed: %s\n", hipGetErrorName(le));
}
```

```cpp
#include <hip/hip_runtime.h>
#include <cstdio>
#include <cstdint>

#define GAS __attribute__((address_space(1)))
#define LAS __attribute__((address_space(3)))
typedef unsigned short bf16_t;
typedef short bf16x8 __attribute__((ext_vector_type(8)));
typedef short s16x4 __attribute__((ext_vector_type(4)));
typedef float f32x2 __attribute__((ext_vector_type(2)));
typedef float f32x4 __attribute__((ext_vector_type(4)));
typedef float f32x8 __attribute__((ext_vector_type(8)));
typedef float f32x16 __attribute__((ext_vector_type(16)));
typedef unsigned u32x2 __attribute__((ext_vector_type(2)));
typedef unsigned u32x4 __attribute__((ext_vector_type(4)));
typedef GAS unsigned gu32;
#define RLX_AGENT __ATOMIC_RELAXED, __HIP_MEMORY_SCOPE_AGENT
#define LDS_WAIT() asm volatile("s_waitcnt lgkmcnt(0)" ::: "memory")
#define VM_WAIT() asm volatile("s_waitcnt vmcnt(0)" ::: "memory")
#define SBAR() __builtin_amdgcn_sched_barrier(0)

__device__ __forceinline__ unsigned cvt_pk_bf16(float lo, float hi) { unsigned r; asm volatile("v_cvt_pk_bf16_f32 %0, %1, %2" : "=v"(r) : "v"(lo), "v"(hi)); return r; }
__device__ __forceinline__ float bf2f(unsigned short b) { return __uint_as_float(((unsigned)b) << 16); }
__device__ __forceinline__ float bflo(unsigned w) { return __uint_as_float(w << 16); }
__device__ __forceinline__ float bfhi(unsigned w) { return __uint_as_float(w & 0xffff0000u); }
__device__ __forceinline__ unsigned short f2bf(float f) { unsigned u = __float_as_uint(f); return (unsigned short)((u + 0x7fffu + ((u >> 16) & 1u)) >> 16); }
__device__ __forceinline__ float fast_rcp(float x) { return __builtin_amdgcn_rcpf(x); }
__device__ __forceinline__ float fast_exp2(float x) { return __builtin_amdgcn_exp2f(x); }
__device__ __forceinline__ float sigmoidf_fast(float x) { return fast_rcp(1.0f + fast_exp2(-1.4426950408889634f * x)); }
__device__ __forceinline__ float silu_f(float x) { return x * sigmoidf_fast(x); }
__device__ __forceinline__ float gelu_tanh_f(float y) { const float z = y + 0.044715f * y * y * y; return y * fast_rcp(1.0f + fast_exp2(-2.3022081982f * z)); }
__device__ __forceinline__ float wave_sum(float v) {
#pragma unroll
    for (int o = 1; o < 64; o <<= 1) v += __shfl_xor(v, o);
    return v;
}

#define XB_TMO      128
#define XB_XCNT(j)  (256  + 64 * (j))
#define XB_XSUB(j)  (1280 + 64 * (j))
#define XB_XGEN(j)  (2304 + 64 * (j))
#define XB_TOP      3328
#define XB_TOPGEN   3392
#define XCD_BAR_WORDS 3456
#define XB_SPIN_CAP (1u << 22)

__device__ __forceinline__ unsigned xb_ld(unsigned* p)              { return __hip_atomic_load(p, __ATOMIC_RELAXED, __HIP_MEMORY_SCOPE_AGENT); }
__device__ __forceinline__ unsigned xb_add(unsigned* p, unsigned v) { return __hip_atomic_fetch_add(p, v, __ATOMIC_RELAXED, __HIP_MEMORY_SCOPE_AGENT); }
__device__ __forceinline__ unsigned xb_xcc_id() { return (unsigned)__builtin_amdgcn_s_getreg((3 << 11) | 20) & 0xFu; }
#define XB_SPIN(cond, bar) do { unsigned _sp = 0; while (cond) { __builtin_amdgcn_s_sleep(1); \
    if ((++_sp & 255u) == 0u) { if (xb_ld(&(bar)[XB_TMO])) break; if (_sp > XB_SPIN_CAP) { atomicAdd(&(bar)[XB_TMO], 1u); break; } } } } while (0)

struct XcdBarrier { unsigned* bar; unsigned x; volatile LAS unsigned* st; };

__device__ __forceinline__ XcdBarrier xcd_barrier_post(unsigned* bar, volatile LAS unsigned* st) {
    XcdBarrier b; b.bar = bar; b.x = xb_xcc_id(); b.st = st;
    if (threadIdx.x == 0) (void)xb_add(&bar[XB_XCNT(b.x)], 1u);
    return b;
}
__device__ __forceinline__ void xcd_barrier_complete(unsigned* bar, unsigned x, unsigned& nloc, unsigned& nx) {
    const unsigned G = gridDim.x * gridDim.y * gridDim.z;
    unsigned sum, cnt, mine, sp = 0u;
    for (;;) {
        sum = 0u; cnt = 0u; mine = 0u;
#pragma unroll
        for (unsigned j = 0; j < 16; ++j) { const unsigned c = xb_ld(&bar[XB_XCNT(j)]); sum += c; cnt += (c > 0u) ? 1u : 0u; mine = (j == x) ? c : mine; }
        if (sum == G) break;
        __builtin_amdgcn_s_sleep(1);
        if ((++sp & 255u) == 0u) { if (xb_ld(&bar[XB_TMO])) break; if (sp > XB_SPIN_CAP) { atomicAdd(&bar[XB_TMO], 1u); break; } }
    }
    nloc = mine > 0u ? mine : 1u; nx = cnt > 0u ? cnt : 1u;
}
__device__ __forceinline__ void xcd_barrier(const XcdBarrier& b) {
    asm volatile("s_waitcnt vmcnt(0)" ::: "memory");
    __syncthreads();
    if (threadIdx.x == 0) {
        unsigned* bar = b.bar;
        __builtin_amdgcn_s_waitcnt(0);
        unsigned nloc = b.st[0], nx = b.st[1];
        if (nloc == 0u) { xcd_barrier_complete(bar, b.x, nloc, nx); b.st[0] = nloc; b.st[1] = nx; }
        const unsigned old = xb_add(&bar[XB_XSUB(b.x)], 1u);
        const unsigned gen = old / nloc;
        if (old + 1u == (gen + 1u) * nloc) {
            __builtin_amdgcn_fence(__ATOMIC_RELEASE, "agent");
            asm volatile("s_waitcnt vmcnt(0)" ::: "memory");
            const unsigned og = xb_add(&bar[XB_TOP], 1u);
            const unsigned tg = og / nx;
            if (og + 1u == (tg + 1u) * nx) xb_add(&bar[XB_TOPGEN], 1u);
            else XB_SPIN(xb_ld(&bar[XB_TOPGEN]) == tg, bar);
            __builtin_amdgcn_fence(__ATOMIC_ACQUIRE, "agent");
            xb_add(&bar[XB_XGEN(b.x)], 1u);
            asm volatile("s_waitcnt vmcnt(0)" ::: "memory");
        } else {
            XB_SPIN(xb_ld(&bar[XB_XGEN(b.x)]) == gen, bar);
            __builtin_amdgcn_fence(__ATOMIC_ACQUIRE, "agent");
            asm volatile("s_waitcnt vmcnt(0)" ::: "memory");
        }
    }
    __syncthreads();
}

namespace pg8 {
constexpr int BM = 256, BK = 64, HALF = 128, HTB = HALF * BK * 2, STAGE_BYTES = 8 * HTB, NXCD = 8, WGM = 8;
__host__ __device__ __forceinline__ int lds_byte(int r, int c) { const int st = (r >> 4) * 2 + (c >> 5), rr = r & 15, cc = c & 31, ob = rr * 64 + cc * 2; return st * 1024 + (ob ^ (((ob >> 9) & 1) << 5)); }
__host__ __device__ __forceinline__ void stage_rc(int b, int& R, int& C) { const int st = b / 1024, sb = b % 1024, swz = sb ^ (((sb >> 9) & 1) << 5); R = (st >> 1) * 16 + swz / 64; C = (st & 1) * 32 + (swz % 64) / 2; }
__host__ __device__ __forceinline__ int perm32(int rho) { const int n = rho >> 4, i = rho & 15; return 8 * (i >> 2) + 4 * n + (i & 3); }

struct Unit { int pm, pn, z; };
struct Enum {
    int nM, nN, nZ, nwg, G, c;
    __device__ __forceinline__ void init(int nM_, int nN_, int nZ_, int G_, int c_) { nM = nM_; nN = nN_; nZ = nZ_; nwg = nM * nN * nZ; G = G_; c = c_; }
    __device__ __forceinline__ bool next(int i, Unit& u) const {
        const long L = (long)i * G + c; if (L >= nwg) return false;
        int wgid = (int)L; { const int q = nwg / NXCD, r = nwg % NXCD, xcd = wgid % NXCD, off = wgid / NXCD; wgid = (xcd < r ? xcd * (q + 1) : r * (q + 1) + (xcd - r) * q) + off; }
        const int per = nM * nN; u.z = wgid / per; wgid -= u.z * per;
        const int nig = WGM * nN, gid = wgid / nig, fm = gid * WGM, gsz = (nM - fm) < WGM ? (nM - fm) : WGM;
        u.pm = fm + ((wgid % nig) % gsz); u.pn = (wgid % nig) / gsz; return true;
    }
};

template <class Epi, class Sched>
__device__ __forceinline__ void gemm_phase(LAS unsigned char* lds, const int lda, const int ldb, const int K, const Sched& S, const Epi& E, const int tid) {
    const int wid = __builtin_amdgcn_readfirstlane(tid >> 6), lane = tid & 63, wr = wid >> 2, wc = wid & 3, fr = lane & 15, fq = lane >> 4;
    const int nt = K / BK;
    unsigned voffA[2], voffB[2];
#pragma unroll
    for (int i = 0; i < 2; ++i) { int R, C; stage_rc(tid * 16 + i * 8192, R, C); const int Rb = Epi::PERM ? ((R & ~31) + perm32(R & 31)) : R;
        voffA[i] = (unsigned)(R * lda + C) * 2u; voffB[i] = (unsigned)(Rb * ldb + C) * 2u; }
    const size_t kstep = (size_t)(BK * 2);
    const size_t hstepA = (size_t)HALF * lda * 2, hstepB = (size_t)HALF * ldb * 2;
    const unsigned ldsw = (unsigned)wid * 1024u;
    const int aoff = lds_byte(wr * 64 + fr, fq * 8), boff = lds_byte(wc * 32 + fr, fq * 8);
#define PG8_SA(b, h) (((b) * 2 + (h)) * HTB)
#define PG8_SB(b, h) ((4 + (b) * 2 + (h)) * HTB)
#define PG8_STAGE(bufoff, gbase, voff) do { _Pragma("unroll") for (int _i = 0; _i < 2; ++_i) \
        __builtin_amdgcn_global_load_lds((const unsigned*)((const char*)(gbase) + (voff)[_i]), (LAS unsigned*)(lds + (bufoff) + ldsw + _i * 8192), 16, 0, 0); } while (0)
#define PG8_LDA(dst, b, h) do { _Pragma("unroll") for (int m = 0; m < 4; ++m) _Pragma("unroll") for (int k = 0; k < 2; ++k) dst[m][k] = *(const LAS bf16x8*)(lds + PG8_SA(b, h) + aoff + m * 2048 + k * 1024); } while (0)
#define PG8_LDB(dst, b, h) do { _Pragma("unroll") for (int n = 0; n < 2; ++n) _Pragma("unroll") for (int k = 0; k < 2; ++k) dst[n][k] = *(const LAS bf16x8*)(lds + PG8_SB(b, h) + boff + n * 2048 + k * 1024); } while (0)
#define PG8_MMA(ai, bj, At, Bt) do { __builtin_amdgcn_s_setprio(1); _Pragma("unroll") for (int m = 0; m < 4; ++m) _Pragma("unroll") for (int n = 0; n < 2; ++n) _Pragma("unroll") for (int k = 0; k < 2; ++k) \
        acc[ai][bj][m][n] = __builtin_amdgcn_mfma_f32_16x16x32_bf16(Bt[n][k], At[m][k], acc[ai][bj][m][n], 0, 0, 0); __builtin_amdgcn_s_setprio(0); } while (0)
#define PG8_WAIT_V(n) asm volatile("s_waitcnt vmcnt(" #n ")" ::: "memory")
#define PG8_WAIT_L(n) asm volatile("s_waitcnt lgkmcnt(" #n ")" ::: "memory")
#define PG8_BAR __builtin_amdgcn_s_barrier()
#define PG8_SCHED __builtin_amdgcn_sched_barrier(0)
    Unit cur, nxt; int ui = 0;
    if (!S.next(0, cur)) return;
    f32x4 acc[2][2][4][2];
#pragma unroll
    for (int a = 0; a < 2; ++a)
#pragma unroll
        for (int b = 0; b < 2; ++b)
#pragma unroll
            for (int m = 0; m < 4; ++m)
#pragma unroll
                for (int n = 0; n < 2; ++n) acc[a][b][m][n] = (f32x4){0.f, 0.f, 0.f, 0.f};
    bf16x8 At[4][2], B0[2][2], B1[2][2];
    const char* cA = S.a_base(cur); const char* cB = S.b_base(cur);
    {
        PG8_STAGE(PG8_SB(0, 0), cB, voffB); PG8_STAGE(PG8_SB(0, 1), cB + hstepB, voffB); PG8_STAGE(PG8_SA(0, 0), cA, voffA); PG8_STAGE(PG8_SA(0, 1), cA + hstepA, voffA);
        if (wr == 1) PG8_BAR;
        PG8_WAIT_V(2); PG8_BAR;
        PG8_STAGE(PG8_SB(1, 0), cB + kstep, voffB); PG8_STAGE(PG8_SA(1, 0), cA + kstep, voffA); PG8_STAGE(PG8_SB(1, 1), cB + hstepB + kstep, voffB);
        PG8_WAIT_V(6); PG8_BAR;
    }
    for (;;) {
        if constexpr (Epi::PREFETCH) E.prefetch(lds, cur, ui, wid, lane);
        const bool has_next = S.next(ui + 1, nxt);
        const char* nA = has_next ? S.a_base(nxt) : cA; const char* nB = has_next ? S.b_base(nxt) : cB;
        for (int t = 0; t < nt; t += 2) {
            const bool last = (t == nt - 2);
            const char* a1 = cA + (size_t)(t + 1) * kstep;
            const char* a2 = last ? nA : cA + (size_t)(t + 2) * kstep; const char* b2 = last ? nB : cB + (size_t)(t + 2) * kstep;
            const char* a3 = a2 + kstep; const char* b3 = b2 + kstep;
            PG8_LDB(B0, 0, 0); PG8_LDB(B1, 0, 1); PG8_SCHED; PG8_LDA(At, 0, 0); PG8_STAGE(PG8_SA(1, 1), a1 + hstepA, voffA);
            PG8_WAIT_V(8); PG8_WAIT_L(0); PG8_BAR; PG8_MMA(0, 0, At, B0); PG8_MMA(0, 1, At, B1); PG8_BAR; PG8_SCHED;
            PG8_LDA(At, 0, 1); PG8_STAGE(PG8_SB(0, 0), b2, voffB); PG8_STAGE(PG8_SB(0, 1), b2 + hstepB, voffB); PG8_STAGE(PG8_SA(0, 0), a2, voffA);
            PG8_WAIT_V(8); PG8_WAIT_L(0); PG8_BAR; PG8_MMA(1, 0, At, B0); PG8_MMA(1, 1, At, B1); PG8_BAR; PG8_SCHED;
            PG8_LDB(B0, 1, 0); PG8_LDB(B1, 1, 1); PG8_SCHED; PG8_LDA(At, 1, 0); PG8_STAGE(PG8_SA(0, 1), a2 + hstepA, voffA);
            PG8_WAIT_V(8); PG8_WAIT_L(0); PG8_BAR; PG8_MMA(0, 0, At, B0); PG8_MMA(0, 1, At, B1); PG8_BAR; PG8_SCHED;
            PG8_LDA(At, 1, 1); PG8_STAGE(PG8_SB(1, 0), b3, voffB); PG8_STAGE(PG8_SB(1, 1), b3 + hstepB, voffB); PG8_STAGE(PG8_SA(1, 0), a3, voffA);
            PG8_WAIT_V(8); PG8_WAIT_L(0); PG8_BAR; PG8_MMA(1, 0, At, B0); PG8_MMA(1, 1, At, B1); PG8_BAR; PG8_SCHED;
        }
        if (wr == 0) PG8_BAR;
        E(acc, cur, wr, wc, fr, fq, ui);
        if (!has_next) break;
#pragma unroll
        for (int a = 0; a < 2; ++a)
#pragma unroll
            for (int b = 0; b < 2; ++b)
#pragma unroll
                for (int m = 0; m < 4; ++m)
#pragma unroll
                    for (int n = 0; n < 2; ++n) acc[a][b][m][n] = (f32x4){0.f, 0.f, 0.f, 0.f};
        cur = nxt; cA = nA; cB = nB; ++ui;
        if (wr == 1) PG8_BAR;
    }
    PG8_WAIT_V(0);
    PG8_BAR;
#undef PG8_SA
#undef PG8_SB
#undef PG8_STAGE
#undef PG8_LDA
#undef PG8_LDB
#undef PG8_MMA
#undef PG8_WAIT_V
#undef PG8_WAIT_L
#undef PG8_BAR
#undef PG8_SCHED
}
}

constexpr int DM = 2048, T_P = 8192, T_S = 16384, TT = T_P + T_S, DEPTH = 4, NMEM = 256, DFF = 5632;
constexpr int S5W = 1024, S5G = 64, S5H = 16, S5P = 64, LC = 32, NCH = TT / LC, NCH_P = T_P / LC;
constexpr int S5K1 = LC * S5H  , S5NS = 4 * S5P  , S5K2 = S5K1 + S5NS  ;
constexpr int EVEN_IN = 4096, ODD_IN = 3072, ZLD = 3072;
constexpr float EPS = 1e-6f, SUBLN_EPS = 1e-5f;
constexpr int NWAVES = 8, NTHREADS = 512;

enum { I_XP = 0, I_XS, I_MP, I_MS, I_F1N, I_F1GU, I_F1D, I_MIXN, I_EWIN, I_EWOUT, I_LRE, I_LIM, I_LDT, I_BRE, I_BIM, I_CRE, I_CIM, I_S5D, I_GLUW, I_GLUB,
       I_LQ1, I_LK1, I_LQ2, I_LK2, I_SUBLN, I_OWIN, I_OWOUT, I_QN, I_KN, I_CN, I_MN, I_CWQ, I_CWKV, I_CWO, I_F2N, I_F2GU, I_F2D, I_FINN, N_IN };

constexpr size_t MiB = 1u << 20;
constexpr size_t WS_CTL = 0, CTL_BYTES = 2 * MiB;
constexpr size_t WS_WGU = 2 * MiB;
constexpr size_t SZ_WGU = (size_t)2 * DFF * DM * 2;
constexpr size_t WS_WD = WS_WGU + 8 * SZ_WGU;
constexpr size_t SZ_WD = (size_t)DM * DFF * 2;
constexpr size_t WS_WINE = WS_WD + 8 * SZ_WD;
constexpr size_t SZ_WINE = (size_t)EVEN_IN * DM * 2;
constexpr size_t WS_WOUTE = WS_WINE + 2 * SZ_WINE;
constexpr size_t SZ_SQ = (size_t)DM * DM * 2;
constexpr size_t WS_GLU = WS_WOUTE + 2 * SZ_SQ;
constexpr size_t SZ_GLU = (size_t)S5W * S5W * 2;
constexpr size_t WS_WINO = WS_GLU + 2 * SZ_GLU;
constexpr size_t SZ_WINO = (size_t)ODD_IN * DM * 2;
constexpr size_t WS_WOUTO = WS_WINO + 2 * SZ_WINO;
constexpr size_t WS_KF = WS_WOUTO + 2 * SZ_SQ;
constexpr size_t SZ_KF = (size_t)1024 * DM * 2;
constexpr size_t WS_VWT = WS_KF + 8 * SZ_KF;
constexpr size_t WS_WST = WS_VWT + 8 * SZ_KF;
constexpr size_t SZ_WST = (size_t)S5NS * S5K1 * 2;
constexpr size_t WS_TG = WS_WST + 2 * 64 * SZ_WST;
constexpr size_t SZ_TG = (size_t)S5K1 * S5K2 * 2;
constexpr size_t WS_HB = WS_TG + 2 * 64 * SZ_TG;
constexpr size_t SZ_HB = (size_t)TT * DM * 2;
constexpr size_t WS_MISC = WS_HB + SZ_HB;
constexpr size_t MISC_ROPE = 0, MISC_AL = 65536  , MISC_LAM = 65536 + 131072  , MISC_PSS = 262144  ;
constexpr size_t WS_POOL = WS_MISC + MiB;
constexpr size_t PL_ACT = 0;
constexpr size_t PL_Z = 0;
constexpr size_t PL_UX = 144 * MiB;
constexpr size_t PL_SST = 216 * MiB;
constexpr size_t PL_GB = 264 * MiB;
constexpr size_t PL_CAT = 312 * MiB;
constexpr size_t PL_STASH = 408 * MiB;
constexpr size_t PL_CS = 0;
constexpr size_t PL_CP = 96 * MiB;
constexpr size_t PL_WQB = 0;
constexpr size_t PL_WKVT = 32 * MiB;
constexpr size_t PL_WOT = 96 * MiB;
constexpr size_t PL_MEMN = 128 * MiB;
constexpr size_t PL_KVB = 136 * MiB;
constexpr size_t POOL_BYTES = 440 * MiB;
constexpr size_t WS_END = WS_POOL + POOL_BYTES;

constexpr int CW_BAR = 4096;
constexpr int CW_DBG = 1024;
constexpr int CW_QKB = 2048;
constexpr int CW_QUEUE = 2304;

constexpr int EXCH_OFF = 131072  , PSSB_OFF = 139264  , RING_BYTES = 155648, MISC_OFF = RING_BYTES + 320, LDS_BYTES = 159744;

struct Args { const float* in[N_IN]; float* out; unsigned char* ws; int ph_lo, ph_hi, li, pad; };
struct Frame {
    LAS unsigned char* lds; char* ldsg;
    volatile LAS unsigned* MISC;
    int tid, lane, wave, G, bid;
    const float* const* in; float* x; unsigned char* ws;
};
#define WSP(off) (F.ws + (off))
#define POOLP(off) (F.ws + WS_POOL + (off))

struct ZNone { __device__ __forceinline__ size_t aoff(int) const { return 0; } __device__ __forceinline__ size_t boff(int) const { return 0; } };
struct ZLin { size_t as, bs; __device__ __forceinline__ size_t aoff(int z) const { return (size_t)z * as; } __device__ __forceinline__ size_t boff(int z) const { return (size_t)z * bs; } };
struct ZKv { __device__ __forceinline__ size_t aoff(int z) const { return (size_t)z * (256 * 2048 * 2); } __device__ __forceinline__ size_t boff(int z) const { return (size_t)(z >> 1) * ((size_t)4096 * 2048 * 2); } };
struct ZKf { __device__ __forceinline__ size_t aoff(int z) const { return (size_t)(z >> 2) * ((size_t)256 * 4096 * 2) + (size_t)(z & 3) * 1024; }
             __device__ __forceinline__ size_t boff(int z) const { return (size_t)(z >> 3) * ((size_t)2048 * 2048 * 2) + (size_t)(z & 3) * 1024; } };
struct ZVw { __device__ __forceinline__ size_t aoff(int z) const { return (size_t)(z >> 3) * ((size_t)2048 * 2048 * 2) + (size_t)(z & 3) * 1024; }
             __device__ __forceinline__ size_t boff(int z) const { return (size_t)(z >> 2) * ((size_t)256 * 4096 * 2) + 4096 + (size_t)(z & 3) * 1024; } };
template <class ZM>
struct Sched : pg8::Enum {
    const char* A; const char* B; size_t atile, btile; int split; size_t bseq; ZM zm;
    __device__ __forceinline__ const char* a_base(const pg8::Unit& u) const { return A + (size_t)u.pm * atile + zm.aoff(u.z); }
    __device__ __forceinline__ const char* b_base(const pg8::Unit& u) const { return B + (size_t)u.pn * btile + zm.boff(u.z) + (u.pm >= split ? bseq : 0); }
};
template <class ZM>
__device__ __forceinline__ Sched<ZM> make_sched(const Frame& F, const void* A, int lda, const void* B, int ldb, int M, int N, int nZ, ZM zm) {
    Sched<ZM> S; S.init(M / 256, N / 256, nZ, F.G, F.bid); S.A = (const char*)A; S.B = (const char*)B; S.atile = (size_t)256 * lda * 2; S.btile = (size_t)256 * ldb * 2;
    S.split = 1 << 30; S.bseq = 0; S.zm = zm; return S;
}

typedef f32x4 Acc[2][2][4][2];
__device__ __forceinline__ unsigned char* fresh_ws(unsigned char* ws) { asm volatile("" : "+s"(ws)); return ws; }
__device__ __forceinline__ void pss_prefetch(LAS unsigned char* lds, const unsigned char* ws, int pm, int par, int wid, int lane) {
    const unsigned char* src = ws + WS_MISC + MISC_PSS + (size_t)pm * 8192 + wid * 1024 + lane * 16;
    __builtin_amdgcn_global_load_lds((const unsigned*)src, (LAS unsigned*)(lds + PSSB_OFF + (par & 1) * 8192 + wid * 1024), 16, 0, 0);
}
__device__ __forceinline__ void row_rstd_lds(const LAS unsigned char* lds, int par, int rloc0, float (&rs)[2][4]) {
    const LAS unsigned char* b = lds + PSSB_OFF + (par & 1) * 8192;
#pragma unroll
    for (int ai = 0; ai < 2; ++ai)
#pragma unroll
        for (int m = 0; m < 4; ++m) { const f32x4 a = *(const LAS f32x4*)(b + (rloc0 + ai * 128 + m * 16) * 32), c = *(const LAS f32x4*)(b + (rloc0 + ai * 128 + m * 16) * 32 + 16);
            rs[ai][m] = 1.0f / sqrtf((((a.x + a.y) + (a.z + a.w)) + ((c.x + c.y) + (c.z + c.w))) * (1.f / DM) + EPS); }
}
__device__ __forceinline__ void row_rstd(const float* PSS, int row0, float (&rs)[2][4]) {
#pragma unroll
    for (int ai = 0; ai < 2; ++ai)
#pragma unroll
        for (int m = 0; m < 4; ++m) { const f32x4 a = *(const f32x4*)(PSS + (size_t)(row0 + ai * 128 + m * 16) * 8), b = *(const f32x4*)(PSS + (size_t)(row0 + ai * 128 + m * 16) * 8 + 4);
            rs[ai][m] = 1.0f / sqrtf((((a.x + a.y) + (a.z + a.w)) + ((b.x + b.y) + (b.z + b.w))) * (1.f / DM) + EPS); }
}
struct EpiSwiglu { static constexpr bool PERM = true, PREFETCH = true; unsigned char* ws; int ldc; LAS unsigned char* lds;
    __device__ __forceinline__ void prefetch(LAS unsigned char* l, const pg8::Unit& u, int par, int wid, int lane) const { pss_prefetch(l, ws, u.pm, par, wid, lane); }
    __device__ __forceinline__ void operator()(Acc& acc, const pg8::Unit& u, int wr, int wc, int fr, int fq, int par) const {
        const int row0 = u.pm * 256 + wr * 64 + fr, col0 = u.pn * 128 + wc * 32 + 8 * fq;
        unsigned char* w_ = fresh_ws(ws); bf16_t* O = (bf16_t*)(w_ + WS_POOL + PL_ACT);
        float rs[2][4]; row_rstd_lds(lds, par, wr * 64 + fr, rs);
#pragma unroll
        for (int ai = 0; ai < 2; ++ai)
#pragma unroll
            for (int m = 0; m < 4; ++m) { const f32x4 g0 = acc[ai][0][m][0] * rs[ai][m], g1 = acc[ai][0][m][1] * rs[ai][m], u0 = acc[ai][1][m][0] * rs[ai][m], u1 = acc[ai][1][m][1] * rs[ai][m];
                u32x4 w; w.x = cvt_pk_bf16(silu_f(g0[0]) * u0[0], silu_f(g0[1]) * u0[1]); w.y = cvt_pk_bf16(silu_f(g0[2]) * u0[2], silu_f(g0[3]) * u0[3]);
                w.z = cvt_pk_bf16(silu_f(g1[0]) * u1[0], silu_f(g1[1]) * u1[1]); w.w = cvt_pk_bf16(silu_f(g1[2]) * u1[2], silu_f(g1[3]) * u1[3]);
                *(u32x4*)(O + (size_t)(row0 + ai * 128 + m * 16) * ldc + col0) = w; }
    }
};
struct EpiResidNorm { static constexpr bool PERM = false, PREFETCH = false; float* X; float scale; unsigned char* ws; LAS float* red;
    __device__ __forceinline__ void operator()(Acc& acc, const pg8::Unit& u, int wr, int wc, int fr, int fq, int par) const {
        const int row0 = u.pm * 256 + wr * 64 + fr, col0 = u.pn * 256 + wc * 32 + 4 * fq;
        unsigned char* w_ = fresh_ws(ws); bf16_t* XB = (bf16_t*)(w_ + WS_HB); float* PSS = (float*)(w_ + WS_MISC + MISC_PSS);
#pragma unroll
        for (int ai = 0; ai < 2; ++ai) {
            f32x4 xv[4][2][2];
#pragma unroll
            for (int m = 0; m < 4; ++m) { const float* rp = X + (size_t)(row0 + ai * 128 + m * 16) * DM + col0;
#pragma unroll
                for (int bj = 0; bj < 2; ++bj)
#pragma unroll
                    for (int n = 0; n < 2; ++n) xv[m][bj][n] = *(const f32x4*)(rp + bj * 128 + n * 16); }
#pragma unroll
            for (int m = 0; m < 4; ++m) { const size_t ro = (size_t)(row0 + ai * 128 + m * 16) * DM + col0; float* rp = X + ro; bf16_t* bp = XB + ro; float s = 0.f;
#pragma unroll
                for (int bj = 0; bj < 2; ++bj)
#pragma unroll
                    for (int n = 0; n < 2; ++n) { const f32x4 v = xv[m][bj][n] + acc[ai][bj][m][n] * scale; *(f32x4*)(rp + bj * 128 + n * 16) = v;
                        u32x2 w; w.x = cvt_pk_bf16(v[0], v[1]); w.y = cvt_pk_bf16(v[2], v[3]); *(u32x2*)(bp + bj * 128 + n * 16) = w;
                        s += (v[0] * v[0] + v[1] * v[1]) + (v[2] * v[2] + v[3] * v[3]); }
                s += __shfl_xor(s, 16); s += __shfl_xor(s, 32);
                if (fq == 0) red[(ai * 128 + wr * 64 + m * 16 + fr) * 4 + wc] = s; }
            asm volatile("" ::: "memory"); }
        asm volatile("s_waitcnt lgkmcnt(0)" ::: "memory"); __builtin_amdgcn_s_barrier(); asm volatile("" ::: "memory");
        const int t = (wr * 4 + wc) * 64 + fq * 16 + fr;
        if (t < 256) { const f32x4 r4 = *(const LAS f32x4*)(red + t * 4); PSS[(size_t)(u.pm * 256 + t) * 8 + u.pn] = (r4.x + r4.y) + (r4.z + r4.w); }
    }
};
template <int MODE> struct EpiBf16 { static constexpr bool PERM = true, PREFETCH = (MODE == 1); bf16_t* O; int ldc; size_t zhi, zlo; int zshift; const float* aux; unsigned char* ws; LAS unsigned char* lds;
    __device__ __forceinline__ void prefetch(LAS unsigned char* l, const pg8::Unit& u, int par, int wid, int lane) const { pss_prefetch(l, ws, u.pm, par, wid, lane); }
    __device__ __forceinline__ void operator()(Acc& acc, const pg8::Unit& u, int wr, int wc, int fr, int fq, int par) const {
        bf16_t* base = O + (size_t)(u.z >> zshift) * zhi + (size_t)(u.z & ((1 << zshift) - 1)) * zlo;
        const int row0 = u.pm * 256 + wr * 64 + fr, col0 = u.pn * 256 + wc * 32 + 8 * fq;
        float rs[2][4]; if (MODE == 1) row_rstd_lds(lds, par, wr * 64 + fr, rs);
        f32x4 cs[2][2]; if (MODE == 2) {
#pragma unroll
            for (int bj = 0; bj < 2; ++bj)
#pragma unroll
                for (int n = 0; n < 2; ++n) cs[bj][n] = *(const f32x4*)(aux + (size_t)(u.z >> 3) * DM + col0 + bj * 128 + 4 * n); }
#pragma unroll
        for (int ai = 0; ai < 2; ++ai)
#pragma unroll
            for (int m = 0; m < 4; ++m) { bf16_t* rp = base + (size_t)(row0 + ai * 128 + m * 16) * ldc + col0;
#pragma unroll
                for (int bj = 0; bj < 2; ++bj) { f32x4 v0 = acc[ai][bj][m][0], v1 = acc[ai][bj][m][1];
                    if (MODE == 1) { v0 = v0 * rs[ai][m]; v1 = v1 * rs[ai][m]; }
                    if (MODE == 2) { v0 = v0 * cs[bj][0]; v1 = v1 * cs[bj][1]; }
                    u32x4 w; w.x = cvt_pk_bf16(v0[0], v0[1]); w.y = cvt_pk_bf16(v0[2], v0[3]); w.z = cvt_pk_bf16(v1[0], v1[1]); w.w = cvt_pk_bf16(v1[2], v1[3]);
                    *(u32x4*)(rp + bj * 128) = w; } }
    }
};
struct EpiWinEven { static constexpr bool PERM = true, PREFETCH = true; unsigned char* ws; LAS unsigned char* lds;
    __device__ __forceinline__ void prefetch(LAS unsigned char* l, const pg8::Unit& u, int par, int wid, int lane) const { pss_prefetch(l, ws, u.pm, par, wid, lane); }
    __device__ __forceinline__ void operator()(Acc& acc, const pg8::Unit& u, int wr, int wc, int fr, int fq, int par) const {
        const int row0 = u.pm * 256 + wr * 64 + fr, col0 = u.pn * 256 + wc * 32 + 8 * fq;
        unsigned char* w_ = fresh_ws(ws); bf16_t* UX = (bf16_t*)(w_ + WS_POOL + PL_UX); bf16_t* Z = (bf16_t*)(w_ + WS_POOL + PL_Z);
        float rs[2][4]; row_rstd_lds(lds, par, wr * 64 + fr, rs);
#pragma unroll
        for (int ai = 0; ai < 2; ++ai)
#pragma unroll
            for (int m = 0; m < 4; ++m) { const int row = row0 + ai * 128 + m * 16;
#pragma unroll
                for (int bj = 0; bj < 2; ++bj) { const f32x4 v0 = acc[ai][bj][m][0] * rs[ai][m], v1 = acc[ai][bj][m][1] * rs[ai][m]; const int col = col0 + bj * 128;
                    u32x4 w; w.x = cvt_pk_bf16(v0[0], v0[1]); w.y = cvt_pk_bf16(v0[2], v0[3]); w.z = cvt_pk_bf16(v1[0], v1[1]); w.w = cvt_pk_bf16(v1[2], v1[3]);
                    bf16_t* p;
                    if (u.pn < 4) { const int g = col >> 4, h0 = col & 15, c = row >> 5, i = row & 31; p = UX + ((size_t)(g * NCH + c) * S5K2 + i * 16 + h0); }
                    else p = Z + (size_t)row * ZLD + (col - 1024);
                    *(u32x4*)p = w; } }
    }
};
struct EpiF32 { static constexpr bool PERM = false, PREFETCH = false; float* O; int ldc; size_t zs;
    __device__ __forceinline__ void operator()(Acc& acc, const pg8::Unit& u, int wr, int wc, int fr, int fq, int par) const {
        float* base = O + (size_t)u.z * zs; const int row0 = u.pm * 256 + wr * 64 + fr, col0 = u.pn * 256 + wc * 32 + 4 * fq;
#pragma unroll
        for (int ai = 0; ai < 2; ++ai)
#pragma unroll
            for (int m = 0; m < 4; ++m) { float* rp = base + (size_t)(row0 + ai * 128 + m * 16) * ldc + col0;
#pragma unroll
                for (int bj = 0; bj < 2; ++bj)
#pragma unroll
                    for (int n = 0; n < 2; ++n) *(f32x4*)(rp + bj * 128 + n * 16) = acc[ai][bj][m][n]; }
    }
};
struct EpiS5Out { static constexpr bool PERM = true, PREFETCH = false; bf16_t* GB;
    __device__ __forceinline__ void operator()(Acc& acc, const pg8::Unit& u, int wr, int wc, int fr, int fq, int par) const {
        const int row0 = u.pm * 256 + wr * 64 + fr, col0 = u.pn * 256 + wc * 32 + 8 * fq;
#pragma unroll
        for (int ai = 0; ai < 2; ++ai)
#pragma unroll
            for (int m = 0; m < 4; ++m) { const int c = row0 + ai * 128 + m * 16;
#pragma unroll
                for (int bj = 0; bj < 2; ++bj) { const f32x4 v0 = acc[ai][bj][m][0], v1 = acc[ai][bj][m][1]; const int col = col0 + bj * 128, i = col >> 4, h0 = col & 15;
                    u32x4 w; w.x = cvt_pk_bf16(gelu_tanh_f(v0[0]), gelu_tanh_f(v0[1])); w.y = cvt_pk_bf16(gelu_tanh_f(v0[2]), gelu_tanh_f(v0[3]));
                    w.z = cvt_pk_bf16(gelu_tanh_f(v1[0]), gelu_tanh_f(v1[1])); w.w = cvt_pk_bf16(gelu_tanh_f(v1[2]), gelu_tanh_f(v1[3]));
                    *(u32x4*)(GB + (size_t)(c * LC + i) * S5W + u.z * 16 + h0) = w; } }
    }
};
struct EpiGlu { static constexpr bool PERM = true, PREFETCH = false; const bf16_t* GB; const float* bias; bf16_t* O;
    __device__ __forceinline__ void operator()(Acc& acc, const pg8::Unit& u, int wr, int wc, int fr, int fq, int par) const {
        const int row0 = u.pm * 256 + wr * 64 + fr, col0 = u.pn * 256 + wc * 32 + 8 * fq;
        f32x4 bv[2][2];
#pragma unroll
        for (int bj = 0; bj < 2; ++bj)
#pragma unroll
            for (int n = 0; n < 2; ++n) bv[bj][n] = *(const f32x4*)(bias + col0 + bj * 128 + 4 * n);
#pragma unroll
        for (int ai = 0; ai < 2; ++ai)
#pragma unroll
            for (int m = 0; m < 4; ++m) { const int row = row0 + ai * 128 + m * 16;
#pragma unroll
                for (int bj = 0; bj < 2; ++bj) { const f32x4 v0 = acc[ai][bj][m][0] + bv[bj][0], v1 = acc[ai][bj][m][1] + bv[bj][1]; const int col = col0 + bj * 128;
                    const u32x4 g = *(const u32x4*)(GB + (size_t)row * S5W + col);
                    u32x4 w; w.x = cvt_pk_bf16(bflo(g.x) * sigmoidf_fast(v0[0]), bfhi(g.x) * sigmoidf_fast(v0[1])); w.y = cvt_pk_bf16(bflo(g.y) * sigmoidf_fast(v0[2]), bfhi(g.y) * sigmoidf_fast(v0[3]));
                    w.z = cvt_pk_bf16(bflo(g.z) * sigmoidf_fast(v1[0]), bfhi(g.z) * sigmoidf_fast(v1[1])); w.w = cvt_pk_bf16(bflo(g.w) * sigmoidf_fast(v1[2]), bfhi(g.w) * sigmoidf_fast(v1[3]));
                    *(u32x4*)(O + (size_t)row * DM + col) = w; } }
    }
};

struct EpiCrossSm { static constexpr bool PERM = true, PREFETCH = true; unsigned char* ws; LAS f32x2* red; LAS unsigned char* lds;
    __device__ __forceinline__ void prefetch(LAS unsigned char* l, const pg8::Unit& u, int par, int wid, int lane) const { pss_prefetch(l, ws, u.pm, par, wid, lane); }
    __device__ __forceinline__ void operator()(Acc& acc, const pg8::Unit& u, int wr, int wc, int fr, int fq, int par) const {
        constexpr float C = 0.04419417382415922f * 1.4426950408889634f;
        const int row0 = u.pm * 256 + wr * 64 + fr, col0 = u.pn * 256 + wc * 32 + 8 * fq;
        unsigned char* w_ = fresh_ws(ws); bf16_t* O = (bf16_t*)(w_ + WS_POOL + PL_CP);
        float rs[2][4]; row_rstd_lds(lds, par, wr * 64 + fr, rs);
        float mw[2][4];
#pragma unroll
        for (int ai = 0; ai < 2; ++ai)
#pragma unroll
            for (int m = 0; m < 4; ++m) { const float k = rs[ai][m] * C; float mx = -3.0e38f;
#pragma unroll
                for (int bj = 0; bj < 2; ++bj)
#pragma unroll
                    for (int n = 0; n < 2; ++n) { f32x4 v = acc[ai][bj][m][n] * k; acc[ai][bj][m][n] = v; mx = fmaxf(fmaxf(mx, fmaxf(v[0], v[1])), fmaxf(v[2], v[3])); }
                mx = fmaxf(mx, __shfl_xor(mx, 16)); mx = fmaxf(mx, __shfl_xor(mx, 32)); float s = 0.f;
#pragma unroll
                for (int bj = 0; bj < 2; ++bj)
#pragma unroll
                    for (int n = 0; n < 2; ++n) { f32x4 v = acc[ai][bj][m][n]; v[0] = fast_exp2(v[0] - mx); v[1] = fast_exp2(v[1] - mx); v[2] = fast_exp2(v[2] - mx); v[3] = fast_exp2(v[3] - mx); acc[ai][bj][m][n] = v; s += (v[0] + v[1]) + (v[2] + v[3]); }
                s += __shfl_xor(s, 16); s += __shfl_xor(s, 32); mw[ai][m] = mx;
                if (fq == 0) red[(ai * 128 + wr * 64 + m * 16 + fr) * 4 + wc] = (f32x2){mx, s}; }
        asm volatile("s_waitcnt lgkmcnt(0)" ::: "memory"); __builtin_amdgcn_s_barrier(); asm volatile("" ::: "memory");
#pragma unroll
        for (int ai = 0; ai < 2; ++ai)
#pragma unroll
            for (int m = 0; m < 4; ++m) { const LAS f32x2* rr = red + (ai * 128 + wr * 64 + m * 16 + fr) * 4; const f32x2 r0 = rr[0], r1 = rr[1], r2 = rr[2], r3 = rr[3];
                const float M = fmaxf(fmaxf(r0.x, r1.x), fmaxf(r2.x, r3.x));
                const float tot = (r0.y * fast_exp2(r0.x - M) + r1.y * fast_exp2(r1.x - M)) + (r2.y * fast_exp2(r2.x - M) + r3.y * fast_exp2(r3.x - M));
                const float f = fast_exp2(mw[ai][m] - M) * fast_rcp(tot);
                bf16_t* rp = O + (size_t)(row0 + ai * 128 + m * 16) * 1024 + col0;
#pragma unroll
                for (int bj = 0; bj < 2; ++bj) { const f32x4 v0 = acc[ai][bj][m][0] * f, v1 = acc[ai][bj][m][1] * f;
                    u32x4 w; w.x = cvt_pk_bf16(v0[0], v0[1]); w.y = cvt_pk_bf16(v0[2], v0[3]); w.z = cvt_pk_bf16(v1[0], v1[1]); w.w = cvt_pk_bf16(v1[2], v1[3]);
                    *(u32x4*)(rp + bj * 128) = w; } }
    }
};

template <int MODE>
__device__ __forceinline__ void transpose_item(const float* W, int K, int N, bf16_t* WT, LAS float* scr, int item, int lane, const float* gain = nullptr) {
    const int nblk = N / 32, kb = item / nblk, nb = item % nblk, k0 = 64 * kb, n0 = 32 * nb;
#pragma unroll 8
    for (int i = 0; i < 32; ++i) { const int kk = 2 * i + (lane >> 5); scr[kk * 33 + (lane & 31)] = W[(size_t)(k0 + kk) * N + n0 + (lane & 31)]; }
    LDS_WAIT(); asm volatile("" ::: "memory");
    const int c = lane & 7;
    f32x4 g0 = (f32x4){1.f, 1.f, 1.f, 1.f}, g1 = g0; if (gain) { g0 = *(const f32x4*)(gain + k0 + 8 * c); g1 = *(const f32x4*)(gain + k0 + 8 * c + 4); }
    int r0;
    if (MODE == 1) { r0 = (n0 < DFF) ? (256 * (n0 / 128) + (n0 % 128)) : (256 * ((n0 - DFF) / 128) + 128 + ((n0 - DFF) % 128)); } else r0 = n0;
#pragma unroll
    for (int j = 0; j < 4; ++j) { const int n = (lane >> 3) + 8 * j; const LAS float* s = scr + (8 * c) * 33 + n;
        u32x4 o; o.x = cvt_pk_bf16(s[0 * 33] * g0.x, s[1 * 33] * g0.y); o.y = cvt_pk_bf16(s[2 * 33] * g0.z, s[3 * 33] * g0.w); o.z = cvt_pk_bf16(s[4 * 33] * g1.x, s[5 * 33] * g1.y); o.w = cvt_pk_bf16(s[6 * 33] * g1.z, s[7 * 33] * g1.w);
        *(u32x4*)(WT + (size_t)(r0 + n) * K + k0 + 8 * c) = o; }
    LDS_WAIT(); asm volatile("" ::: "memory");
}
__device__ __forceinline__ void convert_rows(const float* src, bf16_t* dst, size_t n8, size_t gtid, size_t gthreads) {
    for (size_t i = gtid; i < n8; i += gthreads) { const f32x4 a = *(const f32x4*)(src + i * 8), b = *(const f32x4*)(src + i * 8 + 4);
        u32x4 o; o.x = cvt_pk_bf16(a[0], a[1]); o.y = cvt_pk_bf16(a[2], a[3]); o.z = cvt_pk_bf16(b[0], b[1]); o.w = cvt_pk_bf16(b[2], b[3]); *(u32x4*)(dst + i * 8) = o; }
}

__device__ __forceinline__ void rms_row_to_bf16(const float* xrow, const float* g, bf16_t* orow, float* xcopy, int lane) {
    const f32x4* xr = (const f32x4*)xrow + lane;
    f32x4 v[8]; float s = 0.f;
#pragma unroll
    for (int j = 0; j < 8; ++j) { v[j] = xr[64 * j]; s += (v[j].x * v[j].x + v[j].y * v[j].y) + (v[j].z * v[j].z + v[j].w * v[j].w); }
    if (xcopy) {
#pragma unroll
        for (int j = 0; j < 8; ++j) ((f32x4*)xcopy + lane)[64 * j] = v[j]; }
    const float rstd = 1.0f / sqrtf(wave_sum(s) * (1.f / DM) + EPS);
    const f32x4* gr = (const f32x4*)g + lane;
    u32x2* o8 = (u32x2*)orow + lane;
#pragma unroll
    for (int j = 0; j < 8; ++j) { const f32x4 gg = gr[64 * j]; u32x2 w; w.x = cvt_pk_bf16(v[j].x * rstd * gg.x, v[j].y * rstd * gg.y); w.y = cvt_pk_bf16(v[j].z * rstd * gg.z, v[j].w * rstd * gg.w); o8[64 * j] = w; }
}
__device__ __forceinline__ void norm_phase(const Frame& F, const float* g) {
    const int gw = F.bid * NWAVES + F.wave, NGW = F.G * NWAVES; bf16_t* HB = (bf16_t*)WSP(WS_HB);
    for (int m = gw; m < TT; m += NGW) rms_row_to_bf16(F.x + (size_t)m * DM, g, HB + (size_t)m * DM, nullptr, F.lane);
}
__device__ __forceinline__ void final_norm_phase(const Frame& F, const float* g) {
    const int gw = F.bid * NWAVES + F.wave, NGW = F.G * NWAVES;
    for (int m = gw; m < TT; m += NGW) {
        f32x4* xr = (f32x4*)(F.x + (size_t)m * DM) + F.lane; f32x4 v[8]; float s = 0.f;
#pragma unroll
        for (int j = 0; j < 8; ++j) { v[j] = xr[64 * j]; s += (v[j].x * v[j].x + v[j].y * v[j].y) + (v[j].z * v[j].z + v[j].w * v[j].w); }
        const float rstd = 1.0f / sqrtf(wave_sum(s) * (1.f / DM) + EPS); const f32x4* gr = (const f32x4*)g + F.lane;
#pragma unroll
        for (int j = 0; j < 8; ++j) { const f32x4 gg = gr[64 * j]; xr[64 * j] = v[j] * rstd * gg; }
    }
}

__device__ __forceinline__ void s5_precompute_group(const Frame& F, int e, int g) {
    LAS float* L = (LAS float*)F.lds;
    LAS float* apow = L;
    LAS float* bb = apow + 8448;
    LAS float* cc = bb + 4096;
    LAS float* km = cc + 4096;
    LAS float* dsk = km + 16384;
    const float* lre = F.in[I_LRE], *lim = F.in[I_LIM], *ldt = F.in[I_LDT], *bre = F.in[I_BRE], *bim = F.in[I_BIM], *cre = F.in[I_CRE], *cim = F.in[I_CIM], *dsk_g = F.in[I_S5D];
    const int tid = F.tid;
    for (int idx = tid; idx < 2 * 64 * 33; idx += NTHREADS) { const int k = idx % 33, p = (idx / 33) % 64, dir = idx / (33 * 64);
        const size_t pi = ((size_t)(e * 2 + dir) * S5G + g) * S5P + p; const float lr = fminf(lre[pi], -1e-4f), li = lim[pi], dt = expf(ldt[(e * 2 + dir) * S5G + g]);
        const float mag = expf(lr * dt * (float)k); float sn, cs; sincosf(li * dt * (float)k, &sn, &cs); apow[idx * 2] = mag * cs; apow[idx * 2 + 1] = mag * sn; }
    for (int idx = tid; idx < 2 * 64 * 16; idx += NTHREADS) { const int h = idx % 16, p = (idx / 16) % 64, dir = idx / 1024;
        const size_t pi = ((size_t)(e * 2 + dir) * S5G + g) * S5P + p; const float lr = fminf(lre[pi], -1e-4f), li = lim[pi], dt = expf(ldt[(e * 2 + dir) * S5G + g]);
        const float mag = expf(lr * dt); float sn, cs; sincosf(li * dt, &sn, &cs); const float ar = mag * cs, ai = mag * sn, nr = ar - 1.0f, den = lr * lr + li * li;
        const float fr = (nr * lr + ai * li) / den, fi = (ai * lr - nr * li) / den; const float br = bre[pi * 16 + h], bi = bim[pi * 16 + h];
        bb[idx * 2] = fr * br - fi * bi; bb[idx * 2 + 1] = fr * bi + fi * br; }
    for (int idx = tid; idx < 2 * 16 * 64; idx += NTHREADS) { const int p = idx % 64, h = (idx / 64) % 16, dir = idx / 1024;
        const size_t ci = (((size_t)(e * 2 + dir) * S5G + g) * S5H + h) * S5P + p; cc[idx * 2] = cre[ci]; cc[idx * 2 + 1] = cim[ci]; }
    if (tid < 16) dsk[tid] = dsk_g[e * S5W + g * 16 + tid];
    LDS_WAIT(); __syncthreads();
    for (int idx = tid; idx < 2 * 32 * 256; idx += NTHREADS) { const int hp = idx & 15, h = (idx >> 4) & 15, k = (idx >> 8) & 31, dir = idx >> 13; float s = 0.f;
        for (int p = 0; p < 64; ++p) { const float cr = cc[((dir * 16 + h) * 64 + p) * 2], ci = cc[((dir * 16 + h) * 64 + p) * 2 + 1], ar = apow[((dir * 64 + p) * 33 + k) * 2], ai = apow[((dir * 64 + p) * 33 + k) * 2 + 1];
            const float br = bb[((dir * 64 + p) * 16 + hp) * 2], bi = bb[((dir * 64 + p) * 16 + hp) * 2 + 1]; const float wr = cr * ar - ci * ai, wi = cr * ai + ci * ar; s += wr * br - wi * bi; }
        km[idx] = s; }
    LDS_WAIT(); __syncthreads();
    bf16_t* WST = (bf16_t*)WSP(WS_WST) + (size_t)(e * 64 + g) * (S5NS * S5K1);
    bf16_t* TG = (bf16_t*)WSP(WS_TG) + (size_t)(e * 64 + g) * (S5K1 * S5K2);
    for (int idx = tid; idx < S5NS * S5K1 / 2; idx += NTHREADS) { const int k2 = (idx % (S5K1 / 2)) * 2, n = idx / (S5K1 / 2); const int dir = n >> 7, p = (n >> 1) & 63, ri = n & 1; const int j = k2 >> 4, hp = k2 & 15;
        const int ex = dir == 0 ? (LC - 1 - j) : j; const float ar = apow[((dir * 64 + p) * 33 + ex) * 2], ai = apow[((dir * 64 + p) * 33 + ex) * 2 + 1];
        float v[2];
#pragma unroll
        for (int q = 0; q < 2; ++q) { const float br = bb[((dir * 64 + p) * 16 + hp + q) * 2], bi = bb[((dir * 64 + p) * 16 + hp + q) * 2 + 1]; v[q] = ri == 0 ? (ar * br - ai * bi) : (ar * bi + ai * br); }
        *(unsigned*)(WST + (size_t)n * S5K1 + k2) = cvt_pk_bf16(v[0], v[1]); }
    for (int idx = tid; idx < S5K1 * S5K2 / 2; idx += NTHREADS) { const int k2 = (idx % (S5K2 / 2)) * 2, n = idx / (S5K2 / 2); const int i = n >> 4, h = n & 15; float v[2];
        if (k2 < S5K1) { const int j = k2 >> 4, hp = k2 & 15;
#pragma unroll
            for (int q = 0; q < 2; ++q) { float s = 0.f; if (j <= i) s += km[((0 * 32 + (i - j)) * 16 + h) * 16 + hp + q]; if (j >= i) s += km[((1 * 32 + (j - i)) * 16 + h) * 16 + hp + q]; if (i == j && h == hp + q) s += dsk[h]; v[q] = s; }
        } else { const int nn = k2 - S5K1, dir = nn >> 7, p = (nn >> 1) & 63; const int ex = dir == 0 ? (i + 1) : (LC - i);
            const float ar = apow[((dir * 64 + p) * 33 + ex) * 2], ai = apow[((dir * 64 + p) * 33 + ex) * 2 + 1], cr = cc[((dir * 16 + h) * 64 + p) * 2], ci = cc[((dir * 16 + h) * 64 + p) * 2 + 1];
            v[0] = cr * ar - ci * ai; v[1] = -(cr * ai + ci * ar); }
        *(unsigned*)(TG + (size_t)n * S5K2 + k2) = cvt_pk_bf16(v[0], v[1]); }
    f32x2* AL = (f32x2*)(WSP(WS_MISC) + MISC_AL);
    if (tid < 128) { const int dir = tid >> 6, p = tid & 63; AL[((e * 2 + dir) * 64 + g) * 64 + p] = (f32x2){apow[((dir * 64 + p) * 33 + LC) * 2], apow[((dir * 64 + p) * 33 + LC) * 2 + 1]}; }
    __syncthreads();
}

__device__ __forceinline__ void s5_scan_phase(const Frame& F, int e) {
    const int gt = F.bid * NTHREADS + F.tid;
    if (gt >= 2 * 2 * 64 * 64) return;
    const int p = gt & 63, g = (gt >> 6) & 63, dir = (gt >> 12) & 1, seq = gt >> 13;
    const float* SST = (const float*)POOLP(PL_SST); bf16_t* UX = (bf16_t*)POOLP(PL_UX);
    const f32x2 aL = ((const f32x2*)(WSP(WS_MISC) + MISC_AL))[((e * 2 + dir) * 64 + g) * 64 + p];
    const int c0 = seq ? NCH_P : 0, c1 = seq ? NCH : NCH_P, n = c1 - c0;
    float xr = 0.f, xi = 0.f;
    const int step = dir == 0 ? 1 : -1; int c = dir == 0 ? c0 : c1 - 1;
    for (int it = 0; it < n; it += 8) {
        f32x2 s[8];
#pragma unroll
        for (int q = 0; q < 8; ++q) s[q] = *(const f32x2*)(SST + ((size_t)(c + q * step) * 64 + g) * 256 + dir * 128 + 2 * p);
#pragma unroll
        for (int q = 0; q < 8; ++q) { *(unsigned*)(UX + ((size_t)g * NCH + (c + q * step)) * S5K2 + S5K1 + dir * 128 + 2 * p) = cvt_pk_bf16(xr, xi);
            const float nr = aL.x * xr - aL.y * xi + s[q].x, ni = aL.x * xi + aL.y * xr + s[q].y; xr = nr; xi = ni; }
        c += 8 * step;
    }
}

__device__ __forceinline__ void qk_prep_phase(const Frame& F, int o) {
    bf16_t* Z = (bf16_t*)POOLP(PL_Z); const float* rope = (const float*)(WSP(WS_MISC) + MISC_ROPE);
    const float* qg = F.in[I_QN] + o * 128, *kg = F.in[I_KN] + o * 128;
    const int sub = F.lane >> 4, j = F.lane & 15;
    const long nrows = (long)TT * 20, gq = ((long)F.bid * NWAVES + F.wave) * 4 + sub, nq = (long)F.G * NWAVES * 4;
    for (long r = gq; r < nrows; r += nq) {
        const int t = (int)(r / 20), hh = (int)(r % 20);
        bf16_t* p = Z + (size_t)t * ZLD + (hh < 16 ? hh * 128 : 2048 + (hh - 16) * 128) + j * 8;
        const u32x4 w = *(const u32x4*)p; float v[8] = {bflo(w.x), bfhi(w.x), bflo(w.y), bfhi(w.y), bflo(w.z), bfhi(w.z), bflo(w.w), bfhi(w.w)};
        float s = 0.f;
#pragma unroll
        for (int q = 0; q < 8; ++q) s += v[q] * v[q];
        s += __shfl_xor(s, 1); s += __shfl_xor(s, 2); s += __shfl_xor(s, 4); s += __shfl_xor(s, 8);
        const float rstd = 1.0f / sqrtf(s * (1.f / 128.f) + EPS); const float* gg = (hh < 16 ? qg : kg) + j * 8;
        const int tl = t < T_P ? t : t - T_P; const int pos = (j < 8) ? (tl >> 6) : (tl & 63);
        const float* rp = rope + ((size_t)pos * 32 + 8 * (j & 3)) * 2;
        float o[8];
#pragma unroll
        for (int q = 0; q < 8; ++q) { const float x = v[q] * rstd * gg[q]; const float y = __shfl_xor(x, 4); const float cs = rp[2 * q], sn = rp[2 * q + 1];
            o[q] = (j & 4) ? (x * cs + y * sn) : (x * cs - y * sn); }
        u32x4 ow; ow.x = cvt_pk_bf16(o[0], o[1]); ow.y = cvt_pk_bf16(o[2], o[3]); ow.z = cvt_pk_bf16(o[4], o[5]); ow.w = cvt_pk_bf16(o[6], o[7]);
        *(u32x4*)p = ow;
    }
}

__device__ __forceinline__ void cross_softmax_phase(const Frame& F) {
    const float* CS = (const float*)POOLP(PL_CS); bf16_t* CP = (bf16_t*)POOLP(PL_CP);
    const long nrows = (long)TT * 4, gw = (long)F.bid * NWAVES + F.wave, NGW = (long)F.G * NWAVES;
    constexpr float C = 0.04419417382415922f * 1.4426950408889634f;
    for (long r = gw; r < nrows; r += NGW) {
        const f32x4 v = *((const f32x4*)(CS + r * 256) + F.lane);
        float m = fmaxf(fmaxf(v.x, v.y), fmaxf(v.z, v.w));
#pragma unroll
        for (int o = 1; o < 64; o <<= 1) m = fmaxf(m, __shfl_xor(m, o));
        const float e0 = fast_exp2((v.x - m) * C), e1 = fast_exp2((v.y - m) * C), e2 = fast_exp2((v.z - m) * C), e3 = fast_exp2((v.w - m) * C);
        const float inv = fast_rcp(wave_sum((e0 + e1) + (e2 + e3)));
        u32x2 w; w.x = cvt_pk_bf16(e0 * inv, e1 * inv); w.y = cvt_pk_bf16(e2 * inv, e3 * inv);
        *((u32x2*)(CP + r * 256) + F.lane) = w;
    }
}

__device__ __forceinline__ void prologue_phase(const Frame& F) {
    LAS float* scr = (LAS float*)(F.lds + F.wave * 16384);
    const int gw = F.bid * NWAVES + F.wave, NGW = F.G * NWAVES;
    constexpr int IT_GU = (DM / 64) * (2 * DFF / 32), IT_D = (DFF / 64) * (DM / 32), IT_WINE = (DM / 64) * (EVEN_IN / 32), IT_SQ = (DM / 64) * (DM / 32), IT_GLU = (S5W / 64) * (S5W / 32),
                  IT_WINO = (DM / 64) * (ODD_IN / 32), IT_KV = (DM / 64) * (2 * DM / 32);
    constexpr int N_GU = 8 * IT_GU, N_D = 8 * IT_D, N_WINE = 2 * IT_WINE, N_WOUTE = 2 * IT_SQ, N_GLU = 2 * IT_GLU, N_WINO = 2 * IT_WINO, N_WOUTO = 2 * IT_SQ, N_KV = 4 * IT_KV, N_WO = 4 * IT_SQ;
    constexpr int NITEMS = N_GU + N_D + N_WINE + N_WOUTE + N_GLU + N_WINO + N_WOUTO + N_KV + N_WO;
    for (int it = gw; it < NITEMS; it += NGW) {
        int r = it;
        if (r < N_GU) { const int w = r / IT_GU, l = w >> 1, f = w & 1; transpose_item<1>(F.in[f ? I_F2GU : I_F1GU] + (size_t)l * DM * 2 * DFF, DM, 2 * DFF, (bf16_t*)WSP(WS_WGU + w * SZ_WGU), scr, r % IT_GU, F.lane, F.in[f ? I_F2N : I_F1N] + l * DM); continue; } r -= N_GU;
        if (r < N_D) { const int w = r / IT_D, l = w >> 1, f = w & 1; transpose_item<0>(F.in[f ? I_F2D : I_F1D] + (size_t)l * DFF * DM, DFF, DM, (bf16_t*)WSP(WS_WD + w * SZ_WD), scr, r % IT_D, F.lane); continue; } r -= N_D;
        if (r < N_WINE) { const int e = r / IT_WINE; transpose_item<0>(F.in[I_EWIN] + (size_t)e * DM * EVEN_IN, DM, EVEN_IN, (bf16_t*)WSP(WS_WINE + e * SZ_WINE), scr, r % IT_WINE, F.lane, F.in[I_MIXN] + (2 * e) * DM); continue; } r -= N_WINE;
        if (r < N_WOUTE) { const int e = r / IT_SQ; transpose_item<0>(F.in[I_EWOUT] + (size_t)e * DM * DM, DM, DM, (bf16_t*)WSP(WS_WOUTE + e * SZ_SQ), scr, r % IT_SQ, F.lane); continue; } r -= N_WOUTE;
        if (r < N_GLU) { const int e = r / IT_GLU; transpose_item<0>(F.in[I_GLUW] + (size_t)e * S5W * S5W, S5W, S5W, (bf16_t*)WSP(WS_GLU + e * SZ_GLU), scr, r % IT_GLU, F.lane); continue; } r -= N_GLU;
        if (r < N_WINO) { const int o = r / IT_WINO; transpose_item<0>(F.in[I_OWIN] + (size_t)o * DM * ODD_IN, DM, ODD_IN, (bf16_t*)WSP(WS_WINO + o * SZ_WINO), scr, r % IT_WINO, F.lane, F.in[I_MIXN] + (2 * o + 1) * DM); continue; } r -= N_WINO;
        if (r < N_WOUTO) { const int o = r / IT_SQ; transpose_item<0>(F.in[I_OWOUT] + (size_t)o * DM * DM, DM, DM, (bf16_t*)WSP(WS_WOUTO + o * SZ_SQ), scr, r % IT_SQ, F.lane); continue; } r -= N_WOUTO;
        if (r < N_KV) { const int l = r / IT_KV; transpose_item<0>(F.in[I_CWKV] + (size_t)l * DM * 2 * DM, DM, 2 * DM, (bf16_t*)POOLP(PL_WKVT) + (size_t)l * 2 * DM * DM, scr, r % IT_KV, F.lane); continue; } r -= N_KV;
        { const int l = r / IT_SQ; transpose_item<0>(F.in[I_CWO] + (size_t)l * DM * DM, DM, DM, (bf16_t*)POOLP(PL_WOT) + (size_t)l * DM * DM, scr, r % IT_SQ, F.lane); }
    }
    convert_rows(F.in[I_CWQ], (bf16_t*)POOLP(PL_WQB), (size_t)4 * DM * DM / 8, (size_t)F.bid * NTHREADS + F.tid, (size_t)F.G * NTHREADS);
    for (int m = gw; m < 4 * 2 * NMEM; m += NGW) { const int l = m / (2 * NMEM), s = (m / NMEM) & 1, j = m % NMEM;
        rms_row_to_bf16(F.in[s ? I_MS : I_MP] + (size_t)j * DM, F.in[I_MN] + l * DM, (bf16_t*)POOLP(PL_MEMN) + (size_t)m * DM, nullptr, F.lane); }
    for (int m = gw; m < TT; m += NGW) { const float* src = m < T_P ? F.in[I_XP] + (size_t)m * DM : F.in[I_XS] + (size_t)(m - T_P) * DM;
        const f32x4* xr = (const f32x4*)src + F.lane; f32x4* xo = (f32x4*)(F.x + (size_t)m * DM) + F.lane; u32x2* bo = (u32x2*)((bf16_t*)WSP(WS_HB) + (size_t)m * DM) + F.lane; float s = 0.f;
#pragma unroll
        for (int j = 0; j < 8; ++j) { const f32x4 v = xr[64 * j]; xo[64 * j] = v; u32x2 w; w.x = cvt_pk_bf16(v.x, v.y); w.y = cvt_pk_bf16(v.z, v.w); bo[64 * j] = w; s += (v.x * v.x + v.y * v.y) + (v.z * v.z + v.w * v.w); }
        s = wave_sum(s);
        if (F.lane < 8) ((float*)(WSP(WS_MISC) + MISC_PSS))[(size_t)m * 8 + F.lane] = F.lane == 0 ? s : 0.f; }
    { float* rope = (float*)(WSP(WS_MISC) + MISC_ROPE); const int gt = F.bid * NTHREADS + F.tid;
      if (gt < 256 * 32) { const int pos = gt >> 5, i = gt & 31; const float inv = powf(10000.0f, -(float)(2 * i) / 64.0f); float sn, cs; sincosf((float)pos * inv, &sn, &cs); rope[gt * 2] = cs; rope[gt * 2 + 1] = sn; }
      if (gt < 2) { float s1 = 0.f, s2 = 0.f; for (int q = 0; q < 64; ++q) { s1 += F.in[I_LQ1][gt * 64 + q] * F.in[I_LK1][gt * 64 + q]; s2 += F.in[I_LQ2][gt * 64 + q] * F.in[I_LK2][gt * 64 + q]; }
          const float linit = 0.8f - 0.6f * expf(-0.3f * (float)(2 * gt)); ((float*)(WSP(WS_MISC) + MISC_LAM))[gt * 2] = expf(s1) - expf(s2) + linit; ((float*)(WSP(WS_MISC) + MISC_LAM))[gt * 2 + 1] = linit; } }
    __syncthreads();
    for (int w = F.bid; w < 2 * S5G; w += F.G) s5_precompute_group(F, w / S5G, w % S5G);
}

#ifndef GQA_SDEPTH
#define GQA_SDEPTH 1
#endif
#ifndef DIFF_SDEPTH
#define DIFF_SDEPTH 1
#endif
namespace att {
constexpr int NW = 8, QBLK = 32, KVBLK = 64, DV = 128;
constexpr float THR = 8.f;
__device__ __forceinline__ int crow(int r, int hi) { return (r & 3) + 8 * (r >> 2) + 4 * hi; }
template <int DQK> __device__ __forceinline__ int kswz(int row, int colB) { if (DQK == 128) return row * 256 + (colB ^ ((row & 7) << 4)); else return row * 128 + (colB ^ (((row >> 1) & 7) << 4)); }
__device__ __forceinline__ int v_st(int k, int c) { const int kk = (k & ~0xC) | ((k & 4) << 1) | ((k & 8) >> 1); return ((kk >> 3) * 4 + (c >> 5)) * 512 + ((kk & 7) * 32 + (c & 31)) * 2; }
__device__ __forceinline__ int v_rd_base(int lane) { return ((lane & 3) << 3) | (((lane >> 2) & 3) << 6) | (((lane >> 4) & 1) << 5) | (((lane >> 5) & 1) << 8); }
constexpr int v_rd_off(int d0, int ks, int half) { return d0 * 512 + ks * 4096 + half * 2048; }
template <int OFF> __device__ __forceinline__ s16x4 tr_read(int vb) { s16x4 r; asm volatile("ds_read_b64_tr_b16 %0, %1 offset:%2" : "=&v"(r) : "v"(vb), "i"(OFF) : "memory"); return r; }
template <int D0> __device__ __forceinline__ void pv_one(f32x16& od, int vb, bf16x8 pa0, bf16x8 pa1, bf16x8 pa2, bf16x8 pa3) {
  const s16x4 l0 = tr_read<v_rd_off(D0, 0, 0)>(vb), h0 = tr_read<v_rd_off(D0, 0, 1)>(vb), l1 = tr_read<v_rd_off(D0, 1, 0)>(vb), h1 = tr_read<v_rd_off(D0, 1, 1)>(vb);
  const s16x4 l2 = tr_read<v_rd_off(D0, 2, 0)>(vb), h2 = tr_read<v_rd_off(D0, 2, 1)>(vb), l3 = tr_read<v_rd_off(D0, 3, 0)>(vb), h3 = tr_read<v_rd_off(D0, 3, 1)>(vb);
  asm volatile("s_waitcnt lgkmcnt(0)" ::: "memory"); SBAR();
#define PK(L, H) (bf16x8){L[0], L[1], L[2], L[3], H[0], H[1], H[2], H[3]}
  od = __builtin_amdgcn_mfma_f32_32x32x16_bf16(pa0, PK(l0, h0), od, 0, 0, 0);
  od = __builtin_amdgcn_mfma_f32_32x32x16_bf16(pa1, PK(l1, h1), od, 0, 0, 0);
  od = __builtin_amdgcn_mfma_f32_32x32x16_bf16(pa2, PK(l2, h2), od, 0, 0, 0);
  od = __builtin_amdgcn_mfma_f32_32x32x16_bf16(pa3, PK(l3, h3), od, 0, 0, 0);
#undef PK
}
__device__ __forceinline__ void pv_d0(f32x16* o, int vb, bf16x8 pa0, bf16x8 pa1, bf16x8 pa2, bf16x8 pa3) {
  pv_one<0>(o[0], vb, pa0, pa1, pa2, pa3); pv_one<1>(o[1], vb, pa0, pa1, pa2, pa3); pv_one<2>(o[2], vb, pa0, pa1, pa2, pa3); pv_one<3>(o[3], vb, pa0, pa1, pa2, pa3);
}
template <int DQK> struct Cst { static constexpr float SCALE = DQK == 128 ? 0.088388347648318440f : 0.125f; static constexpr float C = SCALE * 1.4426950408889634f; };

template <int DQK>
__device__ __forceinline__ void partialSM(f32x16& p0, f32x16& p1, float& m_reg, float& mn, float& alpha) {
  constexpr float C = Cst<DQK>::C, SCALE = Cst<DQK>::SCALE;
  float pmax = p0[0];
#pragma unroll
  for (int r = 1; r < 16; ++r) pmax = fmaxf(pmax, p0[r]);
#pragma unroll
  for (int r = 0; r < 16; ++r) pmax = fmaxf(pmax, p1[r]);
  { auto rr = __builtin_amdgcn_permlane32_swap(__float_as_uint(pmax), __float_as_uint(pmax), false, false);
    pmax = fmaxf(__uint_as_float(rr[0]), __uint_as_float(rr[1])); }
  if (__builtin_expect(__all(pmax - m_reg <= THR / SCALE), 1)) { mn = m_reg; alpha = 1.f; }
  else { mn = fmaxf(m_reg, pmax); alpha = __builtin_amdgcn_exp2f((m_reg - mn) * C); m_reg = mn; }
  const float mnC = -mn * C;
#pragma unroll
  for (int r = 0; r < 16; ++r) p0[r] = fmaf(p0[r], C, mnC);
#pragma unroll
  for (int r = 0; r < 16; ++r) p1[r] = fmaf(p1[r], C, mnC);
#pragma unroll
  for (int r = 0; r < 16; ++r) p0[r] = __builtin_amdgcn_exp2f(p0[r]);
}
__device__ __forceinline__ void finishSM(f32x16& p0, f32x16& p1, float alpha, float& l_reg, bf16x8& pa0, bf16x8& pa1, bf16x8& pa2, bf16x8& pa3) {
#pragma unroll
  for (int r = 0; r < 16; ++r) p1[r] = __builtin_amdgcn_exp2f(p1[r]);
  float ps = 0;
#pragma unroll
  for (int r = 0; r < 16; ++r) ps += p0[r];
#pragma unroll
  for (int r = 0; r < 16; ++r) ps += p1[r];
  { auto rr = __builtin_amdgcn_permlane32_swap(__float_as_uint(ps), __float_as_uint(ps), false, false);
    ps = __uint_as_float(rr[0]) + __uint_as_float(rr[1]); }
  l_reg = l_reg * alpha + ps;
#define PK4(P, BASE, OUT) do { unsigned a0 = cvt_pk_bf16(P[BASE + 0], P[BASE + 1]), a1 = cvt_pk_bf16(P[BASE + 2], P[BASE + 3]);   \
    unsigned b0 = cvt_pk_bf16(P[BASE + 4], P[BASE + 5]), b1 = cvt_pk_bf16(P[BASE + 6], P[BASE + 7]);                              \
    auto r0 = __builtin_amdgcn_permlane32_swap(a0, b0, false, false); auto r1 = __builtin_amdgcn_permlane32_swap(a1, b1, false, false); \
    u32x4 w = {r0[0], r1[0], r0[1], r1[1]}; OUT = *reinterpret_cast<bf16x8*>(&w); } while (0)
  PK4(p0, 0, pa0); PK4(p0, 8, pa1); PK4(p1, 0, pa2); PK4(p1, 8, pa3);
#undef PK4
}
template <int DQK, bool ALIBI>
__device__ __forceinline__ void qkt(f32x16& p0, f32x16& p1, const char* Ks, const bf16x8* qr, int r32, int hi, float dq, float sl) {
  if (ALIBI) {
    float dh = dq - (float)(4 * hi); asm volatile("" : "+v"(dh));
#pragma unroll
    for (int r = 0; r < 16; ++r) { const float c = (float)((r & 3) + 8 * (r >> 2)); p0[r] = -sl * fabsf(dh - c); p1[r] = -sl * fabsf(dh - (c + 32.f)); }
  } else { p0 = f32x16{}; p1 = f32x16{}; }
#pragma unroll
  for (int d0 = 0; d0 < DQK / 16; ++d0) { const int cb = (d0 * 16 + hi * 8) * 2;
    const bf16x8 b0 = *reinterpret_cast<const bf16x8*>(Ks + kswz<DQK>(r32, cb));
    const bf16x8 b1 = *reinterpret_cast<const bf16x8*>(Ks + kswz<DQK>(32 + r32, cb));
    p0 = __builtin_amdgcn_mfma_f32_32x32x16_bf16(b0, qr[d0], p0, 0, 0, 0);
    p1 = __builtin_amdgcn_mfma_f32_32x32x16_bf16(b1, qr[d0], p1, 0, 0, 0); }
}

template <int DQK, bool ALIBI, int SDEPTH>
__device__ __forceinline__ void attn_pass(const bf16_t* __restrict__ Qw, const bf16_t* __restrict__ Kh, const bf16_t* __restrict__ Vh, int seq, char* lds, f32x16 (&o)[4], float qpos, float sl, int tid) {
  constexpr int SHM_V = KVBLK * DV * 2, SHM_K = KVBLK * DQK * 2;
  const int wid = tid >> 6, lane = tid & 63, r32 = lane & 31, hi = lane >> 5;
  char* V_lds = lds; char* K_lds = lds + 2 * SHM_V;
  float* ws = (float*)(lds + 2 * SHM_V + 2 * SHM_K) + wid * 64; float* li_l = ws; float* al_l = ws + 32;
  float m_reg = -1e30f, l_reg = 0; bf16x8 qr[DQK / 16];
#pragma unroll
  for (int d0 = 0; d0 < 4; ++d0) o[d0] = f32x16{};
#pragma unroll
  for (int d0 = 0; d0 < DQK / 16; ++d0) qr[d0] = *reinterpret_cast<const bf16x8*>(Qw + d0 * 16);
  const int sr = tid >> 4, sc = (tid & 15) * 8, vst0 = v_st(sr, sc), vst1 = v_st(32 + sr, sc);
  const int kr = DQK == 128 ? sr : (tid >> 3), kc = DQK == 128 ? sc : (tid & 7) * 8;
  const int vb0 = (int)(uintptr_t)V_lds + v_rd_base(lane);
  struct { bf16x8 vs0, vs1, ks0, ks1; } sr_[SDEPTH];
#define SLOAD(i, k0) do { sr_[i].vs0 = *(const bf16x8*)(Vh + (size_t)((k0) + sr) * ZLD + sc); sr_[i].vs1 = *(const bf16x8*)(Vh + (size_t)((k0) + 32 + sr) * ZLD + sc); \
    sr_[i].ks0 = *(const bf16x8*)(Kh + (size_t)((k0) + kr) * ZLD + kc); if (DQK == 128) sr_[i].ks1 = *(const bf16x8*)(Kh + (size_t)((k0) + 32 + kr) * ZLD + kc); } while (0)
#define SWRITE(b, i) do { *(bf16x8*)(V_lds + (b) * SHM_V + vst0) = sr_[i].vs0; *(bf16x8*)(V_lds + (b) * SHM_V + vst1) = sr_[i].vs1; \
    *(bf16x8*)(K_lds + (b) * SHM_K + kswz<DQK>(kr, kc * 2)) = sr_[i].ks0; if (DQK == 128) *(bf16x8*)(K_lds + (b) * SHM_K + kswz<DQK>(32 + kr, kc * 2)) = sr_[i].ks1; } while (0)
#define SWAIT() do { if (SDEPTH == 1) asm volatile("s_waitcnt vmcnt(0)" ::: "memory"); else if (DQK == 128) asm volatile("s_waitcnt vmcnt(4)" ::: "memory"); else asm volatile("s_waitcnt vmcnt(3)" ::: "memory"); } while (0)
#define RESC(a) do { if (__any((a) < 1.f)) { if (hi == 0) al_l[r32] = (a); asm volatile("s_waitcnt lgkmcnt(0)" ::: "memory"); \
    _Pragma("unroll") for (int d = 0; d < 4; ++d) _Pragma("unroll") for (int r = 0; r < 16; ++r) o[d][r] *= al_l[crow(r, hi)]; } } while (0)
  f32x16 pA0, pA1, pB0, pB1; float mnA, mnB, alA, alB; bf16x8 pa0, pa1, pa2, pa3; const int NT = seq / KVBLK;
  constexpr int SE = 0, SO = SDEPTH - 1;
  SLOAD(SE, 0); asm volatile("s_waitcnt vmcnt(0)" ::: "memory"); SWRITE(0, SE); __syncthreads();
  qkt<DQK, ALIBI>(pA0, pA1, K_lds, qr, r32, hi, qpos, sl); partialSM<DQK>(pA0, pA1, m_reg, mnA, alA);
  SLOAD(SO, KVBLK); if (SDEPTH == 2) { if (2 < NT) SLOAD(SE, 2 * KVBLK); }
  SWAIT(); SWRITE(1, SO); __syncthreads();
  _Pragma("unroll 1") for (int j = 1; j + 1 < NT; j += 2) {
    SBAR(); qkt<DQK, ALIBI>(pB0, pB1, K_lds + SHM_K, qr, r32, hi, qpos - (float)(j * KVBLK), sl);
    finishSM(pA0, pA1, alA, l_reg, pa0, pa1, pa2, pa3); SBAR();
    SLOAD(SO, (j + SDEPTH) * KVBLK); SBAR();
    pv_d0(o, vb0, pa0, pa1, pa2, pa3); partialSM<DQK>(pB0, pB1, m_reg, mnB, alB);
    __syncthreads(); SWAIT(); SWRITE(0, SE);
    RESC(alB); __syncthreads();
    SBAR(); qkt<DQK, ALIBI>(pA0, pA1, K_lds, qr, r32, hi, qpos - (float)((j + 1) * KVBLK), sl);
    finishSM(pB0, pB1, alB, l_reg, pa0, pa1, pa2, pa3); SBAR();
    if (SDEPTH == 1 || j + 3 < NT) SLOAD(SE, (j + 1 + SDEPTH) * KVBLK); SBAR();
    pv_d0(o, vb0 + SHM_V, pa0, pa1, pa2, pa3); partialSM<DQK>(pA0, pA1, m_reg, mnA, alA);
    __syncthreads(); SWAIT(); SWRITE(1, SO);
    RESC(alA); __syncthreads();
  }
  SBAR(); qkt<DQK, ALIBI>(pB0, pB1, K_lds + SHM_K, qr, r32, hi, qpos - (float)((NT - 1) * KVBLK), sl);
  finishSM(pA0, pA1, alA, l_reg, pa0, pa1, pa2, pa3); SBAR();
  pv_d0(o, vb0, pa0, pa1, pa2, pa3); partialSM<DQK>(pB0, pB1, m_reg, mnB, alB);
  __syncthreads(); RESC(alB);
  finishSM(pB0, pB1, alB, l_reg, pa0, pa1, pa2, pa3); SBAR();
  pv_d0(o, vb0 + SHM_V, pa0, pa1, pa2, pa3);
  if (hi == 0) li_l[r32] = l_reg; asm volatile("s_waitcnt lgkmcnt(0)" ::: "memory");
#pragma unroll
  for (int r = 0; r < 16; ++r) { const float rl = __builtin_amdgcn_rcpf(li_l[crow(r, hi)]);
#pragma unroll
    for (int d0 = 0; d0 < 4; ++d0) o[d0][r] *= rl; }
#undef SLOAD
#undef SWRITE
#undef SWAIT
#undef RESC
}
}

__device__ __forceinline__ void gqa_attn_phase(const Frame& F) {
    const bf16_t* Z = (const bf16_t*)POOLP(PL_Z); bf16_t* CAT = (bf16_t*)POOLP(PL_CAT);
    constexpr int NU_S = 16 * (T_S / 256), NU = NU_S + 16 * (T_P / 256);
    for (int L = F.bid; L < NU; L += F.G) {
        int tid = threadIdx.x; asm volatile("" : "+v"(tid));
        const int lane = tid & 63, r32 = lane & 31, hi = lane >> 5, wid = tid >> 6;
        int seq, head, qb;
        if (L < NU_S) { const int x = L & 7, r = L >> 3, kvh = x & 3, half = x >> 2; seq = 1; head = kvh * 4 + (r & 3); qb = half * 32 + (r >> 2); }
        else { const int Lp = L - NU_S, x = Lp & 7, r = Lp >> 3, kvh = x & 3, half = x >> 2; seq = 0; head = kvh * 4 + (r & 3); qb = half * 16 + (r >> 2); }
        const int t0 = seq ? T_P : 0, slen = seq ? T_S : T_P, kvh = head >> 2;
        const bf16_t* Qw = Z + (size_t)(t0 + qb * 256 + wid * 32 + r32) * ZLD + head * 128 + hi * 8;
        const bf16_t* Kh = Z + (size_t)t0 * ZLD + 2048 + kvh * 128; const bf16_t* Vh = Z + (size_t)t0 * ZLD + 2560 + kvh * 128;
        f32x16 o[4];
        att::attn_pass<128, false, GQA_SDEPTH>(Qw, Kh, Vh, slen, F.ldsg, o, 0.f, 0.f, tid);
        bf16_t* Ow = CAT + (size_t)(t0 + qb * 256 + wid * 32) * DM + head * 128;
#pragma unroll
        for (int r = 0; r < 16; ++r) { const int orow = att::crow(r, hi);
#pragma unroll
            for (int d0 = 0; d0 < 4; ++d0) Ow[(size_t)orow * DM + d0 * 32 + r32] = f2bf(o[d0][r]); }
    }
}

__device__ __forceinline__ void qk_bound_pass(const Frame& F, int e) {
    const bf16_t* Z = (const bf16_t*)POOLP(PL_Z); unsigned* ctl = (unsigned*)WSP(WS_CTL) + CW_QKB + e * 64;
    const int gw = F.bid * NWAVES + F.wave, NGW = F.G * NWAVES, lane = F.lane;
    float mx[2][2] = {{0.f, 0.f}, {0.f, 0.f}};
    for (int t = gw; t < TT; t += NGW) {
        const bf16_t* row = Z + (size_t)t * ZLD + lane * 16;
#pragma unroll
        for (int qk = 0; qk < 2; ++qk) { const u32x4 a = *(const u32x4*)(row + qk * 1024), b = *(const u32x4*)(row + qk * 1024 + 8);
            float s = bflo(a.x) * bflo(a.x) + bfhi(a.x) * bfhi(a.x) + bflo(a.y) * bflo(a.y) + bfhi(a.y) * bfhi(a.y) + bflo(a.z) * bflo(a.z) + bfhi(a.z) * bfhi(a.z) + bflo(a.w) * bflo(a.w) + bfhi(a.w) * bfhi(a.w)
                    + bflo(b.x) * bflo(b.x) + bfhi(b.x) * bfhi(b.x) + bflo(b.y) * bflo(b.y) + bfhi(b.y) * bfhi(b.y) + bflo(b.z) * bflo(b.z) + bfhi(b.z) * bfhi(b.z) + bflo(b.w) * bflo(b.w) + bfhi(b.w) * bfhi(b.w);
            s += __shfl_xor(s, 1); s += __shfl_xor(s, 2);
            if (t < T_P) mx[0][qk] = fmaxf(mx[0][qk], s); else mx[1][qk] = fmaxf(mx[1][qk], s); }
    }
    LAS float* red = (LAS float*)F.lds;
    if ((lane & 3) == 0) {
#pragma unroll
        for (int sq = 0; sq < 2; ++sq)
#pragma unroll
            for (int qk = 0; qk < 2; ++qk) red[(F.wave * 4 + sq * 2 + qk) * 16 + (lane >> 2)] = mx[sq][qk]; }
    LDS_WAIT(); __syncthreads();
    if (F.tid < 64) { float m = 0.f;
#pragma unroll
        for (int w = 0; w < 8; ++w) m = fmaxf(m, red[w * 64 + F.tid]);
        atomicMax(ctl + F.tid, __float_as_uint(m)); }
    __syncthreads();
}

__device__ __forceinline__ void diff_attn_phase(const Frame& F, int e, int rep = 0) {
    const bf16_t* Z = (const bf16_t*)POOLP(PL_Z); bf16_t* CAT = (bf16_t*)POOLP(PL_CAT); float* ST = (float*)POOLP(PL_STASH);
    const float lam = ((const float*)(WSP(WS_MISC) + MISC_LAM))[e * 2], linit = ((const float*)(WSP(WS_MISC) + MISC_LAM))[e * 2 + 1];
    const float* sg = F.in[I_SUBLN] + e * 128;
    unsigned* ctl = (unsigned*)WSP(WS_CTL); const unsigned* qkb = ctl + CW_QKB + e * 64; unsigned* qctr = ctl + CW_QUEUE + e * 64 + rep * 256;
    constexpr int NU = 8 * (T_S / 256) + 8 * (T_P / 256);
    LAS int* uslot = (LAS int*)(F.lds + RING_BYTES + 64);
    for (;;) {
        __syncthreads();
        if (threadIdx.x == 0) *uslot = (int)__hip_atomic_fetch_add(qctr, 1u, RLX_AGENT);
        LDS_WAIT(); __syncthreads();
        const int u = __builtin_amdgcn_readfirstlane(*uslot);
        if (u >= NU) break;
        int tid = threadIdx.x; asm volatile("" : "+v"(tid));
        const int lane = tid & 63, r32 = lane & 31, hi = lane >> 5, wid = tid >> 6;
        f32x4* st = (f32x4*)ST + ((size_t)F.bid * NTHREADS + tid) * 16;
        const int head = 7 - u / 96, rr = u % 96, seq = rr < 64 ? 1 : 0, qb = seq ? rr : rr - 64;
        const int t0 = seq ? T_P : 0, slen = seq ? T_S : T_P;
        const float slope = exp2f(-(float)(head + 1)), sl = slope * 8.0f;
        const bf16_t* Vh = Z + (size_t)t0 * ZLD + 2048 + head * 128;
        f32x16 o[4];
        for (int m = 0; m < 2; ++m) {
            const float q2 = __uint_as_float(__hip_atomic_load(qkb + (seq * 2 + 0) * 16 + head * 2 + m, RLX_AGENT)), k2 = __uint_as_float(__hip_atomic_load(qkb + (seq * 2 + 1) * 16 + head * 2 + m, RLX_AGENT));
            const float Bnd = 0.25f * sqrtf(q2 * k2) + 32.0f;
            float Wf = Bnd / slope; if (!(Wf < (float)slen)) Wf = (float)slen;
            const int W = (int)Wf + 1;
            int tlo = (qb * 256 - W) >> 6; if (tlo < 0) tlo = 0;
            int thi = (qb * 256 + 256 + W + 63) >> 6; if (thi > slen / 64) thi = slen / 64;
            if ((thi - tlo) & 1) { if (thi < slen / 64) ++thi; else --tlo; }
            tlo = __builtin_amdgcn_readfirstlane(tlo); thi = __builtin_amdgcn_readfirstlane(thi);
            const float qpos = (float)(qb * 256 + wid * 32 + r32 - tlo * 64);
            const bf16_t* Qw = Z + (size_t)(t0 + qb * 256 + wid * 32 + r32) * ZLD + head * 128 + m * 64 + hi * 8;
            const bf16_t* Kh = Z + (size_t)(t0 + tlo * 64) * ZLD + 1024 + head * 128 + m * 64;
            att::attn_pass<64, true, DIFF_SDEPTH>(Qw, Kh, Vh + (size_t)(tlo * 64) * ZLD, (thi - tlo) * 64, F.ldsg, o, qpos, sl, tid);
            if (m == 0) {
#pragma unroll
                for (int d0 = 0; d0 < 4; ++d0)
#pragma unroll
                    for (int q = 0; q < 4; ++q) st[d0 * 4 + q] = (f32x4){o[d0][4 * q], o[d0][4 * q + 1], o[d0][4 * q + 2], o[d0][4 * q + 3]};
            }
        }
        float ss[16];
#pragma unroll
        for (int r = 0; r < 16; ++r) ss[r] = 0.f;
#pragma unroll
        for (int d0 = 0; d0 < 4; ++d0) {
#pragma unroll
            for (int q = 0; q < 4; ++q) { const f32x4 s4 = st[d0 * 4 + q];
#pragma unroll
                for (int i = 0; i < 4; ++i) { const int r = 4 * q + i; const float a = s4[i] - lam * o[d0][r]; o[d0][r] = a; ss[r] += a * a; } }
            asm volatile("" ::: "memory"); }
#pragma unroll
        for (int r = 0; r < 16; ++r) { float s = ss[r]; s += __shfl_xor(s, 1); s += __shfl_xor(s, 2); s += __shfl_xor(s, 4); s += __shfl_xor(s, 8); s += __shfl_xor(s, 16);
            ss[r] = (1.0f - linit) / sqrtf(s * (1.f / 128.f) + SUBLN_EPS); }
        bf16_t* Ow = CAT + (size_t)(t0 + qb * 256 + wid * 32) * DM + 1024 + head * 128;
#pragma unroll
        for (int d0 = 0; d0 < 4; ++d0) { const float gcol = sg[d0 * 32 + r32];
#pragma unroll
            for (int r = 0; r < 16; ++r) Ow[(size_t)att::crow(r, hi) * DM + d0 * 32 + r32] = f2bf(o[d0][r] * ss[r] * gcol); }
    }
}

constexpr int PH_BASE = 3, PH_PER = 16, PH_END = PH_BASE + 8 * PH_PER - 1;
__host__ __device__ inline bool phase_exists(int pid) {
    if (pid < PH_BASE) return true;
    const int hl = (pid - PH_BASE) / PH_PER, k = (pid - PH_BASE) % PH_PER, f = hl & 1, l = hl >> 1;
    if (k <= 1) return true;
    if (k == 14) return hl == 7;
    if (k == 15 || f == 1 || k == 2 || k == 10 || k == 12) return false;
    if ((l & 1) && (k == 6 || k == 7 || k == 8)) return false;
    return true;
}

__device__ __forceinline__ bool fresh_frame(Frame& F) { int t = threadIdx.x; asm volatile("" : "+v"(t)); F.tid = t; F.lane = t & 63; F.wave = __builtin_amdgcn_readfirstlane(t >> 6); return true; }
__global__ void __launch_bounds__(NTHREADS, 2) fwd_kernel(Args args) {
    extern __shared__ __attribute__((aligned(16))) unsigned char lds[];
    Frame F;
    F.lds = (LAS unsigned char*)lds; F.ldsg = (char*)lds;
    F.MISC = (volatile LAS unsigned*)(F.lds + MISC_OFF);
    F.tid = threadIdx.x; F.lane = F.tid & 63; F.wave = __builtin_amdgcn_readfirstlane(F.tid >> 6);
    F.G = gridDim.x; F.bid = blockIdx.x; F.in = args.in; F.x = args.out; F.ws = args.ws;
    for (int u = F.tid; u < (LDS_BYTES - RING_BYTES) / 4; u += NTHREADS) ((LAS unsigned*)(F.lds + RING_BYTES))[u] = 0u;
    __syncthreads();
    XcdBarrier bar = xcd_barrier_post((unsigned*)(F.ws + WS_CTL) + CW_BAR + args.li * XCD_BAR_WORDS, F.MISC + 8);
    const int lo = args.ph_lo, hi = args.ph_hi;
#define PH(p) (lo <= (p) && (p) < hi && fresh_frame(F))
#define ENDPH(p) do { if ((p) + 1 < hi) xcd_barrier(bar); } while (0)
    float* const PSS = (float*)(F.ws + WS_MISC + MISC_PSS);
    const int rep = args.pad;
#ifdef PROBE_K
#define RSCALE(s) (rep == 0 ? (s) : 0.0f)
#else
#define RSCALE(s) (s)
#endif

    if (PH(0)) { prologue_phase(F); ENDPH(0); }
    if (PH(1)) {
        auto S = make_sched(F, POOLP(PL_MEMN), DM, POOLP(PL_WKVT), DM, 256, 2 * DM, 8, ZKv{});
        EpiBf16<0> E{(bf16_t*)POOLP(PL_KVB), 2 * DM, (size_t)256 * 2 * DM, 0, 0, nullptr, nullptr, nullptr};
        pg8::gemm_phase(F.lds, DM, DM, DM, S, E, F.tid); ENDPH(1);
    }
    if (PH(2)) {
        { auto S = make_sched(F, POOLP(PL_KVB), 2 * DM, POOLP(PL_WQB), DM, 256, DM, 32, ZKf{});
          EpiBf16<2> E{(bf16_t*)WSP(WS_KF), DM, (size_t)256 * DM, 0, 0, F.in[I_CN], nullptr, nullptr};
          pg8::gemm_phase(F.lds, 2 * DM, DM, 512, S, E, F.tid); }
        { auto S = make_sched(F, POOLP(PL_WOT), DM, POOLP(PL_KVB), 2 * DM, DM, 256, 32, ZVw{});
          EpiBf16<0> E{(bf16_t*)WSP(WS_VWT), 1024, (size_t)DM * 1024, 256, 2, nullptr, nullptr, nullptr};
          pg8::gemm_phase(F.lds, DM, 2 * DM, 512, S, E, F.tid); }
        ENDPH(2);
    }
    for (int hl = 0; hl < 8; ++hl) {
        const int l = hl >> 1, f = hl & 1, pb = PH_BASE + hl * PH_PER, eo = l >> 1;
        const bool even = (l & 1) == 0;
        if (PH(pb + 0)) {
            auto S = make_sched(F, WSP(WS_HB), DM, WSP(WS_WGU + (size_t)hl * SZ_WGU), DM, TT, 2 * DFF, 1, ZNone{});
            EpiSwiglu E{F.ws, DFF, F.lds};
            pg8::gemm_phase(F.lds, DM, DM, DM, S, E, F.tid);
            ENDPH(pb + 0);
        }
        if (PH(pb + 1)) {
            auto S = make_sched(F, POOLP(PL_ACT), DFF, WSP(WS_WD + (size_t)hl * SZ_WD), DFF, TT, DM, 1, ZNone{});
            { EpiResidNorm E{F.x, RSCALE(0.5f), F.ws, (LAS float*)(F.lds + EXCH_OFF)}; pg8::gemm_phase(F.lds, DFF, DFF, DFF, S, E, F.tid); }
            ENDPH(pb + 1);
        }
        if (f == 0) {
            if (even) {
                if (PH(pb + 3)) {
                    auto S = make_sched(F, WSP(WS_HB), DM, WSP(WS_WINE + (size_t)eo * SZ_WINE), DM, TT, EVEN_IN, 1, ZNone{});
                    EpiWinEven E{F.ws, F.lds};
                    pg8::gemm_phase(F.lds, DM, DM, DM, S, E, F.tid);
                    ENDPH(pb + 3);
                }
                if (PH(pb + 4)) {
                    auto S = make_sched(F, POOLP(PL_UX), S5K2, WSP(WS_WST + (size_t)eo * 64 * SZ_WST), S5K1, NCH, S5NS, S5G, ZLin{(size_t)NCH * S5K2 * 2, SZ_WST});
                    EpiF32 E{(float*)POOLP(PL_SST), S5G * S5NS, (size_t)S5NS};
                    pg8::gemm_phase(F.lds, S5K2, S5K1, S5K1, S, E, F.tid);
                    qk_bound_pass(F, eo); ENDPH(pb + 4);
                }
                if (PH(pb + 5)) { s5_scan_phase(F, eo); ENDPH(pb + 5); }
                if (PH(pb + 6)) {
                    auto S = make_sched(F, POOLP(PL_UX), S5K2, WSP(WS_TG + (size_t)eo * 64 * SZ_TG), S5K2, NCH, S5K1, S5G, ZLin{(size_t)NCH * S5K2 * 2, SZ_TG});
                    EpiS5Out E{(bf16_t*)POOLP(PL_GB)};
                    pg8::gemm_phase(F.lds, S5K2, S5K2, S5K2, S, E, F.tid); ENDPH(pb + 6);
                }
                if (PH(pb + 7)) {
                    auto S = make_sched(F, POOLP(PL_GB), S5W, WSP(WS_GLU + (size_t)eo * SZ_GLU), S5W, TT, S5W, 1, ZNone{});
                    EpiGlu E{(const bf16_t*)POOLP(PL_GB), F.in[I_GLUB] + eo * S5W, (bf16_t*)POOLP(PL_CAT)};
                    pg8::gemm_phase(F.lds, S5W, S5W, S5W, S, E, F.tid); ENDPH(pb + 7);
                }
                if (PH(pb + 8)) { diff_attn_phase(F, eo, rep); ENDPH(pb + 8); }
            } else {
                if (PH(pb + 3)) {
                    auto S = make_sched(F, WSP(WS_HB), DM, WSP(WS_WINO + (size_t)eo * SZ_WINO), DM, TT, ODD_IN, 1, ZNone{});
                    EpiBf16<1> E{(bf16_t*)POOLP(PL_Z), ZLD, 0, 0, 0, nullptr, F.ws, F.lds};
                    pg8::gemm_phase(F.lds, DM, DM, DM, S, E, F.tid); ENDPH(pb + 3);
                }
                if (PH(pb + 4)) { qk_prep_phase(F, eo); ENDPH(pb + 4); }
                if (PH(pb + 5)) { gqa_attn_phase(F); ENDPH(pb + 5); }
            }
            if (PH(pb + 9)) {
                auto S = make_sched(F, POOLP(PL_CAT), DM, even ? WSP(WS_WOUTE + (size_t)eo * SZ_SQ) : WSP(WS_WOUTO + (size_t)eo * SZ_SQ), DM, TT, DM, 1, ZNone{});
                { EpiResidNorm E{F.x, RSCALE(1.0f), F.ws, (LAS float*)(F.lds + EXCH_OFF)}; pg8::gemm_phase(F.lds, DM, DM, DM, S, E, F.tid); }
                ENDPH(pb + 9);
            }
            if (PH(pb + 11)) {
                auto S = make_sched(F, WSP(WS_HB), DM, WSP(WS_KF + (size_t)l * 2 * SZ_KF), DM, TT, 1024, 1, ZNone{}); S.split = T_P / 256; S.bseq = SZ_KF;
                EpiCrossSm E{F.ws, (LAS f32x2*)(F.lds + EXCH_OFF), F.lds};
                pg8::gemm_phase(F.lds, DM, DM, DM, S, E, F.tid);
                ENDPH(pb + 11);
            }
            if (PH(pb + 13)) {
                auto S = make_sched(F, POOLP(PL_CP), 1024, WSP(WS_VWT + (size_t)l * 2 * SZ_KF), 1024, TT, DM, 1, ZNone{}); S.split = T_P / 256; S.bseq = SZ_KF;
                EpiResidNorm E{F.x, RSCALE(1.0f), F.ws, (LAS float*)(F.lds + EXCH_OFF)};
                pg8::gemm_phase(F.lds, 1024, 1024, 1024, S, E, F.tid); ENDPH(pb + 13);
            }
        }
        if (hl == 7 && PH(pb + 14)) { final_norm_phase(F, F.in[I_FINN]); ENDPH(pb + 14); }
    }
#undef PH
#undef ENDPH
}

#ifndef MK_PER_PHASE
#define MK_PER_PHASE 0
#endif
extern "C" void kernel_launch(void* const* d_in, const int* in_sizes, int n_in, void* d_out, int out_size, void* d_ws, size_t ws_size, hipStream_t stream) {
    static int grid = 0;
    if (grid == 0) {
        if (n_in != N_IN || out_size != TT * DM || ws_size < WS_END) { fprintf(stderr, "kernel_launch: unexpected shapes: n_in %d out %d ws %zu (need %zu)\n", n_in, out_size, ws_size, (size_t)WS_END); grid = -1; return; }
        int dev = 0, cus = 0, per_cu = 0;
        if (hipGetDevice(&dev) != hipSuccess || hipDeviceGetAttribute(&cus, hipDeviceAttributeMultiprocessorCount, dev) != hipSuccess) { grid = -1; return; }
        if (hipFuncSetAttribute((const void*)fwd_kernel, hipFuncAttributeMaxDynamicSharedMemorySize, LDS_BYTES) != hipSuccess) { fprintf(stderr, "kernel_launch: hipFuncSetAttribute failed\n"); grid = -1; return; }
        if (hipOccupancyMaxActiveBlocksPerMultiprocessor(&per_cu, (const void*)fwd_kernel, NTHREADS, LDS_BYTES) != hipSuccess || per_cu < 1) { fprintf(stderr, "kernel_launch: occupancy query says %d\n", per_cu); (void)hipGetLastError(); grid = -1; return; }
        grid = cus;
    }
    if (grid < 0) return;
    (void)hipMemsetAsync((char*)d_ws + WS_CTL, 0, CTL_BYTES, stream);
    Args a{};
    for (int i = 0; i < N_IN; ++i) a.in[i] = (const float*)d_in[i];
    a.out = (float*)d_out; a.ws = (unsigned char*)d_ws; a.pad = 0;
#if MK_PER_PHASE
    int li = 0;
    for (int p = 0; p < PH_END; ++p) { if (!phase_exists(p)) continue; a.ph_lo = p; a.ph_hi = p + 1; a.li = li++; a.pad = 0;
        hipLaunchKernelGGL(fwd_kernel, dim3(grid), dim3(NTHREADS), LDS_BYTES, stream, a);
#ifdef PROBE_K
        { const int kind = p < PH_BASE ? 100 + p : (p - PH_BASE) % PH_PER;
          if (kind == PROBE_K) for (int r = 1; r <= PROBE_REPS; ++r) { a.pad = r; hipLaunchKernelGGL(fwd_kernel, dim3(grid), dim3(NTHREADS), LDS_BYTES, stream, a); } }
#endif
    }
#else
    a.ph_lo = 0; a.ph_hi = PH_END; a.li = 0;
    hipLaunchKernelGGL(fwd_kernel, dim3(grid), dim3(NTHREADS), LDS_BYTES, stream, a);
#endif
    const hipError_t le = hipPeekAtLastError();
    if (le != hipSuccess) fprintf(stderr, "kernel_launch: launch failed: %s\n", hipGetErrorName(le));
}
```

```cpp
#include <hip/hip_runtime.h>
#include <cstdio>
#include <cstdint>

#define GAS __attribute__((address_space(1)))
#define LAS __attribute__((address_space(3)))
typedef unsigned short bf16_t;
typedef short bf16x8 __attribute__((ext_vector_type(8)));
typedef short s16x4 __attribute__((ext_vector_type(4)));
typedef float f32x2 __attribute__((ext_vector_type(2)));
typedef float f32x4 __attribute__((ext_vector_type(4)));
typedef float f32x8 __attribute__((ext_vector_type(8)));
typedef float f32x16 __attribute__((ext_vector_type(16)));
typedef unsigned u32x2 __attribute__((ext_vector_type(2)));
typedef unsigned u32x4 __attribute__((ext_vector_type(4)));
typedef GAS unsigned gu32;
#define RLX_AGENT __ATOMIC_RELAXED, __HIP_MEMORY_SCOPE_AGENT
#define LDS_WAIT() asm volatile("s_waitcnt lgkmcnt(0)" ::: "memory")
#define VM_WAIT() asm volatile("s_waitcnt vmcnt(0)" ::: "memory")
#define SBAR() __builtin_amdgcn_sched_barrier(0)

__device__ __forceinline__ unsigned cvt_pk_bf16(float lo, float hi) { unsigned r; asm volatile("v_cvt_pk_bf16_f32 %0, %1, %2" : "=v"(r) : "v"(lo), "v"(hi)); return r; }
__device__ __forceinline__ float bf2f(unsigned short b) { return __uint_as_float(((unsigned)b) << 16); }
__device__ __forceinline__ float bflo(unsigned w) { return __uint_as_float(w << 16); }
__device__ __forceinline__ float bfhi(unsigned w) { return __uint_as_float(w & 0xffff0000u); }
__device__ __forceinline__ unsigned short f2bf(float f) { unsigned u = __float_as_uint(f); return (unsigned short)((u + 0x7fffu + ((u >> 16) & 1u)) >> 16); }
__device__ __forceinline__ float fast_rcp(float x) { return __builtin_amdgcn_rcpf(x); }
__device__ __forceinline__ float fast_exp2(float x) { return __builtin_amdgcn_exp2f(x); }
__device__ __forceinline__ float sigmoidf_fast(float x) { return fast_rcp(1.0f + fast_exp2(-1.4426950408889634f * x)); }
__device__ __forceinline__ float silu_f(float x) { return x * sigmoidf_fast(x); }
__device__ __forceinline__ float gelu_tanh_f(float y) { const float z = y + 0.044715f * y * y * y; return y * fast_rcp(1.0f + fast_exp2(-2.3022081982f * z)); }
__device__ __forceinline__ float wave_sum(float v) {
#pragma unroll
    for (int o = 1; o < 64; o <<= 1) v += __shfl_xor(v, o);
    return v;
}

#define XB_TMO      128
#define XB_XCNT(j)  (256  + 64 * (j))
#define XB_XSUB(j)  (1280 + 64 * (j))
#define XB_XGEN(j)  (2304 + 64 * (j))
#define XB_TOP      3328
#define XB_TOPGEN   3392
#define XCD_BAR_WORDS 3456
#define XB_SPIN_CAP (1u << 22)

__device__ __forceinline__ unsigned xb_ld(unsigned* p)              { return __hip_atomic_load(p, __ATOMIC_RELAXED, __HIP_MEMORY_SCOPE_AGENT); }
__device__ __forceinline__ unsigned xb_add(unsigned* p, unsigned v) { return __hip_atomic_fetch_add(p, v, __ATOMIC_RELAXED, __HIP_MEMORY_SCOPE_AGENT); }
__device__ __forceinline__ unsigned xb_xcc_id() { return (unsigned)__builtin_amdgcn_s_getreg((3 << 11) | 20) & 0xFu; }
#define XB_SPIN(cond, bar) do { unsigned _sp = 0; while (cond) { __builtin_amdgcn_s_sleep(1); \
    if ((++_sp & 255u) == 0u) { if (xb_ld(&(bar)[XB_TMO])) break; if (_sp > XB_SPIN_CAP) { atomicAdd(&(bar)[XB_TMO], 1u); break; } } } } while (0)

struct XcdBarrier { unsigned* bar; unsigned x; volatile LAS unsigned* st; };

__device__ __forceinline__ XcdBarrier xcd_barrier_post(unsigned* bar, volatile LAS unsigned* st) {
    XcdBarrier b; b.bar = bar; b.x = xb_xcc_id(); b.st = st;
    if (threadIdx.x == 0) (void)xb_add(&bar[XB_XCNT(b.x)], 1u);
    return b;
}
__device__ __forceinline__ void xcd_barrier_complete(unsigned* bar, unsigned x, unsigned& nloc, unsigned& nx) {
    const unsigned G = gridDim.x * gridDim.y * gridDim.z;
    unsigned sum, cnt, mine, sp = 0u;
    for (;;) {
        sum = 0u; cnt = 0u; mine = 0u;
#pragma unroll
        for (unsigned j = 0; j < 16; ++j) { const unsigned c = xb_ld(&bar[XB_XCNT(j)]); sum += c; cnt += (c > 0u) ? 1u : 0u; mine = (j == x) ? c : mine; }
        if (sum == G) break;
        __builtin_amdgcn_s_sleep(1);
        if ((++sp & 255u) == 0u) { if (xb_ld(&bar[XB_TMO])) break; if (sp > XB_SPIN_CAP) { atomicAdd(&bar[XB_TMO], 1u); break; } }
    }
    nloc = mine > 0u ? mine : 1u; nx = cnt > 0u ? cnt : 1u;
}
__device__ __forceinline__ void xcd_barrier(const XcdBarrier& b) {
    asm volatile("s_waitcnt vmcnt(0)" ::: "memory");
    __syncthreads();
    if (threadIdx.x == 0) {
        unsigned* bar = b.bar;
        __builtin_amdgcn_s_waitcnt(0);
        unsigned nloc = b.st[0], nx = b.st[1];
        if (nloc == 0u) { xcd_barrier_complete(bar, b.x, nloc, nx); b.st[0] = nloc; b.st[1] = nx; }
        const unsigned old = xb_add(&bar[XB_XSUB(b.x)], 1u);
        const unsigned gen = old / nloc;
        if (old + 1u == (gen + 1u) * nloc) {
            __builtin_amdgcn_fence(__ATOMIC_RELEASE, "agent");
            asm volatile("s_waitcnt vmcnt(0)" ::: "memory");
            const unsigned og = xb_add(&bar[XB_TOP], 1u);
            const unsigned tg = og / nx;
            if (og + 1u == (tg + 1u) * nx) xb_add(&bar[XB_TOPGEN], 1u);
            else XB_SPIN(xb_ld(&bar[XB_TOPGEN]) == tg, bar);
            __builtin_amdgcn_fence(__ATOMIC_ACQUIRE, "agent");
            xb_add(&bar[XB_XGEN(b.x)], 1u);
            asm volatile("s_waitcnt vmcnt(0)" ::: "memory");
        } else {
            XB_SPIN(xb_ld(&bar[XB_XGEN(b.x)]) == gen, bar);
            __builtin_amdgcn_fence(__ATOMIC_ACQUIRE, "agent");
            asm volatile("s_waitcnt vmcnt(0)" ::: "memory");
        }
    }
    __syncthreads();
}

namespace pg8 {
constexpr int BM = 256, BK = 64, HALF = 128, HTB = HALF * BK * 2, STAGE_BYTES = 8 * HTB, NXCD = 8, WGM = 8;
__host__ __device__ __forceinline__ int lds_byte(int r, int c) { const int st = (r >> 4) * 2 + (c >> 5), rr = r & 15, cc = c & 31, ob = rr * 64 + cc * 2; return st * 1024 + (ob ^ (((ob >> 9) & 1) << 5)); }
__host__ __device__ __forceinline__ void stage_rc(int b, int& R, int& C) { const int st = b / 1024, sb = b % 1024, swz = sb ^ (((sb >> 9) & 1) << 5); R = (st >> 1) * 16 + swz / 64; C = (st & 1) * 32 + (swz % 64) / 2; }
__host__ __device__ __forceinline__ int perm32(int rho) { const int n = rho >> 4, i = rho & 15; return 8 * (i >> 2) + 4 * n + (i & 3); }

struct Unit { int pm, pn, z; };
struct Enum {
    int nM, nN, nZ, nwg, G, c, rev;
    __device__ __forceinline__ void init(int nM_, int nN_, int nZ_, int G_, int c_) { nM = nM_; nN = nN_; nZ = nZ_; nwg = nM * nN * nZ; G = G_; c = c_; rev = 0; }
    __device__ __forceinline__ bool next(int i, Unit& u) const {
        const long L = (long)i * G + c; if (L >= nwg) return false;
        int wgid = (int)L; { const int q = nwg / NXCD, r = nwg % NXCD, xcd = wgid % NXCD, off = wgid / NXCD; wgid = (xcd < r ? xcd * (q + 1) : r * (q + 1) + (xcd - r) * q) + off; }
        const int per = nM * nN; u.z = wgid / per; wgid -= u.z * per;
        const int nig = WGM * nN, gid = wgid / nig, fm = gid * WGM, gsz = (nM - fm) < WGM ? (nM - fm) : WGM;
        u.pm = fm + ((wgid % nig) % gsz); u.pn = (wgid % nig) / gsz; if (rev) u.pm = nM - 1 - u.pm; return true;
    }
};

template <class Epi, class Sched>
__device__ __forceinline__ void gemm_phase(LAS unsigned char* lds, const int lda, const int ldb, const int K, const Sched& S, const Epi& E, const int tid) {
    const int wid = __builtin_amdgcn_readfirstlane(tid >> 6), lane = tid & 63, wr = wid >> 2, wc = wid & 3, fr = lane & 15, fq = lane >> 4;
    const int nt = K / BK;
    unsigned voffA[2], voffB[2];
#pragma unroll
    for (int i = 0; i < 2; ++i) { int R, C; stage_rc(tid * 16 + i * 8192, R, C); const int Rb = Epi::PERM ? ((R & ~31) + perm32(R & 31)) : R;
        voffA[i] = (unsigned)(R * lda + C) * 2u; voffB[i] = (unsigned)(Rb * ldb + C) * 2u; }
    const size_t kstep = (size_t)(BK * 2);
    const size_t hstepA = (size_t)HALF * lda * 2, hstepB = (size_t)HALF * ldb * 2;
    const unsigned ldsw = (unsigned)wid * 1024u;
    const int aoff = lds_byte(wr * 64 + fr, fq * 8), boff = lds_byte(wc * 32 + fr, fq * 8);
#define PG8_SA(b, h) (((b) * 2 + (h)) * HTB)
#define PG8_SB(b, h) ((4 + (b) * 2 + (h)) * HTB)
#define PG8_STAGE(bufoff, gbase, voff) do { _Pragma("unroll") for (int _i = 0; _i < 2; ++_i) \
        __builtin_amdgcn_global_load_lds((const unsigned*)((const char*)(gbase) + (voff)[_i]), (LAS unsigned*)(lds + (bufoff) + ldsw + _i * 8192), 16, 0, 0); } while (0)
#define PG8_LDA(dst, b, h) do { _Pragma("unroll") for (int m = 0; m < 4; ++m) _Pragma("unroll") for (int k = 0; k < 2; ++k) dst[m][k] = *(const LAS bf16x8*)(lds + PG8_SA(b, h) + aoff + m * 2048 + k * 1024); } while (0)
#define PG8_LDB(dst, b, h) do { _Pragma("unroll") for (int n = 0; n < 2; ++n) _Pragma("unroll") for (int k = 0; k < 2; ++k) dst[n][k] = *(const LAS bf16x8*)(lds + PG8_SB(b, h) + boff + n * 2048 + k * 1024); } while (0)
#define PG8_MMA(ai, bj, At, Bt) do { __builtin_amdgcn_s_setprio(1); _Pragma("unroll") for (int m = 0; m < 4; ++m) _Pragma("unroll") for (int n = 0; n < 2; ++n) _Pragma("unroll") for (int k = 0; k < 2; ++k) \
        acc[ai][bj][m][n] = __builtin_amdgcn_mfma_f32_16x16x32_bf16(Bt[n][k], At[m][k], acc[ai][bj][m][n], 0, 0, 0); __builtin_amdgcn_s_setprio(0); } while (0)
#define PG8_WAIT_V(n) asm volatile("s_waitcnt vmcnt(" #n ")" ::: "memory")
#define PG8_WAIT_L(n) asm volatile("s_waitcnt lgkmcnt(" #n ")" ::: "memory")
#define PG8_BAR __builtin_amdgcn_s_barrier()
#define PG8_SCHED __builtin_amdgcn_sched_barrier(0)
    Unit cur, nxt; int ui = 0;
    if (!S.next(0, cur)) return;
    f32x4 acc[2][2][4][2];
#pragma unroll
    for (int a = 0; a < 2; ++a)
#pragma unroll
        for (int b = 0; b < 2; ++b)
#pragma unroll
            for (int m = 0; m < 4; ++m)
#pragma unroll
                for (int n = 0; n < 2; ++n) acc[a][b][m][n] = (f32x4){0.f, 0.f, 0.f, 0.f};
    bf16x8 At[4][2], B0[2][2], B1[2][2];
    const char* cA = S.a_base(cur); const char* cB = S.b_base(cur);
    {
        PG8_STAGE(PG8_SB(0, 0), cB, voffB); PG8_STAGE(PG8_SB(0, 1), cB + hstepB, voffB); PG8_STAGE(PG8_SA(0, 0), cA, voffA); PG8_STAGE(PG8_SA(0, 1), cA + hstepA, voffA);
        if (wr == 1) PG8_BAR;
        PG8_WAIT_V(2); PG8_BAR;
        PG8_STAGE(PG8_SB(1, 0), cB + kstep, voffB); PG8_STAGE(PG8_SA(1, 0), cA + kstep, voffA); PG8_STAGE(PG8_SB(1, 1), cB + hstepB + kstep, voffB);
        PG8_WAIT_V(6); PG8_BAR;
    }
    for (;;) {
        if constexpr (Epi::PREFETCH) E.prefetch(lds, cur, ui, wid, lane);
        const bool has_next = S.next(ui + 1, nxt);
        const char* nA = has_next ? S.a_base(nxt) : cA; const char* nB = has_next ? S.b_base(nxt) : cB;
        for (int t = 0; t < nt; t += 2) {
            const bool last = (t == nt - 2);
            const char* a1 = cA + (size_t)(t + 1) * kstep;
            const char* a2 = last ? nA : cA + (size_t)(t + 2) * kstep; const char* b2 = last ? nB : cB + (size_t)(t + 2) * kstep;
            const char* a3 = a2 + kstep; const char* b3 = b2 + kstep;
            PG8_LDB(B0, 0, 0); PG8_LDB(B1, 0, 1); PG8_SCHED; PG8_LDA(At, 0, 0); PG8_STAGE(PG8_SA(1, 1), a1 + hstepA, voffA);
            PG8_WAIT_V(8); PG8_WAIT_L(0); PG8_BAR; PG8_MMA(0, 0, At, B0); PG8_MMA(0, 1, At, B1); PG8_BAR; PG8_SCHED;
            PG8_LDA(At, 0, 1); PG8_STAGE(PG8_SB(0, 0), b2, voffB); PG8_STAGE(PG8_SB(0, 1), b2 + hstepB, voffB); PG8_STAGE(PG8_SA(0, 0), a2, voffA);
            PG8_WAIT_V(8); PG8_WAIT_L(0); PG8_BAR; PG8_MMA(1, 0, At, B0); PG8_MMA(1, 1, At, B1); PG8_BAR; PG8_SCHED;
            PG8_LDB(B0, 1, 0); PG8_LDB(B1, 1, 1); PG8_SCHED; PG8_LDA(At, 1, 0); PG8_STAGE(PG8_SA(0, 1), a2 + hstepA, voffA);
            PG8_WAIT_V(8); PG8_WAIT_L(0); PG8_BAR; PG8_MMA(0, 0, At, B0); PG8_MMA(0, 1, At, B1); PG8_BAR; PG8_SCHED;
            PG8_LDA(At, 1, 1); PG8_STAGE(PG8_SB(1, 0), b3, voffB); PG8_STAGE(PG8_SB(1, 1), b3 + hstepB, voffB); PG8_STAGE(PG8_SA(1, 0), a3, voffA);
            PG8_WAIT_V(8); PG8_WAIT_L(0); PG8_BAR; PG8_MMA(1, 0, At, B0); PG8_MMA(1, 1, At, B1); PG8_BAR; PG8_SCHED;
        }
        if (wr == 0) PG8_BAR;
        E(acc, cur, wr, wc, fr, fq, ui);
        if (!has_next) break;
#pragma unroll
        for (int a = 0; a < 2; ++a)
#pragma unroll
            for (int b = 0; b < 2; ++b)
#pragma unroll
                for (int m = 0; m < 4; ++m)
#pragma unroll
                    for (int n = 0; n < 2; ++n) acc[a][b][m][n] = (f32x4){0.f, 0.f, 0.f, 0.f};
        cur = nxt; cA = nA; cB = nB; ++ui;
        if (wr == 1) PG8_BAR;
    }
    PG8_WAIT_V(0);
    PG8_BAR;
#undef PG8_SA
#undef PG8_SB
#undef PG8_STAGE
#undef PG8_LDA
#undef PG8_LDB
#undef PG8_MMA
#undef PG8_WAIT_V
#undef PG8_WAIT_L
#undef PG8_BAR
#undef PG8_SCHED
}
}

constexpr int DM = 2048, T_P = 8192, T_S = 16384, TT = T_P + T_S, DEPTH = 4, NMEM = 256, DFF = 5632;
constexpr int S5W = 1024, S5G = 64, S5H = 16, S5P = 64, LC = 32, NCH = TT / LC, NCH_P = T_P / LC;
constexpr int S5K1 = LC * S5H  , S5NS = 4 * S5P  , S5K2 = S5K1 + S5NS  ;
constexpr int EVEN_IN = 4096, ODD_IN = 3072, ZLD = 3072;
constexpr float EPS = 1e-6f, SUBLN_EPS = 1e-5f;
constexpr int NWAVES = 8, NTHREADS = 512;

enum { I_XP = 0, I_XS, I_MP, I_MS, I_F1N, I_F1GU, I_F1D, I_MIXN, I_EWIN, I_EWOUT, I_LRE, I_LIM, I_LDT, I_BRE, I_BIM, I_CRE, I_CIM, I_S5D, I_GLUW, I_GLUB,
       I_LQ1, I_LK1, I_LQ2, I_LK2, I_SUBLN, I_OWIN, I_OWOUT, I_QN, I_KN, I_CN, I_MN, I_CWQ, I_CWKV, I_CWO, I_F2N, I_F2GU, I_F2D, I_FINN, N_IN };

constexpr size_t MiB = 1u << 20;
constexpr size_t WS_CTL = 0, CTL_BYTES = 2 * MiB;
constexpr size_t WS_WGU = 2 * MiB;
constexpr size_t SZ_WGU = (size_t)2 * DFF * DM * 2;
constexpr size_t WS_WD = WS_WGU + 8 * SZ_WGU;
constexpr size_t SZ_WD = (size_t)DM * DFF * 2;
constexpr size_t WS_WINE = WS_WD + 8 * SZ_WD;
constexpr size_t SZ_WINE = (size_t)EVEN_IN * DM * 2;
constexpr size_t WS_WOUTE = WS_WINE + 2 * SZ_WINE;
constexpr size_t SZ_SQ = (size_t)DM * DM * 2;
constexpr size_t WS_GLU = WS_WOUTE + 2 * SZ_SQ;
constexpr size_t SZ_GLU = (size_t)S5W * S5W * 2;
constexpr size_t WS_WINO = WS_GLU + 2 * SZ_GLU;
constexpr size_t SZ_WINO = (size_t)ODD_IN * DM * 2;
constexpr size_t WS_WOUTO = WS_WINO + 2 * SZ_WINO;
constexpr size_t WS_KF = WS_WOUTO + 2 * SZ_SQ;
constexpr size_t SZ_KF = (size_t)1024 * DM * 2;
constexpr size_t WS_VWT = WS_KF + 8 * SZ_KF;
constexpr size_t WS_WST = WS_VWT + 8 * SZ_KF;
constexpr size_t SZ_WST = (size_t)S5NS * S5K1 * 2;
constexpr size_t WS_TG = WS_WST + 2 * 64 * SZ_WST;
constexpr size_t SZ_TG = (size_t)S5K1 * S5K2 * 2;
constexpr size_t WS_HB = WS_TG + 2 * 64 * SZ_TG;
constexpr size_t SZ_HB = (size_t)TT * DM * 2;
constexpr size_t WS_MISC = WS_HB + SZ_HB;
constexpr size_t MISC_ROPE = 0, MISC_AL = 65536  , MISC_LAM = 65536 + 131072  , MISC_PSS = 262144  ;
constexpr size_t WS_POOL = WS_MISC + MiB;
constexpr size_t PL_ACT = 0;
constexpr size_t PL_Z = 0;
constexpr size_t PL_UX = 144 * MiB;
constexpr size_t PL_KC = 144 * MiB;
constexpr size_t PL_SST = 216 * MiB;
constexpr size_t PL_GB = 264 * MiB;
constexpr size_t PL_CAT = 312 * MiB;
constexpr size_t PL_STASH = 408 * MiB;
constexpr size_t PL_CS = 0;
constexpr size_t PL_CP = 96 * MiB;
constexpr size_t PL_WQB = 0;
constexpr size_t PL_WKVT = 32 * MiB;
constexpr size_t PL_WOT = 96 * MiB;
constexpr size_t PL_MEMN = 128 * MiB;
constexpr size_t PL_KVB = 136 * MiB;
constexpr size_t POOL_BYTES = 440 * MiB;
constexpr size_t WS_X = WS_POOL + POOL_BYTES;
constexpr size_t WS_END = WS_X + (size_t)TT * DM;

constexpr int CW_BAR = 4096;
constexpr int CW_DBG = 1024;
constexpr int CW_QKB = 2048;
constexpr int CW_QUEUE = 2304;

constexpr int EXCH_OFF = 131072  , PSSB_OFF = 139264  , RING_BYTES = 155648, MISC_OFF = RING_BYTES + 320, LDS_BYTES = 159744;

struct Args { const float* in[N_IN]; float* out; unsigned char* ws; int ph_lo, ph_hi, li, pad; };
struct Frame {
    LAS unsigned char* lds; char* ldsg;
    volatile LAS unsigned* MISC;
    int tid, lane, wave, G, bid;
    const float* const* in; float* x; unsigned char* ws;
};
#define WSP(off) (F.ws + (off))
#define POOLP(off) (F.ws + WS_POOL + (off))

struct ZNone { __device__ __forceinline__ size_t aoff(int) const { return 0; } __device__ __forceinline__ size_t boff(int) const { return 0; } };
struct ZLin { size_t as, bs; __device__ __forceinline__ size_t aoff(int z) const { return (size_t)z * as; } __device__ __forceinline__ size_t boff(int z) const { return (size_t)z * bs; } };
struct ZKv { __device__ __forceinline__ size_t aoff(int z) const { return (size_t)z * (256 * 2048 * 2); } __device__ __forceinline__ size_t boff(int z) const { return (size_t)(z >> 1) * ((size_t)4096 * 2048 * 2); } };
struct ZKf { __device__ __forceinline__ size_t aoff(int z) const { return (size_t)(z >> 2) * ((size_t)256 * 4096 * 2) + (size_t)(z & 3) * 1024; }
             __device__ __forceinline__ size_t boff(int z) const { return (size_t)(z >> 3) * ((size_t)2048 * 2048 * 2) + (size_t)(z & 3) * 1024; } };
struct ZVw { __device__ __forceinline__ size_t aoff(int z) const { return (size_t)(z >> 3) * ((size_t)2048 * 2048 * 2) + (size_t)(z & 3) * 1024; }
             __device__ __forceinline__ size_t boff(int z) const { return (size_t)(z >> 2) * ((size_t)256 * 4096 * 2) + 4096 + (size_t)(z & 3) * 1024; } };
template <class ZM>
struct Sched : pg8::Enum {
    const char* A; const char* B; size_t atile, btile; int split; size_t bseq; ZM zm;
    __device__ __forceinline__ const char* a_base(const pg8::Unit& u) const { return A + (size_t)u.pm * atile + zm.aoff(u.z); }
    __device__ __forceinline__ const char* b_base(const pg8::Unit& u) const { return B + (size_t)u.pn * btile + zm.boff(u.z) + (u.pm >= split ? bseq : 0); }
};
template <class ZM>
__device__ __forceinline__ Sched<ZM> make_sched(const Frame& F, const void* A, int lda, const void* B, int ldb, int M, int N, int nZ, ZM zm) {
    Sched<ZM> S; S.init(M / 256, N / 256, nZ, F.G, F.bid); S.A = (const char*)A; S.B = (const char*)B; S.atile = (size_t)256 * lda * 2; S.btile = (size_t)256 * ldb * 2;
    S.split = 1 << 30; S.bseq = 0; S.zm = zm; return S;
}

typedef f32x4 Acc[2][2][4][2];
__device__ __forceinline__ float res_dec(unsigned hb  , float lob  ) {
    const int e = (int)((hb >> 7) & 0xFFu); const float sd = __uint_as_float((unsigned)(e > 15 ? e - 15 : 0) << 23);
    return fmaf(lob - 128.0f, sd, __uint_as_float(hb << 16));
}
__device__ __forceinline__ float res_enc_lo(float x, unsigned hb) {
    const int e = (int)((hb >> 7) & 0xFFu); const float se = e > 15 ? __uint_as_float((unsigned)(269 - e) << 23) : 0.f;
    return fminf(__builtin_rintf(fmaf(x - __uint_as_float(hb << 16), se, 128.0f)), 255.0f);
}
__device__ __forceinline__ unsigned pack4_u8(float a, float b, float c, float dd) { return (unsigned)a | ((unsigned)b << 8) | ((unsigned)c << 16) | ((unsigned)dd << 24); }
__device__ __forceinline__ void res_enc4(const f32x4 v, unsigned& w0, unsigned& w1, unsigned& lo) {
    w0 = cvt_pk_bf16(v[0], v[1]); w1 = cvt_pk_bf16(v[2], v[3]);
    lo = pack4_u8(res_enc_lo(v[0], w0 & 0xFFFFu), res_enc_lo(v[1], w0 >> 16), res_enc_lo(v[2], w1 & 0xFFFFu), res_enc_lo(v[3], w1 >> 16));
}
__device__ __forceinline__ f32x4 res_dec4(unsigned w0, unsigned w1, unsigned lo) {
    return (f32x4){res_dec(w0 & 0xFFFFu, (float)(lo & 0xFFu)), res_dec(w0 >> 16, (float)((lo >> 8) & 0xFFu)), res_dec(w1 & 0xFFFFu, (float)((lo >> 16) & 0xFFu)), res_dec(w1 >> 16, (float)(lo >> 24))};
}
__device__ __forceinline__ unsigned char* fresh_ws(unsigned char* ws) { asm volatile("" : "+s"(ws)); return ws; }
__device__ __forceinline__ void pss_prefetch(LAS unsigned char* lds, const unsigned char* ws, int pm, int par, int wid, int lane) {
    const unsigned char* src = ws + WS_MISC + MISC_PSS + (size_t)pm * 8192 + wid * 1024 + lane * 16;
    __builtin_amdgcn_global_load_lds((const unsigned*)src, (LAS unsigned*)(lds + PSSB_OFF + (par & 1) * 8192 + wid * 1024), 16, 0, 0);
}
__device__ __forceinline__ void row_rstd_lds(const LAS unsigned char* lds, int par, int rloc0, float (&rs)[2][4]) {
    const LAS unsigned char* b = lds + PSSB_OFF + (par & 1) * 8192;
#pragma unroll
    for (int ai = 0; ai < 2; ++ai)
#pragma unroll
        for (int m = 0; m < 4; ++m) { const f32x4 a = *(const LAS f32x4*)(b + (rloc0 + ai * 128 + m * 16) * 32), c = *(const LAS f32x4*)(b + (rloc0 + ai * 128 + m * 16) * 32 + 16);
            rs[ai][m] = 1.0f / sqrtf((((a.x + a.y) + (a.z + a.w)) + ((c.x + c.y) + (c.z + c.w))) * (1.f / DM) + EPS); }
}
__device__ __forceinline__ void row_rstd(const float* PSS, int row0, float (&rs)[2][4]) {
#pragma unroll
    for (int ai = 0; ai < 2; ++ai)
#pragma unroll
        for (int m = 0; m < 4; ++m) { const f32x4 a = *(const f32x4*)(PSS + (size_t)(row0 + ai * 128 + m * 16) * 8), b = *(const f32x4*)(PSS + (size_t)(row0 + ai * 128 + m * 16) * 8 + 4);
            rs[ai][m] = 1.0f / sqrtf((((a.x + a.y) + (a.z + a.w)) + ((b.x + b.y) + (b.z + b.w))) * (1.f / DM) + EPS); }
}
struct EpiSwiglu { static constexpr bool PERM = true, PREFETCH = true; unsigned char* ws; int ldc; LAS unsigned char* lds;
    __device__ __forceinline__ void prefetch(LAS unsigned char* l, const pg8::Unit& u, int par, int wid, int lane) const { pss_prefetch(l, ws, u.pm, par, wid, lane); }
    __device__ __forceinline__ void operator()(Acc& acc, const pg8::Unit& u, int wr, int wc, int fr, int fq, int par) const {
        const int row0 = u.pm * 256 + wr * 64 + fr, col0 = u.pn * 128 + wc * 32 + 8 * fq;
        unsigned char* w_ = fresh_ws(ws); bf16_t* O = (bf16_t*)(w_ + WS_POOL + PL_ACT);
        float rs[2][4]; row_rstd_lds(lds, par, wr * 64 + fr, rs);
#pragma unroll
        for (int ai = 0; ai < 2; ++ai)
#pragma unroll
            for (int m = 0; m < 4; ++m) { const f32x4 g0 = acc[ai][0][m][0] * rs[ai][m], g1 = acc[ai][0][m][1] * rs[ai][m], u0 = acc[ai][1][m][0] * rs[ai][m], u1 = acc[ai][1][m][1] * rs[ai][m];
                u32x4 w; w.x = cvt_pk_bf16(silu_f(g0[0]) * u0[0], silu_f(g0[1]) * u0[1]); w.y = cvt_pk_bf16(silu_f(g0[2]) * u0[2], silu_f(g0[3]) * u0[3]);
                w.z = cvt_pk_bf16(silu_f(g1[0]) * u1[0], silu_f(g1[1]) * u1[1]); w.w = cvt_pk_bf16(silu_f(g1[2]) * u1[2], silu_f(g1[3]) * u1[3]);
                *(u32x4*)(O + (size_t)(row0 + ai * 128 + m * 16) * ldc + col0) = w; }
    }
};
struct EpiResidNorm { static constexpr bool PERM = true, PREFETCH = false; float scale; unsigned char* ws; LAS float* red;
    __device__ __forceinline__ void operator()(Acc& acc, const pg8::Unit& u, int wr, int wc, int fr, int fq, int par) const {
        const int row0 = u.pm * 256 + wr * 64 + fr, col0 = u.pn * 256 + wc * 32 + 8 * fq, tid = (wr * 4 + wc) * 64 + fq * 16 + fr;
        unsigned char* w_ = fresh_ws(ws); bf16_t* XB = (bf16_t*)(w_ + WS_HB); float* PSS = (float*)(w_ + WS_MISC + MISC_PSS);
        u32x4* XL = (u32x4*)(w_ + WS_X + (size_t)(u.pm * 8 + u.pn) * 65536) + tid;
#pragma unroll
        for (int ai = 0; ai < 2; ++ai) {
            u32x4 hv[4][2], lv[4];
#pragma unroll
            for (int m = 0; m < 4; ++m) { const bf16_t* bp = XB + (size_t)(row0 + ai * 128 + m * 16) * DM + col0; hv[m][0] = *(const u32x4*)bp; hv[m][1] = *(const u32x4*)(bp + 128); lv[m] = XL[(ai * 4 + m) * 512]; }
#pragma unroll
            for (int m = 0; m < 4; ++m) { bf16_t* bp = XB + (size_t)(row0 + ai * 128 + m * 16) * DM + col0; float s = 0.f; u32x4 lo;
#pragma unroll
                for (int bj = 0; bj < 2; ++bj) { const f32x4 v0 = res_dec4(hv[m][bj].x, hv[m][bj].y, lv[m][bj * 2]) + acc[ai][bj][m][0] * scale, v1 = res_dec4(hv[m][bj].z, hv[m][bj].w, lv[m][bj * 2 + 1]) + acc[ai][bj][m][1] * scale;
                    unsigned a0, a1, a2, a3, l0, l1; res_enc4(v0, a0, a1, l0); res_enc4(v1, a2, a3, l1); *(u32x4*)(bp + bj * 128) = (u32x4){a0, a1, a2, a3}; lo[bj * 2] = l0; lo[bj * 2 + 1] = l1;
                    s += ((v0[0] * v0[0] + v0[1] * v0[1]) + (v0[2] * v0[2] + v0[3] * v0[3])) + ((v1[0] * v1[0] + v1[1] * v1[1]) + (v1[2] * v1[2] + v1[3] * v1[3])); }
                XL[(ai * 4 + m) * 512] = lo;
                s += __shfl_xor(s, 16); s += __shfl_xor(s, 32);
                if (fq == 0) red[(ai * 128 + wr * 64 + m * 16 + fr) * 4 + wc] = s; }
            asm volatile("" ::: "memory"); }
        asm volatile("s_waitcnt lgkmcnt(0)" ::: "memory"); __builtin_amdgcn_s_barrier(); asm volatile("" ::: "memory");
        if (tid < 256) { const f32x4 r4 = *(const LAS f32x4*)(red + tid * 4); PSS[(size_t)(u.pm * 256 + tid) * 8 + u.pn] = (r4.x + r4.y) + (r4.z + r4.w); }
    }
};
template <int MODE> struct EpiBf16 { static constexpr bool PERM = true, PREFETCH = (MODE == 1); bf16_t* O; int ldc; size_t zhi, zlo; int zshift; const float* aux; unsigned char* ws; LAS unsigned char* lds;
    __device__ __forceinline__ void prefetch(LAS unsigned char* l, const pg8::Unit& u, int par, int wid, int lane) const { pss_prefetch(l, ws, u.pm, par, wid, lane); }
    __device__ __forceinline__ void operator()(Acc& acc, const pg8::Unit& u, int wr, int wc, int fr, int fq, int par) const {
        bf16_t* base = O + (size_t)(u.z >> zshift) * zhi + (size_t)(u.z & ((1 << zshift) - 1)) * zlo;
        const int row0 = u.pm * 256 + wr * 64 + fr, col0 = u.pn * 256 + wc * 32 + 8 * fq;
        float rs[2][4]; if (MODE == 1) row_rstd_lds(lds, par, wr * 64 + fr, rs);
        f32x4 cs[2][2]; if (MODE == 2) {
#pragma unroll
            for (int bj = 0; bj < 2; ++bj)
#pragma unroll
                for (int n = 0; n < 2; ++n) cs[bj][n] = *(const f32x4*)(aux + (size_t)(u.z >> 3) * DM + col0 + bj * 128 + 4 * n); }
#pragma unroll
        for (int ai = 0; ai < 2; ++ai)
#pragma unroll
            for (int m = 0; m < 4; ++m) { bf16_t* rp = base + (size_t)(row0 + ai * 128 + m * 16) * ldc + col0;
#pragma unroll
                for (int bj = 0; bj < 2; ++bj) { f32x4 v0 = acc[ai][bj][m][0], v1 = acc[ai][bj][m][1];
                    if (MODE == 1) { v0 = v0 * rs[ai][m]; v1 = v1 * rs[ai][m]; }
                    if (MODE == 2) { v0 = v0 * cs[bj][0]; v1 = v1 * cs[bj][1]; }
                    u32x4 w; w.x = cvt_pk_bf16(v0[0], v0[1]); w.y = cvt_pk_bf16(v0[2], v0[3]); w.z = cvt_pk_bf16(v1[0], v1[1]); w.w = cvt_pk_bf16(v1[2], v1[3]);
                    *(u32x4*)(rp + bj * 128) = w; } }
    }
};
struct EpiWinEven { static constexpr bool PERM = true, PREFETCH = true; unsigned char* ws; LAS unsigned char* lds;
    __device__ __forceinline__ void prefetch(LAS unsigned char* l, const pg8::Unit& u, int par, int wid, int lane) const { pss_prefetch(l, ws, u.pm, par, wid, lane); }
    __device__ __forceinline__ void operator()(Acc& acc, const pg8::Unit& u, int wr, int wc, int fr, int fq, int par) const {
        const int row0 = u.pm * 256 + wr * 64 + fr, col0 = u.pn * 256 + wc * 32 + 8 * fq;
        unsigned char* w_ = fresh_ws(ws); bf16_t* UX = (bf16_t*)(w_ + WS_POOL + PL_UX); bf16_t* Z = (bf16_t*)(w_ + WS_POOL + PL_Z);
        float rs[2][4]; row_rstd_lds(lds, par, wr * 64 + fr, rs);
#pragma unroll
        for (int ai = 0; ai < 2; ++ai)
#pragma unroll
            for (int m = 0; m < 4; ++m) { const int row = row0 + ai * 128 + m * 16;
#pragma unroll
                for (int bj = 0; bj < 2; ++bj) { const f32x4 v0 = acc[ai][bj][m][0] * rs[ai][m], v1 = acc[ai][bj][m][1] * rs[ai][m]; const int col = col0 + bj * 128;
                    u32x4 w; w.x = cvt_pk_bf16(v0[0], v0[1]); w.y = cvt_pk_bf16(v0[2], v0[3]); w.z = cvt_pk_bf16(v1[0], v1[1]); w.w = cvt_pk_bf16(v1[2], v1[3]);
                    bf16_t* p;
                    if (u.pn < 4) { const int g = col >> 4, h0 = col & 15, c = row >> 5, i = row & 31; p = UX + ((size_t)(g * NCH + c) * S5K2 + i * 16 + h0); }
                    else p = Z + (size_t)row * ZLD + (col - 1024);
                    *(u32x4*)p = w; } }
    }
};
struct EpiF32 { static constexpr bool PERM = false, PREFETCH = false; float* O; int ldc; size_t zs;
    __device__ __forceinline__ void operator()(Acc& acc, const pg8::Unit& u, int wr, int wc, int fr, int fq, int par) const {
        float* base = O + (size_t)u.z * zs; const int row0 = u.pm * 256 + wr * 64 + fr, col0 = u.pn * 256 + wc * 32 + 4 * fq;
#pragma unroll
        for (int ai = 0; ai < 2; ++ai)
#pragma unroll
            for (int m = 0; m < 4; ++m) { float* rp = base + (size_t)(row0 + ai * 128 + m * 16) * ldc + col0;
#pragma unroll
                for (int bj = 0; bj < 2; ++bj)
#pragma unroll
                    for (int n = 0; n < 2; ++n) *(f32x4*)(rp + bj * 128 + n * 16) = acc[ai][bj][m][n]; }
    }
};
struct EpiS5Out { static constexpr bool PERM = true, PREFETCH = false; bf16_t* GB;
    __device__ __forceinline__ void operator()(Acc& acc, const pg8::Unit& u, int wr, int wc, int fr, int fq, int par) const {
        const int row0 = u.pm * 256 + wr * 64 + fr, col0 = u.pn * 256 + wc * 32 + 8 * fq;
#pragma unroll
        for (int ai = 0; ai < 2; ++ai)
#pragma unroll
            for (int m = 0; m < 4; ++m) { const int c = row0 + ai * 128 + m * 16;
#pragma unroll
                for (int bj = 0; bj < 2; ++bj) { const f32x4 v0 = acc[ai][bj][m][0], v1 = acc[ai][bj][m][1]; const int col = col0 + bj * 128, i = col >> 4, h0 = col & 15;
                    u32x4 w; w.x = cvt_pk_bf16(gelu_tanh_f(v0[0]), gelu_tanh_f(v0[1])); w.y = cvt_pk_bf16(gelu_tanh_f(v0[2]), gelu_tanh_f(v0[3]));
                    w.z = cvt_pk_bf16(gelu_tanh_f(v1[0]), gelu_tanh_f(v1[1])); w.w = cvt_pk_bf16(gelu_tanh_f(v1[2]), gelu_tanh_f(v1[3]));
                    *(u32x4*)(GB + (size_t)(c * LC + i) * S5W + u.z * 16 + h0) = w; } }
    }
};
struct EpiGlu { static constexpr bool PERM = true, PREFETCH = false; const bf16_t* GB; const float* bias; bf16_t* O;
    __device__ __forceinline__ void operator()(Acc& acc, const pg8::Unit& u, int wr, int wc, int fr, int fq, int par) const {
        const int row0 = u.pm * 256 + wr * 64 + fr, col0 = u.pn * 256 + wc * 32 + 8 * fq;
        f32x4 bv[2][2];
#pragma unroll
        for (int bj = 0; bj < 2; ++bj)
#pragma unroll
            for (int n = 0; n < 2; ++n) bv[bj][n] = *(const f32x4*)(bias + col0 + bj * 128 + 4 * n);
#pragma unroll
        for (int ai = 0; ai < 2; ++ai)
#pragma unroll
            for (int m = 0; m < 4; ++m) { const int row = row0 + ai * 128 + m * 16;
#pragma unroll
                for (int bj = 0; bj < 2; ++bj) { const f32x4 v0 = acc[ai][bj][m][0] + bv[bj][0], v1 = acc[ai][bj][m][1] + bv[bj][1]; const int col = col0 + bj * 128;
                    const u32x4 g = *(const u32x4*)(GB + (size_t)row * S5W + col);
                    u32x4 w; w.x = cvt_pk_bf16(bflo(g.x) * sigmoidf_fast(v0[0]), bfhi(g.x) * sigmoidf_fast(v0[1])); w.y = cvt_pk_bf16(bflo(g.y) * sigmoidf_fast(v0[2]), bfhi(g.y) * sigmoidf_fast(v0[3]));
                    w.z = cvt_pk_bf16(bflo(g.z) * sigmoidf_fast(v1[0]), bfhi(g.z) * sigmoidf_fast(v1[1])); w.w = cvt_pk_bf16(bflo(g.w) * sigmoidf_fast(v1[2]), bfhi(g.w) * sigmoidf_fast(v1[3]));
                    *(u32x4*)(O + (size_t)row * DM + col) = w; } }
    }
};

struct EpiCrossSm { static constexpr bool PERM = true, PREFETCH = true; unsigned char* ws; LAS f32x2* red; LAS unsigned char* lds;
    __device__ __forceinline__ void prefetch(LAS unsigned char* l, const pg8::Unit& u, int par, int wid, int lane) const { pss_prefetch(l, ws, u.pm, par, wid, lane); }
    __device__ __forceinline__ void operator()(Acc& acc, const pg8::Unit& u, int wr, int wc, int fr, int fq, int par) const {
        constexpr float C = 0.04419417382415922f * 1.4426950408889634f;
        const int row0 = u.pm * 256 + wr * 64 + fr, col0 = u.pn * 256 + wc * 32 + 8 * fq;
        unsigned char* w_ = fresh_ws(ws); bf16_t* O = (bf16_t*)(w_ + WS_POOL + PL_CP);
        float rs[2][4]; row_rstd_lds(lds, par, wr * 64 + fr, rs);
        float mw[2][4];
#pragma unroll
        for (int ai = 0; ai < 2; ++ai)
#pragma unroll
            for (int m = 0; m < 4; ++m) { const float k = rs[ai][m] * C; float mx = -3.0e38f;
#pragma unroll
                for (int bj = 0; bj < 2; ++bj)
#pragma unroll
                    for (int n = 0; n < 2; ++n) { f32x4 v = acc[ai][bj][m][n] * k; acc[ai][bj][m][n] = v; mx = fmaxf(fmaxf(mx, fmaxf(v[0], v[1])), fmaxf(v[2], v[3])); }
                mx = fmaxf(mx, __shfl_xor(mx, 16)); mx = fmaxf(mx, __shfl_xor(mx, 32)); float s = 0.f;
#pragma unroll
                for (int bj = 0; bj < 2; ++bj)
#pragma unroll
                    for (int n = 0; n < 2; ++n) { f32x4 v = acc[ai][bj][m][n]; v[0] = fast_exp2(v[0] - mx); v[1] = fast_exp2(v[1] - mx); v[2] = fast_exp2(v[2] - mx); v[3] = fast_exp2(v[3] - mx); acc[ai][bj][m][n] = v; s += (v[0] + v[1]) + (v[2] + v[3]); }
                s += __shfl_xor(s, 16); s += __shfl_xor(s, 32); mw[ai][m] = mx;
                if (fq == 0) red[(ai * 128 + wr * 64 + m * 16 + fr) * 4 + wc] = (f32x2){mx, s}; }
        asm volatile("s_waitcnt lgkmcnt(0)" ::: "memory"); __builtin_amdgcn_s_barrier(); asm volatile("" ::: "memory");
#pragma unroll
        for (int ai = 0; ai < 2; ++ai)
#pragma unroll
            for (int m = 0; m < 4; ++m) { const LAS f32x2* rr = red + (ai * 128 + wr * 64 + m * 16 + fr) * 4; const f32x2 r0 = rr[0], r1 = rr[1], r2 = rr[2], r3 = rr[3];
                const float M = fmaxf(fmaxf(r0.x, r1.x), fmaxf(r2.x, r3.x));
                const float tot = (r0.y * fast_exp2(r0.x - M) + r1.y * fast_exp2(r1.x - M)) + (r2.y * fast_exp2(r2.x - M) + r3.y * fast_exp2(r3.x - M));
                const float f = fast_exp2(mw[ai][m] - M) * fast_rcp(tot);
                bf16_t* rp = O + (size_t)(row0 + ai * 128 + m * 16) * 1024 + col0;
#pragma unroll
                for (int bj = 0; bj < 2; ++bj) { const f32x4 v0 = acc[ai][bj][m][0] * f, v1 = acc[ai][bj][m][1] * f;
                    u32x4 w; w.x = cvt_pk_bf16(v0[0], v0[1]); w.y = cvt_pk_bf16(v0[2], v0[3]); w.z = cvt_pk_bf16(v1[0], v1[1]); w.w = cvt_pk_bf16(v1[2], v1[3]);
                    *(u32x4*)(rp + bj * 128) = w; } }
    }
};

template <int MODE>
__device__ __forceinline__ void transpose_item(const float* W, int K, int N, bf16_t* WT, LAS float* scr, int item, int lane, const float* gain = nullptr) {
    const int nblk = N / 32, kb = item / nblk, nb = item % nblk, k0 = 64 * kb, n0 = 32 * nb;
#pragma unroll 8
    for (int i = 0; i < 32; ++i) { const int kk = 2 * i + (lane >> 5); scr[kk * 33 + (lane & 31)] = W[(size_t)(k0 + kk) * N + n0 + (lane & 31)]; }
    LDS_WAIT(); asm volatile("" ::: "memory");
    const int c = lane & 7;
    f32x4 g0 = (f32x4){1.f, 1.f, 1.f, 1.f}, g1 = g0; if (gain) { g0 = *(const f32x4*)(gain + k0 + 8 * c); g1 = *(const f32x4*)(gain + k0 + 8 * c + 4); }
    int r0;
    if (MODE == 1) { r0 = (n0 < DFF) ? (256 * (n0 / 128) + (n0 % 128)) : (256 * ((n0 - DFF) / 128) + 128 + ((n0 - DFF) % 128)); } else r0 = n0;
#pragma unroll
    for (int j = 0; j < 4; ++j) { const int n = (lane >> 3) + 8 * j; const LAS float* s = scr + (8 * c) * 33 + n;
        u32x4 o; o.x = cvt_pk_bf16(s[0 * 33] * g0.x, s[1 * 33] * g0.y); o.y = cvt_pk_bf16(s[2 * 33] * g0.z, s[3 * 33] * g0.w); o.z = cvt_pk_bf16(s[4 * 33] * g1.x, s[5 * 33] * g1.y); o.w = cvt_pk_bf16(s[6 * 33] * g1.z, s[7 * 33] * g1.w);
        *(u32x4*)(WT + (size_t)(r0 + n) * K + k0 + 8 * c) = o; }
    LDS_WAIT(); asm volatile("" ::: "memory");
}
__device__ __forceinline__ void convert_rows(const float* src, bf16_t* dst, size_t n8, size_t gtid, size_t gthreads) {
    for (size_t i = gtid; i < n8; i += gthreads) { const f32x4 a = *(const f32x4*)(src + i * 8), b = *(const f32x4*)(src + i * 8 + 4);
        u32x4 o; o.x = cvt_pk_bf16(a[0], a[1]); o.y = cvt_pk_bf16(a[2], a[3]); o.z = cvt_pk_bf16(b[0], b[1]); o.w = cvt_pk_bf16(b[2], b[3]); *(u32x4*)(dst + i * 8) = o; }
}

__device__ __forceinline__ void rms_row_to_bf16(const float* xrow, const float* g, bf16_t* orow, float* xcopy, int lane) {
    const f32x4* xr = (const f32x4*)xrow + lane;
    f32x4 v[8]; float s = 0.f;
#pragma unroll
    for (int j = 0; j < 8; ++j) { v[j] = xr[64 * j]; s += (v[j].x * v[j].x + v[j].y * v[j].y) + (v[j].z * v[j].z + v[j].w * v[j].w); }
    if (xcopy) {
#pragma unroll
        for (int j = 0; j < 8; ++j) ((f32x4*)xcopy + lane)[64 * j] = v[j]; }
    const float rstd = 1.0f / sqrtf(wave_sum(s) * (1.f / DM) + EPS);
    const f32x4* gr = (const f32x4*)g + lane;
    u32x2* o8 = (u32x2*)orow + lane;
#pragma unroll
    for (int j = 0; j < 8; ++j) { const f32x4 gg = gr[64 * j]; u32x2 w; w.x = cvt_pk_bf16(v[j].x * rstd * gg.x, v[j].y * rstd * gg.y); w.y = cvt_pk_bf16(v[j].z * rstd * gg.z, v[j].w * rstd * gg.w); o8[64 * j] = w; }
}
__device__ __forceinline__ void norm_phase(const Frame& F, const float* g) {
    const int gw = F.bid * NWAVES + F.wave, NGW = F.G * NWAVES; bf16_t* HB = (bf16_t*)WSP(WS_HB);
    for (int m = gw; m < TT; m += NGW) rms_row_to_bf16(F.x + (size_t)m * DM, g, HB + (size_t)m * DM, nullptr, F.lane);
}
__device__ __forceinline__ void final_norm_phase(const Frame& F, const float* g) {
    const float* PSS = (const float*)(WSP(WS_MISC) + MISC_PSS); const bf16_t* XB = (const bf16_t*)WSP(WS_HB);
    const int tid = F.tid, wid = tid >> 6, wr = wid >> 2, wc = wid & 3, fq = (tid >> 4) & 3, fr = tid & 15;
    for (int L = F.bid; L < (TT / 256) * 8; L += F.G) { const int pm = L >> 3, pn = L & 7;
        const u32x4* XL = (const u32x4*)(WSP(WS_X) + (size_t)L * 65536) + tid; const int row0 = pm * 256 + wr * 64 + fr, col0 = pn * 256 + wc * 32 + 8 * fq;
        float rs[2][4]; row_rstd(PSS, row0, rs);
        f32x4 gg[2][2];
#pragma unroll
        for (int bj = 0; bj < 2; ++bj) { gg[bj][0] = *(const f32x4*)(g + col0 + bj * 128); gg[bj][1] = *(const f32x4*)(g + col0 + bj * 128 + 4); }
#pragma unroll
        for (int ai = 0; ai < 2; ++ai)
#pragma unroll
            for (int m = 0; m < 4; ++m) { const size_t ro = (size_t)(row0 + ai * 128 + m * 16) * DM + col0; const u32x4 lo = XL[(ai * 4 + m) * 512];
#pragma unroll
                for (int bj = 0; bj < 2; ++bj) { const u32x4 h = *(const u32x4*)(XB + ro + bj * 128); float* op = F.x + ro + bj * 128;
                    *(f32x4*)op = res_dec4(h.x, h.y, lo[bj * 2]) * rs[ai][m] * gg[bj][0]; *(f32x4*)(op + 4) = res_dec4(h.z, h.w, lo[bj * 2 + 1]) * rs[ai][m] * gg[bj][1]; } }
    }
}

__device__ __forceinline__ void s5_precompute_group(const Frame& F, int e, int g) {
    LAS float* L = (LAS float*)F.lds;
    LAS float* apow = L;
    LAS float* bb = apow + 8448;
    LAS float* cc = bb + 4096;
    LAS float* km = cc + 4096;
    LAS float* dsk = km + 16384;
    const float* lre = F.in[I_LRE], *lim = F.in[I_LIM], *ldt = F.in[I_LDT], *bre = F.in[I_BRE], *bim = F.in[I_BIM], *cre = F.in[I_CRE], *cim = F.in[I_CIM], *dsk_g = F.in[I_S5D];
    const int tid = F.tid;
    for (int idx = tid; idx < 2 * 64 * 33; idx += NTHREADS) { const int k = idx % 33, p = (idx / 33) % 64, dir = idx / (33 * 64);
        const size_t pi = ((size_t)(e * 2 + dir) * S5G + g) * S5P + p; const float lr = fminf(lre[pi], -1e-4f), li = lim[pi], dt = expf(ldt[(e * 2 + dir) * S5G + g]);
        const float mag = expf(lr * dt * (float)k); float sn, cs; sincosf(li * dt * (float)k, &sn, &cs); apow[idx * 2] = mag * cs; apow[idx * 2 + 1] = mag * sn; }
    for (int idx = tid; idx < 2 * 64 * 16; idx += NTHREADS) { const int h = idx % 16, p = (idx / 16) % 64, dir = idx / 1024;
        const size_t pi = ((size_t)(e * 2 + dir) * S5G + g) * S5P + p; const float lr = fminf(lre[pi], -1e-4f), li = lim[pi], dt = expf(ldt[(e * 2 + dir) * S5G + g]);
        const float mag = expf(lr * dt); float sn, cs; sincosf(li * dt, &sn, &cs); const float ar = mag * cs, ai = mag * sn, nr = ar - 1.0f, den = lr * lr + li * li;
        const float fr = (nr * lr + ai * li) / den, fi = (ai * lr - nr * li) / den; const float br = bre[pi * 16 + h], bi = bim[pi * 16 + h];
        bb[idx * 2] = fr * br - fi * bi; bb[idx * 2 + 1] = fr * bi + fi * br; }
    for (int idx = tid; idx < 2 * 16 * 64; idx += NTHREADS) { const int p = idx % 64, h = (idx / 64) % 16, dir = idx / 1024;
        const size_t ci = (((size_t)(e * 2 + dir) * S5G + g) * S5H + h) * S5P + p; cc[idx * 2] = cre[ci]; cc[idx * 2 + 1] = cim[ci]; }
    if (tid < 16) dsk[tid] = dsk_g[e * S5W + g * 16 + tid];
    LDS_WAIT(); __syncthreads();
    for (int idx = tid; idx < 2 * 32 * 256; idx += NTHREADS) { const int hp = idx & 15, h = (idx >> 4) & 15, k = (idx >> 8) & 31, dir = idx >> 13; float s = 0.f;
        for (int p = 0; p < 64; ++p) { const float cr = cc[((dir * 16 + h) * 64 + p) * 2], ci = cc[((dir * 16 + h) * 64 + p) * 2 + 1], ar = apow[((dir * 64 + p) * 33 + k) * 2], ai = apow[((dir * 64 + p) * 33 + k) * 2 + 1];
            const float br = bb[((dir * 64 + p) * 16 + hp) * 2], bi = bb[((dir * 64 + p) * 16 + hp) * 2 + 1]; const float wr = cr * ar - ci * ai, wi = cr * ai + ci * ar; s += wr * br - wi * bi; }
        km[idx] = s; }
    LDS_WAIT(); __syncthreads();
    bf16_t* WST = (bf16_t*)WSP(WS_WST) + (size_t)(e * 64 + g) * (S5NS * S5K1);
    bf16_t* TG = (bf16_t*)WSP(WS_TG) + (size_t)(e * 64 + g) * (S5K1 * S5K2);
    for (int idx = tid; idx < S5NS * S5K1 / 2; idx += NTHREADS) { const int k2 = (idx % (S5K1 / 2)) * 2, n = idx / (S5K1 / 2); const int dir = n >> 7, p = (n >> 1) & 63, ri = n & 1; const int j = k2 >> 4, hp = k2 & 15;
        const int ex = dir == 0 ? (LC - 1 - j) : j; const float ar = apow[((dir * 64 + p) * 33 + ex) * 2], ai = apow[((dir * 64 + p) * 33 + ex) * 2 + 1];
        float v[2];
#pragma unroll
        for (int q = 0; q < 2; ++q) { const float br = bb[((dir * 64 + p) * 16 + hp + q) * 2], bi = bb[((dir * 64 + p) * 16 + hp + q) * 2 + 1]; v[q] = ri == 0 ? (ar * br - ai * bi) : (ar * bi + ai * br); }
        *(unsigned*)(WST + (size_t)n * S5K1 + k2) = cvt_pk_bf16(v[0], v[1]); }
    for (int idx = tid; idx < S5K1 * S5K2 / 2; idx += NTHREADS) { const int k2 = (idx % (S5K2 / 2)) * 2, n = idx / (S5K2 / 2); const int i = n >> 4, h = n & 15; float v[2];
        if (k2 < S5K1) { const int j = k2 >> 4, hp = k2 & 15;
#pragma unroll
            for (int q = 0; q < 2; ++q) { float s = 0.f; if (j <= i) s += km[((0 * 32 + (i - j)) * 16 + h) * 16 + hp + q]; if (j >= i) s += km[((1 * 32 + (j - i)) * 16 + h) * 16 + hp + q]; if (i == j && h == hp + q) s += dsk[h]; v[q] = s; }
        } else { const int nn = k2 - S5K1, dir = nn >> 7, p = (nn >> 1) & 63; const int ex = dir == 0 ? (i + 1) : (LC - i);
            const float ar = apow[((dir * 64 + p) * 33 + ex) * 2], ai = apow[((dir * 64 + p) * 33 + ex) * 2 + 1], cr = cc[((dir * 16 + h) * 64 + p) * 2], ci = cc[((dir * 16 + h) * 64 + p) * 2 + 1];
            v[0] = cr * ar - ci * ai; v[1] = -(cr * ai + ci * ar); }
        *(unsigned*)(TG + (size_t)n * S5K2 + k2) = cvt_pk_bf16(v[0], v[1]); }
    f32x2* AL = (f32x2*)(WSP(WS_MISC) + MISC_AL);
    if (tid < 128) { const int dir = tid >> 6, p = tid & 63; AL[((e * 2 + dir) * 64 + g) * 64 + p] = (f32x2){apow[((dir * 64 + p) * 33 + LC) * 2], apow[((dir * 64 + p) * 33 + LC) * 2 + 1]}; }
    __syncthreads();
}

__device__ __forceinline__ void s5_scan_phase(const Frame& F, int e) {
    const float* SST = (const float*)POOLP(PL_SST); bf16_t* UX = (bf16_t*)POOLP(PL_UX);
    LAS f32x2* tot = (LAS f32x2*)F.lds;
    const int p = F.lane, w = F.wave;
    for (int item = F.bid; item < 2 * 2 * 64; item += F.G) {
        const int g = item & 63, dir = (item >> 6) & 1, seq = item >> 7;
        const f32x2 aL = ((const f32x2*)(WSP(WS_MISC) + MISC_AL))[((e * 2 + dir) * 64 + g) * 64 + p];
        const int c0 = seq ? NCH_P : 0, cs = seq ? 32 : 16;
        const int step = dir == 0 ? 1 : -1;
        const float* sbase = SST + (size_t)g * 256 + dir * 128 + 2 * p;
        bf16_t* xbase = UX + (size_t)g * NCH * S5K2 + S5K1 + dir * 128 + 2 * p;
#pragma unroll 1
        for (int q = 0; q < 2; ++q) { const int s = 2 * w + q; int c = c0 + s * cs + (dir == 0 ? 0 : cs - 1); float xr = 0.f, xi = 0.f;
#pragma unroll 1
            for (int it = 0; it < cs; it += 8) { f32x2 sv[8];
#pragma unroll
                for (int k = 0; k < 8; ++k) sv[k] = *(const f32x2*)(sbase + (size_t)(c + k * step) * (64 * 256));
#pragma unroll
                for (int k = 0; k < 8; ++k) { const float nr = aL.x * xr - aL.y * xi + sv[k].x, ni = aL.x * xi + aL.y * xr + sv[k].y; xr = nr; xi = ni; }
                c += 8 * step; }
            tot[s * 64 + p] = (f32x2){xr, xi}; }
        LDS_WAIT(); __syncthreads();
        float pr = aL.x, pi = aL.y;
        for (int k = cs; k > 1; k >>= 1) { const float nr = pr * pr - pi * pi, ni = 2.f * pr * pi; pr = nr; pi = ni; }
#pragma unroll 1
        for (int q = 0; q < 2; ++q) { const int s = 2 * w + q; float xr = 0.f, xi = 0.f;
            if (dir == 0) { for (int j = 0; j < s; ++j) { const f32x2 t = tot[j * 64 + p]; const float nr = pr * xr - pi * xi + t.x, ni = pr * xi + pi * xr + t.y; xr = nr; xi = ni; } }
            else { for (int j = 15; j > s; --j) { const f32x2 t = tot[j * 64 + p]; const float nr = pr * xr - pi * xi + t.x, ni = pr * xi + pi * xr + t.y; xr = nr; xi = ni; } }
            int c = c0 + s * cs + (dir == 0 ? 0 : cs - 1);
#pragma unroll 1
            for (int it = 0; it < cs; it += 8) { f32x2 sv[8];
#pragma unroll
                for (int k = 0; k < 8; ++k) sv[k] = *(const f32x2*)(sbase + (size_t)(c + k * step) * (64 * 256));
#pragma unroll
                for (int k = 0; k < 8; ++k) { *(unsigned*)(xbase + (size_t)(c + k * step) * S5K2) = cvt_pk_bf16(xr, xi);
                    const float nr = aL.x * xr - aL.y * xi + sv[k].x, ni = aL.x * xi + aL.y * xr + sv[k].y; xr = nr; xi = ni; }
                c += 8 * step; } }
        __syncthreads();
    }
}

__device__ __forceinline__ void qk_prep_phase(const Frame& F, int o) {
    bf16_t* Z = (bf16_t*)POOLP(PL_Z); bf16_t* KC = (bf16_t*)POOLP(PL_KC); const float* rope = (const float*)(WSP(WS_MISC) + MISC_ROPE);
    const float* qg = F.in[I_QN] + o * 128, *kg = F.in[I_KN] + o * 128;
    const int sub = F.lane >> 4, j = F.lane & 15;
    const long nrows = (long)TT * 20, gq = ((long)F.bid * NWAVES + F.wave) * 4 + sub, nq = (long)F.G * NWAVES * 4;
    for (long r = gq; r < nrows; r += nq) {
        const int t = (int)(r / 20), hh = (int)(r % 20);
        bf16_t* p = Z + (size_t)t * ZLD + (hh < 16 ? hh * 128 : 2048 + (hh - 16) * 128) + j * 8;
        const u32x4 w = *(const u32x4*)p; float v[8] = {bflo(w.x), bfhi(w.x), bflo(w.y), bfhi(w.y), bflo(w.z), bfhi(w.z), bflo(w.w), bfhi(w.w)};
        float s = 0.f;
#pragma unroll
        for (int q = 0; q < 8; ++q) s += v[q] * v[q];
        s += __shfl_xor(s, 1); s += __shfl_xor(s, 2); s += __shfl_xor(s, 4); s += __shfl_xor(s, 8);
        const float rstd = 1.0f / sqrtf(s * (1.f / 128.f) + EPS); const float* gg = (hh < 16 ? qg : kg) + j * 8;
        const int tl = t < T_P ? t : t - T_P; const int pos = (j < 8) ? (tl >> 6) : (tl & 63);
        const float* rp = rope + ((size_t)pos * 32 + 8 * (j & 3)) * 2;
        float ov[8];
#pragma unroll
        for (int q = 0; q < 8; ++q) { const float x = v[q] * rstd * gg[q]; const float y = __shfl_xor(x, 4); const float cs = rp[2 * q], sn = rp[2 * q + 1];
            ov[q] = (j & 4) ? (x * cs + y * sn) : (x * cs - y * sn); }
        u32x4 ow; ow.x = cvt_pk_bf16(ov[0], ov[1]); ow.y = cvt_pk_bf16(ov[2], ov[3]); ow.z = cvt_pk_bf16(ov[4], ov[5]); ow.w = cvt_pk_bf16(ov[6], ov[7]);
        *(u32x4*)p = ow;
    }
}

__device__ __forceinline__ void cross_softmax_phase(const Frame& F) {
    const float* CS = (const float*)POOLP(PL_CS); bf16_t* CP = (bf16_t*)POOLP(PL_CP);
    const long nrows = (long)TT * 4, gw = (long)F.bid * NWAVES + F.wave, NGW = (long)F.G * NWAVES;
    constexpr float C = 0.04419417382415922f * 1.4426950408889634f;
    for (long r = gw; r < nrows; r += NGW) {
        const f32x4 v = *((const f32x4*)(CS + r * 256) + F.lane);
        float m = fmaxf(fmaxf(v.x, v.y), fmaxf(v.z, v.w));
#pragma unroll
        for (int o = 1; o < 64; o <<= 1) m = fmaxf(m, __shfl_xor(m, o));
        const float e0 = fast_exp2((v.x - m) * C), e1 = fast_exp2((v.y - m) * C), e2 = fast_exp2((v.z - m) * C), e3 = fast_exp2((v.w - m) * C);
        const float inv = fast_rcp(wave_sum((e0 + e1) + (e2 + e3)));
        u32x2 w; w.x = cvt_pk_bf16(e0 * inv, e1 * inv); w.y = cvt_pk_bf16(e2 * inv, e3 * inv);
        *((u32x2*)(CP + r * 256) + F.lane) = w;
    }
}

__device__ __forceinline__ void prologue_phase(const Frame& F) {
    LAS float* scr = (LAS float*)(F.lds + F.wave * 16384);
    const int gw = F.bid * NWAVES + F.wave, NGW = F.G * NWAVES;
    constexpr int IT_GU = (DM / 64) * (2 * DFF / 32), IT_D = (DFF / 64) * (DM / 32), IT_WINE = (DM / 64) * (EVEN_IN / 32), IT_SQ = (DM / 64) * (DM / 32), IT_GLU = (S5W / 64) * (S5W / 32),
                  IT_WINO = (DM / 64) * (ODD_IN / 32), IT_KV = (DM / 64) * (2 * DM / 32);
    constexpr int N_GU = 8 * IT_GU, N_D = 8 * IT_D, N_WINE = 2 * IT_WINE, N_WOUTE = 2 * IT_SQ, N_GLU = 2 * IT_GLU, N_WINO = 2 * IT_WINO, N_WOUTO = 2 * IT_SQ, N_KV = 4 * IT_KV, N_WO = 4 * IT_SQ;
    constexpr int NITEMS = N_GU + N_D + N_WINE + N_WOUTE + N_GLU + N_WINO + N_WOUTO + N_KV + N_WO;
    for (int it = gw; it < NITEMS; it += NGW) {
        int r = it;
        if (r < N_GU) { const int w = r / IT_GU, l = w >> 1, f = w & 1; transpose_item<1>(F.in[f ? I_F2GU : I_F1GU] + (size_t)l * DM * 2 * DFF, DM, 2 * DFF, (bf16_t*)WSP(WS_WGU + w * SZ_WGU), scr, r % IT_GU, F.lane, F.in[f ? I_F2N : I_F1N] + l * DM); continue; } r -= N_GU;
        if (r < N_D) { const int w = r / IT_D, l = w >> 1, f = w & 1; transpose_item<0>(F.in[f ? I_F2D : I_F1D] + (size_t)l * DFF * DM, DFF, DM, (bf16_t*)WSP(WS_WD + w * SZ_WD), scr, r % IT_D, F.lane); continue; } r -= N_D;
        if (r < N_WINE) { const int e = r / IT_WINE; transpose_item<0>(F.in[I_EWIN] + (size_t)e * DM * EVEN_IN, DM, EVEN_IN, (bf16_t*)WSP(WS_WINE + e * SZ_WINE), scr, r % IT_WINE, F.lane, F.in[I_MIXN] + (2 * e) * DM); continue; } r -= N_WINE;
        if (r < N_WOUTE) { const int e = r / IT_SQ; transpose_item<0>(F.in[I_EWOUT] + (size_t)e * DM * DM, DM, DM, (bf16_t*)WSP(WS_WOUTE + e * SZ_SQ), scr, r % IT_SQ, F.lane); continue; } r -= N_WOUTE;
        if (r < N_GLU) { const int e = r / IT_GLU; transpose_item<0>(F.in[I_GLUW] + (size_t)e * S5W * S5W, S5W, S5W, (bf16_t*)WSP(WS_GLU + e * SZ_GLU), scr, r % IT_GLU, F.lane); continue; } r -= N_GLU;
        if (r < N_WINO) { const int o = r / IT_WINO; transpose_item<0>(F.in[I_OWIN] + (size_t)o * DM * ODD_IN, DM, ODD_IN, (bf16_t*)WSP(WS_WINO + o * SZ_WINO), scr, r % IT_WINO, F.lane, F.in[I_MIXN] + (2 * o + 1) * DM); continue; } r -= N_WINO;
        if (r < N_WOUTO) { const int o = r / IT_SQ; transpose_item<0>(F.in[I_OWOUT] + (size_t)o * DM * DM, DM, DM, (bf16_t*)WSP(WS_WOUTO + o * SZ_SQ), scr, r % IT_SQ, F.lane); continue; } r -= N_WOUTO;
        if (r < N_KV) { const int l = r / IT_KV; transpose_item<0>(F.in[I_CWKV] + (size_t)l * DM * 2 * DM, DM, 2 * DM, (bf16_t*)POOLP(PL_WKVT) + (size_t)l * 2 * DM * DM, scr, r % IT_KV, F.lane); continue; } r -= N_KV;
        { const int l = r / IT_SQ; transpose_item<0>(F.in[I_CWO] + (size_t)l * DM * DM, DM, DM, (bf16_t*)POOLP(PL_WOT) + (size_t)l * DM * DM, scr, r % IT_SQ, F.lane); }
    }
    convert_rows(F.in[I_CWQ], (bf16_t*)POOLP(PL_WQB), (size_t)4 * DM * DM / 8, (size_t)F.bid * NTHREADS + F.tid, (size_t)F.G * NTHREADS);
    for (int m = gw; m < 4 * 2 * NMEM; m += NGW) { const int l = m / (2 * NMEM), s = (m / NMEM) & 1, j = m % NMEM;
        rms_row_to_bf16(F.in[s ? I_MS : I_MP] + (size_t)j * DM, F.in[I_MN] + l * DM, (bf16_t*)POOLP(PL_MEMN) + (size_t)m * DM, nullptr, F.lane); }
    for (int m = gw; m < TT; m += NGW) { const float* src = m < T_P ? F.in[I_XP] + (size_t)m * DM : F.in[I_XS] + (size_t)(m - T_P) * DM;
        const f32x4* xr = (const f32x4*)src + F.lane; u32x2* bo = (u32x2*)((bf16_t*)WSP(WS_HB) + (size_t)m * DM) + F.lane; float s = 0.f;
        const int rr = m & 255, ai = rr >> 7, wr = (rr >> 6) & 1, mm = (rr >> 4) & 3, fr = rr & 15, cc = 4 * F.lane, bj = cc >> 7, wc = (cc >> 5) & 3, fq = (cc >> 3) & 3, n = (cc >> 2) & 1;
        unsigned* xl = (unsigned*)(WSP(WS_X) + (size_t)(m >> 8) * 8 * 65536) + ((size_t)((ai * 4 + mm) * 512 + (wr * 4 + wc) * 64 + fq * 16 + fr)) * 4 + bj * 2 + n;
#pragma unroll
        for (int j = 0; j < 8; ++j) { const f32x4 v = xr[64 * j]; unsigned a0, a1, lo; res_enc4(v, a0, a1, lo); bo[64 * j] = (u32x2){a0, a1}; xl[(size_t)j * 16384] = lo; s += (v.x * v.x + v.y * v.y) + (v.z * v.z + v.w * v.w); }
        s = wave_sum(s);
        if (F.lane < 8) ((float*)(WSP(WS_MISC) + MISC_PSS))[(size_t)m * 8 + F.lane] = F.lane == 0 ? s : 0.f; }
    { float* rope = (float*)(WSP(WS_MISC) + MISC_ROPE); const int gt = F.bid * NTHREADS + F.tid;
      if (gt < 256 * 32) { const int pos = gt >> 5, i = gt & 31; const float inv = powf(10000.0f, -(float)(2 * i) / 64.0f); float sn, cs; sincosf((float)pos * inv, &sn, &cs); rope[gt * 2] = cs; rope[gt * 2 + 1] = sn; }
      if (gt < 2) { float s1 = 0.f, s2 = 0.f; for (int q = 0; q < 64; ++q) { s1 += F.in[I_LQ1][gt * 64 + q] * F.in[I_LK1][gt * 64 + q]; s2 += F.in[I_LQ2][gt * 64 + q] * F.in[I_LK2][gt * 64 + q]; }
          const float linit = 0.8f - 0.6f * expf(-0.3f * (float)(2 * gt)); ((float*)(WSP(WS_MISC) + MISC_LAM))[gt * 2] = expf(s1) - expf(s2) + linit; ((float*)(WSP(WS_MISC) + MISC_LAM))[gt * 2 + 1] = linit; } }
    __syncthreads();
    for (int w = F.bid; w < 2 * S5G; w += F.G) s5_precompute_group(F, w / S5G, w % S5G);
}

#ifndef GQA_SDEPTH
#define GQA_SDEPTH 1
#endif
#ifndef DIFF_SDEPTH
#define DIFF_SDEPTH 1
#endif
#ifndef ATT_SETPRIO
#define ATT_SETPRIO 0
#endif
#if ATT_SETPRIO
#define ATT_PRIO(x) __builtin_amdgcn_s_setprio(x)
#else
#define ATT_PRIO(x) do {} while (0)
#endif
namespace att {
constexpr int NW = 8, QBLK = 32, KVBLK = 64, DV = 128;
constexpr float THR = 8.f;
__device__ __forceinline__ int crow(int r, int hi) { return (r & 3) + 8 * (r >> 2) + 4 * hi; }
template <int DQK> __device__ __forceinline__ int kswz(int row, int colB) { if (DQK == 128) return row * 256 + (colB ^ ((row & 7) << 4)); else return row * 128 + (colB ^ (((row >> 1) & 7) << 4)); }
__device__ __forceinline__ int v_st(int k, int c) { const int kk = (k & ~0xC) | ((k & 4) << 1) | ((k & 8) >> 1); return ((kk >> 3) * 4 + (c >> 5)) * 512 + ((kk & 7) * 32 + (c & 31)) * 2; }
__device__ __forceinline__ int v_rd_base(int lane) { return ((lane & 3) << 3) | (((lane >> 2) & 3) << 6) | (((lane >> 4) & 1) << 5) | (((lane >> 5) & 1) << 8); }
constexpr int v_rd_off(int d0, int ks, int half) { return d0 * 512 + ks * 4096 + half * 2048; }
template <int OFF> __device__ __forceinline__ s16x4 tr_read(int vb) { s16x4 r; asm volatile("ds_read_b64_tr_b16 %0, %1 offset:%2" : "=&v"(r) : "v"(vb), "i"(OFF) : "memory"); return r; }
template <int D0> __device__ __forceinline__ void pv_one(f32x16& od, int vb, bf16x8 pa0, bf16x8 pa1, bf16x8 pa2, bf16x8 pa3) {
  const s16x4 l0 = tr_read<v_rd_off(D0, 0, 0)>(vb), h0 = tr_read<v_rd_off(D0, 0, 1)>(vb), l1 = tr_read<v_rd_off(D0, 1, 0)>(vb), h1 = tr_read<v_rd_off(D0, 1, 1)>(vb);
  const s16x4 l2 = tr_read<v_rd_off(D0, 2, 0)>(vb), h2 = tr_read<v_rd_off(D0, 2, 1)>(vb), l3 = tr_read<v_rd_off(D0, 3, 0)>(vb), h3 = tr_read<v_rd_off(D0, 3, 1)>(vb);
  asm volatile("s_waitcnt lgkmcnt(0)" ::: "memory"); SBAR();
#define PK(L, H) (bf16x8){L[0], L[1], L[2], L[3], H[0], H[1], H[2], H[3]}
  ATT_PRIO(1);
  od = __builtin_amdgcn_mfma_f32_32x32x16_bf16(pa0, PK(l0, h0), od, 0, 0, 0);
  od = __builtin_amdgcn_mfma_f32_32x32x16_bf16(pa1, PK(l1, h1), od, 0, 0, 0);
  od = __builtin_amdgcn_mfma_f32_32x32x16_bf16(pa2, PK(l2, h2), od, 0, 0, 0);
  od = __builtin_amdgcn_mfma_f32_32x32x16_bf16(pa3, PK(l3, h3), od, 0, 0, 0);
  ATT_PRIO(0);
#undef PK
}
__device__ __forceinline__ void pv_d0(f32x16* o, int vb, bf16x8 pa0, bf16x8 pa1, bf16x8 pa2, bf16x8 pa3) {
  pv_one<0>(o[0], vb, pa0, pa1, pa2, pa3); pv_one<1>(o[1], vb, pa0, pa1, pa2, pa3); pv_one<2>(o[2], vb, pa0, pa1, pa2, pa3); pv_one<3>(o[3], vb, pa0, pa1, pa2, pa3);
}
template <int DQK> struct Cst { static constexpr float SCALE = DQK == 128 ? 0.088388347648318440f : 0.125f; static constexpr float C = SCALE * 1.4426950408889634f; };

template <int DQK>
__device__ __forceinline__ void partialSM(f32x16& p0, f32x16& p1, float& m_reg, float& mn, float& alpha) {
  constexpr float C = Cst<DQK>::C, SCALE = Cst<DQK>::SCALE;
  float pmax = p0[0];
#pragma unroll
  for (int r = 1; r < 16; ++r) pmax = fmaxf(pmax, p0[r]);
#pragma unroll
  for (int r = 0; r < 16; ++r) pmax = fmaxf(pmax, p1[r]);
  { auto rr = __builtin_amdgcn_permlane32_swap(__float_as_uint(pmax), __float_as_uint(pmax), false, false);
    pmax = fmaxf(__uint_as_float(rr[0]), __uint_as_float(rr[1])); }
  if (__builtin_expect(__all(pmax - m_reg <= THR / SCALE), 1)) { mn = m_reg; alpha = 1.f; }
  else { mn = fmaxf(m_reg, pmax); alpha = __builtin_amdgcn_exp2f((m_reg - mn) * C); m_reg = mn; }
  const float mnC = -mn * C;
#pragma unroll
  for (int r = 0; r < 16; ++r) p0[r] = fmaf(p0[r], C, mnC);
#pragma unroll
  for (int r = 0; r < 16; ++r) p1[r] = fmaf(p1[r], C, mnC);
#pragma unroll
  for (int r = 0; r < 16; ++r) p0[r] = __builtin_amdgcn_exp2f(p0[r]);
}
__device__ __forceinline__ void finishSM(f32x16& p0, f32x16& p1, float alpha, float& l_reg, bf16x8& pa0, bf16x8& pa1, bf16x8& pa2, bf16x8& pa3) {
#pragma unroll
  for (int r = 0; r < 16; ++r) p1[r] = __builtin_amdgcn_exp2f(p1[r]);
  float ps = 0;
#pragma unroll
  for (int r = 0; r < 16; ++r) ps += p0[r];
#pragma unroll
  for (int r = 0; r < 16; ++r) ps += p1[r];
  { auto rr = __builtin_amdgcn_permlane32_swap(__float_as_uint(ps), __float_as_uint(ps), false, false);
    ps = __uint_as_float(rr[0]) + __uint_as_float(rr[1]); }
  l_reg = l_reg * alpha + ps;
#define PK4(P, BASE, OUT) do { unsigned a0 = cvt_pk_bf16(P[BASE + 0], P[BASE + 1]), a1 = cvt_pk_bf16(P[BASE + 2], P[BASE + 3]);   \
    unsigned b0 = cvt_pk_bf16(P[BASE + 4], P[BASE + 5]), b1 = cvt_pk_bf16(P[BASE + 6], P[BASE + 7]);                              \
    auto r0 = __builtin_amdgcn_permlane32_swap(a0, b0, false, false); auto r1 = __builtin_amdgcn_permlane32_swap(a1, b1, false, false); \
    u32x4 w = {r0[0], r1[0], r0[1], r1[1]}; OUT = *reinterpret_cast<bf16x8*>(&w); } while (0)
  PK4(p0, 0, pa0); PK4(p0, 8, pa1); PK4(p1, 0, pa2); PK4(p1, 8, pa3);
#undef PK4
}
template <int DQK, bool ALIBI>
__device__ __forceinline__ void qkt(f32x16& p0, f32x16& p1, const char* Ks, const bf16x8* qr, int r32, int hi, float dq, float sl) {
  if (ALIBI) {
    float dh = dq - (float)(4 * hi); asm volatile("" : "+v"(dh));
#pragma unroll
    for (int r = 0; r < 16; ++r) { const float c = (float)((r & 3) + 8 * (r >> 2)); p0[r] = -sl * fabsf(dh - c); p1[r] = -sl * fabsf(dh - (c + 32.f)); }
  } else { p0 = f32x16{}; p1 = f32x16{}; }
  ATT_PRIO(1);
#pragma unroll
  for (int d0 = 0; d0 < DQK / 16; ++d0) { const int cb = (d0 * 16 + hi * 8) * 2;
    const bf16x8 b0 = *reinterpret_cast<const bf16x8*>(Ks + kswz<DQK>(r32, cb));
    const bf16x8 b1 = *reinterpret_cast<const bf16x8*>(Ks + kswz<DQK>(32 + r32, cb));
    p0 = __builtin_amdgcn_mfma_f32_32x32x16_bf16(b0, qr[d0], p0, 0, 0, 0);
    p1 = __builtin_amdgcn_mfma_f32_32x32x16_bf16(b1, qr[d0], p1, 0, 0, 0); }
  ATT_PRIO(0);
}

template <int DQK, bool ALIBI, int SDEPTH, int LDKV>
__device__ __forceinline__ void attn_pass(const bf16_t* __restrict__ Qw, const bf16_t* __restrict__ Kh, const bf16_t* __restrict__ Vh, int seq, char* lds, f32x16 (&o)[4], float qpos, float sl, int tid) {
  constexpr int SHM_V = KVBLK * DV * 2, SHM_K = KVBLK * DQK * 2;
  const int wid = tid >> 6, lane = tid & 63, r32 = lane & 31, hi = lane >> 5;
  char* V_lds = lds; char* K_lds = lds + 2 * SHM_V;
  float* ws = (float*)(lds + 2 * SHM_V + 2 * SHM_K) + wid * 64; float* li_l = ws; float* al_l = ws + 32;
  float m_reg = -1e30f, l_reg = 0; bf16x8 qr[DQK / 16];
#pragma unroll
  for (int d0 = 0; d0 < 4; ++d0) o[d0] = f32x16{};
#pragma unroll
  for (int d0 = 0; d0 < DQK / 16; ++d0) qr[d0] = *reinterpret_cast<const bf16x8*>(Qw + d0 * 16);
  const int sr = tid >> 4, sc = (tid & 15) * 8, vst0 = v_st(sr, sc), vst1 = v_st(32 + sr, sc);
  const int kr = DQK == 128 ? sr : (tid >> 3), kc = DQK == 128 ? sc : (tid & 7) * 8;
  const int vb0 = (int)(uintptr_t)V_lds + v_rd_base(lane);
  struct { bf16x8 vs0, vs1, ks0, ks1; } sr_[SDEPTH];
#define SLOAD(i, k0) do { sr_[i].vs0 = *(const bf16x8*)(Vh + (size_t)((k0) + sr) * LDKV + sc); sr_[i].vs1 = *(const bf16x8*)(Vh + (size_t)((k0) + 32 + sr) * LDKV + sc); \
    sr_[i].ks0 = *(const bf16x8*)(Kh + (size_t)((k0) + kr) * LDKV + kc); if (DQK == 128) sr_[i].ks1 = *(const bf16x8*)(Kh + (size_t)((k0) + 32 + kr) * LDKV + kc); } while (0)
#define SWRITE(b, i) do { *(bf16x8*)(V_lds + (b) * SHM_V + vst0) = sr_[i].vs0; *(bf16x8*)(V_lds + (b) * SHM_V + vst1) = sr_[i].vs1; \
    *(bf16x8*)(K_lds + (b) * SHM_K + kswz<DQK>(kr, kc * 2)) = sr_[i].ks0; if (DQK == 128) *(bf16x8*)(K_lds + (b) * SHM_K + kswz<DQK>(32 + kr, kc * 2)) = sr_[i].ks1; } while (0)
#define SWAIT() do { if (SDEPTH == 1) asm volatile("s_waitcnt vmcnt(0)" ::: "memory"); else if (DQK == 128) asm volatile("s_waitcnt vmcnt(4)" ::: "memory"); else asm volatile("s_waitcnt vmcnt(3)" ::: "memory"); } while (0)
#define RESC(a) do { if (__any((a) < 1.f)) { if (hi == 0) al_l[r32] = (a); asm volatile("s_waitcnt lgkmcnt(0)" ::: "memory"); \
    _Pragma("unroll") for (int d = 0; d < 4; ++d) _Pragma("unroll") for (int r = 0; r < 16; ++r) o[d][r] *= al_l[crow(r, hi)]; } } while (0)
  f32x16 pA0, pA1, pB0, pB1; float mnA, mnB, alA, alB; bf16x8 pa0, pa1, pa2, pa3; const int NT = seq / KVBLK;
  constexpr int SE = 0, SO = SDEPTH - 1;
  SLOAD(SE, 0); asm volatile("s_waitcnt vmcnt(0)" ::: "memory"); SWRITE(0, SE); __syncthreads();
  qkt<DQK, ALIBI>(pA0, pA1, K_lds, qr, r32, hi, qpos, sl); partialSM<DQK>(pA0, pA1, m_reg, mnA, alA);
  SLOAD(SO, KVBLK); if (SDEPTH == 2) { if (2 < NT) SLOAD(SE, 2 * KVBLK); }
  SWAIT(); SWRITE(1, SO); __syncthreads();
  _Pragma("unroll 1") for (int j = 1; j + 1 < NT; j += 2) {
    SBAR(); qkt<DQK, ALIBI>(pB0, pB1, K_lds + SHM_K, qr, r32, hi, qpos - (float)(j * KVBLK), sl);
    finishSM(pA0, pA1, alA, l_reg, pa0, pa1, pa2, pa3); SBAR();
    SLOAD(SO, (j + SDEPTH) * KVBLK); SBAR();
    pv_d0(o, vb0, pa0, pa1, pa2, pa3); partialSM<DQK>(pB0, pB1, m_reg, mnB, alB);
    __syncthreads(); SWAIT(); SWRITE(0, SE);
    RESC(alB); __syncthreads();
    SBAR(); qkt<DQK, ALIBI>(pA0, pA1, K_lds, qr, r32, hi, qpos - (float)((j + 1) * KVBLK), sl);
    finishSM(pB0, pB1, alB, l_reg, pa0, pa1, pa2, pa3); SBAR();
    if (SDEPTH == 1 || j + 3 < NT) SLOAD(SE, (j + 1 + SDEPTH) * KVBLK); SBAR();
    pv_d0(o, vb0 + SHM_V, pa0, pa1, pa2, pa3); partialSM<DQK>(pA0, pA1, m_reg, mnA, alA);
    __syncthreads(); SWAIT(); SWRITE(1, SO);
    RESC(alA); __syncthreads();
  }
  SBAR(); qkt<DQK, ALIBI>(pB0, pB1, K_lds + SHM_K, qr, r32, hi, qpos - (float)((NT - 1) * KVBLK), sl);
  finishSM(pA0, pA1, alA, l_reg, pa0, pa1, pa2, pa3); SBAR();
  pv_d0(o, vb0, pa0, pa1, pa2, pa3); partialSM<DQK>(pB0, pB1, m_reg, mnB, alB);
  __syncthreads(); RESC(alB);
  finishSM(pB0, pB1, alB, l_reg, pa0, pa1, pa2, pa3); SBAR();
  pv_d0(o, vb0 + SHM_V, pa0, pa1, pa2, pa3);
  if (hi == 0) li_l[r32] = l_reg; asm volatile("s_waitcnt lgkmcnt(0)" ::: "memory");
#pragma unroll
  for (int r = 0; r < 16; ++r) { const float rl = __builtin_amdgcn_rcpf(li_l[crow(r, hi)]);
#pragma unroll
    for (int d0 = 0; d0 < 4; ++d0) o[d0][r] *= rl; }
#undef SLOAD
#undef SWRITE
#undef SWAIT
#undef RESC
}
}

__device__ __forceinline__ void gqa_attn_phase(const Frame& F) {
    const bf16_t* Z = (const bf16_t*)POOLP(PL_Z); bf16_t* CAT = (bf16_t*)POOLP(PL_CAT);
    constexpr int NU_S = 16 * (T_S / 256), NU = NU_S + 16 * (T_P / 256);
    for (int L = F.bid; L < NU; L += F.G) {
        int tid = threadIdx.x; asm volatile("" : "+v"(tid));
        const int lane = tid & 63, r32 = lane & 31, hi = lane >> 5, wid = tid >> 6;
        int seq, head, qb;
        if (L < NU_S) { const int x = L & 7, r = L >> 3, kvh = x & 3, half = x >> 2; seq = 1; head = kvh * 4 + (r & 3); qb = half * 32 + (r >> 2); }
        else { const int Lp = L - NU_S, x = Lp & 7, r = Lp >> 3, kvh = x & 3, half = x >> 2; seq = 0; head = kvh * 4 + (r & 3); qb = half * 16 + (r >> 2); }
        const int t0 = seq ? T_P : 0, slen = seq ? T_S : T_P, kvh = head >> 2;
        const bf16_t* Qw = Z + (size_t)(t0 + qb * 256 + wid * 32 + r32) * ZLD + head * 128 + hi * 8;
        const bf16_t* Kh = Z + (size_t)t0 * ZLD + 2048 + kvh * 128; const bf16_t* Vh = Z + (size_t)t0 * ZLD + 2560 + kvh * 128;
        f32x16 o[4];
        att::attn_pass<128, false, GQA_SDEPTH, ZLD>(Qw, Kh, Vh, slen, F.ldsg, o, 0.f, 0.f, tid);
        bf16_t* Ow = CAT + (size_t)(t0 + qb * 256 + wid * 32) * DM + head * 128;
#pragma unroll
        for (int r = 0; r < 16; ++r) { const int orow = att::crow(r, hi);
#pragma unroll
            for (int d0 = 0; d0 < 4; ++d0) Ow[(size_t)orow * DM + d0 * 32 + r32] = f2bf(o[d0][r]); }
    }
}

__device__ __forceinline__ void qk_bound_pass(const Frame& F, int e) {
    const bf16_t* Z = (const bf16_t*)POOLP(PL_Z); unsigned* ctl = (unsigned*)WSP(WS_CTL) + CW_QKB + e * 64;
    const int gw = F.bid * NWAVES + F.wave, NGW = F.G * NWAVES, lane = F.lane;
    float mx[2][2] = {{0.f, 0.f}, {0.f, 0.f}};
    for (int t = gw; t < TT; t += NGW) {
        const bf16_t* row = Z + (size_t)t * ZLD + lane * 16;
#pragma unroll
        for (int qk = 0; qk < 2; ++qk) { const u32x4 a = *(const u32x4*)(row + qk * 1024), b = *(const u32x4*)(row + qk * 1024 + 8);
            float s = bflo(a.x) * bflo(a.x) + bfhi(a.x) * bfhi(a.x) + bflo(a.y) * bflo(a.y) + bfhi(a.y) * bfhi(a.y) + bflo(a.z) * bflo(a.z) + bfhi(a.z) * bfhi(a.z) + bflo(a.w) * bflo(a.w) + bfhi(a.w) * bfhi(a.w)
                    + bflo(b.x) * bflo(b.x) + bfhi(b.x) * bfhi(b.x) + bflo(b.y) * bflo(b.y) + bfhi(b.y) * bfhi(b.y) + bflo(b.z) * bflo(b.z) + bfhi(b.z) * bfhi(b.z) + bflo(b.w) * bflo(b.w) + bfhi(b.w) * bfhi(b.w);
            s += __shfl_xor(s, 1); s += __shfl_xor(s, 2);
            if (t < T_P) mx[0][qk] = fmaxf(mx[0][qk], s); else mx[1][qk] = fmaxf(mx[1][qk], s); }
    }
    LAS float* red = (LAS float*)F.lds;
    if ((lane & 3) == 0) {
#pragma unroll
        for (int sq = 0; sq < 2; ++sq)
#pragma unroll
            for (int qk = 0; qk < 2; ++qk) red[(F.wave * 4 + sq * 2 + qk) * 16 + (lane >> 2)] = mx[sq][qk]; }
    LDS_WAIT(); __syncthreads();
    if (F.tid < 64) { float m = 0.f;
#pragma unroll
        for (int w = 0; w < 8; ++w) m = fmaxf(m, red[w * 64 + F.tid]);
        atomicMax(ctl + F.tid, __float_as_uint(m)); }
    __syncthreads();
}

__device__ __forceinline__ void diff_attn_phase(const Frame& F, int e, int rep = 0) {
    const bf16_t* Z = (const bf16_t*)POOLP(PL_Z); bf16_t* CAT = (bf16_t*)POOLP(PL_CAT); float* ST = (float*)POOLP(PL_STASH);
    const float lam = ((const float*)(WSP(WS_MISC) + MISC_LAM))[e * 2], linit = ((const float*)(WSP(WS_MISC) + MISC_LAM))[e * 2 + 1];
    const float* sg = F.in[I_SUBLN] + e * 128;
    unsigned* ctl = (unsigned*)WSP(WS_CTL); const unsigned* qkb = ctl + CW_QKB + e * 64; unsigned* qctr = ctl + CW_QUEUE + e * 64 + rep * 256;
    constexpr int NU = 8 * (T_S / 256) + 8 * (T_P / 256);
    LAS int* uslot = (LAS int*)(F.lds + RING_BYTES + 64);
    for (;;) {
        __syncthreads();
        if (threadIdx.x == 0) *uslot = (int)__hip_atomic_fetch_add(qctr, 1u, RLX_AGENT);
        LDS_WAIT(); __syncthreads();
        const int u = __builtin_amdgcn_readfirstlane(*uslot);
        if (u >= NU) break;
        int tid = threadIdx.x; asm volatile("" : "+v"(tid));
        const int lane = tid & 63, r32 = lane & 31, hi = lane >> 5, wid = tid >> 6;
        f32x4* st = (f32x4*)ST + ((size_t)F.bid * NTHREADS + tid) * 16;
        const int head = 7 - u / 96, rr = u % 96, seq = rr < 64 ? 1 : 0, qb = seq ? rr : rr - 64;
        const int t0 = seq ? T_P : 0, slen = seq ? T_S : T_P;
        const float slope = exp2f(-(float)(head + 1)), sl = slope * 8.0f;
        const bf16_t* Vh = Z + (size_t)t0 * ZLD + 2048 + head * 128;
        f32x16 o[4];
        for (int m = 0; m < 2; ++m) {
            const float q2 = __uint_as_float(__hip_atomic_load(qkb + (seq * 2 + 0) * 16 + head * 2 + m, RLX_AGENT)), k2 = __uint_as_float(__hip_atomic_load(qkb + (seq * 2 + 1) * 16 + head * 2 + m, RLX_AGENT));
            const float Bnd = 0.25f * sqrtf(q2 * k2) + 32.0f;
            float Wf = Bnd / slope; if (!(Wf < (float)slen)) Wf = (float)slen;
            const int W = (int)Wf + 1;
            int tlo = (qb * 256 - W) >> 6; if (tlo < 0) tlo = 0;
            int thi = (qb * 256 + 256 + W + 63) >> 6; if (thi > slen / 64) thi = slen / 64;
            if ((thi - tlo) & 1) { if (thi < slen / 64) ++thi; else --tlo; }
            tlo = __builtin_amdgcn_readfirstlane(tlo); thi = __builtin_amdgcn_readfirstlane(thi);
            const float qpos = (float)(qb * 256 + wid * 32 + r32 - tlo * 64);
            const bf16_t* Qw = Z + (size_t)(t0 + qb * 256 + wid * 32 + r32) * ZLD + head * 128 + m * 64 + hi * 8;
            const bf16_t* Kh = Z + (size_t)(t0 + tlo * 64) * ZLD + 1024 + head * 128 + m * 64;
            att::attn_pass<64, true, DIFF_SDEPTH, ZLD>(Qw, Kh, Vh + (size_t)(tlo * 64) * ZLD, (thi - tlo) * 64, F.ldsg, o, qpos, sl, tid);
            if (m == 0) {
#pragma unroll
                for (int d0 = 0; d0 < 4; ++d0)
#pragma unroll
                    for (int q = 0; q < 4; ++q) st[d0 * 4 + q] = (f32x4){o[d0][4 * q], o[d0][4 * q + 1], o[d0][4 * q + 2], o[d0][4 * q + 3]};
            }
        }
        float ss[16];
#pragma unroll
        for (int r = 0; r < 16; ++r) ss[r] = 0.f;
#pragma unroll
        for (int d0 = 0; d0 < 4; ++d0) {
#pragma unroll
            for (int q = 0; q < 4; ++q) { const f32x4 s4 = st[d0 * 4 + q];
#pragma unroll
                for (int i = 0; i < 4; ++i) { const int r = 4 * q + i; const float a = s4[i] - lam * o[d0][r]; o[d0][r] = a; ss[r] += a * a; } }
            asm volatile("" ::: "memory"); }
#pragma unroll
        for (int r = 0; r < 16; ++r) { float s = ss[r]; s += __shfl_xor(s, 1); s += __shfl_xor(s, 2); s += __shfl_xor(s, 4); s += __shfl_xor(s, 8); s += __shfl_xor(s, 16);
            ss[r] = (1.0f - linit) / sqrtf(s * (1.f / 128.f) + SUBLN_EPS); }
        bf16_t* Ow = CAT + (size_t)(t0 + qb * 256 + wid * 32) * DM + 1024 + head * 128;
#pragma unroll
        for (int d0 = 0; d0 < 4; ++d0) { const float gcol = sg[d0 * 32 + r32];
#pragma unroll
            for (int r = 0; r < 16; ++r) Ow[(size_t)att::crow(r, hi) * DM + d0 * 32 + r32] = f2bf(o[d0][r] * ss[r] * gcol); }
    }
}

constexpr int PH_BASE = 3, PH_PER = 16, PH_END = PH_BASE + 8 * PH_PER - 1;
__host__ __device__ inline bool phase_exists(int pid) {
    if (pid < PH_BASE) return true;
    const int hl = (pid - PH_BASE) / PH_PER, k = (pid - PH_BASE) % PH_PER, f = hl & 1, l = hl >> 1;
    if (k <= 1) return true;
    if (k == 14) return hl == 7;
    if (k == 15 || f == 1 || k == 2 || k == 10 || k == 12) return false;
    if ((l & 1) && (k == 6 || k == 7 || k == 8)) return false;
    return true;
}

__device__ __forceinline__ bool fresh_frame(Frame& F) { int t = threadIdx.x; asm volatile("" : "+v"(t)); F.tid = t; F.lane = t & 63; F.wave = __builtin_amdgcn_readfirstlane(t >> 6); return true; }
__global__ void __launch_bounds__(NTHREADS, 2) fwd_kernel(Args args) {
    extern __shared__ __attribute__((aligned(16))) unsigned char lds[];
    Frame F;
    F.lds = (LAS unsigned char*)lds; F.ldsg = (char*)lds;
    F.MISC = (volatile LAS unsigned*)(F.lds + MISC_OFF);
    F.tid = threadIdx.x; F.lane = F.tid & 63; F.wave = __builtin_amdgcn_readfirstlane(F.tid >> 6);
    F.G = gridDim.x; F.bid = blockIdx.x; F.in = args.in; F.x = args.out; F.ws = args.ws;
    for (int u = F.tid; u < (LDS_BYTES - RING_BYTES) / 4; u += NTHREADS) ((LAS unsigned*)(F.lds + RING_BYTES))[u] = 0u;
    __syncthreads();
    XcdBarrier bar = xcd_barrier_post((unsigned*)(F.ws + WS_CTL) + CW_BAR + args.li * XCD_BAR_WORDS, F.MISC + 8);
    const int lo = args.ph_lo, hi = args.ph_hi;
#define PH(p) (lo <= (p) && (p) < hi && fresh_frame(F))
#define ENDPH(p) do { if ((p) + 1 < hi) xcd_barrier(bar); } while (0)
    float* const PSS = (float*)(F.ws + WS_MISC + MISC_PSS);
    const int rep = args.pad;
#ifdef PROBE_K
#define RSCALE(s) (rep == 0 ? (s) : 0.0f)
#else
#define RSCALE(s) (s)
#endif

    if (PH(0)) { prologue_phase(F); ENDPH(0); }
    if (PH(1)) {
        auto S = make_sched(F, POOLP(PL_MEMN), DM, POOLP(PL_WKVT), DM, 256, 2 * DM, 8, ZKv{});
        EpiBf16<0> E{(bf16_t*)POOLP(PL_KVB), 2 * DM, (size_t)256 * 2 * DM, 0, 0, nullptr, nullptr, nullptr};
        pg8::gemm_phase(F.lds, DM, DM, DM, S, E, F.tid); ENDPH(1);
    }
    if (PH(2)) {
        { auto S = make_sched(F, POOLP(PL_KVB), 2 * DM, POOLP(PL_WQB), DM, 256, DM, 32, ZKf{});
          EpiBf16<2> E{(bf16_t*)WSP(WS_KF), DM, (size_t)256 * DM, 0, 0, F.in[I_CN], nullptr, nullptr};
          pg8::gemm_phase(F.lds, 2 * DM, DM, 512, S, E, F.tid); }
        { auto S = make_sched(F, POOLP(PL_WOT), DM, POOLP(PL_KVB), 2 * DM, DM, 256, 32, ZVw{});
          EpiBf16<0> E{(bf16_t*)WSP(WS_VWT), 1024, (size_t)DM * 1024, 256, 2, nullptr, nullptr, nullptr};
          pg8::gemm_phase(F.lds, DM, 2 * DM, 512, S, E, F.tid); }
        ENDPH(2);
    }
    for (int hl = 0; hl < 8; ++hl) {
        const int l = hl >> 1, f = hl & 1, pb = PH_BASE + hl * PH_PER, eo = l >> 1;
        const bool even = (l & 1) == 0;
        if (PH(pb + 0)) {
            auto S = make_sched(F, WSP(WS_HB), DM, WSP(WS_WGU + (size_t)hl * SZ_WGU), DM, TT, 2 * DFF, 1, ZNone{});
            EpiSwiglu E{F.ws, DFF, F.lds};
            pg8::gemm_phase(F.lds, DM, DM, DM, S, E, F.tid);
            ENDPH(pb + 0);
        }
        if (PH(pb + 1)) {
            auto S = make_sched(F, POOLP(PL_ACT), DFF, WSP(WS_WD + (size_t)hl * SZ_WD), DFF, TT, DM, 1, ZNone{});
            { EpiResidNorm E{RSCALE(0.5f), F.ws, (LAS float*)(F.lds + EXCH_OFF)}; pg8::gemm_phase(F.lds, DFF, DFF, DFF, S, E, F.tid); }
            ENDPH(pb + 1);
        }
        if (f == 0) {
            if (even) {
                if (PH(pb + 3)) {
                    auto S = make_sched(F, WSP(WS_HB), DM, WSP(WS_WINE + (size_t)eo * SZ_WINE), DM, TT, EVEN_IN, 1, ZNone{});
                    EpiWinEven E{F.ws, F.lds};
                    pg8::gemm_phase(F.lds, DM, DM, DM, S, E, F.tid);
                    ENDPH(pb + 3);
                }
                if (PH(pb + 4)) {
                    auto S = make_sched(F, POOLP(PL_UX), S5K2, WSP(WS_WST + (size_t)eo * 64 * SZ_WST), S5K1, NCH, S5NS, S5G, ZLin{(size_t)NCH * S5K2 * 2, SZ_WST});
                    EpiF32 E{(float*)POOLP(PL_SST), S5G * S5NS, (size_t)S5NS};
                    pg8::gemm_phase(F.lds, S5K2, S5K1, S5K1, S, E, F.tid);
                    qk_bound_pass(F, eo); ENDPH(pb + 4);
                }
                if (PH(pb + 5)) { s5_scan_phase(F, eo); ENDPH(pb + 5); }
                if (PH(pb + 6)) {
                    auto S = make_sched(F, POOLP(PL_UX), S5K2, WSP(WS_TG + (size_t)eo * 64 * SZ_TG), S5K2, NCH, S5K1, S5G, ZLin{(size_t)NCH * S5K2 * 2, SZ_TG});
                    EpiS5Out E{(bf16_t*)POOLP(PL_GB)};
                    pg8::gemm_phase(F.lds, S5K2, S5K2, S5K2, S, E, F.tid); ENDPH(pb + 6);
                }
                if (PH(pb + 7)) {
                    auto S = make_sched(F, POOLP(PL_GB), S5W, WSP(WS_GLU + (size_t)eo * SZ_GLU), S5W, TT, S5W, 1, ZNone{});
                    EpiGlu E{(const bf16_t*)POOLP(PL_GB), F.in[I_GLUB] + eo * S5W, (bf16_t*)POOLP(PL_CAT)};
                    pg8::gemm_phase(F.lds, S5W, S5W, S5W, S, E, F.tid); ENDPH(pb + 7);
                }
                if (PH(pb + 8)) { diff_attn_phase(F, eo, rep); ENDPH(pb + 8); }
            } else {
                if (PH(pb + 3)) {
                    auto S = make_sched(F, WSP(WS_HB), DM, WSP(WS_WINO + (size_t)eo * SZ_WINO), DM, TT, ODD_IN, 1, ZNone{});
                    EpiBf16<1> E{(bf16_t*)POOLP(PL_Z), ZLD, 0, 0, 0, nullptr, F.ws, F.lds};
                    pg8::gemm_phase(F.lds, DM, DM, DM, S, E, F.tid); ENDPH(pb + 3);
                }
                if (PH(pb + 4)) { qk_prep_phase(F, eo); ENDPH(pb + 4); }
                if (PH(pb + 5)) { gqa_attn_phase(F); ENDPH(pb + 5); }
            }
            if (PH(pb + 9)) {
                auto S = make_sched(F, POOLP(PL_CAT), DM, even ? WSP(WS_WOUTE + (size_t)eo * SZ_SQ) : WSP(WS_WOUTO + (size_t)eo * SZ_SQ), DM, TT, DM, 1, ZNone{});
                { EpiResidNorm E{RSCALE(1.0f), F.ws, (LAS float*)(F.lds + EXCH_OFF)}; pg8::gemm_phase(F.lds, DM, DM, DM, S, E, F.tid); }
                ENDPH(pb + 9);
            }
            if (PH(pb + 11)) {
                auto S = make_sched(F, WSP(WS_HB), DM, WSP(WS_KF + (size_t)l * 2 * SZ_KF), DM, TT, 1024, 1, ZNone{}); S.split = T_P / 256; S.bseq = SZ_KF;
                EpiCrossSm E{F.ws, (LAS f32x2*)(F.lds + EXCH_OFF), F.lds};
                pg8::gemm_phase(F.lds, DM, DM, DM, S, E, F.tid);
                ENDPH(pb + 11);
            }
            if (PH(pb + 13)) {
                auto S = make_sched(F, POOLP(PL_CP), 1024, WSP(WS_VWT + (size_t)l * 2 * SZ_KF), 1024, TT, DM, 1, ZNone{}); S.split = T_P / 256; S.bseq = SZ_KF;
                EpiResidNorm E{RSCALE(1.0f), F.ws, (LAS float*)(F.lds + EXCH_OFF)};
                pg8::gemm_phase(F.lds, 1024, 1024, 1024, S, E, F.tid); ENDPH(pb + 13);
            }
        }
        if (hl == 7 && PH(pb + 14)) { final_norm_phase(F, F.in[I_FINN]); ENDPH(pb + 14); }
    }
#undef PH
#undef ENDPH
}

#ifndef MK_PER_PHASE
#define MK_PER_PHASE 0
#endif
extern "C" void kernel_launch(void* const* d_in, const int* in_sizes, int n_in, void* d_out, int out_size, void* d_ws, size_t ws_size, hipStream_t stream) {
    static int grid = 0;
    if (grid == 0) {
        if (n_in != N_IN || out_size != TT * DM || ws_size < WS_END) { fprintf(stderr, "kernel_launch: unexpected shapes: n_in %d out %d ws %zu (need %zu)\n", n_in, out_size, ws_size, (size_t)WS_END); grid = -1; return; }
        int dev = 0, cus = 0, per_cu = 0;
        if (hipGetDevice(&dev) != hipSuccess || hipDeviceGetAttribute(&cus, hipDeviceAttributeMultiprocessorCount, dev) != hipSuccess) { grid = -1; return; }
        if (hipFuncSetAttribute((const void*)fwd_kernel, hipFuncAttributeMaxDynamicSharedMemorySize, LDS_BYTES) != hipSuccess) { fprintf(stderr, "kernel_launch: hipFuncSetAttribute failed\n"); grid = -1; return; }
        if (hipOccupancyMaxActiveBlocksPerMultiprocessor(&per_cu, (const void*)fwd_kernel, NTHREADS, LDS_BYTES) != hipSuccess || per_cu < 1) { fprintf(stderr, "kernel_launch: occupancy query says %d\n", per_cu); (void)hipGetLastError(); grid = -1; return; }
        grid = cus;
    }
    if (grid < 0) return;
    (void)hipMemsetAsync((char*)d_ws + WS_CTL, 0, CTL_BYTES, stream);
    Args a{};
    for (int i = 0; i < N_IN; ++i) a.in[i] = (const float*)d_in[i];
    a.out = (float*)d_out; a.ws = (unsigned char*)d_ws; a.pad = 0;
#if MK_PER_PHASE
    int li = 0;
    for (int p = 0; p < PH_END; ++p) { if (!phase_exists(p)) continue; a.ph_lo = p; a.ph_hi = p + 1; a.li = li++; a.pad = 0;
        hipLaunchKernelGGL(fwd_kernel, dim3(grid), dim3(NTHREADS), LDS_BYTES, stream, a);
#ifdef PROBE_K
        { const int kind = p < PH_BASE ? 100 + p : (p - PH_BASE) % PH_PER;
          if (kind == PROBE_K) for (int r = 1; r <= PROBE_REPS; ++r) { a.pad = r; hipLaunchKernelGGL(fwd_kernel, dim3(grid), dim3(NTHREADS), LDS_BYTES, stream, a); } }
#endif
    }
#else
    a.ph_lo = 0; a.ph_hi = PH_END; a.li = 0;
    hipLaunchKernelGGL(fwd_kernel, dim3(grid), dim3(NTHREADS), LDS_BYTES, stream, a);
#endif
    const hipError_t le = hipPeekAtLastError();
    if (le != hipSuccess) fprintf(stderr, "kernel_launch: launch failed: %s\n", hipGetErrorName(le));
}
```

```cpp
#include <hip/hip_runtime.h>
#include <cstdio>
#include <cstdint>

#define GAS __attribute__((address_space(1)))
#define LAS __attribute__((address_space(3)))
typedef unsigned short bf16_t;
typedef short bf16x8 __attribute__((ext_vector_type(8)));
typedef short s16x4 __attribute__((ext_vector_type(4)));
typedef float f32x2 __attribute__((ext_vector_type(2)));
typedef float f32x4 __attribute__((ext_vector_type(4)));
typedef float f32x8 __attribute__((ext_vector_type(8)));
typedef float f32x16 __attribute__((ext_vector_type(16)));
typedef unsigned u32x2 __attribute__((ext_vector_type(2)));
typedef unsigned u32x4 __attribute__((ext_vector_type(4)));
typedef GAS unsigned gu32;
#define RLX_AGENT __ATOMIC_RELAXED, __HIP_MEMORY_SCOPE_AGENT
#define LDS_WAIT() asm volatile("s_waitcnt lgkmcnt(0)" ::: "memory")
#define VM_WAIT() asm volatile("s_waitcnt vmcnt(0)" ::: "memory")
#define SBAR() __builtin_amdgcn_sched_barrier(0)

__device__ __forceinline__ unsigned cvt_pk_bf16(float lo, float hi) { unsigned r; asm volatile("v_cvt_pk_bf16_f32 %0, %1, %2" : "=v"(r) : "v"(lo), "v"(hi)); return r; }
__device__ __forceinline__ float bf2f(unsigned short b) { return __uint_as_float(((unsigned)b) << 16); }
__device__ __forceinline__ float bflo(unsigned w) { return __uint_as_float(w << 16); }
__device__ __forceinline__ float bfhi(unsigned w) { return __uint_as_float(w & 0xffff0000u); }
__device__ __forceinline__ unsigned short f2bf(float f) { unsigned u = __float_as_uint(f); return (unsigned short)((u + 0x7fffu + ((u >> 16) & 1u)) >> 16); }
__device__ __forceinline__ float fast_rcp(float x) { return __builtin_amdgcn_rcpf(x); }
__device__ __forceinline__ float fast_exp2(float x) { return __builtin_amdgcn_exp2f(x); }
__device__ __forceinline__ float sigmoidf_fast(float x) { return fast_rcp(1.0f + fast_exp2(-1.4426950408889634f * x)); }
__device__ __forceinline__ float silu_f(float x) { return x * sigmoidf_fast(x); }
__device__ __forceinline__ float gelu_tanh_f(float y) { const float z = y + 0.044715f * y * y * y; return y * fast_rcp(1.0f + fast_exp2(-2.3022081982f * z)); }
__device__ __forceinline__ float wave_sum(float v) {
#pragma unroll
    for (int o = 1; o < 64; o <<= 1) v += __shfl_xor(v, o);
    return v;
}

#define XB_TMO      128
#define XB_XCNT(j)  (256  + 64 * (j))
#define XB_XSUB(j)  (1280 + 64 * (j))
#define XB_XGEN(j)  (2304 + 64 * (j))
#define XB_TOP      3328
#define XB_TOPGEN   3392
#define XCD_BAR_WORDS 3456
#define XB_SPIN_CAP (1u << 22)

__device__ __forceinline__ unsigned xb_ld(unsigned* p)              { return __hip_atomic_load(p, __ATOMIC_RELAXED, __HIP_MEMORY_SCOPE_AGENT); }
__device__ __forceinline__ unsigned xb_add(unsigned* p, unsigned v) { return __hip_atomic_fetch_add(p, v, __ATOMIC_RELAXED, __HIP_MEMORY_SCOPE_AGENT); }
__device__ __forceinline__ unsigned xb_xcc_id() { return (unsigned)__builtin_amdgcn_s_getreg((3 << 11) | 20) & 0xFu; }
#define XB_SPIN(cond, bar) do { unsigned _sp = 0; while (cond) { __builtin_amdgcn_s_sleep(1); \
    if ((++_sp & 255u) == 0u) { if (xb_ld(&(bar)[XB_TMO])) break; if (_sp > XB_SPIN_CAP) { atomicAdd(&(bar)[XB_TMO], 1u); break; } } } } while (0)

struct XcdBarrier { unsigned* bar; unsigned x; volatile LAS unsigned* st; };

__device__ __forceinline__ XcdBarrier xcd_barrier_post(unsigned* bar, volatile LAS unsigned* st) {
    XcdBarrier b; b.bar = bar; b.x = xb_xcc_id(); b.st = st;
    if (threadIdx.x == 0) (void)xb_add(&bar[XB_XCNT(b.x)], 1u);
    return b;
}
__device__ __forceinline__ void xcd_barrier_complete(unsigned* bar, unsigned x, unsigned& nloc, unsigned& nx) {
    const unsigned G = gridDim.x * gridDim.y * gridDim.z;
    unsigned sum, cnt, mine, sp = 0u;
    for (;;) {
        sum = 0u; cnt = 0u; mine = 0u;
#pragma unroll
        for (unsigned j = 0; j < 16; ++j) { const unsigned c = xb_ld(&bar[XB_XCNT(j)]); sum += c; cnt += (c > 0u) ? 1u : 0u; mine = (j == x) ? c : mine; }
        if (sum == G) break;
        __builtin_amdgcn_s_sleep(1);
        if ((++sp & 255u) == 0u) { if (xb_ld(&bar[XB_TMO])) break; if (sp > XB_SPIN_CAP) { atomicAdd(&bar[XB_TMO], 1u); break; } }
    }
    nloc = mine > 0u ? mine : 1u; nx = cnt > 0u ? cnt : 1u;
}
__device__ __forceinline__ void xcd_barrier(const XcdBarrier& b) {
    asm volatile("s_waitcnt vmcnt(0)" ::: "memory");
    __syncthreads();
    if (threadIdx.x == 0) {
        unsigned* bar = b.bar;
        __builtin_amdgcn_s_waitcnt(0);
        unsigned nloc = b.st[0], nx = b.st[1];
        if (nloc == 0u) { xcd_barrier_complete(bar, b.x, nloc, nx); b.st[0] = nloc; b.st[1] = nx; }
        const unsigned old = xb_add(&bar[XB_XSUB(b.x)], 1u);
        const unsigned gen = old / nloc;
        if (old + 1u == (gen + 1u) * nloc) {
            __builtin_amdgcn_fence(__ATOMIC_RELEASE, "agent");
            asm volatile("s_waitcnt vmcnt(0)" ::: "memory");
            const unsigned og = xb_add(&bar[XB_TOP], 1u);
            const unsigned tg = og / nx;
            if (og + 1u == (tg + 1u) * nx) xb_add(&bar[XB_TOPGEN], 1u);
            else XB_SPIN(xb_ld(&bar[XB_TOPGEN]) == tg, bar);
            __builtin_amdgcn_fence(__ATOMIC_ACQUIRE, "agent");
            xb_add(&bar[XB_XGEN(b.x)], 1u);
            asm volatile("s_waitcnt vmcnt(0)" ::: "memory");
        } else {
            XB_SPIN(xb_ld(&bar[XB_XGEN(b.x)]) == gen, bar);
            __builtin_amdgcn_fence(__ATOMIC_ACQUIRE, "agent");
            asm volatile("s_waitcnt vmcnt(0)" ::: "memory");
        }
    }
    __syncthreads();
}

namespace pg8 {
constexpr int BM = 256, BK = 64, HALF = 128, HTB = HALF * BK * 2, STAGE_BYTES = 8 * HTB, NXCD = 8, WGM = 4;
__host__ __device__ __forceinline__ int lds_byte(int r, int c) { const int st = (r >> 4) * 2 + (c >> 5), rr = r & 15, cc = c & 31, ob = rr * 64 + cc * 2; return st * 1024 + (ob ^ (((ob >> 9) & 1) << 5)); }
__host__ __device__ __forceinline__ void stage_rc(int b, int& R, int& C) { const int st = b / 1024, sb = b % 1024, swz = sb ^ (((sb >> 9) & 1) << 5); R = (st >> 1) * 16 + swz / 64; C = (st & 1) * 32 + (swz % 64) / 2; }
__host__ __device__ __forceinline__ int perm32(int rho) { const int n = rho >> 4, i = rho & 15; return 8 * (i >> 2) + 4 * n + (i & 3); }

struct Unit { int pm, pn, z; };
struct Enum {
    int nM, nN, nZ, nwg, G, c, rev, wgm;
    __device__ __forceinline__ void init(int nM_, int nN_, int nZ_, int G_, int c_) { nM = nM_; nN = nN_; nZ = nZ_; nwg = nM * nN * nZ; G = G_; c = c_; rev = 0; wgm = WGM; }
    __device__ __forceinline__ bool next(int i, Unit& u) const {
        const long L = (long)i * G + c; if (L >= nwg) return false;
        int wgid = (int)L; { const int q = nwg / NXCD, r = nwg % NXCD, xcd = wgid % NXCD, off = wgid / NXCD; wgid = (xcd < r ? xcd * (q + 1) : r * (q + 1) + (xcd - r) * q) + off; }
        const int per = nM * nN; u.z = wgid / per; wgid -= u.z * per;
        const int nig = wgm * nN, gid = wgid / nig, fm = gid * wgm, gsz = (nM - fm) < wgm ? (nM - fm) : wgm;
        u.pm = fm + ((wgid % nig) % gsz); u.pn = (wgid % nig) / gsz; if (rev) u.pm = nM - 1 - u.pm; return true;
    }
};

template <class Epi, class Sched>
__device__ __forceinline__ void gemm_phase(LAS unsigned char* lds, const int lda, const int ldb, const int K, const Sched& S, const Epi& E, const int tid) {
    const int wid = __builtin_amdgcn_readfirstlane(tid >> 6), lane = tid & 63, wr = wid >> 2, wc = wid & 3, fr = lane & 15, fq = lane >> 4;
    const int nt = K / BK;
    unsigned voffA[2], voffB[2];
#pragma unroll
    for (int i = 0; i < 2; ++i) { int R, C; stage_rc(tid * 16 + i * 8192, R, C); const int Rb = Epi::PERM ? ((R & ~31) + perm32(R & 31)) : R;
        voffA[i] = (unsigned)(R * lda + C) * 2u; voffB[i] = (unsigned)(Rb * ldb + C) * 2u; }
    const size_t kstep = (size_t)(BK * 2);
    const size_t hstepA = (size_t)HALF * lda * 2, hstepB = (size_t)HALF * ldb * 2;
    const unsigned ldsw = (unsigned)wid * 1024u;
    const int aoff = lds_byte(wr * 64 + fr, fq * 8), boff = lds_byte(wc * 32 + fr, fq * 8);
#define PG8_SA(b, h) (((b) * 2 + (h)) * HTB)
#define PG8_SB(b, h) ((4 + (b) * 2 + (h)) * HTB)
#define PG8_STAGE(bufoff, gbase, voff) do { _Pragma("unroll") for (int _i = 0; _i < 2; ++_i) \
        __builtin_amdgcn_global_load_lds((const unsigned*)((const char*)(gbase) + (voff)[_i]), (LAS unsigned*)(lds + (bufoff) + ldsw + _i * 8192), 16, 0, 0); } while (0)
#define PG8_LDA(dst, b, h) do { _Pragma("unroll") for (int m = 0; m < 4; ++m) _Pragma("unroll") for (int k = 0; k < 2; ++k) dst[m][k] = *(const LAS bf16x8*)(lds + PG8_SA(b, h) + aoff + m * 2048 + k * 1024); } while (0)
#define PG8_LDB(dst, b, h) do { _Pragma("unroll") for (int n = 0; n < 2; ++n) _Pragma("unroll") for (int k = 0; k < 2; ++k) dst[n][k] = *(const LAS bf16x8*)(lds + PG8_SB(b, h) + boff + n * 2048 + k * 1024); } while (0)
#define PG8_MMA(ai, bj, At, Bt) do { __builtin_amdgcn_s_setprio(1); _Pragma("unroll") for (int m = 0; m < 4; ++m) _Pragma("unroll") for (int n = 0; n < 2; ++n) _Pragma("unroll") for (int k = 0; k < 2; ++k) \
        acc[ai][bj][m][n] = __builtin_amdgcn_mfma_f32_16x16x32_bf16(Bt[n][k], At[m][k], acc[ai][bj][m][n], 0, 0, 0); __builtin_amdgcn_s_setprio(0); } while (0)
#define PG8_WAIT_V(n) asm volatile("s_waitcnt vmcnt(" #n ")" ::: "memory")
#define PG8_WAIT_L(n) asm volatile("s_waitcnt lgkmcnt(" #n ")" ::: "memory")
#define PG8_BAR __builtin_amdgcn_s_barrier()
#define PG8_SCHED __builtin_amdgcn_sched_barrier(0)
    Unit cur, nxt; int ui = 0;
    if (!S.next(0, cur)) return;
    f32x4 acc[2][2][4][2];
#pragma unroll
    for (int a = 0; a < 2; ++a)
#pragma unroll
        for (int b = 0; b < 2; ++b)
#pragma unroll
            for (int m = 0; m < 4; ++m)
#pragma unroll
                for (int n = 0; n < 2; ++n) acc[a][b][m][n] = (f32x4){0.f, 0.f, 0.f, 0.f};
    bf16x8 At[4][2], B0[2][2], B1[2][2];
    const char* cA = S.a_base(cur); const char* cB = S.b_base(cur);
    {
        PG8_STAGE(PG8_SB(0, 0), cB, voffB); PG8_STAGE(PG8_SB(0, 1), cB + hstepB, voffB); PG8_STAGE(PG8_SA(0, 0), cA, voffA); PG8_STAGE(PG8_SA(0, 1), cA + hstepA, voffA);
        if (wr == 1) PG8_BAR;
        PG8_WAIT_V(2); PG8_BAR;
        PG8_STAGE(PG8_SB(1, 0), cB + kstep, voffB); PG8_STAGE(PG8_SA(1, 0), cA + kstep, voffA); PG8_STAGE(PG8_SB(1, 1), cB + hstepB + kstep, voffB);
        PG8_WAIT_V(6); PG8_BAR;
    }
    for (;;) {
        if constexpr (Epi::PREFETCH) E.prefetch(lds, cur, ui, wid, lane);
        const bool has_next = S.next(ui + 1, nxt);
        const char* nA = has_next ? S.a_base(nxt) : cA; const char* nB = has_next ? S.b_base(nxt) : cB;
        for (int t = 0; t < nt; t += 2) {
            const bool last = (t == nt - 2);
            const char* a1 = cA + (size_t)(t + 1) * kstep;
            const char* a2 = last ? nA : cA + (size_t)(t + 2) * kstep; const char* b2 = last ? nB : cB + (size_t)(t + 2) * kstep;
            const char* a3 = a2 + kstep; const char* b3 = b2 + kstep;
            PG8_LDB(B0, 0, 0); PG8_LDB(B1, 0, 1); PG8_SCHED; PG8_LDA(At, 0, 0); PG8_STAGE(PG8_SA(1, 1), a1 + hstepA, voffA);
            PG8_WAIT_V(8); PG8_WAIT_L(0); PG8_BAR; PG8_MMA(0, 0, At, B0); PG8_MMA(0, 1, At, B1); PG8_BAR; PG8_SCHED;
            PG8_LDA(At, 0, 1); PG8_STAGE(PG8_SB(0, 0), b2, voffB); PG8_STAGE(PG8_SB(0, 1), b2 + hstepB, voffB); PG8_STAGE(PG8_SA(0, 0), a2, voffA);
            PG8_WAIT_V(8); PG8_WAIT_L(0); PG8_BAR; PG8_MMA(1, 0, At, B0); PG8_MMA(1, 1, At, B1); PG8_BAR; PG8_SCHED;
            PG8_LDB(B0, 1, 0); PG8_LDB(B1, 1, 1); PG8_SCHED; PG8_LDA(At, 1, 0); PG8_STAGE(PG8_SA(0, 1), a2 + hstepA, voffA);
            PG8_WAIT_V(8); PG8_WAIT_L(0); PG8_BAR; PG8_MMA(0, 0, At, B0); PG8_MMA(0, 1, At, B1); PG8_BAR; PG8_SCHED;
            PG8_LDA(At, 1, 1); PG8_STAGE(PG8_SB(1, 0), b3, voffB); PG8_STAGE(PG8_SB(1, 1), b3 + hstepB, voffB); PG8_STAGE(PG8_SA(1, 0), a3, voffA);
            PG8_WAIT_V(8); PG8_WAIT_L(0); PG8_BAR; PG8_MMA(1, 0, At, B0); PG8_MMA(1, 1, At, B1); PG8_BAR; PG8_SCHED;
        }
        if (wr == 0) PG8_BAR;
        E(acc, cur, wr, wc, fr, fq, ui);
        if (!has_next) break;
#pragma unroll
        for (int a = 0; a < 2; ++a)
#pragma unroll
            for (int b = 0; b < 2; ++b)
#pragma unroll
                for (int m = 0; m < 4; ++m)
#pragma unroll
                    for (int n = 0; n < 2; ++n) acc[a][b][m][n] = (f32x4){0.f, 0.f, 0.f, 0.f};
        cur = nxt; cA = nA; cB = nB; ++ui;
        if (wr == 1) PG8_BAR;
    }
    PG8_WAIT_V(0);
    PG8_BAR;
#undef PG8_SA
#undef PG8_SB
#undef PG8_STAGE
#undef PG8_LDA
#undef PG8_LDB
#undef PG8_MMA
#undef PG8_WAIT_V
#undef PG8_WAIT_L
#undef PG8_BAR
#undef PG8_SCHED
}
}

constexpr int DM = 2048, T_P = 8192, T_S = 16384, TT = T_P + T_S, DEPTH = 4, NMEM = 256, DFF = 5632;
constexpr int S5W = 1024, S5G = 64, S5H = 16, S5P = 64, LC = 32, NCH = TT / LC, NCH_P = T_P / LC;
constexpr int S5K1 = LC * S5H  , S5NS = 4 * S5P  , S5K2 = S5K1 + S5NS  ;
constexpr int EVEN_IN = 4096, ODD_IN = 3072, ZLD = 3072;
constexpr float EPS = 1e-6f, SUBLN_EPS = 1e-5f;
constexpr int NWAVES = 8, NTHREADS = 512;

enum { I_XP = 0, I_XS, I_MP, I_MS, I_F1N, I_F1GU, I_F1D, I_MIXN, I_EWIN, I_EWOUT, I_LRE, I_LIM, I_LDT, I_BRE, I_BIM, I_CRE, I_CIM, I_S5D, I_GLUW, I_GLUB,
       I_LQ1, I_LK1, I_LQ2, I_LK2, I_SUBLN, I_OWIN, I_OWOUT, I_QN, I_KN, I_CN, I_MN, I_CWQ, I_CWKV, I_CWO, I_F2N, I_F2GU, I_F2D, I_FINN, N_IN };

constexpr size_t MiB = 1u << 20;
constexpr size_t WS_CTL = 0, CTL_BYTES = 2 * MiB;
constexpr size_t WS_WGU = 2 * MiB;
constexpr size_t SZ_WGU = (size_t)2 * DFF * DM * 2;
constexpr size_t WS_WD = WS_WGU + 8 * SZ_WGU;
constexpr size_t SZ_WD = (size_t)DM * DFF * 2;
constexpr size_t WS_WINE = WS_WD + 8 * SZ_WD;
constexpr size_t SZ_WINE = (size_t)EVEN_IN * DM * 2;
constexpr size_t WS_WOUTE = WS_WINE + 2 * SZ_WINE;
constexpr size_t SZ_SQ = (size_t)DM * DM * 2;
constexpr size_t WS_GLU = WS_WOUTE + 2 * SZ_SQ;
constexpr size_t SZ_GLU = (size_t)S5W * S5W * 2;
constexpr size_t WS_WINO = WS_GLU + 2 * SZ_GLU;
constexpr size_t SZ_WINO = (size_t)ODD_IN * DM * 2;
constexpr size_t WS_WOUTO = WS_WINO + 2 * SZ_WINO;
constexpr size_t WS_KF = WS_WOUTO + 2 * SZ_SQ;
constexpr size_t SZ_KF = (size_t)1024 * DM * 2;
constexpr size_t WS_VWT = WS_KF + 8 * SZ_KF;
constexpr size_t WS_WST = WS_VWT + 8 * SZ_KF;
constexpr size_t SZ_WST = (size_t)S5NS * S5K1 * 2;
constexpr size_t WS_TG = WS_WST + 2 * 64 * SZ_WST;
constexpr size_t SZ_TG = (size_t)S5K1 * S5K2 * 2;
constexpr size_t WS_HB = WS_TG + 2 * 64 * SZ_TG;
constexpr size_t SZ_HB = (size_t)TT * DM * 2;
constexpr size_t WS_MISC = WS_HB + SZ_HB;
constexpr size_t MISC_ROPE = 0, MISC_AL = 65536  , MISC_LAM = 65536 + 131072  , MISC_PSS = 262144  ;
constexpr size_t WS_POOL = WS_MISC + MiB;
constexpr size_t PL_ACT = 0;
constexpr size_t PL_Z = 0;
constexpr size_t PL_UX = 144 * MiB;
constexpr size_t PL_KC = 144 * MiB;
constexpr size_t PL_SST = 216 * MiB;
constexpr size_t PL_GB = 264 * MiB;
constexpr size_t PL_CAT = 312 * MiB;
constexpr size_t PL_STASH = 408 * MiB;
constexpr size_t PL_CS = 0;
constexpr size_t PL_CP = 96 * MiB;
constexpr size_t PL_WQB = 0;
constexpr size_t PL_WKVT = 32 * MiB;
constexpr size_t PL_WOT = 96 * MiB;
constexpr size_t PL_MEMN = 128 * MiB;
constexpr size_t PL_KVB = 136 * MiB;
constexpr size_t POOL_BYTES = 440 * MiB;
constexpr size_t WS_X = WS_POOL + POOL_BYTES;
constexpr size_t WS_END = WS_X + (size_t)TT * DM;

constexpr int CW_BAR = 4096;
constexpr int CW_DBG = 1024;
constexpr int CW_QKB = 2048;
constexpr int CW_QUEUE = 2304;

constexpr int EXCH_OFF = 131072  , PSSB_OFF = 139264  , RING_BYTES = 155648, MISC_OFF = RING_BYTES + 320, LDS_BYTES = 159744;

struct Args { const float* in[N_IN]; float* out; unsigned char* ws; int ph_lo, ph_hi, li, pad; };
struct Frame {
    LAS unsigned char* lds; char* ldsg;
    volatile LAS unsigned* MISC;
    int tid, lane, wave, G, bid;
    const float* const* in; float* x; unsigned char* ws;
};
#define WSP(off) (F.ws + (off))
#define POOLP(off) (F.ws + WS_POOL + (off))

struct ZNone { __device__ __forceinline__ size_t aoff(int) const { return 0; } __device__ __forceinline__ size_t boff(int) const { return 0; } };
struct ZLin { size_t as, bs; __device__ __forceinline__ size_t aoff(int z) const { return (size_t)z * as; } __device__ __forceinline__ size_t boff(int z) const { return (size_t)z * bs; } };
struct ZKv { __device__ __forceinline__ size_t aoff(int z) const { return (size_t)z * (256 * 2048 * 2); } __device__ __forceinline__ size_t boff(int z) const { return (size_t)(z >> 1) * ((size_t)4096 * 2048 * 2); } };
struct ZKf { __device__ __forceinline__ size_t aoff(int z) const { return (size_t)(z >> 2) * ((size_t)256 * 4096 * 2) + (size_t)(z & 3) * 1024; }
             __device__ __forceinline__ size_t boff(int z) const { return (size_t)(z >> 3) * ((size_t)2048 * 2048 * 2) + (size_t)(z & 3) * 1024; } };
struct ZVw { __device__ __forceinline__ size_t aoff(int z) const { return (size_t)(z >> 3) * ((size_t)2048 * 2048 * 2) + (size_t)(z & 3) * 1024; }
             __device__ __forceinline__ size_t boff(int z) const { return (size_t)(z >> 2) * ((size_t)256 * 4096 * 2) + 4096 + (size_t)(z & 3) * 1024; } };
template <class ZM>
struct Sched : pg8::Enum {
    const char* A; const char* B; size_t atile, btile; int split; size_t bseq; ZM zm;
    __device__ __forceinline__ const char* a_base(const pg8::Unit& u) const { return A + (size_t)u.pm * atile + zm.aoff(u.z); }
    __device__ __forceinline__ const char* b_base(const pg8::Unit& u) const { return B + (size_t)u.pn * btile + zm.boff(u.z) + (u.pm >= split ? bseq : 0); }
};
template <class ZM>
__device__ __forceinline__ Sched<ZM> make_sched(const Frame& F, const void* A, int lda, const void* B, int ldb, int M, int N, int nZ, ZM zm) {
    Sched<ZM> S; S.init(M / 256, N / 256, nZ, F.G, F.bid); S.A = (const char*)A; S.B = (const char*)B; S.atile = (size_t)256 * lda * 2; S.btile = (size_t)256 * ldb * 2;
    S.split = 1 << 30; S.bseq = 0; S.zm = zm; return S;
}

typedef f32x4 Acc[2][2][4][2];
__device__ __forceinline__ float res_dec(unsigned hb  , float lob  ) {
    const int e = (int)((hb >> 7) & 0xFFu); const float sd = __uint_as_float((unsigned)(e > 15 ? e - 15 : 0) << 23);
    return fmaf(lob - 128.0f, sd, __uint_as_float(hb << 16));
}
__device__ __forceinline__ float res_enc_lo(float x, unsigned hb) {
    const int e = (int)((hb >> 7) & 0xFFu); const float se = e > 15 ? __uint_as_float((unsigned)(269 - e) << 23) : 0.f;
    return fminf(__builtin_rintf(fmaf(x - __uint_as_float(hb << 16), se, 128.0f)), 255.0f);
}
__device__ __forceinline__ unsigned pack4_u8(float a, float b, float c, float dd) { return (unsigned)a | ((unsigned)b << 8) | ((unsigned)c << 16) | ((unsigned)dd << 24); }
__device__ __forceinline__ void res_enc4(const f32x4 v, unsigned& w0, unsigned& w1, unsigned& lo) {
    w0 = cvt_pk_bf16(v[0], v[1]); w1 = cvt_pk_bf16(v[2], v[3]);
    lo = pack4_u8(res_enc_lo(v[0], w0 & 0xFFFFu), res_enc_lo(v[1], w0 >> 16), res_enc_lo(v[2], w1 & 0xFFFFu), res_enc_lo(v[3], w1 >> 16));
}
__device__ __forceinline__ f32x4 res_dec4(unsigned w0, unsigned w1, unsigned lo) {
    return (f32x4){res_dec(w0 & 0xFFFFu, (float)(lo & 0xFFu)), res_dec(w0 >> 16, (float)((lo >> 8) & 0xFFu)), res_dec(w1 & 0xFFFFu, (float)((lo >> 16) & 0xFFu)), res_dec(w1 >> 16, (float)(lo >> 24))};
}
__device__ __forceinline__ unsigned char* fresh_ws(unsigned char* ws) { asm volatile("" : "+s"(ws)); return ws; }
__device__ __forceinline__ void pss_prefetch(LAS unsigned char* lds, const unsigned char* ws, int pm, int par, int wid, int lane) {
    const unsigned char* src = ws + WS_MISC + MISC_PSS + (size_t)pm * 8192 + wid * 1024 + lane * 16;
    __builtin_amdgcn_global_load_lds((const unsigned*)src, (LAS unsigned*)(lds + PSSB_OFF + (par & 1) * 8192 + wid * 1024), 16, 0, 0);
}
__device__ __forceinline__ void row_rstd_lds(const LAS unsigned char* lds, int par, int rloc0, float (&rs)[2][4]) {
    const LAS unsigned char* b = lds + PSSB_OFF + (par & 1) * 8192;
#pragma unroll
    for (int ai = 0; ai < 2; ++ai)
#pragma unroll
        for (int m = 0; m < 4; ++m) { const f32x4 a = *(const LAS f32x4*)(b + (rloc0 + ai * 128 + m * 16) * 32), c = *(const LAS f32x4*)(b + (rloc0 + ai * 128 + m * 16) * 32 + 16);
            rs[ai][m] = 1.0f / sqrtf((((a.x + a.y) + (a.z + a.w)) + ((c.x + c.y) + (c.z + c.w))) * (1.f / DM) + EPS); }
}
__device__ __forceinline__ void row_rstd(const float* PSS, int row0, float (&rs)[2][4]) {
#pragma unroll
    for (int ai = 0; ai < 2; ++ai)
#pragma unroll
        for (int m = 0; m < 4; ++m) { const f32x4 a = *(const f32x4*)(PSS + (size_t)(row0 + ai * 128 + m * 16) * 8), b = *(const f32x4*)(PSS + (size_t)(row0 + ai * 128 + m * 16) * 8 + 4);
            rs[ai][m] = 1.0f / sqrtf((((a.x + a.y) + (a.z + a.w)) + ((b.x + b.y) + (b.z + b.w))) * (1.f / DM) + EPS); }
}
struct EpiSwiglu { static constexpr bool PERM = true, PREFETCH = true; unsigned char* ws; int ldc; LAS unsigned char* lds;
    __device__ __forceinline__ void prefetch(LAS unsigned char* l, const pg8::Unit& u, int par, int wid, int lane) const { pss_prefetch(l, ws, u.pm, par, wid, lane); }
    __device__ __forceinline__ void operator()(Acc& acc, const pg8::Unit& u, int wr, int wc, int fr, int fq, int par) const {
        const int row0 = u.pm * 256 + wr * 64 + fr, col0 = u.pn * 128 + wc * 32 + 8 * fq;
        unsigned char* w_ = fresh_ws(ws); bf16_t* O = (bf16_t*)(w_ + WS_POOL + PL_ACT);
        float rs[2][4]; row_rstd_lds(lds, par, wr * 64 + fr, rs);
#pragma unroll
        for (int ai = 0; ai < 2; ++ai)
#pragma unroll
            for (int m = 0; m < 4; ++m) { const f32x4 g0 = acc[ai][0][m][0] * rs[ai][m], g1 = acc[ai][0][m][1] * rs[ai][m], u0 = acc[ai][1][m][0] * rs[ai][m], u1 = acc[ai][1][m][1] * rs[ai][m];
                u32x4 w; w.x = cvt_pk_bf16(silu_f(g0[0]) * u0[0], silu_f(g0[1]) * u0[1]); w.y = cvt_pk_bf16(silu_f(g0[2]) * u0[2], silu_f(g0[3]) * u0[3]);
                w.z = cvt_pk_bf16(silu_f(g1[0]) * u1[0], silu_f(g1[1]) * u1[1]); w.w = cvt_pk_bf16(silu_f(g1[2]) * u1[2], silu_f(g1[3]) * u1[3]);
                *(u32x4*)(O + (size_t)(row0 + ai * 128 + m * 16) * ldc + col0) = w; }
    }
};
struct EpiResidNorm { static constexpr bool PERM = true, PREFETCH = false; float scale; unsigned char* ws; LAS float* red;
    __device__ __forceinline__ void operator()(Acc& acc, const pg8::Unit& u, int wr, int wc, int fr, int fq, int par) const {
        const int row0 = u.pm * 256 + wr * 64 + fr, col0 = u.pn * 256 + wc * 32 + 8 * fq, tid = (wr * 4 + wc) * 64 + fq * 16 + fr;
        unsigned char* w_ = fresh_ws(ws); bf16_t* XB = (bf16_t*)(w_ + WS_HB); float* PSS = (float*)(w_ + WS_MISC + MISC_PSS);
        u32x4* XL = (u32x4*)(w_ + WS_X + (size_t)(u.pm * 8 + u.pn) * 65536) + tid;
#pragma unroll
        for (int ai = 0; ai < 2; ++ai) {
            u32x4 hv[4][2], lv[4];
#pragma unroll
            for (int m = 0; m < 4; ++m) { const bf16_t* bp = XB + (size_t)(row0 + ai * 128 + m * 16) * DM + col0; hv[m][0] = *(const u32x4*)bp; hv[m][1] = *(const u32x4*)(bp + 128); lv[m] = XL[(ai * 4 + m) * 512]; }
#pragma unroll
            for (int m = 0; m < 4; ++m) { bf16_t* bp = XB + (size_t)(row0 + ai * 128 + m * 16) * DM + col0; float s = 0.f; u32x4 lo;
#pragma unroll
                for (int bj = 0; bj < 2; ++bj) { const f32x4 v0 = res_dec4(hv[m][bj].x, hv[m][bj].y, lv[m][bj * 2]) + acc[ai][bj][m][0] * scale, v1 = res_dec4(hv[m][bj].z, hv[m][bj].w, lv[m][bj * 2 + 1]) + acc[ai][bj][m][1] * scale;
                    unsigned a0, a1, a2, a3, l0, l1; res_enc4(v0, a0, a1, l0); res_enc4(v1, a2, a3, l1); *(u32x4*)(bp + bj * 128) = (u32x4){a0, a1, a2, a3}; lo[bj * 2] = l0; lo[bj * 2 + 1] = l1;
                    s += ((v0[0] * v0[0] + v0[1] * v0[1]) + (v0[2] * v0[2] + v0[3] * v0[3])) + ((v1[0] * v1[0] + v1[1] * v1[1]) + (v1[2] * v1[2] + v1[3] * v1[3])); }
                XL[(ai * 4 + m) * 512] = lo;
                s += __shfl_xor(s, 16); s += __shfl_xor(s, 32);
                if (fq == 0) red[(ai * 128 + wr * 64 + m * 16 + fr) * 4 + wc] = s; }
            asm volatile("" ::: "memory"); }
        asm volatile("s_waitcnt lgkmcnt(0)" ::: "memory"); __builtin_amdgcn_s_barrier(); asm volatile("" ::: "memory");
        if (tid < 256) { const f32x4 r4 = *(const LAS f32x4*)(red + tid * 4); PSS[(size_t)(u.pm * 256 + tid) * 8 + u.pn] = (r4.x + r4.y) + (r4.z + r4.w); }
    }
};
template <int MODE> struct EpiBf16 { static constexpr bool PERM = true, PREFETCH = (MODE == 1); bf16_t* O; int ldc; size_t zhi, zlo; int zshift; const float* aux; unsigned char* ws; LAS unsigned char* lds;
    __device__ __forceinline__ void prefetch(LAS unsigned char* l, const pg8::Unit& u, int par, int wid, int lane) const { pss_prefetch(l, ws, u.pm, par, wid, lane); }
    __device__ __forceinline__ void operator()(Acc& acc, const pg8::Unit& u, int wr, int wc, int fr, int fq, int par) const {
        bf16_t* base = O + (size_t)(u.z >> zshift) * zhi + (size_t)(u.z & ((1 << zshift) - 1)) * zlo;
        const int row0 = u.pm * 256 + wr * 64 + fr, col0 = u.pn * 256 + wc * 32 + 8 * fq;
        float rs[2][4]; if (MODE == 1) row_rstd_lds(lds, par, wr * 64 + fr, rs);
        f32x4 cs[2][2]; if (MODE == 2) {
#pragma unroll
            for (int bj = 0; bj < 2; ++bj)
#pragma unroll
                for (int n = 0; n < 2; ++n) cs[bj][n] = *(const f32x4*)(aux + (size_t)(u.z >> 3) * DM + col0 + bj * 128 + 4 * n); }
#pragma unroll
        for (int ai = 0; ai < 2; ++ai)
#pragma unroll
            for (int m = 0; m < 4; ++m) { bf16_t* rp = base + (size_t)(row0 + ai * 128 + m * 16) * ldc + col0;
#pragma unroll
                for (int bj = 0; bj < 2; ++bj) { f32x4 v0 = acc[ai][bj][m][0], v1 = acc[ai][bj][m][1];
                    if (MODE == 1) { v0 = v0 * rs[ai][m]; v1 = v1 * rs[ai][m]; }
                    if (MODE == 2) { v0 = v0 * cs[bj][0]; v1 = v1 * cs[bj][1]; }
                    u32x4 w; w.x = cvt_pk_bf16(v0[0], v0[1]); w.y = cvt_pk_bf16(v0[2], v0[3]); w.z = cvt_pk_bf16(v1[0], v1[1]); w.w = cvt_pk_bf16(v1[2], v1[3]);
                    *(u32x4*)(rp + bj * 128) = w; } }
    }
};
struct EpiWinEven { static constexpr bool PERM = true, PREFETCH = true; unsigned char* ws; LAS unsigned char* lds;
    __device__ __forceinline__ void prefetch(LAS unsigned char* l, const pg8::Unit& u, int par, int wid, int lane) const { pss_prefetch(l, ws, u.pm, par, wid, lane); }
    __device__ __forceinline__ void operator()(Acc& acc, const pg8::Unit& u, int wr, int wc, int fr, int fq, int par) const {
        const int row0 = u.pm * 256 + wr * 64 + fr, col0 = u.pn * 256 + wc * 32 + 8 * fq;
        unsigned char* w_ = fresh_ws(ws); bf16_t* UX = (bf16_t*)(w_ + WS_POOL + PL_UX); bf16_t* Z = (bf16_t*)(w_ + WS_POOL + PL_Z);
        float rs[2][4]; row_rstd_lds(lds, par, wr * 64 + fr, rs);
#pragma unroll
        for (int ai = 0; ai < 2; ++ai)
#pragma unroll
            for (int m = 0; m < 4; ++m) { const int row = row0 + ai * 128 + m * 16;
#pragma unroll
                for (int bj = 0; bj < 2; ++bj) { const f32x4 v0 = acc[ai][bj][m][0] * rs[ai][m], v1 = acc[ai][bj][m][1] * rs[ai][m]; const int col = col0 + bj * 128;
                    u32x4 w; w.x = cvt_pk_bf16(v0[0], v0[1]); w.y = cvt_pk_bf16(v0[2], v0[3]); w.z = cvt_pk_bf16(v1[0], v1[1]); w.w = cvt_pk_bf16(v1[2], v1[3]);
                    bf16_t* p;
                    if (u.pn < 4) { const int g = col >> 4, h0 = col & 15, c = row >> 5, i = row & 31; p = UX + ((size_t)(g * NCH + c) * S5K2 + i * 16 + h0); }
                    else p = Z + (size_t)row * ZLD + (col - 1024);
                    *(u32x4*)p = w; } }
    }
};
struct EpiF32 { static constexpr bool PERM = false, PREFETCH = false; float* O; int ldc; size_t zs;
    __device__ __forceinline__ void operator()(Acc& acc, const pg8::Unit& u, int wr, int wc, int fr, int fq, int par) const {
        float* base = O + (size_t)u.z * zs; const int row0 = u.pm * 256 + wr * 64 + fr, col0 = u.pn * 256 + wc * 32 + 4 * fq;
#pragma unroll
        for (int ai = 0; ai < 2; ++ai)
#pragma unroll
            for (int m = 0; m < 4; ++m) { float* rp = base + (size_t)(row0 + ai * 128 + m * 16) * ldc + col0;
#pragma unroll
                for (int bj = 0; bj < 2; ++bj)
#pragma unroll
                    for (int n = 0; n < 2; ++n) *(f32x4*)(rp + bj * 128 + n * 16) = acc[ai][bj][m][n]; }
    }
};
struct EpiS5Out { static constexpr bool PERM = true, PREFETCH = false; bf16_t* GB;
    __device__ __forceinline__ void operator()(Acc& acc, const pg8::Unit& u, int wr, int wc, int fr, int fq, int par) const {
        const int row0 = u.pm * 256 + wr * 64 + fr, col0 = u.pn * 256 + wc * 32 + 8 * fq;
#pragma unroll
        for (int ai = 0; ai < 2; ++ai)
#pragma unroll
            for (int m = 0; m < 4; ++m) { const int c = row0 + ai * 128 + m * 16;
#pragma unroll
                for (int bj = 0; bj < 2; ++bj) { const f32x4 v0 = acc[ai][bj][m][0], v1 = acc[ai][bj][m][1]; const int col = col0 + bj * 128, i = col >> 4, h0 = col & 15;
                    u32x4 w; w.x = cvt_pk_bf16(gelu_tanh_f(v0[0]), gelu_tanh_f(v0[1])); w.y = cvt_pk_bf16(gelu_tanh_f(v0[2]), gelu_tanh_f(v0[3]));
                    w.z = cvt_pk_bf16(gelu_tanh_f(v1[0]), gelu_tanh_f(v1[1])); w.w = cvt_pk_bf16(gelu_tanh_f(v1[2]), gelu_tanh_f(v1[3]));
                    *(u32x4*)(GB + (size_t)(c * LC + i) * S5W + u.z * 16 + h0) = w; } }
    }
};
struct EpiGlu { static constexpr bool PERM = true, PREFETCH = false; const bf16_t* GB; const float* bias; bf16_t* O;
    __device__ __forceinline__ void operator()(Acc& acc, const pg8::Unit& u, int wr, int wc, int fr, int fq, int par) const {
        const int row0 = u.pm * 256 + wr * 64 + fr, col0 = u.pn * 256 + wc * 32 + 8 * fq;
        f32x4 bv[2][2];
#pragma unroll
        for (int bj = 0; bj < 2; ++bj)
#pragma unroll
            for (int n = 0; n < 2; ++n) bv[bj][n] = *(const f32x4*)(bias + col0 + bj * 128 + 4 * n);
#pragma unroll
        for (int ai = 0; ai < 2; ++ai)
#pragma unroll
            for (int m = 0; m < 4; ++m) { const int row = row0 + ai * 128 + m * 16;
#pragma unroll
                for (int bj = 0; bj < 2; ++bj) { const f32x4 v0 = acc[ai][bj][m][0] + bv[bj][0], v1 = acc[ai][bj][m][1] + bv[bj][1]; const int col = col0 + bj * 128;
                    const u32x4 g = *(const u32x4*)(GB + (size_t)row * S5W + col);
                    u32x4 w; w.x = cvt_pk_bf16(bflo(g.x) * sigmoidf_fast(v0[0]), bfhi(g.x) * sigmoidf_fast(v0[1])); w.y = cvt_pk_bf16(bflo(g.y) * sigmoidf_fast(v0[2]), bfhi(g.y) * sigmoidf_fast(v0[3]));
                    w.z = cvt_pk_bf16(bflo(g.z) * sigmoidf_fast(v1[0]), bfhi(g.z) * sigmoidf_fast(v1[1])); w.w = cvt_pk_bf16(bflo(g.w) * sigmoidf_fast(v1[2]), bfhi(g.w) * sigmoidf_fast(v1[3]));
                    *(u32x4*)(O + (size_t)row * DM + col) = w; } }
    }
};

struct EpiCrossSm { static constexpr bool PERM = true, PREFETCH = true; unsigned char* ws; LAS f32x2* red; LAS unsigned char* lds;
    __device__ __forceinline__ void prefetch(LAS unsigned char* l, const pg8::Unit& u, int par, int wid, int lane) const { pss_prefetch(l, ws, u.pm, par, wid, lane); }
    __device__ __forceinline__ void operator()(Acc& acc, const pg8::Unit& u, int wr, int wc, int fr, int fq, int par) const {
        constexpr float C = 0.04419417382415922f * 1.4426950408889634f;
        const int row0 = u.pm * 256 + wr * 64 + fr, col0 = u.pn * 256 + wc * 32 + 8 * fq;
        unsigned char* w_ = fresh_ws(ws); bf16_t* O = (bf16_t*)(w_ + WS_POOL + PL_CP);
        float rs[2][4]; row_rstd_lds(lds, par, wr * 64 + fr, rs);
        float mw[2][4];
#pragma unroll
        for (int ai = 0; ai < 2; ++ai)
#pragma unroll
            for (int m = 0; m < 4; ++m) { const float k = rs[ai][m] * C; float mx = -3.0e38f;
#pragma unroll
                for (int bj = 0; bj < 2; ++bj)
#pragma unroll
                    for (int n = 0; n < 2; ++n) { f32x4 v = acc[ai][bj][m][n] * k; acc[ai][bj][m][n] = v; mx = fmaxf(fmaxf(mx, fmaxf(v[0], v[1])), fmaxf(v[2], v[3])); }
                mx = fmaxf(mx, __shfl_xor(mx, 16)); mx = fmaxf(mx, __shfl_xor(mx, 32)); float s = 0.f;
#pragma unroll
                for (int bj = 0; bj < 2; ++bj)
#pragma unroll
                    for (int n = 0; n < 2; ++n) { f32x4 v = acc[ai][bj][m][n]; v[0] = fast_exp2(v[0] - mx); v[1] = fast_exp2(v[1] - mx); v[2] = fast_exp2(v[2] - mx); v[3] = fast_exp2(v[3] - mx); acc[ai][bj][m][n] = v; s += (v[0] + v[1]) + (v[2] + v[3]); }
                s += __shfl_xor(s, 16); s += __shfl_xor(s, 32); mw[ai][m] = mx;
                if (fq == 0) red[(ai * 128 + wr * 64 + m * 16 + fr) * 4 + wc] = (f32x2){mx, s}; }
        asm volatile("s_waitcnt lgkmcnt(0)" ::: "memory"); __builtin_amdgcn_s_barrier(); asm volatile("" ::: "memory");
#pragma unroll
        for (int ai = 0; ai < 2; ++ai)
#pragma unroll
            for (int m = 0; m < 4; ++m) { const LAS f32x2* rr = red + (ai * 128 + wr * 64 + m * 16 + fr) * 4; const f32x2 r0 = rr[0], r1 = rr[1], r2 = rr[2], r3 = rr[3];
                const float M = fmaxf(fmaxf(r0.x, r1.x), fmaxf(r2.x, r3.x));
                const float tot = (r0.y * fast_exp2(r0.x - M) + r1.y * fast_exp2(r1.x - M)) + (r2.y * fast_exp2(r2.x - M) + r3.y * fast_exp2(r3.x - M));
                const float f = fast_exp2(mw[ai][m] - M) * fast_rcp(tot);
                bf16_t* rp = O + (size_t)(row0 + ai * 128 + m * 16) * 1024 + col0;
#pragma unroll
                for (int bj = 0; bj < 2; ++bj) { const f32x4 v0 = acc[ai][bj][m][0] * f, v1 = acc[ai][bj][m][1] * f;
                    u32x4 w; w.x = cvt_pk_bf16(v0[0], v0[1]); w.y = cvt_pk_bf16(v0[2], v0[3]); w.z = cvt_pk_bf16(v1[0], v1[1]); w.w = cvt_pk_bf16(v1[2], v1[3]);
                    *(u32x4*)(rp + bj * 128) = w; } }
    }
};

template <int MODE>
__device__ __forceinline__ void transpose_item(const float* W, int K, int N, bf16_t* WT, LAS float* scr, int item, int lane, const float* gain = nullptr) {
    const int nblk = N / 32, kb = item / nblk, nb = item % nblk, k0 = 64 * kb, n0 = 32 * nb;
#pragma unroll 8
    for (int i = 0; i < 32; ++i) { const int kk = 2 * i + (lane >> 5); scr[kk * 33 + (lane & 31)] = W[(size_t)(k0 + kk) * N + n0 + (lane & 31)]; }
    LDS_WAIT(); asm volatile("" ::: "memory");
    const int c = lane & 7;
    f32x4 g0 = (f32x4){1.f, 1.f, 1.f, 1.f}, g1 = g0; if (gain) { g0 = *(const f32x4*)(gain + k0 + 8 * c); g1 = *(const f32x4*)(gain + k0 + 8 * c + 4); }
    int r0;
    if (MODE == 1) { r0 = (n0 < DFF) ? (256 * (n0 / 128) + (n0 % 128)) : (256 * ((n0 - DFF) / 128) + 128 + ((n0 - DFF) % 128)); } else r0 = n0;
#pragma unroll
    for (int j = 0; j < 4; ++j) { const int n = (lane >> 3) + 8 * j; const LAS float* s = scr + (8 * c) * 33 + n;
        u32x4 o; o.x = cvt_pk_bf16(s[0 * 33] * g0.x, s[1 * 33] * g0.y); o.y = cvt_pk_bf16(s[2 * 33] * g0.z, s[3 * 33] * g0.w); o.z = cvt_pk_bf16(s[4 * 33] * g1.x, s[5 * 33] * g1.y); o.w = cvt_pk_bf16(s[6 * 33] * g1.z, s[7 * 33] * g1.w);
        *(u32x4*)(WT + (size_t)(r0 + n) * K + k0 + 8 * c) = o; }
    LDS_WAIT(); asm volatile("" ::: "memory");
}
__device__ __forceinline__ void convert_rows(const float* src, bf16_t* dst, size_t n8, size_t gtid, size_t gthreads) {
    for (size_t i = gtid; i < n8; i += gthreads) { const f32x4 a = *(const f32x4*)(src + i * 8), b = *(const f32x4*)(src + i * 8 + 4);
        u32x4 o; o.x = cvt_pk_bf16(a[0], a[1]); o.y = cvt_pk_bf16(a[2], a[3]); o.z = cvt_pk_bf16(b[0], b[1]); o.w = cvt_pk_bf16(b[2], b[3]); *(u32x4*)(dst + i * 8) = o; }
}

__device__ __forceinline__ void rms_row_to_bf16(const float* xrow, const float* g, bf16_t* orow, float* xcopy, int lane) {
    const f32x4* xr = (const f32x4*)xrow + lane;
    f32x4 v[8]; float s = 0.f;
#pragma unroll
    for (int j = 0; j < 8; ++j) { v[j] = xr[64 * j]; s += (v[j].x * v[j].x + v[j].y * v[j].y) + (v[j].z * v[j].z + v[j].w * v[j].w); }
    if (xcopy) {
#pragma unroll
        for (int j = 0; j < 8; ++j) ((f32x4*)xcopy + lane)[64 * j] = v[j]; }
    const float rstd = 1.0f / sqrtf(wave_sum(s) * (1.f / DM) + EPS);
    const f32x4* gr = (const f32x4*)g + lane;
    u32x2* o8 = (u32x2*)orow + lane;
#pragma unroll
    for (int j = 0; j < 8; ++j) { const f32x4 gg = gr[64 * j]; u32x2 w; w.x = cvt_pk_bf16(v[j].x * rstd * gg.x, v[j].y * rstd * gg.y); w.y = cvt_pk_bf16(v[j].z * rstd * gg.z, v[j].w * rstd * gg.w); o8[64 * j] = w; }
}
__device__ __forceinline__ void norm_phase(const Frame& F, const float* g) {
    const int gw = F.bid * NWAVES + F.wave, NGW = F.G * NWAVES; bf16_t* HB = (bf16_t*)WSP(WS_HB);
    for (int m = gw; m < TT; m += NGW) rms_row_to_bf16(F.x + (size_t)m * DM, g, HB + (size_t)m * DM, nullptr, F.lane);
}
__device__ __forceinline__ void final_norm_phase(const Frame& F, const float* g) {
    const float* PSS = (const float*)(WSP(WS_MISC) + MISC_PSS); const bf16_t* XB = (const bf16_t*)WSP(WS_HB);
    const int tid = F.tid, wid = tid >> 6, wr = wid >> 2, wc = wid & 3, fq = (tid >> 4) & 3, fr = tid & 15;
    for (int L = F.bid; L < (TT / 256) * 8; L += F.G) { const int pm = L >> 3, pn = L & 7;
        const u32x4* XL = (const u32x4*)(WSP(WS_X) + (size_t)L * 65536) + tid; const int row0 = pm * 256 + wr * 64 + fr, col0 = pn * 256 + wc * 32 + 8 * fq;
        float rs[2][4]; row_rstd(PSS, row0, rs);
        f32x4 gg[2][2];
#pragma unroll
        for (int bj = 0; bj < 2; ++bj) { gg[bj][0] = *(const f32x4*)(g + col0 + bj * 128); gg[bj][1] = *(const f32x4*)(g + col0 + bj * 128 + 4); }
#pragma unroll
        for (int ai = 0; ai < 2; ++ai)
#pragma unroll
            for (int m = 0; m < 4; ++m) { const size_t ro = (size_t)(row0 + ai * 128 + m * 16) * DM + col0; const u32x4 lo = XL[(ai * 4 + m) * 512];
#pragma unroll
                for (int bj = 0; bj < 2; ++bj) { const u32x4 h = *(const u32x4*)(XB + ro + bj * 128); float* op = F.x + ro + bj * 128;
                    *(f32x4*)op = res_dec4(h.x, h.y, lo[bj * 2]) * rs[ai][m] * gg[bj][0]; *(f32x4*)(op + 4) = res_dec4(h.z, h.w, lo[bj * 2 + 1]) * rs[ai][m] * gg[bj][1]; } }
    }
}

__device__ __forceinline__ void s5_precompute_group(const Frame& F, int e, int g) {
    LAS float* L = (LAS float*)F.lds;
    LAS float* apow = L;
    LAS float* bb = apow + 8448;
    LAS float* cc = bb + 4096;
    LAS float* km = cc + 4096;
    LAS float* dsk = km + 16384;
    const float* lre = F.in[I_LRE], *lim = F.in[I_LIM], *ldt = F.in[I_LDT], *bre = F.in[I_BRE], *bim = F.in[I_BIM], *cre = F.in[I_CRE], *cim = F.in[I_CIM], *dsk_g = F.in[I_S5D];
    const int tid = F.tid;
    for (int idx = tid; idx < 2 * 64 * 33; idx += NTHREADS) { const int k = idx % 33, p = (idx / 33) % 64, dir = idx / (33 * 64);
        const size_t pi = ((size_t)(e * 2 + dir) * S5G + g) * S5P + p; const float lr = fminf(lre[pi], -1e-4f), li = lim[pi], dt = expf(ldt[(e * 2 + dir) * S5G + g]);
        const float mag = expf(lr * dt * (float)k); float sn, cs; sincosf(li * dt * (float)k, &sn, &cs); apow[idx * 2] = mag * cs; apow[idx * 2 + 1] = mag * sn; }
    for (int idx = tid; idx < 2 * 64 * 16; idx += NTHREADS) { const int h = idx % 16, p = (idx / 16) % 64, dir = idx / 1024;
        const size_t pi = ((size_t)(e * 2 + dir) * S5G + g) * S5P + p; const float lr = fminf(lre[pi], -1e-4f), li = lim[pi], dt = expf(ldt[(e * 2 + dir) * S5G + g]);
        const float mag = expf(lr * dt); float sn, cs; sincosf(li * dt, &sn, &cs); const float ar = mag * cs, ai = mag * sn, nr = ar - 1.0f, den = lr * lr + li * li;
        const float fr = (nr * lr + ai * li) / den, fi = (ai * lr - nr * li) / den; const float br = bre[pi * 16 + h], bi = bim[pi * 16 + h];
        bb[idx * 2] = fr * br - fi * bi; bb[idx * 2 + 1] = fr * bi + fi * br; }
    for (int idx = tid; idx < 2 * 16 * 64; idx += NTHREADS) { const int p = idx % 64, h = (idx / 64) % 16, dir = idx / 1024;
        const size_t ci = (((size_t)(e * 2 + dir) * S5G + g) * S5H + h) * S5P + p; cc[idx * 2] = cre[ci]; cc[idx * 2 + 1] = cim[ci]; }
    if (tid < 16) dsk[tid] = dsk_g[e * S5W + g * 16 + tid];
    LDS_WAIT(); __syncthreads();
    for (int idx = tid; idx < 2 * 32 * 256; idx += NTHREADS) { const int hp = idx & 15, h = (idx >> 4) & 15, k = (idx >> 8) & 31, dir = idx >> 13; float s = 0.f;
        for (int p = 0; p < 64; ++p) { const float cr = cc[((dir * 16 + h) * 64 + p) * 2], ci = cc[((dir * 16 + h) * 64 + p) * 2 + 1], ar = apow[((dir * 64 + p) * 33 + k) * 2], ai = apow[((dir * 64 + p) * 33 + k) * 2 + 1];
            const float br = bb[((dir * 64 + p) * 16 + hp) * 2], bi = bb[((dir * 64 + p) * 16 + hp) * 2 + 1]; const float wr = cr * ar - ci * ai, wi = cr * ai + ci * ar; s += wr * br - wi * bi; }
        km[idx] = s; }
    LDS_WAIT(); __syncthreads();
    bf16_t* WST = (bf16_t*)WSP(WS_WST) + (size_t)(e * 64 + g) * (S5NS * S5K1);
    bf16_t* TG = (bf16_t*)WSP(WS_TG) + (size_t)(e * 64 + g) * (S5K1 * S5K2);
    for (int idx = tid; idx < S5NS * S5K1 / 2; idx += NTHREADS) { const int k2 = (idx % (S5K1 / 2)) * 2, n = idx / (S5K1 / 2); const int dir = n >> 7, p = (n >> 1) & 63, ri = n & 1; const int j = k2 >> 4, hp = k2 & 15;
        const int ex = dir == 0 ? (LC - 1 - j) : j; const float ar = apow[((dir * 64 + p) * 33 + ex) * 2], ai = apow[((dir * 64 + p) * 33 + ex) * 2 + 1];
        float v[2];
#pragma unroll
        for (int q = 0; q < 2; ++q) { const float br = bb[((dir * 64 + p) * 16 + hp + q) * 2], bi = bb[((dir * 64 + p) * 16 + hp + q) * 2 + 1]; v[q] = ri == 0 ? (ar * br - ai * bi) : (ar * bi + ai * br); }
        *(unsigned*)(WST + (size_t)n * S5K1 + k2) = cvt_pk_bf16(v[0], v[1]); }
    for (int idx = tid; idx < S5K1 * S5K2 / 2; idx += NTHREADS) { const int k2 = (idx % (S5K2 / 2)) * 2, n = idx / (S5K2 / 2); const int i = n >> 4, h = n & 15; float v[2];
        if (k2 < S5K1) { const int j = k2 >> 4, hp = k2 & 15;
#pragma unroll
            for (int q = 0; q < 2; ++q) { float s = 0.f; if (j <= i) s += km[((0 * 32 + (i - j)) * 16 + h) * 16 + hp + q]; if (j >= i) s += km[((1 * 32 + (j - i)) * 16 + h) * 16 + hp + q]; if (i == j && h == hp + q) s += dsk[h]; v[q] = s; }
        } else { const int nn = k2 - S5K1, dir = nn >> 7, p = (nn >> 1) & 63; const int ex = dir == 0 ? (i + 1) : (LC - i);
            const float ar = apow[((dir * 64 + p) * 33 + ex) * 2], ai = apow[((dir * 64 + p) * 33 + ex) * 2 + 1], cr = cc[((dir * 16 + h) * 64 + p) * 2], ci = cc[((dir * 16 + h) * 64 + p) * 2 + 1];
            v[0] = cr * ar - ci * ai; v[1] = -(cr * ai + ci * ar); }
        *(unsigned*)(TG + (size_t)n * S5K2 + k2) = cvt_pk_bf16(v[0], v[1]); }
    f32x2* AL = (f32x2*)(WSP(WS_MISC) + MISC_AL);
    if (tid < 128) { const int dir = tid >> 6, p = tid & 63; AL[((e * 2 + dir) * 64 + g) * 64 + p] = (f32x2){apow[((dir * 64 + p) * 33 + LC) * 2], apow[((dir * 64 + p) * 33 + LC) * 2 + 1]}; }
    __syncthreads();
}

__device__ __forceinline__ void s5_scan_phase(const Frame& F, int e) {
    const float* SST = (const float*)POOLP(PL_SST); bf16_t* UX = (bf16_t*)POOLP(PL_UX);
    LAS f32x2* tot = (LAS f32x2*)F.lds;
    const int p = F.lane, w = F.wave;
    for (int item = F.bid; item < 2 * 2 * 64; item += F.G) {
        const int g = item & 63, dir = (item >> 6) & 1, seq = item >> 7;
        const f32x2 aL = ((const f32x2*)(WSP(WS_MISC) + MISC_AL))[((e * 2 + dir) * 64 + g) * 64 + p];
        const int c0 = seq ? NCH_P : 0, cs = seq ? 32 : 16;
        const int step = dir == 0 ? 1 : -1;
        const float* sbase = SST + (size_t)g * 256 + dir * 128 + 2 * p;
        bf16_t* xbase = UX + (size_t)g * NCH * S5K2 + S5K1 + dir * 128 + 2 * p;
#pragma unroll 1
        for (int q = 0; q < 2; ++q) { const int s = 2 * w + q; int c = c0 + s * cs + (dir == 0 ? 0 : cs - 1); float xr = 0.f, xi = 0.f;
#pragma unroll 1
            for (int it = 0; it < cs; it += 8) { f32x2 sv[8];
#pragma unroll
                for (int k = 0; k < 8; ++k) sv[k] = *(const f32x2*)(sbase + (size_t)(c + k * step) * (64 * 256));
#pragma unroll
                for (int k = 0; k < 8; ++k) { const float nr = aL.x * xr - aL.y * xi + sv[k].x, ni = aL.x * xi + aL.y * xr + sv[k].y; xr = nr; xi = ni; }
                c += 8 * step; }
            tot[s * 64 + p] = (f32x2){xr, xi}; }
        LDS_WAIT(); __syncthreads();
        float pr = aL.x, pi = aL.y;
        for (int k = cs; k > 1; k >>= 1) { const float nr = pr * pr - pi * pi, ni = 2.f * pr * pi; pr = nr; pi = ni; }
#pragma unroll 1
        for (int q = 0; q < 2; ++q) { const int s = 2 * w + q; float xr = 0.f, xi = 0.f;
            if (dir == 0) { for (int j = 0; j < s; ++j) { const f32x2 t = tot[j * 64 + p]; const float nr = pr * xr - pi * xi + t.x, ni = pr * xi + pi * xr + t.y; xr = nr; xi = ni; } }
            else { for (int j = 15; j > s; --j) { const f32x2 t = tot[j * 64 + p]; const float nr = pr * xr - pi * xi + t.x, ni = pr * xi + pi * xr + t.y; xr = nr; xi = ni; } }
            int c = c0 + s * cs + (dir == 0 ? 0 : cs - 1);
#pragma unroll 1
            for (int it = 0; it < cs; it += 8) { f32x2 sv[8];
#pragma unroll
                for (int k = 0; k < 8; ++k) sv[k] = *(const f32x2*)(sbase + (size_t)(c + k * step) * (64 * 256));
#pragma unroll
                for (int k = 0; k < 8; ++k) { *(unsigned*)(xbase + (size_t)(c + k * step) * S5K2) = cvt_pk_bf16(xr, xi);
                    const float nr = aL.x * xr - aL.y * xi + sv[k].x, ni = aL.x * xi + aL.y * xr + sv[k].y; xr = nr; xi = ni; }
                c += 8 * step; } }
        __syncthreads();
    }
}

__device__ __forceinline__ void qk_prep_phase(const Frame& F, int o) {
    bf16_t* Z = (bf16_t*)POOLP(PL_Z); bf16_t* KC = (bf16_t*)POOLP(PL_KC); const float* rope = (const float*)(WSP(WS_MISC) + MISC_ROPE);
    const float* qg = F.in[I_QN] + o * 128, *kg = F.in[I_KN] + o * 128;
    const int sub = F.lane >> 4, j = F.lane & 15;
    const long nrows = (long)TT * 20, gq = ((long)F.bid * NWAVES + F.wave) * 4 + sub, nq = (long)F.G * NWAVES * 4;
    for (long r = gq; r < nrows; r += nq) {
        const int t = (int)(r / 20), hh = (int)(r % 20);
        bf16_t* p = Z + (size_t)t * ZLD + (hh < 16 ? hh * 128 : 2048 + (hh - 16) * 128) + j * 8;
        const u32x4 w = *(const u32x4*)p; float v[8] = {bflo(w.x), bfhi(w.x), bflo(w.y), bfhi(w.y), bflo(w.z), bfhi(w.z), bflo(w.w), bfhi(w.w)};
        float s = 0.f;
#pragma unroll
        for (int q = 0; q < 8; ++q) s += v[q] * v[q];
        s += __shfl_xor(s, 1); s += __shfl_xor(s, 2); s += __shfl_xor(s, 4); s += __shfl_xor(s, 8);
        const float rstd = 1.0f / sqrtf(s * (1.f / 128.f) + EPS); const float* gg = (hh < 16 ? qg : kg) + j * 8;
        const int tl = t < T_P ? t : t - T_P; const int pos = (j < 8) ? (tl >> 6) : (tl & 63);
        const float* rp = rope + ((size_t)pos * 32 + 8 * (j & 3)) * 2;
        float ov[8];
#pragma unroll
        for (int q = 0; q < 8; ++q) { const float x = v[q] * rstd * gg[q]; const float y = __shfl_xor(x, 4); const float cs = rp[2 * q], sn = rp[2 * q + 1];
            ov[q] = (j & 4) ? (x * cs + y * sn) : (x * cs - y * sn); }
        u32x4 ow; ow.x = cvt_pk_bf16(ov[0], ov[1]); ow.y = cvt_pk_bf16(ov[2], ov[3]); ow.z = cvt_pk_bf16(ov[4], ov[5]); ow.w = cvt_pk_bf16(ov[6], ov[7]);
        *(u32x4*)p = ow;
    }
}

__device__ __forceinline__ void cross_softmax_phase(const Frame& F) {
    const float* CS = (const float*)POOLP(PL_CS); bf16_t* CP = (bf16_t*)POOLP(PL_CP);
    const long nrows = (long)TT * 4, gw = (long)F.bid * NWAVES + F.wave, NGW = (long)F.G * NWAVES;
    constexpr float C = 0.04419417382415922f * 1.4426950408889634f;
    for (long r = gw; r < nrows; r += NGW) {
        const f32x4 v = *((const f32x4*)(CS + r * 256) + F.lane);
        float m = fmaxf(fmaxf(v.x, v.y), fmaxf(v.z, v.w));
#pragma unroll
        for (int o = 1; o < 64; o <<= 1) m = fmaxf(m, __shfl_xor(m, o));
        const float e0 = fast_exp2((v.x - m) * C), e1 = fast_exp2((v.y - m) * C), e2 = fast_exp2((v.z - m) * C), e3 = fast_exp2((v.w - m) * C);
        const float inv = fast_rcp(wave_sum((e0 + e1) + (e2 + e3)));
        u32x2 w; w.x = cvt_pk_bf16(e0 * inv, e1 * inv); w.y = cvt_pk_bf16(e2 * inv, e3 * inv);
        *((u32x2*)(CP + r * 256) + F.lane) = w;
    }
}

__device__ __forceinline__ void prologue_phase(const Frame& F) {
    LAS float* scr = (LAS float*)(F.lds + F.wave * 16384);
    const int gw = F.bid * NWAVES + F.wave, NGW = F.G * NWAVES;
    constexpr int IT_GU = (DM / 64) * (2 * DFF / 32), IT_D = (DFF / 64) * (DM / 32), IT_WINE = (DM / 64) * (EVEN_IN / 32), IT_SQ = (DM / 64) * (DM / 32), IT_GLU = (S5W / 64) * (S5W / 32),
                  IT_WINO = (DM / 64) * (ODD_IN / 32), IT_KV = (DM / 64) * (2 * DM / 32);
    constexpr int N_GU = 8 * IT_GU, N_D = 8 * IT_D, N_WINE = 2 * IT_WINE, N_WOUTE = 2 * IT_SQ, N_GLU = 2 * IT_GLU, N_WINO = 2 * IT_WINO, N_WOUTO = 2 * IT_SQ, N_KV = 4 * IT_KV, N_WO = 4 * IT_SQ;
    constexpr int NITEMS = N_GU + N_D + N_WINE + N_WOUTE + N_GLU + N_WINO + N_WOUTO + N_KV + N_WO;
    for (int it = gw; it < NITEMS; it += NGW) {
        int r = it;
        if (r < N_GU) { const int w = r / IT_GU, l = w >> 1, f = w & 1; transpose_item<1>(F.in[f ? I_F2GU : I_F1GU] + (size_t)l * DM * 2 * DFF, DM, 2 * DFF, (bf16_t*)WSP(WS_WGU + w * SZ_WGU), scr, r % IT_GU, F.lane, F.in[f ? I_F2N : I_F1N] + l * DM); continue; } r -= N_GU;
        if (r < N_D) { const int w = r / IT_D, l = w >> 1, f = w & 1; transpose_item<0>(F.in[f ? I_F2D : I_F1D] + (size_t)l * DFF * DM, DFF, DM, (bf16_t*)WSP(WS_WD + w * SZ_WD), scr, r % IT_D, F.lane); continue; } r -= N_D;
        if (r < N_WINE) { const int e = r / IT_WINE; transpose_item<0>(F.in[I_EWIN] + (size_t)e * DM * EVEN_IN, DM, EVEN_IN, (bf16_t*)WSP(WS_WINE + e * SZ_WINE), scr, r % IT_WINE, F.lane, F.in[I_MIXN] + (2 * e) * DM); continue; } r -= N_WINE;
        if (r < N_WOUTE) { const int e = r / IT_SQ; transpose_item<0>(F.in[I_EWOUT] + (size_t)e * DM * DM, DM, DM, (bf16_t*)WSP(WS_WOUTE + e * SZ_SQ), scr, r % IT_SQ, F.lane); continue; } r -= N_WOUTE;
        if (r < N_GLU) { const int e = r / IT_GLU; transpose_item<0>(F.in[I_GLUW] + (size_t)e * S5W * S5W, S5W, S5W, (bf16_t*)WSP(WS_GLU + e * SZ_GLU), scr, r % IT_GLU, F.lane); continue; } r -= N_GLU;
        if (r < N_WINO) { const int o = r / IT_WINO; transpose_item<0>(F.in[I_OWIN] + (size_t)o * DM * ODD_IN, DM, ODD_IN, (bf16_t*)WSP(WS_WINO + o * SZ_WINO), scr, r % IT_WINO, F.lane, F.in[I_MIXN] + (2 * o + 1) * DM); continue; } r -= N_WINO;
        if (r < N_WOUTO) { const int o = r / IT_SQ; transpose_item<0>(F.in[I_OWOUT] + (size_t)o * DM * DM, DM, DM, (bf16_t*)WSP(WS_WOUTO + o * SZ_SQ), scr, r % IT_SQ, F.lane); continue; } r -= N_WOUTO;
        if (r < N_KV) { const int l = r / IT_KV; transpose_item<0>(F.in[I_CWKV] + (size_t)l * DM * 2 * DM, DM, 2 * DM, (bf16_t*)POOLP(PL_WKVT) + (size_t)l * 2 * DM * DM, scr, r % IT_KV, F.lane); continue; } r -= N_KV;
        { const int l = r / IT_SQ; transpose_item<0>(F.in[I_CWO] + (size_t)l * DM * DM, DM, DM, (bf16_t*)POOLP(PL_WOT) + (size_t)l * DM * DM, scr, r % IT_SQ, F.lane); }
    }
    convert_rows(F.in[I_CWQ], (bf16_t*)POOLP(PL_WQB), (size_t)4 * DM * DM / 8, (size_t)F.bid * NTHREADS + F.tid, (size_t)F.G * NTHREADS);
    for (int m = gw; m < 4 * 2 * NMEM; m += NGW) { const int l = m / (2 * NMEM), s = (m / NMEM) & 1, j = m % NMEM;
        rms_row_to_bf16(F.in[s ? I_MS : I_MP] + (size_t)j * DM, F.in[I_MN] + l * DM, (bf16_t*)POOLP(PL_MEMN) + (size_t)m * DM, nullptr, F.lane); }
    for (int m = gw; m < TT; m += NGW) { const float* src = m < T_P ? F.in[I_XP] + (size_t)m * DM : F.in[I_XS] + (size_t)(m - T_P) * DM;
        const f32x4* xr = (const f32x4*)src + F.lane; u32x2* bo = (u32x2*)((bf16_t*)WSP(WS_HB) + (size_t)m * DM) + F.lane; float s = 0.f;
        const int rr = m & 255, ai = rr >> 7, wr = (rr >> 6) & 1, mm = (rr >> 4) & 3, fr = rr & 15, cc = 4 * F.lane, bj = cc >> 7, wc = (cc >> 5) & 3, fq = (cc >> 3) & 3, n = (cc >> 2) & 1;
        unsigned* xl = (unsigned*)(WSP(WS_X) + (size_t)(m >> 8) * 8 * 65536) + ((size_t)((ai * 4 + mm) * 512 + (wr * 4 + wc) * 64 + fq * 16 + fr)) * 4 + bj * 2 + n;
#pragma unroll
        for (int j = 0; j < 8; ++j) { const f32x4 v = xr[64 * j]; unsigned a0, a1, lo; res_enc4(v, a0, a1, lo); bo[64 * j] = (u32x2){a0, a1}; xl[(size_t)j * 16384] = lo; s += (v.x * v.x + v.y * v.y) + (v.z * v.z + v.w * v.w); }
        s = wave_sum(s);
        if (F.lane < 8) ((float*)(WSP(WS_MISC) + MISC_PSS))[(size_t)m * 8 + F.lane] = F.lane == 0 ? s : 0.f; }
    { float* rope = (float*)(WSP(WS_MISC) + MISC_ROPE); const int gt = F.bid * NTHREADS + F.tid;
      if (gt < 256 * 32) { const int pos = gt >> 5, i = gt & 31; const float inv = powf(10000.0f, -(float)(2 * i) / 64.0f); float sn, cs; sincosf((float)pos * inv, &sn, &cs); rope[gt * 2] = cs; rope[gt * 2 + 1] = sn; }
      if (gt < 2) { float s1 = 0.f, s2 = 0.f; for (int q = 0; q < 64; ++q) { s1 += F.in[I_LQ1][gt * 64 + q] * F.in[I_LK1][gt * 64 + q]; s2 += F.in[I_LQ2][gt * 64 + q] * F.in[I_LK2][gt * 64 + q]; }
          const float linit = 0.8f - 0.6f * expf(-0.3f * (float)(2 * gt)); ((float*)(WSP(WS_MISC) + MISC_LAM))[gt * 2] = expf(s1) - expf(s2) + linit; ((float*)(WSP(WS_MISC) + MISC_LAM))[gt * 2 + 1] = linit; } }
}
__device__ __forceinline__ void s5_precompute_phase(const Frame& F) {
    for (int w = F.G - 1 - F.bid; w < 2 * S5G; w += F.G) s5_precompute_group(F, w / S5G, w % S5G);
}

#ifndef GQA_SDEPTH
#define GQA_SDEPTH 1
#endif
#ifndef DIFF_SDEPTH
#define DIFF_SDEPTH 1
#endif
#ifndef ATT_SETPRIO
#define ATT_SETPRIO 0
#endif
#if ATT_SETPRIO
#define ATT_PRIO(x) __builtin_amdgcn_s_setprio(x)
#else
#define ATT_PRIO(x) do {} while (0)
#endif
namespace att {
constexpr int NW = 8, QBLK = 32, KVBLK = 64, DV = 128;
constexpr float THR = 8.f;
__device__ __forceinline__ int crow(int r, int hi) { return (r & 3) + 8 * (r >> 2) + 4 * hi; }
template <int DQK> __device__ __forceinline__ int kswz(int row, int colB) { if (DQK == 128) return row * 256 + (colB ^ ((row & 7) << 4)); else return row * 128 + (colB ^ (((row >> 1) & 7) << 4)); }
__device__ __forceinline__ int v_st(int k, int c) { const int kk = (k & ~0xC) | ((k & 4) << 1) | ((k & 8) >> 1); return ((kk >> 3) * 4 + (c >> 5)) * 512 + ((kk & 7) * 32 + (c & 31)) * 2; }
__device__ __forceinline__ int v_rd_base(int lane) { return ((lane & 3) << 3) | (((lane >> 2) & 3) << 6) | (((lane >> 4) & 1) << 5) | (((lane >> 5) & 1) << 8); }
constexpr int v_rd_off(int d0, int ks, int half) { return d0 * 512 + ks * 4096 + half * 2048; }
template <int OFF> __device__ __forceinline__ s16x4 tr_read(int vb) { s16x4 r; asm volatile("ds_read_b64_tr_b16 %0, %1 offset:%2" : "=&v"(r) : "v"(vb), "i"(OFF) : "memory"); return r; }
template <int D0> __device__ __forceinline__ void pv_one(f32x16& od, int vb, bf16x8 pa0, bf16x8 pa1, bf16x8 pa2, bf16x8 pa3) {
  const s16x4 l0 = tr_read<v_rd_off(D0, 0, 0)>(vb), h0 = tr_read<v_rd_off(D0, 0, 1)>(vb), l1 = tr_read<v_rd_off(D0, 1, 0)>(vb), h1 = tr_read<v_rd_off(D0, 1, 1)>(vb);
  const s16x4 l2 = tr_read<v_rd_off(D0, 2, 0)>(vb), h2 = tr_read<v_rd_off(D0, 2, 1)>(vb), l3 = tr_read<v_rd_off(D0, 3, 0)>(vb), h3 = tr_read<v_rd_off(D0, 3, 1)>(vb);
  asm volatile("s_waitcnt lgkmcnt(0)" ::: "memory"); SBAR();
#define PK(L, H) (bf16x8){L[0], L[1], L[2], L[3], H[0], H[1], H[2], H[3]}
  ATT_PRIO(1);
  od = __builtin_amdgcn_mfma_f32_32x32x16_bf16(pa0, PK(l0, h0), od, 0, 0, 0);
  od = __builtin_amdgcn_mfma_f32_32x32x16_bf16(pa1, PK(l1, h1), od, 0, 0, 0);
  od = __builtin_amdgcn_mfma_f32_32x32x16_bf16(pa2, PK(l2, h2), od, 0, 0, 0);
  od = __builtin_amdgcn_mfma_f32_32x32x16_bf16(pa3, PK(l3, h3), od, 0, 0, 0);
  ATT_PRIO(0);
#undef PK
}
__device__ __forceinline__ void pv_d0(f32x16* o, int vb, bf16x8 pa0, bf16x8 pa1, bf16x8 pa2, bf16x8 pa3) {
  pv_one<0>(o[0], vb, pa0, pa1, pa2, pa3); pv_one<1>(o[1], vb, pa0, pa1, pa2, pa3); pv_one<2>(o[2], vb, pa0, pa1, pa2, pa3); pv_one<3>(o[3], vb, pa0, pa1, pa2, pa3);
}
template <int DQK> struct Cst { static constexpr float SCALE = DQK == 128 ? 0.088388347648318440f : 0.125f; static constexpr float C = SCALE * 1.4426950408889634f; };

template <int DQK>
__device__ __forceinline__ void partialSM(f32x16& p0, f32x16& p1, float& m_reg, float& mn, float& alpha) {
  constexpr float C = Cst<DQK>::C, SCALE = Cst<DQK>::SCALE;
  float pmax = p0[0];
#pragma unroll
  for (int r = 1; r < 16; ++r) pmax = fmaxf(pmax, p0[r]);
#pragma unroll
  for (int r = 0; r < 16; ++r) pmax = fmaxf(pmax, p1[r]);
  { auto rr = __builtin_amdgcn_permlane32_swap(__float_as_uint(pmax), __float_as_uint(pmax), false, false);
    pmax = fmaxf(__uint_as_float(rr[0]), __uint_as_float(rr[1])); }
  if (__builtin_expect(__all(pmax - m_reg <= THR / SCALE), 1)) { mn = m_reg; alpha = 1.f; }
  else { mn = fmaxf(m_reg, pmax); alpha = __builtin_amdgcn_exp2f((m_reg - mn) * C); m_reg = mn; }
  const float mnC = -mn * C;
#pragma unroll
  for (int r = 0; r < 16; ++r) p0[r] = fmaf(p0[r], C, mnC);
#pragma unroll
  for (int r = 0; r < 16; ++r) p1[r] = fmaf(p1[r], C, mnC);
#pragma unroll
  for (int r = 0; r < 16; ++r) p0[r] = __builtin_amdgcn_exp2f(p0[r]);
}
__device__ __forceinline__ void finishSM(f32x16& p0, f32x16& p1, float alpha, float& l_reg, bf16x8& pa0, bf16x8& pa1, bf16x8& pa2, bf16x8& pa3) {
#pragma unroll
  for (int r = 0; r < 16; ++r) p1[r] = __builtin_amdgcn_exp2f(p1[r]);
  float ps = 0;
#pragma unroll
  for (int r = 0; r < 16; ++r) ps += p0[r];
#pragma unroll
  for (int r = 0; r < 16; ++r) ps += p1[r];
  { auto rr = __builtin_amdgcn_permlane32_swap(__float_as_uint(ps), __float_as_uint(ps), false, false);
    ps = __uint_as_float(rr[0]) + __uint_as_float(rr[1]); }
  l_reg = l_reg * alpha + ps;
#define PK4(P, BASE, OUT) do { unsigned a0 = cvt_pk_bf16(P[BASE + 0], P[BASE + 1]), a1 = cvt_pk_bf16(P[BASE + 2], P[BASE + 3]);   \
    unsigned b0 = cvt_pk_bf16(P[BASE + 4], P[BASE + 5]), b1 = cvt_pk_bf16(P[BASE + 6], P[BASE + 7]);                              \
    auto r0 = __builtin_amdgcn_permlane32_swap(a0, b0, false, false); auto r1 = __builtin_amdgcn_permlane32_swap(a1, b1, false, false); \
    u32x4 w = {r0[0], r1[0], r0[1], r1[1]}; OUT = *reinterpret_cast<bf16x8*>(&w); } while (0)
  PK4(p0, 0, pa0); PK4(p0, 8, pa1); PK4(p1, 0, pa2); PK4(p1, 8, pa3);
#undef PK4
}
template <int DQK, bool ALIBI>
__device__ __forceinline__ void qkt(f32x16& p0, f32x16& p1, const char* Ks, const bf16x8* qr, int r32, int hi, float dq, float sl) {
  if (ALIBI) {
    float dh = dq - (float)(4 * hi); asm volatile("" : "+v"(dh));
#pragma unroll
    for (int r = 0; r < 16; ++r) { const float c = (float)((r & 3) + 8 * (r >> 2)); p0[r] = -sl * fabsf(dh - c); p1[r] = -sl * fabsf(dh - (c + 32.f)); }
  } else { p0 = f32x16{}; p1 = f32x16{}; }
  ATT_PRIO(1);
#pragma unroll
  for (int d0 = 0; d0 < DQK / 16; ++d0) { const int cb = (d0 * 16 + hi * 8) * 2;
    const bf16x8 b0 = *reinterpret_cast<const bf16x8*>(Ks + kswz<DQK>(r32, cb));
    const bf16x8 b1 = *reinterpret_cast<const bf16x8*>(Ks + kswz<DQK>(32 + r32, cb));
    p0 = __builtin_amdgcn_mfma_f32_32x32x16_bf16(b0, qr[d0], p0, 0, 0, 0);
    p1 = __builtin_amdgcn_mfma_f32_32x32x16_bf16(b1, qr[d0], p1, 0, 0, 0); }
  ATT_PRIO(0);
}

template <int DQK, bool ALIBI, int SDEPTH, int LDKV>
__device__ __forceinline__ void attn_pass(const bf16_t* __restrict__ Qw, const bf16_t* __restrict__ Kh, const bf16_t* __restrict__ Vh, int seq, char* lds, f32x16 (&o)[4], float qpos, float sl, int tid) {
  constexpr int SHM_V = KVBLK * DV * 2, SHM_K = KVBLK * DQK * 2;
  const int wid = tid >> 6, lane = tid & 63, r32 = lane & 31, hi = lane >> 5;
  char* V_lds = lds; char* K_lds = lds + 2 * SHM_V;
  float* ws = (float*)(lds + 2 * SHM_V + 2 * SHM_K) + wid * 64; float* li_l = ws; float* al_l = ws + 32;
  float m_reg = -1e30f, l_reg = 0; bf16x8 qr[DQK / 16];
#pragma unroll
  for (int d0 = 0; d0 < 4; ++d0) o[d0] = f32x16{};
#pragma unroll
  for (int d0 = 0; d0 < DQK / 16; ++d0) qr[d0] = *reinterpret_cast<const bf16x8*>(Qw + d0 * 16);
  const int sr = tid >> 4, sc = (tid & 15) * 8, vst0 = v_st(sr, sc), vst1 = v_st(32 + sr, sc);
  const int kr = DQK == 128 ? sr : (tid >> 3), kc = DQK == 128 ? sc : (tid & 7) * 8;
  const int vb0 = (int)(uintptr_t)V_lds + v_rd_base(lane);
  struct { bf16x8 vs0, vs1, ks0, ks1; } sr_[SDEPTH];
#define SLOAD(i, k0) do { sr_[i].vs0 = *(const bf16x8*)(Vh + (size_t)((k0) + sr) * LDKV + sc); sr_[i].vs1 = *(const bf16x8*)(Vh + (size_t)((k0) + 32 + sr) * LDKV + sc); \
    sr_[i].ks0 = *(const bf16x8*)(Kh + (size_t)((k0) + kr) * LDKV + kc); if (DQK == 128) sr_[i].ks1 = *(const bf16x8*)(Kh + (size_t)((k0) + 32 + kr) * LDKV + kc); } while (0)
#define SWRITE(b, i) do { *(bf16x8*)(V_lds + (b) * SHM_V + vst0) = sr_[i].vs0; *(bf16x8*)(V_lds + (b) * SHM_V + vst1) = sr_[i].vs1; \
    *(bf16x8*)(K_lds + (b) * SHM_K + kswz<DQK>(kr, kc * 2)) = sr_[i].ks0; if (DQK == 128) *(bf16x8*)(K_lds + (b) * SHM_K + kswz<DQK>(32 + kr, kc * 2)) = sr_[i].ks1; } while (0)
#define SWAIT() do { if (SDEPTH == 1) asm volatile("s_waitcnt vmcnt(0)" ::: "memory"); else if (DQK == 128) asm volatile("s_waitcnt vmcnt(4)" ::: "memory"); else asm volatile("s_waitcnt vmcnt(3)" ::: "memory"); } while (0)
#define RESC(a) do { if (__any((a) < 1.f)) { if (hi == 0) al_l[r32] = (a); asm volatile("s_waitcnt lgkmcnt(0)" ::: "memory"); \
    _Pragma("unroll") for (int d = 0; d < 4; ++d) _Pragma("unroll") for (int r = 0; r < 16; ++r) o[d][r] *= al_l[crow(r, hi)]; } } while (0)
  f32x16 pA0, pA1, pB0, pB1; float mnA, mnB, alA, alB; bf16x8 pa0, pa1, pa2, pa3; const int NT = seq / KVBLK;
  constexpr int SE = 0, SO = SDEPTH - 1;
  SLOAD(SE, 0); asm volatile("s_waitcnt vmcnt(0)" ::: "memory"); SWRITE(0, SE); __syncthreads();
  qkt<DQK, ALIBI>(pA0, pA1, K_lds, qr, r32, hi, qpos, sl); partialSM<DQK>(pA0, pA1, m_reg, mnA, alA);
  SLOAD(SO, KVBLK); if (SDEPTH == 2) { if (2 < NT) SLOAD(SE, 2 * KVBLK); }
  SWAIT(); SWRITE(1, SO); __syncthreads();
  _Pragma("unroll 1") for (int j = 1; j + 1 < NT; j += 2) {
    SBAR(); qkt<DQK, ALIBI>(pB0, pB1, K_lds + SHM_K, qr, r32, hi, qpos - (float)(j * KVBLK), sl);
    finishSM(pA0, pA1, alA, l_reg, pa0, pa1, pa2, pa3); SBAR();
    SLOAD(SO, (j + SDEPTH) * KVBLK); SBAR();
    pv_d0(o, vb0, pa0, pa1, pa2, pa3); partialSM<DQK>(pB0, pB1, m_reg, mnB, alB);
    __syncthreads(); SWAIT(); SWRITE(0, SE);
    RESC(alB); __syncthreads();
    SBAR(); qkt<DQK, ALIBI>(pA0, pA1, K_lds, qr, r32, hi, qpos - (float)((j + 1) * KVBLK), sl);
    finishSM(pB0, pB1, alB, l_reg, pa0, pa1, pa2, pa3); SBAR();
    if (SDEPTH == 1 || j + 3 < NT) SLOAD(SE, (j + 1 + SDEPTH) * KVBLK); SBAR();
    pv_d0(o, vb0 + SHM_V, pa0, pa1, pa2, pa3); partialSM<DQK>(pA0, pA1, m_reg, mnA, alA);
    __syncthreads(); SWAIT(); SWRITE(1, SO);
    RESC(alA); __syncthreads();
  }
  SBAR(); qkt<DQK, ALIBI>(pB0, pB1, K_lds + SHM_K, qr, r32, hi, qpos - (float)((NT - 1) * KVBLK), sl);
  finishSM(pA0, pA1, alA, l_reg, pa0, pa1, pa2, pa3); SBAR();
  pv_d0(o, vb0, pa0, pa1, pa2, pa3); partialSM<DQK>(pB0, pB1, m_reg, mnB, alB);
  __syncthreads(); RESC(alB);
  finishSM(pB0, pB1, alB, l_reg, pa0, pa1, pa2, pa3); SBAR();
  pv_d0(o, vb0 + SHM_V, pa0, pa1, pa2, pa3);
  if (hi == 0) li_l[r32] = l_reg; asm volatile("s_waitcnt lgkmcnt(0)" ::: "memory");
#pragma unroll
  for (int r = 0; r < 16; ++r) { const float rl = __builtin_amdgcn_rcpf(li_l[crow(r, hi)]);
#pragma unroll
    for (int d0 = 0; d0 < 4; ++d0) o[d0][r] *= rl; }
#undef SLOAD
#undef SWRITE
#undef SWAIT
#undef RESC
}
template <int DQK, bool ALIBI, int LDKV>
__device__ __forceinline__ void attn_pass3(const bf16_t* __restrict__ Qw, const bf16_t* __restrict__ Kh, const bf16_t* __restrict__ Vh, int seq, char* lds, f32x16 (&o)[4], float qpos, float sl, int tid) {
  constexpr int SHM_V = KVBLK * DV * 2, SHM_K = KVBLK * DQK * 2;
  const int wid = tid >> 6, lane = tid & 63, r32 = lane & 31, hi = lane >> 5;
  char* V_lds = lds; char* K_lds = lds + 3 * SHM_V;
  float* ws = (float*)(lds + 3 * SHM_V + 3 * SHM_K) + wid * 64; float* li_l = ws; float* al_l = ws + 32;
  float m_reg = -1e30f, l_reg = 0; bf16x8 qr[DQK / 16];
#pragma unroll
  for (int d0 = 0; d0 < 4; ++d0) o[d0] = f32x16{};
#pragma unroll
  for (int d0 = 0; d0 < DQK / 16; ++d0) qr[d0] = *reinterpret_cast<const bf16x8*>(Qw + d0 * 16);
  const int sr = tid >> 4, sc = (tid & 15) * 8, vst0 = v_st(sr, sc), vst1 = v_st(32 + sr, sc);
  const int kr = DQK == 128 ? sr : (tid >> 3), kc = DQK == 128 ? sc : (tid & 7) * 8;
  const int vb0 = (int)(uintptr_t)V_lds + v_rd_base(lane);
  bf16x8 vs0, vs1, ks0, ks1;
#define SLOAD(k0) do { vs0 = *(const bf16x8*)(Vh + (size_t)((k0) + sr) * LDKV + sc); vs1 = *(const bf16x8*)(Vh + (size_t)((k0) + 32 + sr) * LDKV + sc); \
    ks0 = *(const bf16x8*)(Kh + (size_t)((k0) + kr) * LDKV + kc); if (DQK == 128) ks1 = *(const bf16x8*)(Kh + (size_t)((k0) + 32 + kr) * LDKV + kc); } while (0)
#define SWRITE(b) do { *(bf16x8*)(V_lds + (b) * SHM_V + vst0) = vs0; *(bf16x8*)(V_lds + (b) * SHM_V + vst1) = vs1; \
    *(bf16x8*)(K_lds + (b) * SHM_K + kswz<DQK>(kr, kc * 2)) = ks0; if (DQK == 128) *(bf16x8*)(K_lds + (b) * SHM_K + kswz<DQK>(32 + kr, kc * 2)) = ks1; } while (0)
#define RESC(a) do { if (__any((a) < 1.f)) { if (hi == 0) al_l[r32] = (a); asm volatile("s_waitcnt lgkmcnt(0)" ::: "memory"); \
    _Pragma("unroll") for (int d = 0; d < 4; ++d) _Pragma("unroll") for (int r = 0; r < 16; ++r) o[d][r] *= al_l[crow(r, hi)]; } } while (0)
  f32x16 pA0, pA1, pB0, pB1; float mnA, mnB, alA, alB; bf16x8 pa0, pa1, pa2, pa3; const int NT = seq / KVBLK;
  __syncthreads();
  SLOAD(0); asm volatile("s_waitcnt vmcnt(0)" ::: "memory"); SWRITE(0);
  SLOAD(KVBLK); asm volatile("s_waitcnt vmcnt(0)" ::: "memory"); SWRITE(1);
  if (2 < NT) SLOAD(2 * KVBLK);
  __syncthreads();
  qkt<DQK, ALIBI>(pA0, pA1, K_lds, qr, r32, hi, qpos, sl); partialSM<DQK>(pA0, pA1, m_reg, mnA, alA);
  int s0 = 0, s1 = 1, s2 = 2;
#define ITER(PC0, PC1, mnC, alC, PP0, PP1, alP, t, DO_WRITE, DO_LOAD) do { \
    if (DO_WRITE) { asm volatile("s_waitcnt vmcnt(0)" ::: "memory"); SWRITE(s2); } \
    SBAR(); qkt<DQK, ALIBI>(PC0, PC1, K_lds + s1 * SHM_K, qr, r32, hi, qpos - (float)((t) * KVBLK), sl); \
    finishSM(PP0, PP1, alP, l_reg, pa0, pa1, pa2, pa3); SBAR(); \
    if (DO_LOAD) SLOAD(((t) + 2) * KVBLK); SBAR(); \
    pv_d0(o, vb0 + s0 * SHM_V, pa0, pa1, pa2, pa3); partialSM<DQK>(PC0, PC1, m_reg, mnC, alC); \
    RESC(alC); __syncthreads(); \
    { const int t_ = s0; s0 = s1; s1 = s2; s2 = t_; } } while (0)
  _Pragma("unroll 1") for (int t = 1; t + 2 < NT; t += 2) {
    ITER(pB0, pB1, mnB, alB, pA0, pA1, alA, t, true, true);
    ITER(pA0, pA1, mnA, alA, pB0, pB1, alB, t + 1, true, (t + 3 < NT));
  }
  ITER(pB0, pB1, mnB, alB, pA0, pA1, alA, NT - 1, false, false);
  finishSM(pB0, pB1, alB, l_reg, pa0, pa1, pa2, pa3); SBAR();
  pv_d0(o, vb0 + s0 * SHM_V, pa0, pa1, pa2, pa3);
  if (hi == 0) li_l[r32] = l_reg; asm volatile("s_waitcnt lgkmcnt(0)" ::: "memory");
#pragma unroll
  for (int r = 0; r < 16; ++r) { const float rl = __builtin_amdgcn_rcpf(li_l[crow(r, hi)]);
#pragma unroll
    for (int d0 = 0; d0 < 4; ++d0) o[d0][r] *= rl; }
#undef ITER
#undef SLOAD
#undef SWRITE
#undef RESC
}
}

__device__ __forceinline__ void gqa_attn_phase(const Frame& F) {
    const bf16_t* Z = (const bf16_t*)POOLP(PL_Z); bf16_t* CAT = (bf16_t*)POOLP(PL_CAT);
    constexpr int NU_S = 16 * (T_S / 256), NU = NU_S + 16 * (T_P / 256);
    for (int L = F.bid; L < NU; L += F.G) {
        int tid = threadIdx.x; asm volatile("" : "+v"(tid));
        const int lane = tid & 63, r32 = lane & 31, hi = lane >> 5, wid = tid >> 6;
        int seq, head, qb;
        if (L < NU_S) { const int x = L & 7, r = L >> 3, kvh = x & 3, half = x >> 2; seq = 1; head = kvh * 4 + (r & 3); qb = half * 32 + (r >> 2); }
        else { const int Lp = L - NU_S, x = Lp & 7, r = Lp >> 3, kvh = x & 3, half = x >> 2; seq = 0; head = kvh * 4 + (r & 3); qb = half * 16 + (r >> 2); }
        const int t0 = seq ? T_P : 0, slen = seq ? T_S : T_P, kvh = head >> 2;
        const bf16_t* Qw = Z + (size_t)(t0 + qb * 256 + wid * 32 + r32) * ZLD + head * 128 + hi * 8;
        const bf16_t* Kh = Z + (size_t)t0 * ZLD + 2048 + kvh * 128; const bf16_t* Vh = Z + (size_t)t0 * ZLD + 2560 + kvh * 128;
        f32x16 o[4];
        att::attn_pass<128, false, GQA_SDEPTH, ZLD>(Qw, Kh, Vh, slen, F.ldsg, o, 0.f, 0.f, tid);
        bf16_t* Ow = CAT + (size_t)(t0 + qb * 256 + wid * 32) * DM + head * 128;
#pragma unroll
        for (int r = 0; r < 16; ++r) { const int orow = att::crow(r, hi);
#pragma unroll
            for (int d0 = 0; d0 < 4; ++d0) Ow[(size_t)orow * DM + d0 * 32 + r32] = f2bf(o[d0][r]); }
    }
}

__device__ __forceinline__ void qk_bound_pass(const Frame& F, int e) {
    const bf16_t* Z = (const bf16_t*)POOLP(PL_Z); unsigned* ctl = (unsigned*)WSP(WS_CTL) + CW_QKB + e * 64;
    const int gw = F.bid * NWAVES + F.wave, NGW = F.G * NWAVES, lane = F.lane;
    float mx[2][2] = {{0.f, 0.f}, {0.f, 0.f}};
    for (int t = gw; t < TT; t += NGW) {
        const bf16_t* row = Z + (size_t)t * ZLD + lane * 16;
#pragma unroll
        for (int qk = 0; qk < 2; ++qk) { const u32x4 a = *(const u32x4*)(row + qk * 1024), b = *(const u32x4*)(row + qk * 1024 + 8);
            float s = bflo(a.x) * bflo(a.x) + bfhi(a.x) * bfhi(a.x) + bflo(a.y) * bflo(a.y) + bfhi(a.y) * bfhi(a.y) + bflo(a.z) * bflo(a.z) + bfhi(a.z) * bfhi(a.z) + bflo(a.w) * bflo(a.w) + bfhi(a.w) * bfhi(a.w)
                    + bflo(b.x) * bflo(b.x) + bfhi(b.x) * bfhi(b.x) + bflo(b.y) * bflo(b.y) + bfhi(b.y) * bfhi(b.y) + bflo(b.z) * bflo(b.z) + bfhi(b.z) * bfhi(b.z) + bflo(b.w) * bflo(b.w) + bfhi(b.w) * bfhi(b.w);
            s += __shfl_xor(s, 1); s += __shfl_xor(s, 2);
            if (t < T_P) mx[0][qk] = fmaxf(mx[0][qk], s); else mx[1][qk] = fmaxf(mx[1][qk], s); }
    }
    LAS float* red = (LAS float*)F.lds;
    if ((lane & 3) == 0) {
#pragma unroll
        for (int sq = 0; sq < 2; ++sq)
#pragma unroll
            for (int qk = 0; qk < 2; ++qk) red[(F.wave * 4 + sq * 2 + qk) * 16 + (lane >> 2)] = mx[sq][qk]; }
    LDS_WAIT(); __syncthreads();
    if (F.tid < 64) { float m = 0.f;
#pragma unroll
        for (int w = 0; w < 8; ++w) m = fmaxf(m, red[w * 64 + F.tid]);
        atomicMax(ctl + F.tid, __float_as_uint(m)); }
    __syncthreads();
}

__device__ __forceinline__ void diff_attn_phase(const Frame& F, int e, int rep = 0) {
    const bf16_t* Z = (const bf16_t*)POOLP(PL_Z); bf16_t* CAT = (bf16_t*)POOLP(PL_CAT); float* ST = (float*)POOLP(PL_STASH);
    const float lam = ((const float*)(WSP(WS_MISC) + MISC_LAM))[e * 2], linit = ((const float*)(WSP(WS_MISC) + MISC_LAM))[e * 2 + 1];
    const float* sg = F.in[I_SUBLN] + e * 128;
    unsigned* ctl = (unsigned*)WSP(WS_CTL); const unsigned* qkb = ctl + CW_QKB + e * 64; unsigned* qctr = ctl + CW_QUEUE + e * 64 + rep * 256;
    constexpr int NU = 8 * (T_S / 256) + 8 * (T_P / 256);
    LAS int* uslot = (LAS int*)(F.lds + RING_BYTES + 64);
    for (;;) {
        __syncthreads();
        if (threadIdx.x == 0) *uslot = (int)__hip_atomic_fetch_add(qctr, 1u, RLX_AGENT);
        LDS_WAIT(); __syncthreads();
        const int u = __builtin_amdgcn_readfirstlane(*uslot);
        if (u >= NU) break;
        int tid = threadIdx.x; asm volatile("" : "+v"(tid));
        const int lane = tid & 63, r32 = lane & 31, hi = lane >> 5, wid = tid >> 6;
        f32x4* st = (f32x4*)ST + ((size_t)F.bid * NTHREADS + tid) * 16;
        const int head = 7 - u / 96, rr = u % 96, seq = rr < 64 ? 1 : 0, qb = seq ? rr : rr - 64;
        const int t0 = seq ? T_P : 0, slen = seq ? T_S : T_P;
        const float slope = exp2f(-(float)(head + 1)), sl = slope * 8.0f;
        const bf16_t* Vh = Z + (size_t)t0 * ZLD + 2048 + head * 128;
        f32x16 o[4];
        for (int m = 0; m < 2; ++m) {
            const float q2 = __uint_as_float(__hip_atomic_load(qkb + (seq * 2 + 0) * 16 + head * 2 + m, RLX_AGENT)), k2 = __uint_as_float(__hip_atomic_load(qkb + (seq * 2 + 1) * 16 + head * 2 + m, RLX_AGENT));
            const float Bnd = 0.25f * sqrtf(q2 * k2) + 32.0f;
            float Wf = Bnd / slope; if (!(Wf < (float)slen)) Wf = (float)slen;
            const int W = (int)Wf + 1;
            int tlo = (qb * 256 - W) >> 6; if (tlo < 0) tlo = 0;
            int thi = (qb * 256 + 256 + W + 63) >> 6; if (thi > slen / 64) thi = slen / 64;
            if ((thi - tlo) & 1) { if (thi < slen / 64) ++thi; else --tlo; }
            tlo = __builtin_amdgcn_readfirstlane(tlo); thi = __builtin_amdgcn_readfirstlane(thi);
            const float qpos = (float)(qb * 256 + wid * 32 + r32 - tlo * 64);
            const bf16_t* Qw = Z + (size_t)(t0 + qb * 256 + wid * 32 + r32) * ZLD + head * 128 + m * 64 + hi * 8;
            const bf16_t* Kh = Z + (size_t)(t0 + tlo * 64) * ZLD + 1024 + head * 128 + m * 64;
            att::attn_pass<64, true, DIFF_SDEPTH, ZLD>(Qw, Kh, Vh + (size_t)(tlo * 64) * ZLD, (thi - tlo) * 64, F.ldsg, o, qpos, sl, tid);
            if (m == 0) {
#pragma unroll
                for (int d0 = 0; d0 < 4; ++d0)
#pragma unroll
                    for (int q = 0; q < 4; ++q) st[d0 * 4 + q] = (f32x4){o[d0][4 * q], o[d0][4 * q + 1], o[d0][4 * q + 2], o[d0][4 * q + 3]};
            }
        }
        float ss[16];
#pragma unroll
        for (int r = 0; r < 16; ++r) ss[r] = 0.f;
#pragma unroll
        for (int d0 = 0; d0 < 4; ++d0) {
#pragma unroll
            for (int q = 0; q < 4; ++q) { const f32x4 s4 = st[d0 * 4 + q];
#pragma unroll
                for (int i = 0; i < 4; ++i) { const int r = 4 * q + i; const float a = s4[i] - lam * o[d0][r]; o[d0][r] = a; ss[r] += a * a; } }
            asm volatile("" ::: "memory"); }
#pragma unroll
        for (int r = 0; r < 16; ++r) { float s = ss[r]; s += __shfl_xor(s, 1); s += __shfl_xor(s, 2); s += __shfl_xor(s, 4); s += __shfl_xor(s, 8); s += __shfl_xor(s, 16);
            ss[r] = (1.0f - linit) / sqrtf(s * (1.f / 128.f) + SUBLN_EPS); }
        bf16_t* Ow = CAT + (size_t)(t0 + qb * 256 + wid * 32) * DM + 1024 + head * 128;
#pragma unroll
        for (int d0 = 0; d0 < 4; ++d0) { const float gcol = sg[d0 * 32 + r32];
#pragma unroll
            for (int r = 0; r < 16; ++r) Ow[(size_t)att::crow(r, hi) * DM + d0 * 32 + r32] = f2bf(o[d0][r] * ss[r] * gcol); }
    }
}

constexpr int PH_BASE = 3, PH_PER = 16, PH_END = PH_BASE + 8 * PH_PER - 1;
__host__ __device__ inline bool phase_exists(int pid) {
    if (pid < PH_BASE) return true;
    const int hl = (pid - PH_BASE) / PH_PER, k = (pid - PH_BASE) % PH_PER, f = hl & 1, l = hl >> 1;
    if (k <= 1) return true;
    if (k == 14) return hl == 7;
    if (k == 15 || f == 1 || k == 2 || k == 10 || k == 12) return false;
    if ((l & 1) && (k == 6 || k == 7 || k == 8)) return false;
    return true;
}

__device__ __forceinline__ bool fresh_frame(Frame& F) { int t = threadIdx.x; asm volatile("" : "+v"(t)); F.tid = t; F.lane = t & 63; F.wave = __builtin_amdgcn_readfirstlane(t >> 6); return true; }
#ifndef GU_WGM
#define GU_WGM 4
#endif
__global__ void __launch_bounds__(NTHREADS, 2) fwd_kernel(Args args) {
    extern __shared__ __attribute__((aligned(16))) unsigned char lds[];
    Frame F;
    F.lds = (LAS unsigned char*)lds; F.ldsg = (char*)lds;
    F.MISC = (volatile LAS unsigned*)(F.lds + MISC_OFF);
    F.tid = threadIdx.x; F.lane = F.tid & 63; F.wave = __builtin_amdgcn_readfirstlane(F.tid >> 6);
    F.G = gridDim.x; F.bid = blockIdx.x; F.in = args.in; F.x = args.out; F.ws = args.ws;
    for (int u = F.tid; u < (LDS_BYTES - RING_BYTES) / 4; u += NTHREADS) ((LAS unsigned*)(F.lds + RING_BYTES))[u] = 0u;
    __syncthreads();
    XcdBarrier bar = xcd_barrier_post((unsigned*)(F.ws + WS_CTL) + CW_BAR + args.li * XCD_BAR_WORDS, F.MISC + 8);
    const int lo = args.ph_lo, hi = args.ph_hi;
#define PH(p) (lo <= (p) && (p) < hi && fresh_frame(F))
#define ENDPH(p) do { if ((p) + 1 < hi) xcd_barrier(bar); } while (0)
    float* const PSS = (float*)(F.ws + WS_MISC + MISC_PSS);
    const int rep = args.pad;
#ifdef PROBE_K
#define RSCALE(s) (rep == 0 ? (s) : 0.0f)
#else
#define RSCALE(s) (s)
#endif

    if (PH(0)) { prologue_phase(F); ENDPH(0); }
    if (PH(1)) {
        auto S = make_sched(F, POOLP(PL_MEMN), DM, POOLP(PL_WKVT), DM, 256, 2 * DM, 8, ZKv{});
        EpiBf16<0> E{(bf16_t*)POOLP(PL_KVB), 2 * DM, (size_t)256 * 2 * DM, 0, 0, nullptr, nullptr, nullptr};
        pg8::gemm_phase(F.lds, DM, DM, DM, S, E, F.tid);
        s5_precompute_phase(F); ENDPH(1);
    }
    if (PH(2)) {
        { auto S = make_sched(F, POOLP(PL_KVB), 2 * DM, POOLP(PL_WQB), DM, 256, DM, 32, ZKf{});
          EpiBf16<2> E{(bf16_t*)WSP(WS_KF), DM, (size_t)256 * DM, 0, 0, F.in[I_CN], nullptr, nullptr};
          pg8::gemm_phase(F.lds, 2 * DM, DM, 512, S, E, F.tid); }
        { auto S = make_sched(F, POOLP(PL_WOT), DM, POOLP(PL_KVB), 2 * DM, DM, 256, 32, ZVw{});
          EpiBf16<0> E{(bf16_t*)WSP(WS_VWT), 1024, (size_t)DM * 1024, 256, 2, nullptr, nullptr, nullptr};
          pg8::gemm_phase(F.lds, DM, 2 * DM, 512, S, E, F.tid); }
        ENDPH(2);
    }
    for (int hl = 0; hl < 8; ++hl) {
        const int l = hl >> 1, f = hl & 1, pb = PH_BASE + hl * PH_PER, eo = l >> 1;
        const bool even = (l & 1) == 0;
        if (PH(pb + 0)) {
            auto S = make_sched(F, WSP(WS_HB), DM, WSP(WS_WGU + (size_t)hl * SZ_WGU), DM, TT, 2 * DFF, 1, ZNone{}); S.wgm = GU_WGM;
            EpiSwiglu E{F.ws, DFF, F.lds};
            pg8::gemm_phase(F.lds, DM, DM, DM, S, E, F.tid);
            ENDPH(pb + 0);
        }
        if (PH(pb + 1)) {
            auto S = make_sched(F, POOLP(PL_ACT), DFF, WSP(WS_WD + (size_t)hl * SZ_WD), DFF, TT, DM, 1, ZNone{});
            { EpiResidNorm E{RSCALE(0.5f), F.ws, (LAS float*)(F.lds + EXCH_OFF)}; pg8::gemm_phase(F.lds, DFF, DFF, DFF, S, E, F.tid); }
            ENDPH(pb + 1);
        }
        if (f == 0) {
            if (even) {
                if (PH(pb + 3)) {
                    auto S = make_sched(F, WSP(WS_HB), DM, WSP(WS_WINE + (size_t)eo * SZ_WINE), DM, TT, EVEN_IN, 1, ZNone{});
                    EpiWinEven E{F.ws, F.lds};
                    pg8::gemm_phase(F.lds, DM, DM, DM, S, E, F.tid);
                    ENDPH(pb + 3);
                }
                if (PH(pb + 4)) {
                    auto S = make_sched(F, POOLP(PL_UX), S5K2, WSP(WS_WST + (size_t)eo * 64 * SZ_WST), S5K1, NCH, S5NS, S5G, ZLin{(size_t)NCH * S5K2 * 2, SZ_WST});
                    EpiF32 E{(float*)POOLP(PL_SST), S5G * S5NS, (size_t)S5NS};
                    pg8::gemm_phase(F.lds, S5K2, S5K1, S5K1, S, E, F.tid);
                    qk_bound_pass(F, eo); ENDPH(pb + 4);
                }
                if (PH(pb + 5)) { s5_scan_phase(F, eo); ENDPH(pb + 5); }
                if (PH(pb + 6)) {
                    auto S = make_sched(F, POOLP(PL_UX), S5K2, WSP(WS_TG + (size_t)eo * 64 * SZ_TG), S5K2, NCH, S5K1, S5G, ZLin{(size_t)NCH * S5K2 * 2, SZ_TG});
                    EpiS5Out E{(bf16_t*)POOLP(PL_GB)};
                    pg8::gemm_phase(F.lds, S5K2, S5K2, S5K2, S, E, F.tid); ENDPH(pb + 6);
                }
                if (PH(pb + 7)) {
                    auto S = make_sched(F, POOLP(PL_GB), S5W, WSP(WS_GLU + (size_t)eo * SZ_GLU), S5W, TT, S5W, 1, ZNone{});
                    EpiGlu E{(const bf16_t*)POOLP(PL_GB), F.in[I_GLUB] + eo * S5W, (bf16_t*)POOLP(PL_CAT)};
                    pg8::gemm_phase(F.lds, S5W, S5W, S5W, S, E, F.tid);
                    if (!PH(pb + 8)) ENDPH(pb + 7);
                }
                if (PH(pb + 8)) { diff_attn_phase(F, eo, rep); ENDPH(pb + 8); }
            } else {
                if (PH(pb + 3)) {
                    auto S = make_sched(F, WSP(WS_HB), DM, WSP(WS_WINO + (size_t)eo * SZ_WINO), DM, TT, ODD_IN, 1, ZNone{});
                    EpiBf16<1> E{(bf16_t*)POOLP(PL_Z), ZLD, 0, 0, 0, nullptr, F.ws, F.lds};
                    pg8::gemm_phase(F.lds, DM, DM, DM, S, E, F.tid); ENDPH(pb + 3);
                }
                if (PH(pb + 4)) { qk_prep_phase(F, eo); ENDPH(pb + 4); }
                if (PH(pb + 5)) { gqa_attn_phase(F); ENDPH(pb + 5); }
            }
            if (PH(pb + 9)) {
                auto S = make_sched(F, POOLP(PL_CAT), DM, even ? WSP(WS_WOUTE + (size_t)eo * SZ_SQ) : WSP(WS_WOUTO + (size_t)eo * SZ_SQ), DM, TT, DM, 1, ZNone{});
                    { EpiResidNorm E{RSCALE(1.0f), F.ws, (LAS float*)(F.lds + EXCH_OFF)}; pg8::gemm_phase(F.lds, DM, DM, DM, S, E, F.tid); }
                ENDPH(pb + 9);
            }
            if (PH(pb + 11)) {
                auto S = make_sched(F, WSP(WS_HB), DM, WSP(WS_KF + (size_t)l * 2 * SZ_KF), DM, TT, 1024, 1, ZNone{}); S.split = T_P / 256; S.bseq = SZ_KF;
                EpiCrossSm E{F.ws, (LAS f32x2*)(F.lds + EXCH_OFF), F.lds};
                pg8::gemm_phase(F.lds, DM, DM, DM, S, E, F.tid);
                ENDPH(pb + 11);
            }
            if (PH(pb + 13)) {
                auto S = make_sched(F, POOLP(PL_CP), 1024, WSP(WS_VWT + (size_t)l * 2 * SZ_KF), 1024, TT, DM, 1, ZNone{}); S.split = T_P / 256; S.bseq = SZ_KF;
                EpiResidNorm E{RSCALE(1.0f), F.ws, (LAS float*)(F.lds + EXCH_OFF)};
                    pg8::gemm_phase(F.lds, 1024, 1024, 1024, S, E, F.tid); ENDPH(pb + 13);
            }
        }
        if (hl == 7 && PH(pb + 14)) { final_norm_phase(F, F.in[I_FINN]); ENDPH(pb + 14); }
    }
#undef PH
#undef ENDPH
}

#ifndef MK_PER_PHASE
#define MK_PER_PHASE 0
#endif
extern "C" void kernel_launch(void* const* d_in, const int* in_sizes, int n_in, void* d_out, int out_size, void* d_ws, size_t ws_size, hipStream_t stream) {
    static int grid = 0;
    if (grid == 0) {
        if (n_in != N_IN || out_size != TT * DM || ws_size < WS_END) { fprintf(stderr, "kernel_launch: unexpected shapes: n_in %d out %d ws %zu (need %zu)\n", n_in, out_size, ws_size, (size_t)WS_END); grid = -1; return; }
        int dev = 0, cus = 0, per_cu = 0;
        if (hipGetDevice(&dev) != hipSuccess || hipDeviceGetAttribute(&cus, hipDeviceAttributeMultiprocessorCount, dev) != hipSuccess) { grid = -1; return; }
        if (hipFuncSetAttribute((const void*)fwd_kernel, hipFuncAttributeMaxDynamicSharedMemorySize, LDS_BYTES) != hipSuccess) { fprintf(stderr, "kernel_launch: hipFuncSetAttribute failed\n"); grid = -1; return; }
        if (hipOccupancyMaxActiveBlocksPerMultiprocessor(&per_cu, (const void*)fwd_kernel, NTHREADS, LDS_BYTES) != hipSuccess || per_cu < 1) { fprintf(stderr, "kernel_launch: occupancy query says %d\n", per_cu); (void)hipGetLastError(); grid = -1; return; }
        grid = cus;
    }
    if (grid < 0) return;
    (void)hipMemsetAsync((char*)d_ws + WS_CTL, 0, CTL_BYTES, stream);
    Args a{};
    for (int i = 0; i < N_IN; ++i) a.in[i] = (const float*)d_in[i];
    a.out = (float*)d_out; a.ws = (unsigned char*)d_ws; a.pad = 0;
#if MK_PER_PHASE
    int li = 0;
    for (int p = 0; p < PH_END; ++p) { if (!phase_exists(p)) continue; a.ph_lo = p; a.ph_hi = p + 1; a.li = li++; a.pad = 0;
        hipLaunchKernelGGL(fwd_kernel, dim3(grid), dim3(NTHREADS), LDS_BYTES, stream, a);
#ifdef PROBE_K
        { const int kind = p < PH_BASE ? 100 + p : (p - PH_BASE) % PH_PER;
          if (kind == PROBE_K) for (int r = 1; r <= PROBE_REPS; ++r) { a.pad = r; hipLaunchKernelGGL(fwd_kernel, dim3(grid), dim3(NTHREADS), LDS_BYTES, stream, a); } }
#endif
    }
#else
    a.ph_lo = 0; a.ph_hi = PH_END; a.li = 0;
    hipLaunchKernelGGL(fwd_kernel, dim3(grid), dim3(NTHREADS), LDS_BYTES, stream, a);
#endif
    const hipError_t le = hipPeekAtLastError();
    if (le != hipSuccess) fprintf(stderr, "kernel_launch: launch failed: %s\n", hipGetErrorName(le));
}
```

```cpp
#include <hip/hip_runtime.h>
#include <cstdio>
#include <cstdint>

#define GAS __attribute__((address_space(1)))
#define LAS __attribute__((address_space(3)))
typedef unsigned short bf16_t;
typedef short bf16x8 __attribute__((ext_vector_type(8)));
typedef short s16x4 __attribute__((ext_vector_type(4)));
typedef float f32x2 __attribute__((ext_vector_type(2)));
typedef float f32x4 __attribute__((ext_vector_type(4)));
typedef float f32x8 __attribute__((ext_vector_type(8)));
typedef float f32x16 __attribute__((ext_vector_type(16)));
typedef unsigned u32x2 __attribute__((ext_vector_type(2)));
typedef unsigned u32x4 __attribute__((ext_vector_type(4)));
typedef GAS unsigned gu32;
#define RLX_AGENT __ATOMIC_RELAXED, __HIP_MEMORY_SCOPE_AGENT
#define LDS_WAIT() asm volatile("s_waitcnt lgkmcnt(0)" ::: "memory")
#define VM_WAIT() asm volatile("s_waitcnt vmcnt(0)" ::: "memory")
#define SBAR() __builtin_amdgcn_sched_barrier(0)

__device__ __forceinline__ unsigned cvt_pk_bf16(float lo, float hi) { unsigned r; asm volatile("v_cvt_pk_bf16_f32 %0, %1, %2" : "=v"(r) : "v"(lo), "v"(hi)); return r; }
__device__ __forceinline__ float bf2f(unsigned short b) { return __uint_as_float(((unsigned)b) << 16); }
__device__ __forceinline__ float bflo(unsigned w) { return __uint_as_float(w << 16); }
__device__ __forceinline__ float bfhi(unsigned w) { return __uint_as_float(w & 0xffff0000u); }
__device__ __forceinline__ unsigned short f2bf(float f) { unsigned u = __float_as_uint(f); return (unsigned short)((u + 0x7fffu + ((u >> 16) & 1u)) >> 16); }
__device__ __forceinline__ float fast_rcp(float x) { return __builtin_amdgcn_rcpf(x); }
__device__ __forceinline__ float fast_exp2(float x) { return __builtin_amdgcn_exp2f(x); }
__device__ __forceinline__ float sigmoidf_fast(float x) { return fast_rcp(1.0f + fast_exp2(-1.4426950408889634f * x)); }
__device__ __forceinline__ float silu_f(float x) { return x * sigmoidf_fast(x); }
__device__ __forceinline__ float gelu_tanh_f(float y) { const float z = y + 0.044715f * y * y * y; return y * fast_rcp(1.0f + fast_exp2(-2.3022081982f * z)); }
__device__ __forceinline__ float wave_sum(float v) {
#pragma unroll
    for (int o = 1; o < 64; o <<= 1) v += __shfl_xor(v, o);
    return v;
}

#define XB_TMO      128
#define XB_XCNT(j)  (256  + 64 * (j))
#define XB_XSUB(j)  (1280 + 64 * (j))
#define XB_XGEN(j)  (2304 + 64 * (j))
#define XB_TOP      3328
#define XB_TOPGEN   3392
#define XCD_BAR_WORDS 3456
#define XB_SPIN_CAP (1u << 22)

__device__ __forceinline__ unsigned xb_ld(unsigned* p)              { return __hip_atomic_load(p, __ATOMIC_RELAXED, __HIP_MEMORY_SCOPE_AGENT); }
__device__ __forceinline__ unsigned xb_add(unsigned* p, unsigned v) { return __hip_atomic_fetch_add(p, v, __ATOMIC_RELAXED, __HIP_MEMORY_SCOPE_AGENT); }
__device__ __forceinline__ unsigned xb_xcc_id() { return (unsigned)__builtin_amdgcn_s_getreg((3 << 11) | 20) & 0xFu; }
#define XB_SPIN(cond, bar) do { unsigned _sp = 0; while (cond) { __builtin_amdgcn_s_sleep(1); \
    if ((++_sp & 255u) == 0u) { if (xb_ld(&(bar)[XB_TMO])) break; if (_sp > XB_SPIN_CAP) { atomicAdd(&(bar)[XB_TMO], 1u); break; } } } } while (0)

struct XcdBarrier { unsigned* bar; unsigned x; volatile LAS unsigned* st; };

__device__ __forceinline__ XcdBarrier xcd_barrier_post(unsigned* bar, volatile LAS unsigned* st) {
    XcdBarrier b; b.bar = bar; b.x = xb_xcc_id(); b.st = st;
    if (threadIdx.x == 0) (void)xb_add(&bar[XB_XCNT(b.x)], 1u);
    return b;
}
__device__ __forceinline__ void xcd_barrier_complete(unsigned* bar, unsigned x, unsigned& nloc, unsigned& nx) {
    const unsigned G = gridDim.x * gridDim.y * gridDim.z;
    unsigned sum, cnt, mine, sp = 0u;
    for (;;) {
        sum = 0u; cnt = 0u; mine = 0u;
#pragma unroll
        for (unsigned j = 0; j < 16; ++j) { const unsigned c = xb_ld(&bar[XB_XCNT(j)]); sum += c; cnt += (c > 0u) ? 1u : 0u; mine = (j == x) ? c : mine; }
        if (sum == G) break;
        __builtin_amdgcn_s_sleep(1);
        if ((++sp & 255u) == 0u) { if (xb_ld(&bar[XB_TMO])) break; if (sp > XB_SPIN_CAP) { atomicAdd(&bar[XB_TMO], 1u); break; } }
    }
    nloc = mine > 0u ? mine : 1u; nx = cnt > 0u ? cnt : 1u;
}
__device__ __forceinline__ void xcd_barrier(const XcdBarrier& b) {
    asm volatile("s_waitcnt vmcnt(0)" ::: "memory");
    __syncthreads();
    if (threadIdx.x == 0) {
        unsigned* bar = b.bar;
        __builtin_amdgcn_s_waitcnt(0);
        unsigned nloc = b.st[0], nx = b.st[1];
        if (nloc == 0u) { xcd_barrier_complete(bar, b.x, nloc, nx); b.st[0] = nloc; b.st[1] = nx; }
        const unsigned old = xb_add(&bar[XB_XSUB(b.x)], 1u);
        const unsigned gen = old / nloc;
        if (old + 1u == (gen + 1u) * nloc) {
            __builtin_amdgcn_fence(__ATOMIC_RELEASE, "agent");
            asm volatile("s_waitcnt vmcnt(0)" ::: "memory");
            const unsigned og = xb_add(&bar[XB_TOP], 1u);
            const unsigned tg = og / nx;
            if (og + 1u == (tg + 1u) * nx) xb_add(&bar[XB_TOPGEN], 1u);
            else XB_SPIN(xb_ld(&bar[XB_TOPGEN]) == tg, bar);
            __builtin_amdgcn_fence(__ATOMIC_ACQUIRE, "agent");
            xb_add(&bar[XB_XGEN(b.x)], 1u);
            asm volatile("s_waitcnt vmcnt(0)" ::: "memory");
        } else {
            XB_SPIN(xb_ld(&bar[XB_XGEN(b.x)]) == gen, bar);
            __builtin_amdgcn_fence(__ATOMIC_ACQUIRE, "agent");
            asm volatile("s_waitcnt vmcnt(0)" ::: "memory");
        }
    }
    __syncthreads();
}

namespace pg8 {
constexpr int BM = 256, BK = 64, HALF = 128, HTB = HALF * BK * 2, STAGE_BYTES = 8 * HTB, NXCD = 8, WGM = 4;
__host__ __device__ __forceinline__ int lds_byte(int r, int c) { const int st = (r >> 4) * 2 + (c >> 5), rr = r & 15, cc = c & 31, ob = rr * 64 + cc * 2; return st * 1024 + (ob ^ (((ob >> 9) & 1) << 5)); }
__host__ __device__ __forceinline__ void stage_rc(int b, int& R, int& C) { const int st = b / 1024, sb = b % 1024, swz = sb ^ (((sb >> 9) & 1) << 5); R = (st >> 1) * 16 + swz / 64; C = (st & 1) * 32 + (swz % 64) / 2; }
__host__ __device__ __forceinline__ int perm32(int rho) { const int n = rho >> 4, i = rho & 15; return 8 * (i >> 2) + 4 * n + (i & 3); }

struct Unit { int pm, pn, z; };
struct Enum {
    int nM, nN, nZ, nwg, G, c, rev, wgm;
    __device__ __forceinline__ void init(int nM_, int nN_, int nZ_, int G_, int c_) { nM = nM_; nN = nN_; nZ = nZ_; nwg = nM * nN * nZ; G = G_; c = c_; rev = 0; wgm = WGM; }
    __device__ __forceinline__ bool next(int i, Unit& u) const {
        const long L = (long)i * G + c; if (L >= nwg) return false;
        int wgid = (int)L; { const int q = nwg / NXCD, r = nwg % NXCD, xcd = wgid % NXCD, off = wgid / NXCD; wgid = (xcd < r ? xcd * (q + 1) : r * (q + 1) + (xcd - r) * q) + off; }
        const int per = nM * nN; u.z = wgid / per; wgid -= u.z * per;
        const int nig = wgm * nN, gid = wgid / nig, fm = gid * wgm, gsz = (nM - fm) < wgm ? (nM - fm) : wgm;
        u.pm = fm + ((wgid % nig) % gsz); u.pn = (wgid % nig) / gsz; if (rev) u.pm = nM - 1 - u.pm; return true;
    }
};

template <class Epi, class Sched>
__device__ __forceinline__ void gemm_phase(LAS unsigned char* lds, const int lda, const int ldb, const int K, const Sched& S, const Epi& E, const int tid) {
    const int wid = __builtin_amdgcn_readfirstlane(tid >> 6), lane = tid & 63, wr = wid >> 2, wc = wid & 3, fr = lane & 15, fq = lane >> 4;
    const int nt = K / BK;
    unsigned voffA[2], voffB[2];
#pragma unroll
    for (int i = 0; i < 2; ++i) { int R, C; stage_rc(tid * 16 + i * 8192, R, C); const int Rb = Epi::PERM ? ((R & ~31) + perm32(R & 31)) : R;
        voffA[i] = (unsigned)(R * lda + C) * 2u; voffB[i] = (unsigned)(Rb * ldb + C) * 2u; }
    const size_t kstep = (size_t)(BK * 2);
    const size_t hstepA = (size_t)HALF * lda * 2, hstepB = (size_t)HALF * ldb * 2;
    const unsigned ldsw = (unsigned)wid * 1024u;
    const int aoff = lds_byte(wr * 64 + fr, fq * 8), boff = lds_byte(wc * 32 + fr, fq * 8);
#define PG8_SA(b, h) (((b) * 2 + (h)) * HTB)
#define PG8_SB(b, h) ((4 + (b) * 2 + (h)) * HTB)
#define PG8_STAGE(bufoff, gbase, voff) do { _Pragma("unroll") for (int _i = 0; _i < 2; ++_i) \
        __builtin_amdgcn_global_load_lds((const unsigned*)((const char*)(gbase) + (voff)[_i]), (LAS unsigned*)(lds + (bufoff) + ldsw + _i * 8192), 16, 0, 0); } while (0)
#define PG8_LDA(dst, b, h) do { _Pragma("unroll") for (int m = 0; m < 4; ++m) _Pragma("unroll") for (int k = 0; k < 2; ++k) dst[m][k] = *(const LAS bf16x8*)(lds + PG8_SA(b, h) + aoff + m * 2048 + k * 1024); } while (0)
#define PG8_LDB(dst, b, h) do { _Pragma("unroll") for (int n = 0; n < 2; ++n) _Pragma("unroll") for (int k = 0; k < 2; ++k) dst[n][k] = *(const LAS bf16x8*)(lds + PG8_SB(b, h) + boff + n * 2048 + k * 1024); } while (0)
#define PG8_MMA(ai, bj, At, Bt) do { __builtin_amdgcn_s_setprio(1); _Pragma("unroll") for (int m = 0; m < 4; ++m) _Pragma("unroll") for (int n = 0; n < 2; ++n) _Pragma("unroll") for (int k = 0; k < 2; ++k) \
        acc[ai][bj][m][n] = __builtin_amdgcn_mfma_f32_16x16x32_bf16(Bt[n][k], At[m][k], acc[ai][bj][m][n], 0, 0, 0); __builtin_amdgcn_s_setprio(0); } while (0)
#define PG8_WAIT_V(n) asm volatile("s_waitcnt vmcnt(" #n ")" ::: "memory")
#define PG8_WAIT_L(n) asm volatile("s_waitcnt lgkmcnt(" #n ")" ::: "memory")
#define PG8_BAR __builtin_amdgcn_s_barrier()
#define PG8_SCHED __builtin_amdgcn_sched_barrier(0)
    Unit cur, nxt; int ui = 0;
    if (!S.next(0, cur)) return;
    f32x4 acc[2][2][4][2];
#pragma unroll
    for (int a = 0; a < 2; ++a)
#pragma unroll
        for (int b = 0; b < 2; ++b)
#pragma unroll
            for (int m = 0; m < 4; ++m)
#pragma unroll
                for (int n = 0; n < 2; ++n) acc[a][b][m][n] = (f32x4){0.f, 0.f, 0.f, 0.f};
    bf16x8 At[4][2], B0[2][2], B1[2][2];
    const char* cA = S.a_base(cur); const char* cB = S.b_base(cur);
    {
        PG8_STAGE(PG8_SB(0, 0), cB, voffB); PG8_STAGE(PG8_SB(0, 1), cB + hstepB, voffB); PG8_STAGE(PG8_SA(0, 0), cA, voffA); PG8_STAGE(PG8_SA(0, 1), cA + hstepA, voffA);
        if (wr == 1) PG8_BAR;
        PG8_WAIT_V(2); PG8_BAR;
        PG8_STAGE(PG8_SB(1, 0), cB + kstep, voffB); PG8_STAGE(PG8_SA(1, 0), cA + kstep, voffA); PG8_STAGE(PG8_SB(1, 1), cB + hstepB + kstep, voffB);
        PG8_WAIT_V(6); PG8_BAR;
    }
    for (;;) {
        if constexpr (Epi::PREFETCH) E.prefetch(lds, cur, ui, wid, lane);
        const bool has_next = S.next(ui + 1, nxt);
        const char* nA = has_next ? S.a_base(nxt) : cA; const char* nB = has_next ? S.b_base(nxt) : cB;
        for (int t = 0; t < nt; t += 2) {
            const bool last = (t == nt - 2);
            const char* a1 = cA + (size_t)(t + 1) * kstep;
            const char* a2 = last ? nA : cA + (size_t)(t + 2) * kstep; const char* b2 = last ? nB : cB + (size_t)(t + 2) * kstep;
            const char* a3 = a2 + kstep; const char* b3 = b2 + kstep;
            PG8_LDB(B0, 0, 0); PG8_LDB(B1, 0, 1); PG8_SCHED; PG8_LDA(At, 0, 0); PG8_STAGE(PG8_SA(1, 1), a1 + hstepA, voffA);
            PG8_WAIT_V(8); PG8_WAIT_L(0); PG8_BAR; PG8_MMA(0, 0, At, B0); PG8_MMA(0, 1, At, B1); PG8_BAR; PG8_SCHED;
            PG8_LDA(At, 0, 1); PG8_STAGE(PG8_SB(0, 0), b2, voffB); PG8_STAGE(PG8_SB(0, 1), b2 + hstepB, voffB); PG8_STAGE(PG8_SA(0, 0), a2, voffA);
            PG8_WAIT_V(8); PG8_WAIT_L(0); PG8_BAR; PG8_MMA(1, 0, At, B0); PG8_MMA(1, 1, At, B1); PG8_BAR; PG8_SCHED;
            PG8_LDB(B0, 1, 0); PG8_LDB(B1, 1, 1); PG8_SCHED; PG8_LDA(At, 1, 0); PG8_STAGE(PG8_SA(0, 1), a2 + hstepA, voffA);
            PG8_WAIT_V(8); PG8_WAIT_L(0); PG8_BAR; PG8_MMA(0, 0, At, B0); PG8_MMA(0, 1, At, B1); PG8_BAR; PG8_SCHED;
            PG8_LDA(At, 1, 1); PG8_STAGE(PG8_SB(1, 0), b3, voffB); PG8_STAGE(PG8_SB(1, 1), b3 + hstepB, voffB); PG8_STAGE(PG8_SA(1, 0), a3, voffA);
            PG8_WAIT_V(8); PG8_WAIT_L(0); PG8_BAR; PG8_MMA(1, 0, At, B0); PG8_MMA(1, 1, At, B1); PG8_BAR; PG8_SCHED;
        }
        if (wr == 0) PG8_BAR;
        E(acc, cur, wr, wc, fr, fq, ui);
        if (!has_next) break;
#pragma unroll
        for (int a = 0; a < 2; ++a)
#pragma unroll
            for (int b = 0; b < 2; ++b)
#pragma unroll
                for (int m = 0; m < 4; ++m)
#pragma unroll
                    for (int n = 0; n < 2; ++n) acc[a][b][m][n] = (f32x4){0.f, 0.f, 0.f, 0.f};
        cur = nxt; cA = nA; cB = nB; ++ui;
        if (wr == 1) PG8_BAR;
    }
    PG8_WAIT_V(0);
    PG8_BAR;
#undef PG8_SA
#undef PG8_SB
#undef PG8_STAGE
#undef PG8_LDA
#undef PG8_LDB
#undef PG8_MMA
#undef PG8_WAIT_V
#undef PG8_WAIT_L
#undef PG8_BAR
#undef PG8_SCHED
}
}

constexpr int DM = 2048, T_P = 8192, T_S = 16384, TT = T_P + T_S, DEPTH = 4, NMEM = 256, DFF = 5632;
constexpr int S5W = 1024, S5G = 64, S5H = 16, S5P = 64, LC = 32, NCH = TT / LC, NCH_P = T_P / LC;
constexpr int S5K1 = LC * S5H  , S5NS = 4 * S5P  , S5K2 = S5K1 + S5NS  ;
constexpr int EVEN_IN = 4096, ODD_IN = 3072, ZLD = 3072;
constexpr float EPS = 1e-6f, SUBLN_EPS = 1e-5f;
constexpr int NWAVES = 8, NTHREADS = 512;

enum { I_XP = 0, I_XS, I_MP, I_MS, I_F1N, I_F1GU, I_F1D, I_MIXN, I_EWIN, I_EWOUT, I_LRE, I_LIM, I_LDT, I_BRE, I_BIM, I_CRE, I_CIM, I_S5D, I_GLUW, I_GLUB,
       I_LQ1, I_LK1, I_LQ2, I_LK2, I_SUBLN, I_OWIN, I_OWOUT, I_QN, I_KN, I_CN, I_MN, I_CWQ, I_CWKV, I_CWO, I_F2N, I_F2GU, I_F2D, I_FINN, N_IN };

constexpr size_t MiB = 1u << 20;
constexpr size_t WS_CTL = 0, CTL_BYTES = 2 * MiB;
constexpr size_t WS_WGU = 2 * MiB;
constexpr size_t SZ_WGU = (size_t)2 * DFF * DM * 2;
constexpr size_t WS_WD = WS_WGU + 8 * SZ_WGU;
constexpr size_t SZ_WD = (size_t)DM * DFF * 2;
constexpr size_t WS_WINE = WS_WD + 8 * SZ_WD;
constexpr size_t SZ_WINE = (size_t)EVEN_IN * DM * 2;
constexpr size_t WS_WOUTE = WS_WINE + 2 * SZ_WINE;
constexpr size_t SZ_SQ = (size_t)DM * DM * 2;
constexpr size_t WS_GLU = WS_WOUTE + 2 * SZ_SQ;
constexpr size_t SZ_GLU = (size_t)S5W * S5W * 2;
constexpr size_t WS_WINO = WS_GLU + 2 * SZ_GLU;
constexpr size_t SZ_WINO = (size_t)ODD_IN * DM * 2;
constexpr size_t WS_WOUTO = WS_WINO + 2 * SZ_WINO;
constexpr size_t WS_KF = WS_WOUTO + 2 * SZ_SQ;
constexpr size_t SZ_KF = (size_t)1024 * DM * 2;
constexpr size_t WS_VWT = WS_KF + 8 * SZ_KF;
constexpr size_t WS_WST = WS_VWT + 8 * SZ_KF;
constexpr size_t SZ_WST = (size_t)S5NS * S5K1 * 2;
constexpr size_t WS_TG = WS_WST + 2 * 64 * SZ_WST;
constexpr size_t SZ_TG = (size_t)S5K1 * S5K2 * 2;
constexpr size_t WS_HB = WS_TG + 2 * 64 * SZ_TG;
constexpr size_t SZ_HB = (size_t)TT * DM * 2;
constexpr size_t WS_MISC = WS_HB + SZ_HB;
constexpr size_t MISC_ROPE = 0, MISC_AL = 65536  , MISC_LAM = 65536 + 131072  , MISC_PSS = 262144  ;
constexpr size_t WS_POOL = WS_MISC + MiB;
constexpr size_t PL_ACT = 0;
constexpr size_t PL_Z = 0;
constexpr size_t PL_UX = 144 * MiB;
constexpr size_t PL_KC = 144 * MiB;
constexpr size_t PL_SST = 216 * MiB;
constexpr size_t PL_GB = 264 * MiB;
constexpr size_t PL_CAT = 312 * MiB;
constexpr size_t PL_STASH = 408 * MiB;
constexpr size_t PL_CS = 0;
constexpr size_t PL_CP = 96 * MiB;
constexpr size_t PL_WQB = 0;
constexpr size_t PL_WKVT = 32 * MiB;
constexpr size_t PL_WOT = 96 * MiB;
constexpr size_t PL_MEMN = 128 * MiB;
constexpr size_t PL_KVB = 136 * MiB;
constexpr size_t POOL_BYTES = 440 * MiB;
constexpr size_t WS_X = WS_POOL + POOL_BYTES;
constexpr size_t WS_END = WS_X + (size_t)TT * DM;

constexpr int CW_BAR = 4096;
constexpr int CW_DBG = 1024;
constexpr int CW_QKB = 2048;
constexpr int CW_QUEUE = 2304;

constexpr int EXCH_OFF = 131072  , PSSB_OFF = 139264  , RING_BYTES = 155648, MISC_OFF = RING_BYTES + 320, LDS_BYTES = 159744;

struct Args { const float* in[N_IN]; float* out; unsigned char* ws; int ph_lo, ph_hi, li, pad; };
struct Frame {
    LAS unsigned char* lds; char* ldsg;
    volatile LAS unsigned* MISC;
    int tid, lane, wave, G, bid;
    const float* const* in; float* x; unsigned char* ws;
};
#define WSP(off) (F.ws + (off))
#define POOLP(off) (F.ws + WS_POOL + (off))

struct ZNone { __device__ __forceinline__ size_t aoff(int) const { return 0; } __device__ __forceinline__ size_t boff(int) const { return 0; } };
struct ZLin { size_t as, bs; __device__ __forceinline__ size_t aoff(int z) const { return (size_t)z * as; } __device__ __forceinline__ size_t boff(int z) const { return (size_t)z * bs; } };
struct ZKv { __device__ __forceinline__ size_t aoff(int z) const { return (size_t)z * (256 * 2048 * 2); } __device__ __forceinline__ size_t boff(int z) const { return (size_t)(z >> 1) * ((size_t)4096 * 2048 * 2); } };
struct ZKf { __device__ __forceinline__ size_t aoff(int z) const { return (size_t)(z >> 2) * ((size_t)256 * 4096 * 2) + (size_t)(z & 3) * 1024; }
             __device__ __forceinline__ size_t boff(int z) const { return (size_t)(z >> 3) * ((size_t)2048 * 2048 * 2) + (size_t)(z & 3) * 1024; } };
struct ZVw { __device__ __forceinline__ size_t aoff(int z) const { return (size_t)(z >> 3) * ((size_t)2048 * 2048 * 2) + (size_t)(z & 3) * 1024; }
             __device__ __forceinline__ size_t boff(int z) const { return (size_t)(z >> 2) * ((size_t)256 * 4096 * 2) + 4096 + (size_t)(z & 3) * 1024; } };
template <class ZM>
struct Sched : pg8::Enum {
    const char* A; const char* B; size_t atile, btile; int split; size_t bseq; ZM zm;
    __device__ __forceinline__ const char* a_base(const pg8::Unit& u) const { return A + (size_t)u.pm * atile + zm.aoff(u.z); }
    __device__ __forceinline__ const char* b_base(const pg8::Unit& u) const { return B + (size_t)u.pn * btile + zm.boff(u.z) + (u.pm >= split ? bseq : 0); }
};
template <class ZM>
__device__ __forceinline__ Sched<ZM> make_sched(const Frame& F, const void* A, int lda, const void* B, int ldb, int M, int N, int nZ, ZM zm) {
    Sched<ZM> S; S.init(M / 256, N / 256, nZ, F.G, F.bid); S.A = (const char*)A; S.B = (const char*)B; S.atile = (size_t)256 * lda * 2; S.btile = (size_t)256 * ldb * 2;
    S.split = 1 << 30; S.bseq = 0; S.zm = zm; return S;
}

typedef f32x4 Acc[2][2][4][2];
__device__ __forceinline__ float res_dec(unsigned hb  , float lob  ) {
    const int e = (int)((hb >> 7) & 0xFFu); const float sd = __uint_as_float((unsigned)(e > 15 ? e - 15 : 0) << 23);
    return fmaf(lob - 128.0f, sd, __uint_as_float(hb << 16));
}
__device__ __forceinline__ float res_enc_lo(float x, unsigned hb) {
    const int e = (int)((hb >> 7) & 0xFFu); const float se = e > 15 ? __uint_as_float((unsigned)(269 - e) << 23) : 0.f;
    return fminf(__builtin_rintf(fmaf(x - __uint_as_float(hb << 16), se, 128.0f)), 255.0f);
}
__device__ __forceinline__ unsigned pack4_u8(float a, float b, float c, float dd) { return (unsigned)a | ((unsigned)b << 8) | ((unsigned)c << 16) | ((unsigned)dd << 24); }
__device__ __forceinline__ void res_enc4(const f32x4 v, unsigned& w0, unsigned& w1, unsigned& lo) {
    w0 = cvt_pk_bf16(v[0], v[1]); w1 = cvt_pk_bf16(v[2], v[3]);
    lo = pack4_u8(res_enc_lo(v[0], w0 & 0xFFFFu), res_enc_lo(v[1], w0 >> 16), res_enc_lo(v[2], w1 & 0xFFFFu), res_enc_lo(v[3], w1 >> 16));
}
__device__ __forceinline__ f32x4 res_dec4(unsigned w0, unsigned w1, unsigned lo) {
    return (f32x4){res_dec(w0 & 0xFFFFu, (float)(lo & 0xFFu)), res_dec(w0 >> 16, (float)((lo >> 8) & 0xFFu)), res_dec(w1 & 0xFFFFu, (float)((lo >> 16) & 0xFFu)), res_dec(w1 >> 16, (float)(lo >> 24))};
}
__device__ __forceinline__ unsigned char* fresh_ws(unsigned char* ws) { asm volatile("" : "+s"(ws)); return ws; }
__device__ __forceinline__ void pss_prefetch(LAS unsigned char* lds, const unsigned char* ws, int pm, int par, int wid, int lane) {
    const unsigned char* src = ws + WS_MISC + MISC_PSS + (size_t)pm * 8192 + wid * 1024 + lane * 16;
    __builtin_amdgcn_global_load_lds((const unsigned*)src, (LAS unsigned*)(lds + PSSB_OFF + (par & 1) * 8192 + wid * 1024), 16, 0, 0);
}
__device__ __forceinline__ void row_rstd_lds(const LAS unsigned char* lds, int par, int rloc0, float (&rs)[2][4]) {
    const LAS unsigned char* b = lds + PSSB_OFF + (par & 1) * 8192;
#pragma unroll
    for (int ai = 0; ai < 2; ++ai)
#pragma unroll
        for (int m = 0; m < 4; ++m) { const f32x4 a = *(const LAS f32x4*)(b + (rloc0 + ai * 128 + m * 16) * 32), c = *(const LAS f32x4*)(b + (rloc0 + ai * 128 + m * 16) * 32 + 16);
            rs[ai][m] = 1.0f / sqrtf((((a.x + a.y) + (a.z + a.w)) + ((c.x + c.y) + (c.z + c.w))) * (1.f / DM) + EPS); }
}
__device__ __forceinline__ void row_rstd(const float* PSS, int row0, float (&rs)[2][4]) {
#pragma unroll
    for (int ai = 0; ai < 2; ++ai)
#pragma unroll
        for (int m = 0; m < 4; ++m) { const f32x4 a = *(const f32x4*)(PSS + (size_t)(row0 + ai * 128 + m * 16) * 8), b = *(const f32x4*)(PSS + (size_t)(row0 + ai * 128 + m * 16) * 8 + 4);
            rs[ai][m] = 1.0f / sqrtf((((a.x + a.y) + (a.z + a.w)) + ((b.x + b.y) + (b.z + b.w))) * (1.f / DM) + EPS); }
}
struct EpiSwiglu { static constexpr bool PERM = true, PREFETCH = true; unsigned char* ws; int ldc; LAS unsigned char* lds;
    __device__ __forceinline__ void prefetch(LAS unsigned char* l, const pg8::Unit& u, int par, int wid, int lane) const { pss_prefetch(l, ws, u.pm, par, wid, lane); }
    __device__ __forceinline__ void operator()(Acc& acc, const pg8::Unit& u, int wr, int wc, int fr, int fq, int par) const {
        const int row0 = u.pm * 256 + wr * 64 + fr, col0 = u.pn * 128 + wc * 32 + 8 * fq;
        unsigned char* w_ = fresh_ws(ws); bf16_t* O = (bf16_t*)(w_ + WS_POOL + PL_ACT);
        float rs[2][4]; row_rstd_lds(lds, par, wr * 64 + fr, rs);
#pragma unroll
        for (int ai = 0; ai < 2; ++ai)
#pragma unroll
            for (int m = 0; m < 4; ++m) { const f32x4 g0 = acc[ai][0][m][0] * rs[ai][m], g1 = acc[ai][0][m][1] * rs[ai][m], u0 = acc[ai][1][m][0] * rs[ai][m], u1 = acc[ai][1][m][1] * rs[ai][m];
                u32x4 w; w.x = cvt_pk_bf16(silu_f(g0[0]) * u0[0], silu_f(g0[1]) * u0[1]); w.y = cvt_pk_bf16(silu_f(g0[2]) * u0[2], silu_f(g0[3]) * u0[3]);
                w.z = cvt_pk_bf16(silu_f(g1[0]) * u1[0], silu_f(g1[1]) * u1[1]); w.w = cvt_pk_bf16(silu_f(g1[2]) * u1[2], silu_f(g1[3]) * u1[3]);
                *(u32x4*)(O + (size_t)(row0 + ai * 128 + m * 16) * ldc + col0) = w; }
    }
};
struct EpiResidNorm { static constexpr bool PERM = true, PREFETCH = false; float scale; unsigned char* ws; LAS float* red;
    __device__ __forceinline__ void operator()(Acc& acc, const pg8::Unit& u, int wr, int wc, int fr, int fq, int par) const {
        const int row0 = u.pm * 256 + wr * 64 + fr, col0 = u.pn * 256 + wc * 32 + 8 * fq, tid = (wr * 4 + wc) * 64 + fq * 16 + fr;
        unsigned char* w_ = fresh_ws(ws); bf16_t* XB = (bf16_t*)(w_ + WS_HB); float* PSS = (float*)(w_ + WS_MISC + MISC_PSS);
        u32x4* XL = (u32x4*)(w_ + WS_X + (size_t)(u.pm * 8 + u.pn) * 65536) + tid;
#pragma unroll
        for (int ai = 0; ai < 2; ++ai) {
            u32x4 hv[4][2], lv[4];
#pragma unroll
            for (int m = 0; m < 4; ++m) { const bf16_t* bp = XB + (size_t)(row0 + ai * 128 + m * 16) * DM + col0; hv[m][0] = *(const u32x4*)bp; hv[m][1] = *(const u32x4*)(bp + 128); lv[m] = XL[(ai * 4 + m) * 512]; }
#pragma unroll
            for (int m = 0; m < 4; ++m) { bf16_t* bp = XB + (size_t)(row0 + ai * 128 + m * 16) * DM + col0; float s = 0.f; u32x4 lo;
#pragma unroll
                for (int bj = 0; bj < 2; ++bj) { const f32x4 v0 = res_dec4(hv[m][bj].x, hv[m][bj].y, lv[m][bj * 2]) + acc[ai][bj][m][0] * scale, v1 = res_dec4(hv[m][bj].z, hv[m][bj].w, lv[m][bj * 2 + 1]) + acc[ai][bj][m][1] * scale;
                    unsigned a0, a1, a2, a3, l0, l1; res_enc4(v0, a0, a1, l0); res_enc4(v1, a2, a3, l1); *(u32x4*)(bp + bj * 128) = (u32x4){a0, a1, a2, a3}; lo[bj * 2] = l0; lo[bj * 2 + 1] = l1;
                    s += ((v0[0] * v0[0] + v0[1] * v0[1]) + (v0[2] * v0[2] + v0[3] * v0[3])) + ((v1[0] * v1[0] + v1[1] * v1[1]) + (v1[2] * v1[2] + v1[3] * v1[3])); }
                XL[(ai * 4 + m) * 512] = lo;
                s += __shfl_xor(s, 16); s += __shfl_xor(s, 32);
                if (fq == 0) red[(ai * 128 + wr * 64 + m * 16 + fr) * 4 + wc] = s; }
            asm volatile("" ::: "memory"); }
        asm volatile("s_waitcnt lgkmcnt(0)" ::: "memory"); __builtin_amdgcn_s_barrier(); asm volatile("" ::: "memory");
        if (tid < 256) { const f32x4 r4 = *(const LAS f32x4*)(red + tid * 4); PSS[(size_t)(u.pm * 256 + tid) * 8 + u.pn] = (r4.x + r4.y) + (r4.z + r4.w); }
    }
};
template <int MODE> struct EpiBf16 { static constexpr bool PERM = true, PREFETCH = (MODE == 1); bf16_t* O; int ldc; size_t zhi, zlo; int zshift; const float* aux; unsigned char* ws; LAS unsigned char* lds;
    __device__ __forceinline__ void prefetch(LAS unsigned char* l, const pg8::Unit& u, int par, int wid, int lane) const { pss_prefetch(l, ws, u.pm, par, wid, lane); }
    __device__ __forceinline__ void operator()(Acc& acc, const pg8::Unit& u, int wr, int wc, int fr, int fq, int par) const {
        bf16_t* base = O + (size_t)(u.z >> zshift) * zhi + (size_t)(u.z & ((1 << zshift) - 1)) * zlo;
        const int row0 = u.pm * 256 + wr * 64 + fr, col0 = u.pn * 256 + wc * 32 + 8 * fq;
        float rs[2][4]; if (MODE == 1) row_rstd_lds(lds, par, wr * 64 + fr, rs);
        f32x4 cs[2][2]; if (MODE == 2) {
#pragma unroll
            for (int bj = 0; bj < 2; ++bj)
#pragma unroll
                for (int n = 0; n < 2; ++n) cs[bj][n] = *(const f32x4*)(aux + (size_t)(u.z >> 3) * DM + col0 + bj * 128 + 4 * n); }
#pragma unroll
        for (int ai = 0; ai < 2; ++ai)
#pragma unroll
            for (int m = 0; m < 4; ++m) { bf16_t* rp = base + (size_t)(row0 + ai * 128 + m * 16) * ldc + col0;
#pragma unroll
                for (int bj = 0; bj < 2; ++bj) { f32x4 v0 = acc[ai][bj][m][0], v1 = acc[ai][bj][m][1];
                    if (MODE == 1) { v0 = v0 * rs[ai][m]; v1 = v1 * rs[ai][m]; }
                    if (MODE == 2) { v0 = v0 * cs[bj][0]; v1 = v1 * cs[bj][1]; }
                    u32x4 w; w.x = cvt_pk_bf16(v0[0], v0[1]); w.y = cvt_pk_bf16(v0[2], v0[3]); w.z = cvt_pk_bf16(v1[0], v1[1]); w.w = cvt_pk_bf16(v1[2], v1[3]);
                    *(u32x4*)(rp + bj * 128) = w; } }
    }
};
struct EpiWinEven { static constexpr bool PERM = true, PREFETCH = true; unsigned char* ws; LAS unsigned char* lds;
    __device__ __forceinline__ void prefetch(LAS unsigned char* l, const pg8::Unit& u, int par, int wid, int lane) const { pss_prefetch(l, ws, u.pm, par, wid, lane); }
    __device__ __forceinline__ void operator()(Acc& acc, const pg8::Unit& u, int wr, int wc, int fr, int fq, int par) const {
        const int row0 = u.pm * 256 + wr * 64 + fr, col0 = u.pn * 256 + wc * 32 + 8 * fq;
        unsigned char* w_ = fresh_ws(ws); bf16_t* UX = (bf16_t*)(w_ + WS_POOL + PL_UX); bf16_t* Z = (bf16_t*)(w_ + WS_POOL + PL_Z);
        float rs[2][4]; row_rstd_lds(lds, par, wr * 64 + fr, rs);
#pragma unroll
        for (int ai = 0; ai < 2; ++ai)
#pragma unroll
            for (int m = 0; m < 4; ++m) { const int row = row0 + ai * 128 + m * 16;
#pragma unroll
                for (int bj = 0; bj < 2; ++bj) { const f32x4 v0 = acc[ai][bj][m][0] * rs[ai][m], v1 = acc[ai][bj][m][1] * rs[ai][m]; const int col = col0 + bj * 128;
                    u32x4 w; w.x = cvt_pk_bf16(v0[0], v0[1]); w.y = cvt_pk_bf16(v0[2], v0[3]); w.z = cvt_pk_bf16(v1[0], v1[1]); w.w = cvt_pk_bf16(v1[2], v1[3]);
                    bf16_t* p;
                    if (u.pn < 4) { const int g = col >> 4, h0 = col & 15, c = row >> 5, i = row & 31; p = UX + ((size_t)(g * NCH + c) * S5K2 + i * 16 + h0); }
                    else p = Z + (size_t)row * ZLD + (col - 1024);
                    *(u32x4*)p = w; } }
    }
};
struct EpiF32 { static constexpr bool PERM = false, PREFETCH = false; float* O; int ldc; size_t zs;
    __device__ __forceinline__ void operator()(Acc& acc, const pg8::Unit& u, int wr, int wc, int fr, int fq, int par) const {
        float* base = O + (size_t)u.z * zs; const int row0 = u.pm * 256 + wr * 64 + fr, col0 = u.pn * 256 + wc * 32 + 4 * fq;
#pragma unroll
        for (int ai = 0; ai < 2; ++ai)
#pragma unroll
            for (int m = 0; m < 4; ++m) { float* rp = base + (size_t)(row0 + ai * 128 + m * 16) * ldc + col0;
#pragma unroll
                for (int bj = 0; bj < 2; ++bj)
#pragma unroll
                    for (int n = 0; n < 2; ++n) *(f32x4*)(rp + bj * 128 + n * 16) = acc[ai][bj][m][n]; }
    }
};
struct EpiS5Out { static constexpr bool PERM = true, PREFETCH = false; bf16_t* GB;
    __device__ __forceinline__ void operator()(Acc& acc, const pg8::Unit& u, int wr, int wc, int fr, int fq, int par) const {
        const int row0 = u.pm * 256 + wr * 64 + fr, col0 = u.pn * 256 + wc * 32 + 8 * fq;
#pragma unroll
        for (int ai = 0; ai < 2; ++ai)
#pragma unroll
            for (int m = 0; m < 4; ++m) { const int c = row0 + ai * 128 + m * 16;
#pragma unroll
                for (int bj = 0; bj < 2; ++bj) { const f32x4 v0 = acc[ai][bj][m][0], v1 = acc[ai][bj][m][1]; const int col = col0 + bj * 128, i = col >> 4, h0 = col & 15;
                    u32x4 w; w.x = cvt_pk_bf16(gelu_tanh_f(v0[0]), gelu_tanh_f(v0[1])); w.y = cvt_pk_bf16(gelu_tanh_f(v0[2]), gelu_tanh_f(v0[3]));
                    w.z = cvt_pk_bf16(gelu_tanh_f(v1[0]), gelu_tanh_f(v1[1])); w.w = cvt_pk_bf16(gelu_tanh_f(v1[2]), gelu_tanh_f(v1[3]));
                    *(u32x4*)(GB + (size_t)(c * LC + i) * S5W + u.z * 16 + h0) = w; } }
    }
};
struct EpiGlu { static constexpr bool PERM = true, PREFETCH = false; const bf16_t* GB; const float* bias; bf16_t* O;
    __device__ __forceinline__ void operator()(Acc& acc, const pg8::Unit& u, int wr, int wc, int fr, int fq, int par) const {
        const int row0 = u.pm * 256 + wr * 64 + fr, col0 = u.pn * 256 + wc * 32 + 8 * fq;
        f32x4 bv[2][2];
#pragma unroll
        for (int bj = 0; bj < 2; ++bj)
#pragma unroll
            for (int n = 0; n < 2; ++n) bv[bj][n] = *(const f32x4*)(bias + col0 + bj * 128 + 4 * n);
#pragma unroll
        for (int ai = 0; ai < 2; ++ai)
#pragma unroll
            for (int m = 0; m < 4; ++m) { const int row = row0 + ai * 128 + m * 16;
#pragma unroll
                for (int bj = 0; bj < 2; ++bj) { const f32x4 v0 = acc[ai][bj][m][0] + bv[bj][0], v1 = acc[ai][bj][m][1] + bv[bj][1]; const int col = col0 + bj * 128;
                    const u32x4 g = *(const u32x4*)(GB + (size_t)row * S5W + col);
                    u32x4 w; w.x = cvt_pk_bf16(bflo(g.x) * sigmoidf_fast(v0[0]), bfhi(g.x) * sigmoidf_fast(v0[1])); w.y = cvt_pk_bf16(bflo(g.y) * sigmoidf_fast(v0[2]), bfhi(g.y) * sigmoidf_fast(v0[3]));
                    w.z = cvt_pk_bf16(bflo(g.z) * sigmoidf_fast(v1[0]), bfhi(g.z) * sigmoidf_fast(v1[1])); w.w = cvt_pk_bf16(bflo(g.w) * sigmoidf_fast(v1[2]), bfhi(g.w) * sigmoidf_fast(v1[3]));
                    *(u32x4*)(O + (size_t)row * DM + col) = w; } }
    }
};

struct EpiCrossSm { static constexpr bool PERM = true, PREFETCH = true; unsigned char* ws; LAS f32x2* red; LAS unsigned char* lds;
    __device__ __forceinline__ void prefetch(LAS unsigned char* l, const pg8::Unit& u, int par, int wid, int lane) const { pss_prefetch(l, ws, u.pm, par, wid, lane); }
    __device__ __forceinline__ void operator()(Acc& acc, const pg8::Unit& u, int wr, int wc, int fr, int fq, int par) const {
        constexpr float C = 0.04419417382415922f * 1.4426950408889634f;
        const int row0 = u.pm * 256 + wr * 64 + fr, col0 = u.pn * 256 + wc * 32 + 8 * fq;
        unsigned char* w_ = fresh_ws(ws); bf16_t* O = (bf16_t*)(w_ + WS_POOL + PL_CP);
        float rs[2][4]; row_rstd_lds(lds, par, wr * 64 + fr, rs);
        float mw[2][4];
#pragma unroll
        for (int ai = 0; ai < 2; ++ai)
#pragma unroll
            for (int m = 0; m < 4; ++m) { const float k = rs[ai][m] * C; float mx = -3.0e38f;
#pragma unroll
                for (int bj = 0; bj < 2; ++bj)
#pragma unroll
                    for (int n = 0; n < 2; ++n) { f32x4 v = acc[ai][bj][m][n] * k; acc[ai][bj][m][n] = v; mx = fmaxf(fmaxf(mx, fmaxf(v[0], v[1])), fmaxf(v[2], v[3])); }
                mx = fmaxf(mx, __shfl_xor(mx, 16)); mx = fmaxf(mx, __shfl_xor(mx, 32)); float s = 0.f;
#pragma unroll
                for (int bj = 0; bj < 2; ++bj)
#pragma unroll
                    for (int n = 0; n < 2; ++n) { f32x4 v = acc[ai][bj][m][n]; v[0] = fast_exp2(v[0] - mx); v[1] = fast_exp2(v[1] - mx); v[2] = fast_exp2(v[2] - mx); v[3] = fast_exp2(v[3] - mx); acc[ai][bj][m][n] = v; s += (v[0] + v[1]) + (v[2] + v[3]); }
                s += __shfl_xor(s, 16); s += __shfl_xor(s, 32); mw[ai][m] = mx;
                if (fq == 0) red[(ai * 128 + wr * 64 + m * 16 + fr) * 4 + wc] = (f32x2){mx, s}; }
        asm volatile("s_waitcnt lgkmcnt(0)" ::: "memory"); __builtin_amdgcn_s_barrier(); asm volatile("" ::: "memory");
#pragma unroll
        for (int ai = 0; ai < 2; ++ai)
#pragma unroll
            for (int m = 0; m < 4; ++m) { const LAS f32x2* rr = red + (ai * 128 + wr * 64 + m * 16 + fr) * 4; const f32x2 r0 = rr[0], r1 = rr[1], r2 = rr[2], r3 = rr[3];
                const float M = fmaxf(fmaxf(r0.x, r1.x), fmaxf(r2.x, r3.x));
                const float tot = (r0.y * fast_exp2(r0.x - M) + r1.y * fast_exp2(r1.x - M)) + (r2.y * fast_exp2(r2.x - M) + r3.y * fast_exp2(r3.x - M));
                const float f = fast_exp2(mw[ai][m] - M) * fast_rcp(tot);
                bf16_t* rp = O + (size_t)(row0 + ai * 128 + m * 16) * 1024 + col0;
#pragma unroll
                for (int bj = 0; bj < 2; ++bj) { const f32x4 v0 = acc[ai][bj][m][0] * f, v1 = acc[ai][bj][m][1] * f;
                    u32x4 w; w.x = cvt_pk_bf16(v0[0], v0[1]); w.y = cvt_pk_bf16(v0[2], v0[3]); w.z = cvt_pk_bf16(v1[0], v1[1]); w.w = cvt_pk_bf16(v1[2], v1[3]);
                    *(u32x4*)(rp + bj * 128) = w; } }
    }
};

template <int MODE>
__device__ __forceinline__ void transpose_item(const float* W, int K, int N, bf16_t* WT, LAS float* scr, int item, int lane, const float* gain = nullptr) {
    const int nblk = N / 32, kb = item / nblk, nb = item % nblk, k0 = 64 * kb, n0 = 32 * nb;
#pragma unroll 8
    for (int i = 0; i < 32; ++i) { const int kk = 2 * i + (lane >> 5); scr[kk * 33 + (lane & 31)] = W[(size_t)(k0 + kk) * N + n0 + (lane & 31)]; }
    LDS_WAIT(); asm volatile("" ::: "memory");
    const int c = lane & 7;
    f32x4 g0 = (f32x4){1.f, 1.f, 1.f, 1.f}, g1 = g0; if (gain) { g0 = *(const f32x4*)(gain + k0 + 8 * c); g1 = *(const f32x4*)(gain + k0 + 8 * c + 4); }
    int r0;
    if (MODE == 1) { r0 = (n0 < DFF) ? (256 * (n0 / 128) + (n0 % 128)) : (256 * ((n0 - DFF) / 128) + 128 + ((n0 - DFF) % 128)); } else r0 = n0;
#pragma unroll
    for (int j = 0; j < 4; ++j) { const int n = (lane >> 3) + 8 * j; const LAS float* s = scr + (8 * c) * 33 + n;
        u32x4 o; o.x = cvt_pk_bf16(s[0 * 33] * g0.x, s[1 * 33] * g0.y); o.y = cvt_pk_bf16(s[2 * 33] * g0.z, s[3 * 33] * g0.w); o.z = cvt_pk_bf16(s[4 * 33] * g1.x, s[5 * 33] * g1.y); o.w = cvt_pk_bf16(s[6 * 33] * g1.z, s[7 * 33] * g1.w);
        *(u32x4*)(WT + (size_t)(r0 + n) * K + k0 + 8 * c) = o; }
    LDS_WAIT(); asm volatile("" ::: "memory");
}
__device__ __forceinline__ void convert_rows(const float* src, bf16_t* dst, size_t n8, size_t gtid, size_t gthreads) {
    for (size_t i = gtid; i < n8; i += gthreads) { const f32x4 a = *(const f32x4*)(src + i * 8), b = *(const f32x4*)(src + i * 8 + 4);
        u32x4 o; o.x = cvt_pk_bf16(a[0], a[1]); o.y = cvt_pk_bf16(a[2], a[3]); o.z = cvt_pk_bf16(b[0], b[1]); o.w = cvt_pk_bf16(b[2], b[3]); *(u32x4*)(dst + i * 8) = o; }
}

__device__ __forceinline__ void rms_row_to_bf16(const float* xrow, const float* g, bf16_t* orow, float* xcopy, int lane) {
    const f32x4* xr = (const f32x4*)xrow + lane;
    f32x4 v[8]; float s = 0.f;
#pragma unroll
    for (int j = 0; j < 8; ++j) { v[j] = xr[64 * j]; s += (v[j].x * v[j].x + v[j].y * v[j].y) + (v[j].z * v[j].z + v[j].w * v[j].w); }
    if (xcopy) {
#pragma unroll
        for (int j = 0; j < 8; ++j) ((f32x4*)xcopy + lane)[64 * j] = v[j]; }
    const float rstd = 1.0f / sqrtf(wave_sum(s) * (1.f / DM) + EPS);
    const f32x4* gr = (const f32x4*)g + lane;
    u32x2* o8 = (u32x2*)orow + lane;
#pragma unroll
    for (int j = 0; j < 8; ++j) { const f32x4 gg = gr[64 * j]; u32x2 w; w.x = cvt_pk_bf16(v[j].x * rstd * gg.x, v[j].y * rstd * gg.y); w.y = cvt_pk_bf16(v[j].z * rstd * gg.z, v[j].w * rstd * gg.w); o8[64 * j] = w; }
}
__device__ __forceinline__ void norm_phase(const Frame& F, const float* g) {
    const int gw = F.bid * NWAVES + F.wave, NGW = F.G * NWAVES; bf16_t* HB = (bf16_t*)WSP(WS_HB);
    for (int m = gw; m < TT; m += NGW) rms_row_to_bf16(F.x + (size_t)m * DM, g, HB + (size_t)m * DM, nullptr, F.lane);
}
__device__ __forceinline__ void final_norm_phase(const Frame& F, const float* g) {
    const float* PSS = (const float*)(WSP(WS_MISC) + MISC_PSS); const bf16_t* XB = (const bf16_t*)WSP(WS_HB);
    const int tid = F.tid, wid = tid >> 6, wr = wid >> 2, wc = wid & 3, fq = (tid >> 4) & 3, fr = tid & 15;
    for (int L = F.bid; L < (TT / 256) * 8; L += F.G) { const int pm = L >> 3, pn = L & 7;
        const u32x4* XL = (const u32x4*)(WSP(WS_X) + (size_t)L * 65536) + tid; const int row0 = pm * 256 + wr * 64 + fr, col0 = pn * 256 + wc * 32 + 8 * fq;
        float rs[2][4]; row_rstd(PSS, row0, rs);
        f32x4 gg[2][2];
#pragma unroll
        for (int bj = 0; bj < 2; ++bj) { gg[bj][0] = *(const f32x4*)(g + col0 + bj * 128); gg[bj][1] = *(const f32x4*)(g + col0 + bj * 128 + 4); }
#pragma unroll
        for (int ai = 0; ai < 2; ++ai)
#pragma unroll
            for (int m = 0; m < 4; ++m) { const size_t ro = (size_t)(row0 + ai * 128 + m * 16) * DM + col0; const u32x4 lo = XL[(ai * 4 + m) * 512];
#pragma unroll
                for (int bj = 0; bj < 2; ++bj) { const u32x4 h = *(const u32x4*)(XB + ro + bj * 128); float* op = F.x + ro + bj * 128;
                    *(f32x4*)op = res_dec4(h.x, h.y, lo[bj * 2]) * rs[ai][m] * gg[bj][0]; *(f32x4*)(op + 4) = res_dec4(h.z, h.w, lo[bj * 2 + 1]) * rs[ai][m] * gg[bj][1]; } }
    }
}

__device__ __forceinline__ void s5_precompute_group(const Frame& F, int e, int g) {
    LAS float* L = (LAS float*)F.lds;
    LAS float* apow = L;
    LAS float* bb = apow + 8448;
    LAS float* cc = bb + 4096;
    LAS float* km = cc + 4096;
    LAS float* dsk = km + 16384;
    const float* lre = F.in[I_LRE], *lim = F.in[I_LIM], *ldt = F.in[I_LDT], *bre = F.in[I_BRE], *bim = F.in[I_BIM], *cre = F.in[I_CRE], *cim = F.in[I_CIM], *dsk_g = F.in[I_S5D];
    const int tid = F.tid;
    for (int idx = tid; idx < 2 * 64 * 33; idx += NTHREADS) { const int k = idx % 33, p = (idx / 33) % 64, dir = idx / (33 * 64);
        const size_t pi = ((size_t)(e * 2 + dir) * S5G + g) * S5P + p; const float lr = fminf(lre[pi], -1e-4f), li = lim[pi], dt = expf(ldt[(e * 2 + dir) * S5G + g]);
        const float mag = expf(lr * dt * (float)k); float sn, cs; sincosf(li * dt * (float)k, &sn, &cs); apow[idx * 2] = mag * cs; apow[idx * 2 + 1] = mag * sn; }
    for (int idx = tid; idx < 2 * 64 * 16; idx += NTHREADS) { const int h = idx % 16, p = (idx / 16) % 64, dir = idx / 1024;
        const size_t pi = ((size_t)(e * 2 + dir) * S5G + g) * S5P + p; const float lr = fminf(lre[pi], -1e-4f), li = lim[pi], dt = expf(ldt[(e * 2 + dir) * S5G + g]);
        const float mag = expf(lr * dt); float sn, cs; sincosf(li * dt, &sn, &cs); const float ar = mag * cs, ai = mag * sn, nr = ar - 1.0f, den = lr * lr + li * li;
        const float fr = (nr * lr + ai * li) / den, fi = (ai * lr - nr * li) / den; const float br = bre[pi * 16 + h], bi = bim[pi * 16 + h];
        bb[idx * 2] = fr * br - fi * bi; bb[idx * 2 + 1] = fr * bi + fi * br; }
    for (int idx = tid; idx < 2 * 16 * 64; idx += NTHREADS) { const int p = idx % 64, h = (idx / 64) % 16, dir = idx / 1024;
        const size_t ci = (((size_t)(e * 2 + dir) * S5G + g) * S5H + h) * S5P + p; cc[idx * 2] = cre[ci]; cc[idx * 2 + 1] = cim[ci]; }
    if (tid < 16) dsk[tid] = dsk_g[e * S5W + g * 16 + tid];
    LDS_WAIT(); __syncthreads();
    for (int idx = tid; idx < 2 * 32 * 256; idx += NTHREADS) { const int hp = idx & 15, h = (idx >> 4) & 15, k = (idx >> 8) & 31, dir = idx >> 13; float s = 0.f;
        for (int p = 0; p < 64; ++p) { const float cr = cc[((dir * 16 + h) * 64 + p) * 2], ci = cc[((dir * 16 + h) * 64 + p) * 2 + 1], ar = apow[((dir * 64 + p) * 33 + k) * 2], ai = apow[((dir * 64 + p) * 33 + k) * 2 + 1];
            const float br = bb[((dir * 64 + p) * 16 + hp) * 2], bi = bb[((dir * 64 + p) * 16 + hp) * 2 + 1]; const float wr = cr * ar - ci * ai, wi = cr * ai + ci * ar; s += wr * br - wi * bi; }
        km[idx] = s; }
    LDS_WAIT(); __syncthreads();
    bf16_t* WST = (bf16_t*)WSP(WS_WST) + (size_t)(e * 64 + g) * (S5NS * S5K1);
    bf16_t* TG = (bf16_t*)WSP(WS_TG) + (size_t)(e * 64 + g) * (S5K1 * S5K2);
    for (int idx = tid; idx < S5NS * S5K1 / 2; idx += NTHREADS) { const int k2 = (idx % (S5K1 / 2)) * 2, n = idx / (S5K1 / 2); const int dir = n >> 7, p = (n >> 1) & 63, ri = n & 1; const int j = k2 >> 4, hp = k2 & 15;
        const int ex = dir == 0 ? (LC - 1 - j) : j; const float ar = apow[((dir * 64 + p) * 33 + ex) * 2], ai = apow[((dir * 64 + p) * 33 + ex) * 2 + 1];
        float v[2];
#pragma unroll
        for (int q = 0; q < 2; ++q) { const float br = bb[((dir * 64 + p) * 16 + hp + q) * 2], bi = bb[((dir * 64 + p) * 16 + hp + q) * 2 + 1]; v[q] = ri == 0 ? (ar * br - ai * bi) : (ar * bi + ai * br); }
        *(unsigned*)(WST + (size_t)n * S5K1 + k2) = cvt_pk_bf16(v[0], v[1]); }
    for (int idx = tid; idx < S5K1 * S5K2 / 2; idx += NTHREADS) { const int k2 = (idx % (S5K2 / 2)) * 2, n = idx / (S5K2 / 2); const int i = n >> 4, h = n & 15; float v[2];
        if (k2 < S5K1) { const int j = k2 >> 4, hp = k2 & 15;
#pragma unroll
            for (int q = 0; q < 2; ++q) { float s = 0.f; if (j <= i) s += km[((0 * 32 + (i - j)) * 16 + h) * 16 + hp + q]; if (j >= i) s += km[((1 * 32 + (j - i)) * 16 + h) * 16 + hp + q]; if (i == j && h == hp + q) s += dsk[h]; v[q] = s; }
        } else { const int nn = k2 - S5K1, dir = nn >> 7, p = (nn >> 1) & 63; const int ex = dir == 0 ? (i + 1) : (LC - i);
            const float ar = apow[((dir * 64 + p) * 33 + ex) * 2], ai = apow[((dir * 64 + p) * 33 + ex) * 2 + 1], cr = cc[((dir * 16 + h) * 64 + p) * 2], ci = cc[((dir * 16 + h) * 64 + p) * 2 + 1];
            v[0] = cr * ar - ci * ai; v[1] = -(cr * ai + ci * ar); }
        *(unsigned*)(TG + (size_t)n * S5K2 + k2) = cvt_pk_bf16(v[0], v[1]); }
    f32x2* AL = (f32x2*)(WSP(WS_MISC) + MISC_AL);
    if (tid < 128) { const int dir = tid >> 6, p = tid & 63; AL[((e * 2 + dir) * 64 + g) * 64 + p] = (f32x2){apow[((dir * 64 + p) * 33 + LC) * 2], apow[((dir * 64 + p) * 33 + LC) * 2 + 1]}; }
    __syncthreads();
}

__device__ __forceinline__ void s5_scan_phase(const Frame& F, int e) {
    const float* SST = (const float*)POOLP(PL_SST); bf16_t* UX = (bf16_t*)POOLP(PL_UX);
    LAS f32x2* tot = (LAS f32x2*)F.lds;
    const int p = F.lane, w = F.wave;
    for (int item = F.bid; item < 2 * 2 * 64; item += F.G) {
        const int g = item & 63, dir = (item >> 6) & 1, seq = item >> 7;
        const f32x2 aL = ((const f32x2*)(WSP(WS_MISC) + MISC_AL))[((e * 2 + dir) * 64 + g) * 64 + p];
        const int c0 = seq ? NCH_P : 0, cs = seq ? 32 : 16;
        const int step = dir == 0 ? 1 : -1;
        const float* sbase = SST + (size_t)g * 256 + dir * 128 + 2 * p;
        bf16_t* xbase = UX + (size_t)g * NCH * S5K2 + S5K1 + dir * 128 + 2 * p;
#pragma unroll 1
        for (int q = 0; q < 2; ++q) { const int s = 2 * w + q; int c = c0 + s * cs + (dir == 0 ? 0 : cs - 1); float xr = 0.f, xi = 0.f;
#pragma unroll 1
            for (int it = 0; it < cs; it += 8) { f32x2 sv[8];
#pragma unroll
                for (int k = 0; k < 8; ++k) sv[k] = *(const f32x2*)(sbase + (size_t)(c + k * step) * (64 * 256));
#pragma unroll
                for (int k = 0; k < 8; ++k) { const float nr = aL.x * xr - aL.y * xi + sv[k].x, ni = aL.x * xi + aL.y * xr + sv[k].y; xr = nr; xi = ni; }
                c += 8 * step; }
            tot[s * 64 + p] = (f32x2){xr, xi}; }
        LDS_WAIT(); __syncthreads();
        float pr = aL.x, pi = aL.y;
        for (int k = cs; k > 1; k >>= 1) { const float nr = pr * pr - pi * pi, ni = 2.f * pr * pi; pr = nr; pi = ni; }
#pragma unroll 1
        for (int q = 0; q < 2; ++q) { const int s = 2 * w + q; float xr = 0.f, xi = 0.f;
            if (dir == 0) { for (int j = 0; j < s; ++j) { const f32x2 t = tot[j * 64 + p]; const float nr = pr * xr - pi * xi + t.x, ni = pr * xi + pi * xr + t.y; xr = nr; xi = ni; } }
            else { for (int j = 15; j > s; --j) { const f32x2 t = tot[j * 64 + p]; const float nr = pr * xr - pi * xi + t.x, ni = pr * xi + pi * xr + t.y; xr = nr; xi = ni; } }
            int c = c0 + s * cs + (dir == 0 ? 0 : cs - 1);
#pragma unroll 1
            for (int it = 0; it < cs; it += 8) { f32x2 sv[8];
#pragma unroll
                for (int k = 0; k < 8; ++k) sv[k] = *(const f32x2*)(sbase + (size_t)(c + k * step) * (64 * 256));
#pragma unroll
                for (int k = 0; k < 8; ++k) { *(unsigned*)(xbase + (size_t)(c + k * step) * S5K2) = cvt_pk_bf16(xr, xi);
                    const float nr = aL.x * xr - aL.y * xi + sv[k].x, ni = aL.x * xi + aL.y * xr + sv[k].y; xr = nr; xi = ni; }
                c += 8 * step; } }
        __syncthreads();
    }
}

__device__ __forceinline__ void qk_prep_phase(const Frame& F, int o) {
    bf16_t* Z = (bf16_t*)POOLP(PL_Z); bf16_t* KC = (bf16_t*)POOLP(PL_KC); const float* rope = (const float*)(WSP(WS_MISC) + MISC_ROPE);
    const float* qg = F.in[I_QN] + o * 128, *kg = F.in[I_KN] + o * 128;
    const int sub = F.lane >> 4, j = F.lane & 15;
    const long nrows = (long)TT * 20, gq = ((long)F.bid * NWAVES + F.wave) * 4 + sub, nq = (long)F.G * NWAVES * 4;
    for (long r = gq; r < nrows; r += nq) {
        const int t = (int)(r / 20), hh = (int)(r % 20);
        bf16_t* p = Z + (size_t)t * ZLD + (hh < 16 ? hh * 128 : 2048 + (hh - 16) * 128) + j * 8;
        const u32x4 w = *(const u32x4*)p; float v[8] = {bflo(w.x), bfhi(w.x), bflo(w.y), bfhi(w.y), bflo(w.z), bfhi(w.z), bflo(w.w), bfhi(w.w)};
        float s = 0.f;
#pragma unroll
        for (int q = 0; q < 8; ++q) s += v[q] * v[q];
        s += __shfl_xor(s, 1); s += __shfl_xor(s, 2); s += __shfl_xor(s, 4); s += __shfl_xor(s, 8);
        const float rstd = 1.0f / sqrtf(s * (1.f / 128.f) + EPS); const float* gg = (hh < 16 ? qg : kg) + j * 8;
        const int tl = t < T_P ? t : t - T_P; const int pos = (j < 8) ? (tl >> 6) : (tl & 63);
        const float* rp = rope + ((size_t)pos * 32 + 8 * (j & 3)) * 2;
        float ov[8];
#pragma unroll
        for (int q = 0; q < 8; ++q) { const float x = v[q] * rstd * gg[q]; const float y = __shfl_xor(x, 4); const float cs = rp[2 * q], sn = rp[2 * q + 1];
            ov[q] = (j & 4) ? (x * cs + y * sn) : (x * cs - y * sn); }
        u32x4 ow; ow.x = cvt_pk_bf16(ov[0], ov[1]); ow.y = cvt_pk_bf16(ov[2], ov[3]); ow.z = cvt_pk_bf16(ov[4], ov[5]); ow.w = cvt_pk_bf16(ov[6], ov[7]);
        *(u32x4*)p = ow;
    }
}

__device__ __forceinline__ void cross_softmax_phase(const Frame& F) {
    const float* CS = (const float*)POOLP(PL_CS); bf16_t* CP = (bf16_t*)POOLP(PL_CP);
    const long nrows = (long)TT * 4, gw = (long)F.bid * NWAVES + F.wave, NGW = (long)F.G * NWAVES;
    constexpr float C = 0.04419417382415922f * 1.4426950408889634f;
    for (long r = gw; r < nrows; r += NGW) {
        const f32x4 v = *((const f32x4*)(CS + r * 256) + F.lane);
        float m = fmaxf(fmaxf(v.x, v.y), fmaxf(v.z, v.w));
#pragma unroll
        for (int o = 1; o < 64; o <<= 1) m = fmaxf(m, __shfl_xor(m, o));
        const float e0 = fast_exp2((v.x - m) * C), e1 = fast_exp2((v.y - m) * C), e2 = fast_exp2((v.z - m) * C), e3 = fast_exp2((v.w - m) * C);
        const float inv = fast_rcp(wave_sum((e0 + e1) + (e2 + e3)));
        u32x2 w; w.x = cvt_pk_bf16(e0 * inv, e1 * inv); w.y = cvt_pk_bf16(e2 * inv, e3 * inv);
        *((u32x2*)(CP + r * 256) + F.lane) = w;
    }
}

__device__ __forceinline__ void prologue_phase(const Frame& F) {
    LAS float* scr = (LAS float*)(F.lds + F.wave * 16384);
    const int gw = F.bid * NWAVES + F.wave, NGW = F.G * NWAVES;
    constexpr int IT_GU = (DM / 64) * (2 * DFF / 32), IT_D = (DFF / 64) * (DM / 32), IT_WINE = (DM / 64) * (EVEN_IN / 32), IT_SQ = (DM / 64) * (DM / 32), IT_GLU = (S5W / 64) * (S5W / 32),
                  IT_WINO = (DM / 64) * (ODD_IN / 32), IT_KV = (DM / 64) * (2 * DM / 32);
    constexpr int N_GU = 8 * IT_GU, N_D = 8 * IT_D, N_WINE = 2 * IT_WINE, N_WOUTE = 2 * IT_SQ, N_GLU = 2 * IT_GLU, N_WINO = 2 * IT_WINO, N_WOUTO = 2 * IT_SQ, N_KV = 4 * IT_KV, N_WO = 4 * IT_SQ;
    constexpr int NITEMS = N_GU + N_D + N_WINE + N_WOUTE + N_GLU + N_WINO + N_WOUTO + N_KV + N_WO;
    for (int it = gw; it < NITEMS; it += NGW) {
        int r = it;
        if (r < N_GU) { const int w = r / IT_GU, l = w >> 1, f = w & 1; transpose_item<1>(F.in[f ? I_F2GU : I_F1GU] + (size_t)l * DM * 2 * DFF, DM, 2 * DFF, (bf16_t*)WSP(WS_WGU + w * SZ_WGU), scr, r % IT_GU, F.lane, F.in[f ? I_F2N : I_F1N] + l * DM); continue; } r -= N_GU;
        if (r < N_D) { const int w = r / IT_D, l = w >> 1, f = w & 1; transpose_item<0>(F.in[f ? I_F2D : I_F1D] + (size_t)l * DFF * DM, DFF, DM, (bf16_t*)WSP(WS_WD + w * SZ_WD), scr, r % IT_D, F.lane); continue; } r -= N_D;
        if (r < N_WINE) { const int e = r / IT_WINE; transpose_item<0>(F.in[I_EWIN] + (size_t)e * DM * EVEN_IN, DM, EVEN_IN, (bf16_t*)WSP(WS_WINE + e * SZ_WINE), scr, r % IT_WINE, F.lane, F.in[I_MIXN] + (2 * e) * DM); continue; } r -= N_WINE;
        if (r < N_WOUTE) { const int e = r / IT_SQ; transpose_item<0>(F.in[I_EWOUT] + (size_t)e * DM * DM, DM, DM, (bf16_t*)WSP(WS_WOUTE + e * SZ_SQ), scr, r % IT_SQ, F.lane); continue; } r -= N_WOUTE;
        if (r < N_GLU) { const int e = r / IT_GLU; transpose_item<0>(F.in[I_GLUW] + (size_t)e * S5W * S5W, S5W, S5W, (bf16_t*)WSP(WS_GLU + e * SZ_GLU), scr, r % IT_GLU, F.lane); continue; } r -= N_GLU;
        if (r < N_WINO) { const int o = r / IT_WINO; transpose_item<0>(F.in[I_OWIN] + (size_t)o * DM * ODD_IN, DM, ODD_IN, (bf16_t*)WSP(WS_WINO + o * SZ_WINO), scr, r % IT_WINO, F.lane, F.in[I_MIXN] + (2 * o + 1) * DM); continue; } r -= N_WINO;
        if (r < N_WOUTO) { const int o = r / IT_SQ; transpose_item<0>(F.in[I_OWOUT] + (size_t)o * DM * DM, DM, DM, (bf16_t*)WSP(WS_WOUTO + o * SZ_SQ), scr, r % IT_SQ, F.lane); continue; } r -= N_WOUTO;
        if (r < N_KV) { const int l = r / IT_KV; transpose_item<0>(F.in[I_CWKV] + (size_t)l * DM * 2 * DM, DM, 2 * DM, (bf16_t*)POOLP(PL_WKVT) + (size_t)l * 2 * DM * DM, scr, r % IT_KV, F.lane); continue; } r -= N_KV;
        { const int l = r / IT_SQ; transpose_item<0>(F.in[I_CWO] + (size_t)l * DM * DM, DM, DM, (bf16_t*)POOLP(PL_WOT) + (size_t)l * DM * DM, scr, r % IT_SQ, F.lane); }
    }
    convert_rows(F.in[I_CWQ], (bf16_t*)POOLP(PL_WQB), (size_t)4 * DM * DM / 8, (size_t)F.bid * NTHREADS + F.tid, (size_t)F.G * NTHREADS);
    for (int m = gw; m < 4 * 2 * NMEM; m += NGW) { const int l = m / (2 * NMEM), s = (m / NMEM) & 1, j = m % NMEM;
        rms_row_to_bf16(F.in[s ? I_MS : I_MP] + (size_t)j * DM, F.in[I_MN] + l * DM, (bf16_t*)POOLP(PL_MEMN) + (size_t)m * DM, nullptr, F.lane); }
    for (int m = gw; m < TT; m += NGW) { const float* src = m < T_P ? F.in[I_XP] + (size_t)m * DM : F.in[I_XS] + (size_t)(m - T_P) * DM;
        const f32x4* xr = (const f32x4*)src + F.lane; u32x2* bo = (u32x2*)((bf16_t*)WSP(WS_HB) + (size_t)m * DM) + F.lane; float s = 0.f;
        const int rr = m & 255, ai = rr >> 7, wr = (rr >> 6) & 1, mm = (rr >> 4) & 3, fr = rr & 15, cc = 4 * F.lane, bj = cc >> 7, wc = (cc >> 5) & 3, fq = (cc >> 3) & 3, n = (cc >> 2) & 1;
        unsigned* xl = (unsigned*)(WSP(WS_X) + (size_t)(m >> 8) * 8 * 65536) + ((size_t)((ai * 4 + mm) * 512 + (wr * 4 + wc) * 64 + fq * 16 + fr)) * 4 + bj * 2 + n;
#pragma unroll
        for (int j = 0; j < 8; ++j) { const f32x4 v = xr[64 * j]; unsigned a0, a1, lo; res_enc4(v, a0, a1, lo); bo[64 * j] = (u32x2){a0, a1}; xl[(size_t)j * 16384] = lo; s += (v.x * v.x + v.y * v.y) + (v.z * v.z + v.w * v.w); }
        s = wave_sum(s);
        if (F.lane < 8) ((float*)(WSP(WS_MISC) + MISC_PSS))[(size_t)m * 8 + F.lane] = F.lane == 0 ? s : 0.f; }
    { float* rope = (float*)(WSP(WS_MISC) + MISC_ROPE); const int gt = F.bid * NTHREADS + F.tid;
      if (gt < 256 * 32) { const int pos = gt >> 5, i = gt & 31; const float inv = powf(10000.0f, -(float)(2 * i) / 64.0f); float sn, cs; sincosf((float)pos * inv, &sn, &cs); rope[gt * 2] = cs; rope[gt * 2 + 1] = sn; }
      if (gt < 2) { float s1 = 0.f, s2 = 0.f; for (int q = 0; q < 64; ++q) { s1 += F.in[I_LQ1][gt * 64 + q] * F.in[I_LK1][gt * 64 + q]; s2 += F.in[I_LQ2][gt * 64 + q] * F.in[I_LK2][gt * 64 + q]; }
          const float linit = 0.8f - 0.6f * expf(-0.3f * (float)(2 * gt)); ((float*)(WSP(WS_MISC) + MISC_LAM))[gt * 2] = expf(s1) - expf(s2) + linit; ((float*)(WSP(WS_MISC) + MISC_LAM))[gt * 2 + 1] = linit; } }
}
__device__ __forceinline__ void s5_precompute_phase(const Frame& F) {
    for (int w = F.G - 1 - F.bid; w < 2 * S5G; w += F.G) s5_precompute_group(F, w / S5G, w % S5G);
}

#ifndef GQA_SDEPTH
#define GQA_SDEPTH 1
#endif
#ifndef DIFF_SDEPTH
#define DIFF_SDEPTH 1
#endif
#ifndef ATT_SETPRIO
#define ATT_SETPRIO 0
#endif
#if ATT_SETPRIO
#define ATT_PRIO(x) __builtin_amdgcn_s_setprio(x)
#else
#define ATT_PRIO(x) do {} while (0)
#endif
#ifndef FIXREF_LIMIT_GQA
#define FIXREF_LIMIT_GQA 40.0f
#define FIXREF_LIMIT_DIFF 20.0f
#endif
namespace att {
constexpr int NW = 8, QBLK = 32, KVBLK = 64, DV = 128;
constexpr float THR = 8.f;
__device__ __forceinline__ int crow(int r, int hi) { return (r & 3) + 8 * (r >> 2) + 4 * hi; }
template <int DQK> __device__ __forceinline__ int kswz(int row, int colB) { if (DQK == 128) return row * 256 + (colB ^ ((row & 7) << 4)); else return row * 128 + (colB ^ (((row >> 1) & 7) << 4)); }
__device__ __forceinline__ int v_st(int k, int c) { const int kk = (k & ~0xC) | ((k & 4) << 1) | ((k & 8) >> 1); return ((kk >> 3) * 4 + (c >> 5)) * 512 + ((kk & 7) * 32 + (c & 31)) * 2; }
__device__ __forceinline__ int v_rd_base(int lane) { return ((lane & 3) << 3) | (((lane >> 2) & 3) << 6) | (((lane >> 4) & 1) << 5) | (((lane >> 5) & 1) << 8); }
constexpr int v_rd_off(int d0, int ks, int half) { return d0 * 512 + ks * 4096 + half * 2048; }
template <int OFF> __device__ __forceinline__ s16x4 tr_read(int vb) { s16x4 r; asm volatile("ds_read_b64_tr_b16 %0, %1 offset:%2" : "=&v"(r) : "v"(vb), "i"(OFF) : "memory"); return r; }
template <int D0> __device__ __forceinline__ void pv_one(f32x16& od, int vb, bf16x8 pa0, bf16x8 pa1, bf16x8 pa2, bf16x8 pa3) {
  const s16x4 l0 = tr_read<v_rd_off(D0, 0, 0)>(vb), h0 = tr_read<v_rd_off(D0, 0, 1)>(vb), l1 = tr_read<v_rd_off(D0, 1, 0)>(vb), h1 = tr_read<v_rd_off(D0, 1, 1)>(vb);
  const s16x4 l2 = tr_read<v_rd_off(D0, 2, 0)>(vb), h2 = tr_read<v_rd_off(D0, 2, 1)>(vb), l3 = tr_read<v_rd_off(D0, 3, 0)>(vb), h3 = tr_read<v_rd_off(D0, 3, 1)>(vb);
  asm volatile("s_waitcnt lgkmcnt(0)" ::: "memory"); SBAR();
#define PK(L, H) (bf16x8){L[0], L[1], L[2], L[3], H[0], H[1], H[2], H[3]}
  ATT_PRIO(1);
  od = __builtin_amdgcn_mfma_f32_32x32x16_bf16(pa0, PK(l0, h0), od, 0, 0, 0);
  od = __builtin_amdgcn_mfma_f32_32x32x16_bf16(pa1, PK(l1, h1), od, 0, 0, 0);
  od = __builtin_amdgcn_mfma_f32_32x32x16_bf16(pa2, PK(l2, h2), od, 0, 0, 0);
  od = __builtin_amdgcn_mfma_f32_32x32x16_bf16(pa3, PK(l3, h3), od, 0, 0, 0);
  ATT_PRIO(0);
#undef PK
}
__device__ __forceinline__ void pv_d0(f32x16* o, int vb, bf16x8 pa0, bf16x8 pa1, bf16x8 pa2, bf16x8 pa3) {
  pv_one<0>(o[0], vb, pa0, pa1, pa2, pa3); pv_one<1>(o[1], vb, pa0, pa1, pa2, pa3); pv_one<2>(o[2], vb, pa0, pa1, pa2, pa3); pv_one<3>(o[3], vb, pa0, pa1, pa2, pa3);
}
template <int DQK> struct Cst { static constexpr float SCALE = DQK == 128 ? 0.088388347648318440f : 0.125f; static constexpr float C = SCALE * 1.4426950408889634f; };

template <int DQK, bool FIXED>
__device__ __forceinline__ void partialSM(f32x16& p0, f32x16& p1, float& m_reg, float& mn, float& alpha, const float mfix) {
  constexpr float C = Cst<DQK>::C, SCALE = Cst<DQK>::SCALE;
  if (FIXED) { mn = mfix; alpha = 1.f; const float mnC0 = -mfix * C;
#pragma unroll
    for (int r = 0; r < 16; ++r) p0[r] = fmaf(p0[r], C, mnC0);
#pragma unroll
    for (int r = 0; r < 16; ++r) p1[r] = fmaf(p1[r], C, mnC0);
#pragma unroll
    for (int r = 0; r < 16; ++r) p0[r] = __builtin_amdgcn_exp2f(p0[r]);
    return; }
  float pmax = p0[0];
#pragma unroll
  for (int r = 1; r < 16; ++r) pmax = fmaxf(pmax, p0[r]);
#pragma unroll
  for (int r = 0; r < 16; ++r) pmax = fmaxf(pmax, p1[r]);
  { auto rr = __builtin_amdgcn_permlane32_swap(__float_as_uint(pmax), __float_as_uint(pmax), false, false);
    pmax = fmaxf(__uint_as_float(rr[0]), __uint_as_float(rr[1])); }
  if (__builtin_expect(__all(pmax - m_reg <= THR / SCALE), 1)) { mn = m_reg; alpha = 1.f; }
  else { mn = fmaxf(m_reg, pmax); alpha = __builtin_amdgcn_exp2f((m_reg - mn) * C); m_reg = mn; }
  const float mnC = -mn * C;
#pragma unroll
  for (int r = 0; r < 16; ++r) p0[r] = fmaf(p0[r], C, mnC);
#pragma unroll
  for (int r = 0; r < 16; ++r) p1[r] = fmaf(p1[r], C, mnC);
#pragma unroll
  for (int r = 0; r < 16; ++r) p0[r] = __builtin_amdgcn_exp2f(p0[r]);
}
__device__ __forceinline__ void finishSM(f32x16& p0, f32x16& p1, float alpha, float& l_reg, bf16x8& pa0, bf16x8& pa1, bf16x8& pa2, bf16x8& pa3) {
#pragma unroll
  for (int r = 0; r < 16; ++r) p1[r] = __builtin_amdgcn_exp2f(p1[r]);
  float ps = 0;
#pragma unroll
  for (int r = 0; r < 16; ++r) ps += p0[r];
#pragma unroll
  for (int r = 0; r < 16; ++r) ps += p1[r];
  { auto rr = __builtin_amdgcn_permlane32_swap(__float_as_uint(ps), __float_as_uint(ps), false, false);
    ps = __uint_as_float(rr[0]) + __uint_as_float(rr[1]); }
  l_reg = l_reg * alpha + ps;
#define PK4(P, BASE, OUT) do { unsigned a0 = cvt_pk_bf16(P[BASE + 0], P[BASE + 1]), a1 = cvt_pk_bf16(P[BASE + 2], P[BASE + 3]);   \
    unsigned b0 = cvt_pk_bf16(P[BASE + 4], P[BASE + 5]), b1 = cvt_pk_bf16(P[BASE + 6], P[BASE + 7]);                              \
    auto r0 = __builtin_amdgcn_permlane32_swap(a0, b0, false, false); auto r1 = __builtin_amdgcn_permlane32_swap(a1, b1, false, false); \
    u32x4 w = {r0[0], r1[0], r0[1], r1[1]}; OUT = *reinterpret_cast<bf16x8*>(&w); } while (0)
  PK4(p0, 0, pa0); PK4(p0, 8, pa1); PK4(p1, 0, pa2); PK4(p1, 8, pa3);
#undef PK4
}
template <int DQK, bool ALIBI>
__device__ __forceinline__ void qkt(f32x16& p0, f32x16& p1, const char* Ks, const bf16x8* qr, int r32, int hi, float dq, float sl) {
  if (ALIBI) {
    float dh = dq - (float)(4 * hi); asm volatile("" : "+v"(dh));
#pragma unroll
    for (int r = 0; r < 16; ++r) { const float c = (float)((r & 3) + 8 * (r >> 2)); p0[r] = -sl * fabsf(dh - c); p1[r] = -sl * fabsf(dh - (c + 32.f)); }
  } else { p0 = f32x16{}; p1 = f32x16{}; }
  ATT_PRIO(1);
#pragma unroll
  for (int d0 = 0; d0 < DQK / 16; ++d0) { const int cb = (d0 * 16 + hi * 8) * 2;
    const bf16x8 b0 = *reinterpret_cast<const bf16x8*>(Ks + kswz<DQK>(r32, cb));
    const bf16x8 b1 = *reinterpret_cast<const bf16x8*>(Ks + kswz<DQK>(32 + r32, cb));
    p0 = __builtin_amdgcn_mfma_f32_32x32x16_bf16(b0, qr[d0], p0, 0, 0, 0);
    p1 = __builtin_amdgcn_mfma_f32_32x32x16_bf16(b1, qr[d0], p1, 0, 0, 0); }
  ATT_PRIO(0);
}

template <int DQK, bool ALIBI, int SDEPTH, int LDKV, bool FIXED>
__device__ __forceinline__ void attn_pass(const bf16_t* __restrict__ Qw, const bf16_t* __restrict__ Kh, const bf16_t* __restrict__ Vh, int seq, char* lds, f32x16 (&o)[4], float qpos, float sl, int tid, const float mfix) {
  constexpr int SHM_V = KVBLK * DV * 2, SHM_K = KVBLK * DQK * 2;
  const int wid = tid >> 6, lane = tid & 63, r32 = lane & 31, hi = lane >> 5;
  char* V_lds = lds; char* K_lds = lds + 2 * SHM_V;
  float* ws = (float*)(lds + 2 * SHM_V + 2 * SHM_K) + wid * 64; float* li_l = ws; float* al_l = ws + 32;
  float m_reg = -1e30f, l_reg = 0; bf16x8 qr[DQK / 16];
#pragma unroll
  for (int d0 = 0; d0 < 4; ++d0) o[d0] = f32x16{};
#pragma unroll
  for (int d0 = 0; d0 < DQK / 16; ++d0) qr[d0] = *reinterpret_cast<const bf16x8*>(Qw + d0 * 16);
  const int sr = tid >> 4, sc = (tid & 15) * 8, vst0 = v_st(sr, sc), vst1 = v_st(32 + sr, sc);
  const int kr = DQK == 128 ? sr : (tid >> 3), kc = DQK == 128 ? sc : (tid & 7) * 8;
  const int vb0 = (int)(uintptr_t)V_lds + v_rd_base(lane);
  struct { bf16x8 vs0, vs1, ks0, ks1; } sr_[SDEPTH];
#define SLOAD(i, k0) do { sr_[i].vs0 = *(const bf16x8*)(Vh + (size_t)((k0) + sr) * LDKV + sc); sr_[i].vs1 = *(const bf16x8*)(Vh + (size_t)((k0) + 32 + sr) * LDKV + sc); \
    sr_[i].ks0 = *(const bf16x8*)(Kh + (size_t)((k0) + kr) * LDKV + kc); if (DQK == 128) sr_[i].ks1 = *(const bf16x8*)(Kh + (size_t)((k0) + 32 + kr) * LDKV + kc); } while (0)
#define SWRITE(b, i) do { *(bf16x8*)(V_lds + (b) * SHM_V + vst0) = sr_[i].vs0; *(bf16x8*)(V_lds + (b) * SHM_V + vst1) = sr_[i].vs1; \
    *(bf16x8*)(K_lds + (b) * SHM_K + kswz<DQK>(kr, kc * 2)) = sr_[i].ks0; if (DQK == 128) *(bf16x8*)(K_lds + (b) * SHM_K + kswz<DQK>(32 + kr, kc * 2)) = sr_[i].ks1; } while (0)
#define SWAIT() do { if (SDEPTH == 1) asm volatile("s_waitcnt vmcnt(0)" ::: "memory"); else if (DQK == 128) asm volatile("s_waitcnt vmcnt(4)" ::: "memory"); else asm volatile("s_waitcnt vmcnt(3)" ::: "memory"); } while (0)
#define RESC(a) do { if (!FIXED && __any((a) < 1.f)) { if (hi == 0) al_l[r32] = (a); asm volatile("s_waitcnt lgkmcnt(0)" ::: "memory"); \
    _Pragma("unroll") for (int d = 0; d < 4; ++d) _Pragma("unroll") for (int r = 0; r < 16; ++r) o[d][r] *= al_l[crow(r, hi)]; } } while (0)
  f32x16 pA0, pA1, pB0, pB1; float mnA, mnB, alA, alB; bf16x8 pa0, pa1, pa2, pa3; const int NT = seq / KVBLK;
  constexpr int SE = 0, SO = SDEPTH - 1;
  SLOAD(SE, 0); asm volatile("s_waitcnt vmcnt(0)" ::: "memory"); SWRITE(0, SE); __syncthreads();
  qkt<DQK, ALIBI>(pA0, pA1, K_lds, qr, r32, hi, qpos, sl); partialSM<DQK, FIXED>(pA0, pA1, m_reg, mnA, alA, mfix);
  SLOAD(SO, KVBLK); if (SDEPTH == 2) { if (2 < NT) SLOAD(SE, 2 * KVBLK); }
  SWAIT(); SWRITE(1, SO); __syncthreads();
  _Pragma("unroll 1") for (int j = 1; j + 1 < NT; j += 2) {
    SBAR(); qkt<DQK, ALIBI>(pB0, pB1, K_lds + SHM_K, qr, r32, hi, qpos - (float)(j * KVBLK), sl);
    finishSM(pA0, pA1, alA, l_reg, pa0, pa1, pa2, pa3); SBAR();
    SLOAD(SO, (j + SDEPTH) * KVBLK); SBAR();
    pv_d0(o, vb0, pa0, pa1, pa2, pa3); partialSM<DQK, FIXED>(pB0, pB1, m_reg, mnB, alB, mfix);
    __syncthreads(); SWAIT(); SWRITE(0, SE);
    RESC(alB); __syncthreads();
    SBAR(); qkt<DQK, ALIBI>(pA0, pA1, K_lds, qr, r32, hi, qpos - (float)((j + 1) * KVBLK), sl);
    finishSM(pB0, pB1, alB, l_reg, pa0, pa1, pa2, pa3); SBAR();
    if (SDEPTH == 1 || j + 3 < NT) SLOAD(SE, (j + 1 + SDEPTH) * KVBLK); SBAR();
    pv_d0(o, vb0 + SHM_V, pa0, pa1, pa2, pa3); partialSM<DQK, FIXED>(pA0, pA1, m_reg, mnA, alA, mfix);
    __syncthreads(); SWAIT(); SWRITE(1, SO);
    RESC(alA); __syncthreads();
  }
  SBAR(); qkt<DQK, ALIBI>(pB0, pB1, K_lds + SHM_K, qr, r32, hi, qpos - (float)((NT - 1) * KVBLK), sl);
  finishSM(pA0, pA1, alA, l_reg, pa0, pa1, pa2, pa3); SBAR();
  pv_d0(o, vb0, pa0, pa1, pa2, pa3); partialSM<DQK, FIXED>(pB0, pB1, m_reg, mnB, alB, mfix);
  __syncthreads(); RESC(alB);
  finishSM(pB0, pB1, alB, l_reg, pa0, pa1, pa2, pa3); SBAR();
  pv_d0(o, vb0 + SHM_V, pa0, pa1, pa2, pa3);
  if (hi == 0) li_l[r32] = l_reg; asm volatile("s_waitcnt lgkmcnt(0)" ::: "memory");
#pragma unroll
  for (int r = 0; r < 16; ++r) { const float rl = __builtin_amdgcn_rcpf(li_l[crow(r, hi)]);
#pragma unroll
    for (int d0 = 0; d0 < 4; ++d0) o[d0][r] *= rl; }
#undef SLOAD
#undef SWRITE
#undef SWAIT
#undef RESC
}
template <int DQK, bool ALIBI, int LDKV, bool FIXED>
__device__ __forceinline__ void attn_pass3(const bf16_t* __restrict__ Qw, const bf16_t* __restrict__ Kh, const bf16_t* __restrict__ Vh, int seq, char* lds, f32x16 (&o)[4], float qpos, float sl, int tid, const float mfix) {
  constexpr int SHM_V = KVBLK * DV * 2, SHM_K = KVBLK * DQK * 2;
  const int wid = tid >> 6, lane = tid & 63, r32 = lane & 31, hi = lane >> 5;
  char* V_lds = lds; char* K_lds = lds + 3 * SHM_V;
  float* ws = (float*)(lds + 3 * SHM_V + 3 * SHM_K) + wid * 64; float* li_l = ws; float* al_l = ws + 32;
  float m_reg = -1e30f, l_reg = 0; bf16x8 qr[DQK / 16];
#pragma unroll
  for (int d0 = 0; d0 < 4; ++d0) o[d0] = f32x16{};
#pragma unroll
  for (int d0 = 0; d0 < DQK / 16; ++d0) qr[d0] = *reinterpret_cast<const bf16x8*>(Qw + d0 * 16);
  const int sr = tid >> 4, sc = (tid & 15) * 8, vst0 = v_st(sr, sc), vst1 = v_st(32 + sr, sc);
  const int kr = DQK == 128 ? sr : (tid >> 3), kc = DQK == 128 ? sc : (tid & 7) * 8;
  const int vb0 = (int)(uintptr_t)V_lds + v_rd_base(lane);
  bf16x8 vs0, vs1, ks0, ks1;
#define SLOAD(k0) do { vs0 = *(const bf16x8*)(Vh + (size_t)((k0) + sr) * LDKV + sc); vs1 = *(const bf16x8*)(Vh + (size_t)((k0) + 32 + sr) * LDKV + sc); \
    ks0 = *(const bf16x8*)(Kh + (size_t)((k0) + kr) * LDKV + kc); if (DQK == 128) ks1 = *(const bf16x8*)(Kh + (size_t)((k0) + 32 + kr) * LDKV + kc); } while (0)
#define SWRITE(b) do { *(bf16x8*)(V_lds + (b) * SHM_V + vst0) = vs0; *(bf16x8*)(V_lds + (b) * SHM_V + vst1) = vs1; \
    *(bf16x8*)(K_lds + (b) * SHM_K + kswz<DQK>(kr, kc * 2)) = ks0; if (DQK == 128) *(bf16x8*)(K_lds + (b) * SHM_K + kswz<DQK>(32 + kr, kc * 2)) = ks1; } while (0)
#define RESC(a) do { if (!FIXED && __any((a) < 1.f)) { if (hi == 0) al_l[r32] = (a); asm volatile("s_waitcnt lgkmcnt(0)" ::: "memory"); \
    _Pragma("unroll") for (int d = 0; d < 4; ++d) _Pragma("unroll") for (int r = 0; r < 16; ++r) o[d][r] *= al_l[crow(r, hi)]; } } while (0)
  f32x16 pA0, pA1, pB0, pB1; float mnA, mnB, alA, alB; bf16x8 pa0, pa1, pa2, pa3; const int NT = seq / KVBLK;
  __syncthreads();
  SLOAD(0); asm volatile("s_waitcnt vmcnt(0)" ::: "memory"); SWRITE(0);
  SLOAD(KVBLK); asm volatile("s_waitcnt vmcnt(0)" ::: "memory"); SWRITE(1);
  if (2 < NT) SLOAD(2 * KVBLK);
  __syncthreads();
  qkt<DQK, ALIBI>(pA0, pA1, K_lds, qr, r32, hi, qpos, sl); partialSM<DQK, FIXED>(pA0, pA1, m_reg, mnA, alA, mfix);
  int s0 = 0, s1 = 1, s2 = 2;
#define ITER(PC0, PC1, mnC, alC, PP0, PP1, alP, t, DO_WRITE, DO_LOAD) do { \
    if (DO_WRITE) { asm volatile("s_waitcnt vmcnt(0)" ::: "memory"); SWRITE(s2); } \
    SBAR(); qkt<DQK, ALIBI>(PC0, PC1, K_lds + s1 * SHM_K, qr, r32, hi, qpos - (float)((t) * KVBLK), sl); \
    finishSM(PP0, PP1, alP, l_reg, pa0, pa1, pa2, pa3); SBAR(); \
    if (DO_LOAD) SLOAD(((t) + 2) * KVBLK); SBAR(); \
    pv_d0(o, vb0 + s0 * SHM_V, pa0, pa1, pa2, pa3); partialSM<DQK, FIXED>(PC0, PC1, m_reg, mnC, alC, mfix); \
    RESC(alC); __syncthreads(); \
    { const int t_ = s0; s0 = s1; s1 = s2; s2 = t_; } } while (0)
  _Pragma("unroll 1") for (int t = 1; t + 2 < NT; t += 2) {
    ITER(pB0, pB1, mnB, alB, pA0, pA1, alA, t, true, true);
    ITER(pA0, pA1, mnA, alA, pB0, pB1, alB, t + 1, true, (t + 3 < NT));
  }
  ITER(pB0, pB1, mnB, alB, pA0, pA1, alA, NT - 1, false, false);
  finishSM(pB0, pB1, alB, l_reg, pa0, pa1, pa2, pa3); SBAR();
  pv_d0(o, vb0 + s0 * SHM_V, pa0, pa1, pa2, pa3);
  if (hi == 0) li_l[r32] = l_reg; asm volatile("s_waitcnt lgkmcnt(0)" ::: "memory");
#pragma unroll
  for (int r = 0; r < 16; ++r) { const float rl = __builtin_amdgcn_rcpf(li_l[crow(r, hi)]);
#pragma unroll
    for (int d0 = 0; d0 < 4; ++d0) o[d0][r] *= rl; }
#undef ITER
#undef SLOAD
#undef SWRITE
#undef RESC
}
}

__device__ __forceinline__ void gqa_attn_phase(const Frame& F, int o) {
    const bf16_t* Z = (const bf16_t*)POOLP(PL_Z); bf16_t* CAT = (bf16_t*)POOLP(PL_CAT);
    constexpr int NU_S = 16 * (T_S / 256), NU = NU_S + 16 * (T_P / 256);
    float mfix; { const float* qg = F.in[I_QN] + o * 128, *kg = F.in[I_KN] + o * 128; float a = fmaxf(fabsf(qg[F.lane]), fabsf(qg[F.lane + 64])), b = fmaxf(fabsf(kg[F.lane]), fabsf(kg[F.lane + 64]));
#pragma unroll
        for (int s = 1; s < 64; s <<= 1) { a = fmaxf(a, __shfl_xor(a, s)); b = fmaxf(b, __shfl_xor(b, s)); }
        mfix = 128.0f * 1.01f * a * b;
        if (!(mfix * 0.0883883476f < FIXREF_LIMIT_GQA)) mfix = -1.0f; }
    for (int L = F.bid; L < NU; L += F.G) {
        int tid = threadIdx.x; asm volatile("" : "+v"(tid));
        const int lane = tid & 63, r32 = lane & 31, hi = lane >> 5, wid = tid >> 6;
        int seq, head, qb;
        if (L < NU_S) { const int x = L & 7, r = L >> 3, kvh = x & 3, half = x >> 2; seq = 1; head = kvh * 4 + (r & 3); qb = half * 32 + (r >> 2); }
        else { const int Lp = L - NU_S, x = Lp & 7, r = Lp >> 3, kvh = x & 3, half = x >> 2; seq = 0; head = kvh * 4 + (r & 3); qb = half * 16 + (r >> 2); }
        const int t0 = seq ? T_P : 0, slen = seq ? T_S : T_P, kvh = head >> 2;
        const bf16_t* Qw = Z + (size_t)(t0 + qb * 256 + wid * 32 + r32) * ZLD + head * 128 + hi * 8;
        const bf16_t* Kh = Z + (size_t)t0 * ZLD + 2048 + kvh * 128; const bf16_t* Vh = Z + (size_t)t0 * ZLD + 2560 + kvh * 128;
        f32x16 ov[4];
        if (mfix >= 0.f) att::attn_pass<128, false, GQA_SDEPTH, ZLD, true>(Qw, Kh, Vh, slen, F.ldsg, ov, 0.f, 0.f, tid, mfix);
        else att::attn_pass<128, false, GQA_SDEPTH, ZLD, false>(Qw, Kh, Vh, slen, F.ldsg, ov, 0.f, 0.f, tid, mfix);
        bf16_t* Ow = CAT + (size_t)(t0 + qb * 256 + wid * 32) * DM + head * 128;
#pragma unroll
        for (int r = 0; r < 16; ++r) { const int orow = att::crow(r, hi);
#pragma unroll
            for (int d0 = 0; d0 < 4; ++d0) Ow[(size_t)orow * DM + d0 * 32 + r32] = f2bf(ov[d0][r]); }
    }
}

__device__ __forceinline__ void qk_bound_pass(const Frame& F, int e) {
    const bf16_t* Z = (const bf16_t*)POOLP(PL_Z); unsigned* ctl = (unsigned*)WSP(WS_CTL) + CW_QKB + e * 64;
    const int gw = F.bid * NWAVES + F.wave, NGW = F.G * NWAVES, lane = F.lane;
    float mx[2][2] = {{0.f, 0.f}, {0.f, 0.f}};
    for (int t = gw; t < TT; t += NGW) {
        const bf16_t* row = Z + (size_t)t * ZLD + lane * 16;
#pragma unroll
        for (int qk = 0; qk < 2; ++qk) { const u32x4 a = *(const u32x4*)(row + qk * 1024), b = *(const u32x4*)(row + qk * 1024 + 8);
            float s = bflo(a.x) * bflo(a.x) + bfhi(a.x) * bfhi(a.x) + bflo(a.y) * bflo(a.y) + bfhi(a.y) * bfhi(a.y) + bflo(a.z) * bflo(a.z) + bfhi(a.z) * bfhi(a.z) + bflo(a.w) * bflo(a.w) + bfhi(a.w) * bfhi(a.w)
                    + bflo(b.x) * bflo(b.x) + bfhi(b.x) * bfhi(b.x) + bflo(b.y) * bflo(b.y) + bfhi(b.y) * bfhi(b.y) + bflo(b.z) * bflo(b.z) + bfhi(b.z) * bfhi(b.z) + bflo(b.w) * bflo(b.w) + bfhi(b.w) * bfhi(b.w);
            s += __shfl_xor(s, 1); s += __shfl_xor(s, 2);
            if (t < T_P) mx[0][qk] = fmaxf(mx[0][qk], s); else mx[1][qk] = fmaxf(mx[1][qk], s); }
    }
    LAS float* red = (LAS float*)F.lds;
    if ((lane & 3) == 0) {
#pragma unroll
        for (int sq = 0; sq < 2; ++sq)
#pragma unroll
            for (int qk = 0; qk < 2; ++qk) red[(F.wave * 4 + sq * 2 + qk) * 16 + (lane >> 2)] = mx[sq][qk]; }
    LDS_WAIT(); __syncthreads();
    if (F.tid < 64) { float m = 0.f;
#pragma unroll
        for (int w = 0; w < 8; ++w) m = fmaxf(m, red[w * 64 + F.tid]);
        atomicMax(ctl + F.tid, __float_as_uint(m)); }
    __syncthreads();
}

__device__ __forceinline__ void diff_attn_phase(const Frame& F, int e, int rep = 0) {
    const bf16_t* Z = (const bf16_t*)POOLP(PL_Z); bf16_t* CAT = (bf16_t*)POOLP(PL_CAT); float* ST = (float*)POOLP(PL_STASH);
    const float lam = ((const float*)(WSP(WS_MISC) + MISC_LAM))[e * 2], linit = ((const float*)(WSP(WS_MISC) + MISC_LAM))[e * 2 + 1];
    const float* sg = F.in[I_SUBLN] + e * 128;
    unsigned* ctl = (unsigned*)WSP(WS_CTL); const unsigned* qkb = ctl + CW_QKB + e * 64; unsigned* qctr = ctl + CW_QUEUE + e * 64 + rep * 256;
    constexpr int NU = 8 * (T_S / 256) + 8 * (T_P / 256);
    LAS int* uslot = (LAS int*)(F.lds + RING_BYTES + 64);
    for (;;) {
        __syncthreads();
        if (threadIdx.x == 0) *uslot = (int)__hip_atomic_fetch_add(qctr, 1u, RLX_AGENT);
        LDS_WAIT(); __syncthreads();
        const int u = __builtin_amdgcn_readfirstlane(*uslot);
        if (u >= NU) break;
        int tid = threadIdx.x; asm volatile("" : "+v"(tid));
        const int lane = tid & 63, r32 = lane & 31, hi = lane >> 5, wid = tid >> 6;
        f32x4* st = (f32x4*)ST + ((size_t)F.bid * NTHREADS + tid) * 16;
        const int head = 7 - u / 96, rr = u % 96, seq = rr < 64 ? 1 : 0, qb = seq ? rr : rr - 64;
        const int t0 = seq ? T_P : 0, slen = seq ? T_S : T_P;
        const float slope = exp2f(-(float)(head + 1)), sl = slope * 8.0f;
        const bf16_t* Vh = Z + (size_t)t0 * ZLD + 2048 + head * 128;
        f32x16 o[4];
        for (int m = 0; m < 2; ++m) {
            const float q2 = __uint_as_float(__hip_atomic_load(qkb + (seq * 2 + 0) * 16 + head * 2 + m, RLX_AGENT)), k2 = __uint_as_float(__hip_atomic_load(qkb + (seq * 2 + 1) * 16 + head * 2 + m, RLX_AGENT));
            const float qk = sqrtf(q2 * k2) * 1.001f; const float Bnd = 0.25f * qk + 32.0f;
            const float mfix = (0.125f * qk < FIXREF_LIMIT_DIFF) ? qk : -1.0f;
            float Wf = Bnd / slope; if (!(Wf < (float)slen)) Wf = (float)slen;
            const int W = (int)Wf + 1;
            int tlo = (qb * 256 - W) >> 6; if (tlo < 0) tlo = 0;
            int thi = (qb * 256 + 256 + W + 63) >> 6; if (thi > slen / 64) thi = slen / 64;
            if ((thi - tlo) & 1) { if (thi < slen / 64) ++thi; else --tlo; }
            tlo = __builtin_amdgcn_readfirstlane(tlo); thi = __builtin_amdgcn_readfirstlane(thi);
            const float qpos = (float)(qb * 256 + wid * 32 + r32 - tlo * 64);
            const bf16_t* Qw = Z + (size_t)(t0 + qb * 256 + wid * 32 + r32) * ZLD + head * 128 + m * 64 + hi * 8;
            const bf16_t* Kh = Z + (size_t)(t0 + tlo * 64) * ZLD + 1024 + head * 128 + m * 64;
            if (mfix >= 0.f) att::attn_pass<64, true, DIFF_SDEPTH, ZLD, true>(Qw, Kh, Vh + (size_t)(tlo * 64) * ZLD, (thi - tlo) * 64, F.ldsg, o, qpos, sl, tid, mfix);
            else att::attn_pass<64, true, DIFF_SDEPTH, ZLD, false>(Qw, Kh, Vh + (size_t)(tlo * 64) * ZLD, (thi - tlo) * 64, F.ldsg, o, qpos, sl, tid, mfix);
            if (m == 0) {
#pragma unroll
                for (int d0 = 0; d0 < 4; ++d0)
#pragma unroll
                    for (int q = 0; q < 4; ++q) st[d0 * 4 + q] = (f32x4){o[d0][4 * q], o[d0][4 * q + 1], o[d0][4 * q + 2], o[d0][4 * q + 3]};
            }
        }
        float ss[16];
#pragma unroll
        for (int r = 0; r < 16; ++r) ss[r] = 0.f;
#pragma unroll
        for (int d0 = 0; d0 < 4; ++d0) {
#pragma unroll
            for (int q = 0; q < 4; ++q) { const f32x4 s4 = st[d0 * 4 + q];
#pragma unroll
                for (int i = 0; i < 4; ++i) { const int r = 4 * q + i; const float a = s4[i] - lam * o[d0][r]; o[d0][r] = a; ss[r] += a * a; } }
            asm volatile("" ::: "memory"); }
#pragma unroll
        for (int r = 0; r < 16; ++r) { float s = ss[r]; s += __shfl_xor(s, 1); s += __shfl_xor(s, 2); s += __shfl_xor(s, 4); s += __shfl_xor(s, 8); s += __shfl_xor(s, 16);
            ss[r] = (1.0f - linit) / sqrtf(s * (1.f / 128.f) + SUBLN_EPS); }
        bf16_t* Ow = CAT + (size_t)(t0 + qb * 256 + wid * 32) * DM + 1024 + head * 128;
#pragma unroll
        for (int d0 = 0; d0 < 4; ++d0) { const float gcol = sg[d0 * 32 + r32];
#pragma unroll
            for (int r = 0; r < 16; ++r) Ow[(size_t)att::crow(r, hi) * DM + d0 * 32 + r32] = f2bf(o[d0][r] * ss[r] * gcol); }
    }
}

constexpr int PH_BASE = 3, PH_PER = 16, PH_END = PH_BASE + 8 * PH_PER - 1;
__host__ __device__ inline bool phase_exists(int pid) {
    if (pid < PH_BASE) return true;
    const int hl = (pid - PH_BASE) / PH_PER, k = (pid - PH_BASE) % PH_PER, f = hl & 1, l = hl >> 1;
    if (k <= 1) return true;
    if (k == 14) return hl == 7;
    if (k == 15 || f == 1 || k == 2 || k == 10 || k == 12) return false;
    if ((l & 1) && (k == 6 || k == 7 || k == 8)) return false;
    return true;
}

__device__ __forceinline__ bool fresh_frame(Frame& F) { int t = threadIdx.x; asm volatile("" : "+v"(t)); F.tid = t; F.lane = t & 63; F.wave = __builtin_amdgcn_readfirstlane(t >> 6); return true; }
#ifndef GU_WGM
#define GU_WGM 4
#endif
__global__ void __launch_bounds__(NTHREADS, 2) fwd_kernel(Args args) {
    extern __shared__ __attribute__((aligned(16))) unsigned char lds[];
    Frame F;
    F.lds = (LAS unsigned char*)lds; F.ldsg = (char*)lds;
    F.MISC = (volatile LAS unsigned*)(F.lds + MISC_OFF);
    F.tid = threadIdx.x; F.lane = F.tid & 63; F.wave = __builtin_amdgcn_readfirstlane(F.tid >> 6);
    F.G = gridDim.x; F.bid = blockIdx.x; F.in = args.in; F.x = args.out; F.ws = args.ws;
    for (int u = F.tid; u < (LDS_BYTES - RING_BYTES) / 4; u += NTHREADS) ((LAS unsigned*)(F.lds + RING_BYTES))[u] = 0u;
    __syncthreads();
    XcdBarrier bar = xcd_barrier_post((unsigned*)(F.ws + WS_CTL) + CW_BAR + args.li * XCD_BAR_WORDS, F.MISC + 8);
    const int lo = args.ph_lo, hi = args.ph_hi;
#define PH(p) (lo <= (p) && (p) < hi && fresh_frame(F))
#define ENDPH(p) do { if ((p) + 1 < hi) xcd_barrier(bar); } while (0)
    float* const PSS = (float*)(F.ws + WS_MISC + MISC_PSS);
    const int rep = args.pad;
#ifdef PROBE_K
#define RSCALE(s) (rep == 0 ? (s) : 0.0f)
#else
#define RSCALE(s) (s)
#endif

    if (PH(0)) { prologue_phase(F); ENDPH(0); }
    if (PH(1)) {
        auto S = make_sched(F, POOLP(PL_MEMN), DM, POOLP(PL_WKVT), DM, 256, 2 * DM, 8, ZKv{});
        EpiBf16<0> E{(bf16_t*)POOLP(PL_KVB), 2 * DM, (size_t)256 * 2 * DM, 0, 0, nullptr, nullptr, nullptr};
        pg8::gemm_phase(F.lds, DM, DM, DM, S, E, F.tid);
        s5_precompute_phase(F); ENDPH(1);
    }
    if (PH(2)) {
        { auto S = make_sched(F, POOLP(PL_KVB), 2 * DM, POOLP(PL_WQB), DM, 256, DM, 32, ZKf{});
          EpiBf16<2> E{(bf16_t*)WSP(WS_KF), DM, (size_t)256 * DM, 0, 0, F.in[I_CN], nullptr, nullptr};
          pg8::gemm_phase(F.lds, 2 * DM, DM, 512, S, E, F.tid); }
        { auto S = make_sched(F, POOLP(PL_WOT), DM, POOLP(PL_KVB), 2 * DM, DM, 256, 32, ZVw{});
          EpiBf16<0> E{(bf16_t*)WSP(WS_VWT), 1024, (size_t)DM * 1024, 256, 2, nullptr, nullptr, nullptr};
          pg8::gemm_phase(F.lds, DM, 2 * DM, 512, S, E, F.tid); }
        ENDPH(2);
    }
    for (int hl = 0; hl < 8; ++hl) {
        const int l = hl >> 1, f = hl & 1, pb = PH_BASE + hl * PH_PER, eo = l >> 1;
        const bool even = (l & 1) == 0;
        if (PH(pb + 0)) {
            auto S = make_sched(F, WSP(WS_HB), DM, WSP(WS_WGU + (size_t)hl * SZ_WGU), DM, TT, 2 * DFF, 1, ZNone{}); S.wgm = GU_WGM;
            EpiSwiglu E{F.ws, DFF, F.lds};
            pg8::gemm_phase(F.lds, DM, DM, DM, S, E, F.tid);
            ENDPH(pb + 0);
        }
        if (PH(pb + 1)) {
            auto S = make_sched(F, POOLP(PL_ACT), DFF, WSP(WS_WD + (size_t)hl * SZ_WD), DFF, TT, DM, 1, ZNone{});
            { EpiResidNorm E{RSCALE(0.5f), F.ws, (LAS float*)(F.lds + EXCH_OFF)}; pg8::gemm_phase(F.lds, DFF, DFF, DFF, S, E, F.tid); }
            ENDPH(pb + 1);
        }
        if (f == 0) {
            if (even) {
                if (PH(pb + 3)) {
                    auto S = make_sched(F, WSP(WS_HB), DM, WSP(WS_WINE + (size_t)eo * SZ_WINE), DM, TT, EVEN_IN, 1, ZNone{});
                    EpiWinEven E{F.ws, F.lds};
                    pg8::gemm_phase(F.lds, DM, DM, DM, S, E, F.tid);
                    ENDPH(pb + 3);
                }
                if (PH(pb + 4)) {
                    auto S = make_sched(F, POOLP(PL_UX), S5K2, WSP(WS_WST + (size_t)eo * 64 * SZ_WST), S5K1, NCH, S5NS, S5G, ZLin{(size_t)NCH * S5K2 * 2, SZ_WST});
                    EpiF32 E{(float*)POOLP(PL_SST), S5G * S5NS, (size_t)S5NS};
                    pg8::gemm_phase(F.lds, S5K2, S5K1, S5K1, S, E, F.tid);
                    qk_bound_pass(F, eo); ENDPH(pb + 4);
                }
                if (PH(pb + 5)) { s5_scan_phase(F, eo); ENDPH(pb + 5); }
                if (PH(pb + 6)) {
                    auto S = make_sched(F, POOLP(PL_UX), S5K2, WSP(WS_TG + (size_t)eo * 64 * SZ_TG), S5K2, NCH, S5K1, S5G, ZLin{(size_t)NCH * S5K2 * 2, SZ_TG});
                    EpiS5Out E{(bf16_t*)POOLP(PL_GB)};
                    pg8::gemm_phase(F.lds, S5K2, S5K2, S5K2, S, E, F.tid); ENDPH(pb + 6);
                }
                if (PH(pb + 7)) {
                    auto S = make_sched(F, POOLP(PL_GB), S5W, WSP(WS_GLU + (size_t)eo * SZ_GLU), S5W, TT, S5W, 1, ZNone{});
                    EpiGlu E{(const bf16_t*)POOLP(PL_GB), F.in[I_GLUB] + eo * S5W, (bf16_t*)POOLP(PL_CAT)};
                    pg8::gemm_phase(F.lds, S5W, S5W, S5W, S, E, F.tid);
                    if (!PH(pb + 8)) ENDPH(pb + 7);
                }
                if (PH(pb + 8)) { diff_attn_phase(F, eo, rep); ENDPH(pb + 8); }
            } else {
                if (PH(pb + 3)) {
                    auto S = make_sched(F, WSP(WS_HB), DM, WSP(WS_WINO + (size_t)eo * SZ_WINO), DM, TT, ODD_IN, 1, ZNone{});
                    EpiBf16<1> E{(bf16_t*)POOLP(PL_Z), ZLD, 0, 0, 0, nullptr, F.ws, F.lds};
                    pg8::gemm_phase(F.lds, DM, DM, DM, S, E, F.tid); ENDPH(pb + 3);
                }
                if (PH(pb + 4)) { qk_prep_phase(F, eo); ENDPH(pb + 4); }
                if (PH(pb + 5)) { gqa_attn_phase(F, eo); ENDPH(pb + 5); }
            }
            if (PH(pb + 9)) {
                auto S = make_sched(F, POOLP(PL_CAT), DM, even ? WSP(WS_WOUTE + (size_t)eo * SZ_SQ) : WSP(WS_WOUTO + (size_t)eo * SZ_SQ), DM, TT, DM, 1, ZNone{});
                    { EpiResidNorm E{RSCALE(1.0f), F.ws, (LAS float*)(F.lds + EXCH_OFF)}; pg8::gemm_phase(F.lds, DM, DM, DM, S, E, F.tid); }
                ENDPH(pb + 9);
            }
            if (PH(pb + 11)) {
                auto S = make_sched(F, WSP(WS_HB), DM, WSP(WS_KF + (size_t)l * 2 * SZ_KF), DM, TT, 1024, 1, ZNone{}); S.split = T_P / 256; S.bseq = SZ_KF;
                EpiCrossSm E{F.ws, (LAS f32x2*)(F.lds + EXCH_OFF), F.lds};
                pg8::gemm_phase(F.lds, DM, DM, DM, S, E, F.tid);
                ENDPH(pb + 11);
            }
            if (PH(pb + 13)) {
                auto S = make_sched(F, POOLP(PL_CP), 1024, WSP(WS_VWT + (size_t)l * 2 * SZ_KF), 1024, TT, DM, 1, ZNone{}); S.split = T_P / 256; S.bseq = SZ_KF;
                EpiResidNorm E{RSCALE(1.0f), F.ws, (LAS float*)(F.lds + EXCH_OFF)};
                    pg8::gemm_phase(F.lds, 1024, 1024, 1024, S, E, F.tid); ENDPH(pb + 13);
            }
        }
        if (hl == 7 && PH(pb + 14)) { final_norm_phase(F, F.in[I_FINN]); ENDPH(pb + 14); }
    }
#undef PH
#undef ENDPH
}

#ifndef MK_PER_PHASE
#define MK_PER_PHASE 0
#endif
extern "C" void kernel_launch(void* const* d_in, const int* in_sizes, int n_in, void* d_out, int out_size, void* d_ws, size_t ws_size, hipStream_t stream) {
    static int grid = 0;
    if (grid == 0) {
        if (n_in != N_IN || out_size != TT * DM || ws_size < WS_END) { fprintf(stderr, "kernel_launch: unexpected shapes: n_in %d out %d ws %zu (need %zu)\n", n_in, out_size, ws_size, (size_t)WS_END); grid = -1; return; }
        int dev = 0, cus = 0, per_cu = 0;
        if (hipGetDevice(&dev) != hipSuccess || hipDeviceGetAttribute(&cus, hipDeviceAttributeMultiprocessorCount, dev) != hipSuccess) { grid = -1; return; }
        if (hipFuncSetAttribute((const void*)fwd_kernel, hipFuncAttributeMaxDynamicSharedMemorySize, LDS_BYTES) != hipSuccess) { fprintf(stderr, "kernel_launch: hipFuncSetAttribute failed\n"); grid = -1; return; }
        if (hipOccupancyMaxActiveBlocksPerMultiprocessor(&per_cu, (const void*)fwd_kernel, NTHREADS, LDS_BYTES) != hipSuccess || per_cu < 1) { fprintf(stderr, "kernel_launch: occupancy query says %d\n", per_cu); (void)hipGetLastError(); grid = -1; return; }
        grid = cus;
    }
    if (grid < 0) return;
#if MK_PER_PHASE
    (void)hipMemsetAsync((char*)d_ws + WS_CTL, 0, CTL_BYTES, stream);
#else
    (void)hipMemsetAsync((char*)d_ws + WS_CTL, 0, 32768, stream);
#endif
    Args a{};
    for (int i = 0; i < N_IN; ++i) a.in[i] = (const float*)d_in[i];
    a.out = (float*)d_out; a.ws = (unsigned char*)d_ws; a.pad = 0;
#if MK_PER_PHASE
    int li = 0;
    for (int p = 0; p < PH_END; ++p) { if (!phase_exists(p)) continue; a.ph_lo = p; a.ph_hi = p + 1; a.li = li++; a.pad = 0;
        hipLaunchKernelGGL(fwd_kernel, dim3(grid), dim3(NTHREADS), LDS_BYTES, stream, a);
#ifdef PROBE_K
        { const int kind = p < PH_BASE ? 100 + p : (p - PH_BASE) % PH_PER;
          if (kind == PROBE_K) for (int r = 1; r <= PROBE_REPS; ++r) { a.pad = r; hipLaunchKernelGGL(fwd_kernel, dim3(grid), dim3(NTHREADS), LDS_BYTES, stream, a); } }
#endif
    }
#else
    a.ph_lo = 0; a.ph_hi = PH_END; a.li = 0;
    hipLaunchKernelGGL(fwd_kernel, dim3(grid), dim3(NTHREADS), LDS_BYTES, stream, a);
#endif
    const hipError_t le = hipPeekAtLastError();
    if (le != hipSuccess) fprintf(stderr, "kernel_launch: launch failed: %s\n", hipGetErrorName(le));
}
```

```cpp
#include <hip/hip_runtime.h>
#include <cstdio>
#include <cstdint>

#define GAS __attribute__((address_space(1)))
#define LAS __attribute__((address_space(3)))
typedef unsigned short bf16_t;
typedef short bf16x8 __attribute__((ext_vector_type(8)));
typedef short s16x4 __attribute__((ext_vector_type(4)));
typedef float f32x2 __attribute__((ext_vector_type(2)));
typedef float f32x4 __attribute__((ext_vector_type(4)));
typedef float f32x8 __attribute__((ext_vector_type(8)));
typedef float f32x16 __attribute__((ext_vector_type(16)));
typedef unsigned u32x2 __attribute__((ext_vector_type(2)));
typedef unsigned u32x4 __attribute__((ext_vector_type(4)));
typedef GAS unsigned gu32;
#define RLX_AGENT __ATOMIC_RELAXED, __HIP_MEMORY_SCOPE_AGENT
#define LDS_WAIT() asm volatile("s_waitcnt lgkmcnt(0)" ::: "memory")
#define VM_WAIT() asm volatile("s_waitcnt vmcnt(0)" ::: "memory")
#define SBAR() __builtin_amdgcn_sched_barrier(0)

__device__ __forceinline__ unsigned cvt_pk_bf16(float lo, float hi) { unsigned r; asm volatile("v_cvt_pk_bf16_f32 %0, %1, %2" : "=v"(r) : "v"(lo), "v"(hi)); return r; }
__device__ __forceinline__ float bf2f(unsigned short b) { return __uint_as_float(((unsigned)b) << 16); }
__device__ __forceinline__ float bflo(unsigned w) { return __uint_as_float(w << 16); }
__device__ __forceinline__ float bfhi(unsigned w) { return __uint_as_float(w & 0xffff0000u); }
__device__ __forceinline__ unsigned short f2bf(float f) { unsigned u = __float_as_uint(f); return (unsigned short)((u + 0x7fffu + ((u >> 16) & 1u)) >> 16); }
__device__ __forceinline__ float fast_rcp(float x) { return __builtin_amdgcn_rcpf(x); }
__device__ __forceinline__ float fast_exp2(float x) { return __builtin_amdgcn_exp2f(x); }
__device__ __forceinline__ float sigmoidf_fast(float x) { return fast_rcp(1.0f + fast_exp2(-1.4426950408889634f * x)); }
__device__ __forceinline__ float silu_f(float x) { return x * sigmoidf_fast(x); }
__device__ __forceinline__ float gelu_tanh_f(float y) { const float z = y + 0.044715f * y * y * y; return y * fast_rcp(1.0f + fast_exp2(-2.3022081982f * z)); }
__device__ __forceinline__ float wave_sum(float v) {
#pragma unroll
    for (int o = 1; o < 64; o <<= 1) v += __shfl_xor(v, o);
    return v;
}

#define XB_TMO      128
#define XB_XCNT(j)  (256  + 64 * (j))
#define XB_XSUB(j)  (1280 + 64 * (j))
#define XB_XGEN(j)  (2304 + 64 * (j))
#define XB_TOP      3328
#define XB_TOPGEN   3392
#define XCD_BAR_WORDS 3456
#define XB_SPIN_CAP (1u << 22)

__device__ __forceinline__ unsigned xb_ld(unsigned* p)              { return __hip_atomic_load(p, __ATOMIC_RELAXED, __HIP_MEMORY_SCOPE_AGENT); }
__device__ __forceinline__ unsigned xb_add(unsigned* p, unsigned v) { return __hip_atomic_fetch_add(p, v, __ATOMIC_RELAXED, __HIP_MEMORY_SCOPE_AGENT); }
__device__ __forceinline__ unsigned xb_xcc_id() { return (unsigned)__builtin_amdgcn_s_getreg((3 << 11) | 20) & 0xFu; }
#define XB_SPIN(cond, bar) do { unsigned _sp = 0; while (cond) { __builtin_amdgcn_s_sleep(1); \
    if ((++_sp & 255u) == 0u) { if (xb_ld(&(bar)[XB_TMO])) break; if (_sp > XB_SPIN_CAP) { atomicAdd(&(bar)[XB_TMO], 1u); break; } } } } while (0)

struct XcdBarrier { unsigned* bar; unsigned x; volatile LAS unsigned* st; };

__device__ __forceinline__ XcdBarrier xcd_barrier_post(unsigned* bar, volatile LAS unsigned* st) {
    XcdBarrier b; b.bar = bar; b.x = xb_xcc_id(); b.st = st;
    if (threadIdx.x == 0) (void)xb_add(&bar[XB_XCNT(b.x)], 1u);
    return b;
}
__device__ __forceinline__ void xcd_barrier_complete(unsigned* bar, unsigned x, unsigned& nloc, unsigned& nx) {
    const unsigned G = gridDim.x * gridDim.y * gridDim.z;
    unsigned sum, cnt, mine, sp = 0u;
    for (;;) {
        sum = 0u; cnt = 0u; mine = 0u;
#pragma unroll
        for (unsigned j = 0; j < 16; ++j) { const unsigned c = xb_ld(&bar[XB_XCNT(j)]); sum += c; cnt += (c > 0u) ? 1u : 0u; mine = (j == x) ? c : mine; }
        if (sum == G) break;
        __builtin_amdgcn_s_sleep(1);
        if ((++sp & 255u) == 0u) { if (xb_ld(&bar[XB_TMO])) break; if (sp > XB_SPIN_CAP) { atomicAdd(&bar[XB_TMO], 1u); break; } }
    }
    nloc = mine > 0u ? mine : 1u; nx = cnt > 0u ? cnt : 1u;
}
__device__ __forceinline__ void xcd_barrier(const XcdBarrier& b) {
    asm volatile("s_waitcnt vmcnt(0)" ::: "memory");
    __syncthreads();
    if (threadIdx.x == 0) {
        unsigned* bar = b.bar;
        __builtin_amdgcn_s_waitcnt(0);
        unsigned nloc = b.st[0], nx = b.st[1];
        if (nloc == 0u) { xcd_barrier_complete(bar, b.x, nloc, nx); b.st[0] = nloc; b.st[1] = nx; }
        const unsigned old = xb_add(&bar[XB_XSUB(b.x)], 1u);
        const unsigned gen = old / nloc;
        if (old + 1u == (gen + 1u) * nloc) {
            __builtin_amdgcn_fence(__ATOMIC_RELEASE, "agent");
            asm volatile("s_waitcnt vmcnt(0)" ::: "memory");
            const unsigned og = xb_add(&bar[XB_TOP], 1u);
            const unsigned tg = og / nx;
            if (og + 1u == (tg + 1u) * nx) xb_add(&bar[XB_TOPGEN], 1u);
            else XB_SPIN(xb_ld(&bar[XB_TOPGEN]) == tg, bar);
            __builtin_amdgcn_fence(__ATOMIC_ACQUIRE, "agent");
            xb_add(&bar[XB_XGEN(b.x)], 1u);
            asm volatile("s_waitcnt vmcnt(0)" ::: "memory");
        } else {
            XB_SPIN(xb_ld(&bar[XB_XGEN(b.x)]) == gen, bar);
            __builtin_amdgcn_fence(__ATOMIC_ACQUIRE, "agent");
            asm volatile("s_waitcnt vmcnt(0)" ::: "memory");
        }
    }
    __syncthreads();
}

namespace pg8 {
constexpr int BM = 256, BK = 64, HALF = 128, HTB = HALF * BK * 2, STAGE_BYTES = 8 * HTB, NXCD = 8, WGM = 4;
__host__ __device__ __forceinline__ int lds_byte(int r, int c) { const int st = (r >> 4) * 2 + (c >> 5), rr = r & 15, cc = c & 31, ob = rr * 64 + cc * 2; return st * 1024 + (ob ^ (((ob >> 9) & 1) << 5)); }
__host__ __device__ __forceinline__ void stage_rc(int b, int& R, int& C) { const int st = b / 1024, sb = b % 1024, swz = sb ^ (((sb >> 9) & 1) << 5); R = (st >> 1) * 16 + swz / 64; C = (st & 1) * 32 + (swz % 64) / 2; }
__host__ __device__ __forceinline__ int perm32(int rho) { const int n = rho >> 4, i = rho & 15; return 8 * (i >> 2) + 4 * n + (i & 3); }

struct Unit { int pm, pn, z; };
struct Enum {
    int nM, nN, nZ, nwg, G, c, rev, wgm;
    __device__ __forceinline__ void init(int nM_, int nN_, int nZ_, int G_, int c_) { nM = nM_; nN = nN_; nZ = nZ_; nwg = nM * nN * nZ; G = G_; c = c_; rev = 0; wgm = WGM; }
    __device__ __forceinline__ bool next(int i, Unit& u) const {
        const long L = (long)i * G + c; if (L >= nwg) return false;
        int wgid = (int)L; { const int q = nwg / NXCD, r = nwg % NXCD, xcd = wgid % NXCD, off = wgid / NXCD; wgid = (xcd < r ? xcd * (q + 1) : r * (q + 1) + (xcd - r) * q) + off; }
        const int per = nM * nN; u.z = wgid / per; wgid -= u.z * per;
        const int nig = wgm * nN, gid = wgid / nig, fm = gid * wgm, gsz = (nM - fm) < wgm ? (nM - fm) : wgm;
        u.pm = fm + ((wgid % nig) % gsz); u.pn = (wgid % nig) / gsz; if (rev) u.pm = nM - 1 - u.pm; return true;
    }
};

template <class Epi, class Sched>
__device__ __forceinline__ void gemm_phase(LAS unsigned char* lds, const int lda, const int ldb, const int K, const Sched& S, const Epi& E, const int tid) {
    const int wid = __builtin_amdgcn_readfirstlane(tid >> 6), lane = tid & 63, wr = wid >> 2, wc = wid & 3, fr = lane & 15, fq = lane >> 4;
    const int nt = K / BK;
    unsigned voffA[2], voffB[2];
#pragma unroll
    for (int i = 0; i < 2; ++i) { int R, C; stage_rc(tid * 16 + i * 8192, R, C); const int Rb = Epi::PERM ? ((R & ~31) + perm32(R & 31)) : R;
        voffA[i] = (unsigned)(R * lda + C) * 2u; voffB[i] = (unsigned)(Rb * ldb + C) * 2u; }
    const size_t kstep = (size_t)(BK * 2);
    const size_t hstepA = (size_t)HALF * lda * 2, hstepB = (size_t)HALF * ldb * 2;
    const unsigned ldsw = (unsigned)wid * 1024u;
    const int aoff = lds_byte(wr * 64 + fr, fq * 8), boff = lds_byte(wc * 32 + fr, fq * 8);
#define PG8_SA(b, h) (((b) * 2 + (h)) * HTB)
#define PG8_SB(b, h) ((4 + (b) * 2 + (h)) * HTB)
#define PG8_STAGE(bufoff, gbase, voff) do { _Pragma("unroll") for (int _i = 0; _i < 2; ++_i) \
        __builtin_amdgcn_global_load_lds((const unsigned*)((const char*)(gbase) + (voff)[_i]), (LAS unsigned*)(lds + (bufoff) + ldsw + _i * 8192), 16, 0, 0); } while (0)
#define PG8_LDA(dst, b, h) do { _Pragma("unroll") for (int m = 0; m < 4; ++m) _Pragma("unroll") for (int k = 0; k < 2; ++k) dst[m][k] = *(const LAS bf16x8*)(lds + PG8_SA(b, h) + aoff + m * 2048 + k * 1024); } while (0)
#define PG8_LDB(dst, b, h) do { _Pragma("unroll") for (int n = 0; n < 2; ++n) _Pragma("unroll") for (int k = 0; k < 2; ++k) dst[n][k] = *(const LAS bf16x8*)(lds + PG8_SB(b, h) + boff + n * 2048 + k * 1024); } while (0)
#define PG8_MMA(ai, bj, At, Bt) do { __builtin_amdgcn_s_setprio(1); _Pragma("unroll") for (int m = 0; m < 4; ++m) _Pragma("unroll") for (int n = 0; n < 2; ++n) _Pragma("unroll") for (int k = 0; k < 2; ++k) \
        acc[ai][bj][m][n] = __builtin_amdgcn_mfma_f32_16x16x32_bf16(Bt[n][k], At[m][k], acc[ai][bj][m][n], 0, 0, 0); __builtin_amdgcn_s_setprio(0); } while (0)
#define PG8_WAIT_V(n) asm volatile("s_waitcnt vmcnt(" #n ")" ::: "memory")
#define PG8_WAIT_L(n) asm volatile("s_waitcnt lgkmcnt(" #n ")" ::: "memory")
#define PG8_BAR __builtin_amdgcn_s_barrier()
#define PG8_SCHED __builtin_amdgcn_sched_barrier(0)
    Unit cur, nxt; int ui = 0;
    if (!S.next(0, cur)) return;
    f32x4 acc[2][2][4][2];
#pragma unroll
    for (int a = 0; a < 2; ++a)
#pragma unroll
        for (int b = 0; b < 2; ++b)
#pragma unroll
            for (int m = 0; m < 4; ++m)
#pragma unroll
                for (int n = 0; n < 2; ++n) acc[a][b][m][n] = (f32x4){0.f, 0.f, 0.f, 0.f};
    bf16x8 At[4][2], B0[2][2], B1[2][2];
    const char* cA = S.a_base(cur); const char* cB = S.b_base(cur);
    {
        PG8_STAGE(PG8_SB(0, 0), cB, voffB); PG8_STAGE(PG8_SB(0, 1), cB + hstepB, voffB); PG8_STAGE(PG8_SA(0, 0), cA, voffA); PG8_STAGE(PG8_SA(0, 1), cA + hstepA, voffA);
        if (wr == 1) PG8_BAR;
        PG8_WAIT_V(2); PG8_BAR;
        PG8_STAGE(PG8_SB(1, 0), cB + kstep, voffB); PG8_STAGE(PG8_SA(1, 0), cA + kstep, voffA); PG8_STAGE(PG8_SB(1, 1), cB + hstepB + kstep, voffB);
        PG8_WAIT_V(6); PG8_BAR;
    }
    for (;;) {
        if constexpr (Epi::PREFETCH) E.prefetch(lds, cur, ui, wid, lane);
        const bool has_next = S.next(ui + 1, nxt);
        const char* nA = has_next ? S.a_base(nxt) : cA; const char* nB = has_next ? S.b_base(nxt) : cB;
        for (int t = 0; t < nt; t += 2) {
            const bool last = (t == nt - 2);
            const char* a1 = cA + (size_t)(t + 1) * kstep;
            const char* a2 = last ? nA : cA + (size_t)(t + 2) * kstep; const char* b2 = last ? nB : cB + (size_t)(t + 2) * kstep;
            const char* a3 = a2 + kstep; const char* b3 = b2 + kstep;
            PG8_LDB(B0, 0, 0); PG8_LDB(B1, 0, 1); PG8_SCHED; PG8_LDA(At, 0, 0); PG8_STAGE(PG8_SA(1, 1), a1 + hstepA, voffA);
            PG8_WAIT_V(8); PG8_WAIT_L(0); PG8_BAR; PG8_MMA(0, 0, At, B0); PG8_MMA(0, 1, At, B1); PG8_BAR; PG8_SCHED;
            PG8_LDA(At, 0, 1); PG8_STAGE(PG8_SB(0, 0), b2, voffB); PG8_STAGE(PG8_SB(0, 1), b2 + hstepB, voffB); PG8_STAGE(PG8_SA(0, 0), a2, voffA);
            PG8_WAIT_V(8); PG8_WAIT_L(0); PG8_BAR; PG8_MMA(1, 0, At, B0); PG8_MMA(1, 1, At, B1); PG8_BAR; PG8_SCHED;
            PG8_LDB(B0, 1, 0); PG8_LDB(B1, 1, 1); PG8_SCHED; PG8_LDA(At, 1, 0); PG8_STAGE(PG8_SA(0, 1), a2 + hstepA, voffA);
            PG8_WAIT_V(8); PG8_WAIT_L(0); PG8_BAR; PG8_MMA(0, 0, At, B0); PG8_MMA(0, 1, At, B1); PG8_BAR; PG8_SCHED;
            PG8_LDA(At, 1, 1); PG8_STAGE(PG8_SB(1, 0), b3, voffB); PG8_STAGE(PG8_SB(1, 1), b3 + hstepB, voffB); PG8_STAGE(PG8_SA(1, 0), a3, voffA);
            PG8_WAIT_V(8); PG8_WAIT_L(0); PG8_BAR; PG8_MMA(1, 0, At, B0); PG8_MMA(1, 1, At, B1); PG8_BAR; PG8_SCHED;
        }
        if (wr == 0) PG8_BAR;
        E(acc, cur, wr, wc, fr, fq, ui);
        if (!has_next) break;
#pragma unroll
        for (int a = 0; a < 2; ++a)
#pragma unroll
            for (int b = 0; b < 2; ++b)
#pragma unroll
                for (int m = 0; m < 4; ++m)
#pragma unroll
                    for (int n = 0; n < 2; ++n) acc[a][b][m][n] = (f32x4){0.f, 0.f, 0.f, 0.f};
        cur = nxt; cA = nA; cB = nB; ++ui;
        if (wr == 1) PG8_BAR;
    }
    PG8_WAIT_V(0);
    PG8_BAR;
#undef PG8_SA
#undef PG8_SB
#undef PG8_STAGE
#undef PG8_LDA
#undef PG8_LDB
#undef PG8_MMA
#undef PG8_WAIT_V
#undef PG8_WAIT_L
#undef PG8_BAR
#undef PG8_SCHED
}
}

constexpr int DM = 2048, T_P = 8192, T_S = 16384, TT = T_P + T_S, DEPTH = 4, NMEM = 256, DFF = 5632;
constexpr int S5W = 1024, S5G = 64, S5H = 16, S5P = 64, LC = 32, NCH = TT / LC, NCH_P = T_P / LC;
constexpr int S5K1 = LC * S5H  , S5NS = 4 * S5P  , S5K2 = S5K1 + S5NS  ;
constexpr int EVEN_IN = 4096, ODD_IN = 3072, ZLD = 3072;
constexpr float EPS = 1e-6f, SUBLN_EPS = 1e-5f;
constexpr int NWAVES = 8, NTHREADS = 512;

enum { I_XP = 0, I_XS, I_MP, I_MS, I_F1N, I_F1GU, I_F1D, I_MIXN, I_EWIN, I_EWOUT, I_LRE, I_LIM, I_LDT, I_BRE, I_BIM, I_CRE, I_CIM, I_S5D, I_GLUW, I_GLUB,
       I_LQ1, I_LK1, I_LQ2, I_LK2, I_SUBLN, I_OWIN, I_OWOUT, I_QN, I_KN, I_CN, I_MN, I_CWQ, I_CWKV, I_CWO, I_F2N, I_F2GU, I_F2D, I_FINN, N_IN };

constexpr size_t MiB = 1u << 20;
constexpr size_t WS_CTL = 0, CTL_BYTES = 2 * MiB;
constexpr size_t WS_WGU = 2 * MiB;
constexpr size_t SZ_WGU = (size_t)2 * DFF * DM * 2;
constexpr size_t WS_WD = WS_WGU + 8 * SZ_WGU;
constexpr size_t SZ_WD = (size_t)DM * DFF * 2;
constexpr size_t WS_WINE = WS_WD + 8 * SZ_WD;
constexpr size_t SZ_WINE = (size_t)EVEN_IN * DM * 2;
constexpr size_t WS_WOUTE = WS_WINE + 2 * SZ_WINE;
constexpr size_t SZ_SQ = (size_t)DM * DM * 2;
constexpr size_t WS_GLU = WS_WOUTE + 2 * SZ_SQ;
constexpr size_t SZ_GLU = (size_t)S5W * S5W * 2;
constexpr size_t WS_WINO = WS_GLU + 2 * SZ_GLU;
constexpr size_t SZ_WINO = (size_t)ODD_IN * DM * 2;
constexpr size_t WS_WOUTO = WS_WINO + 2 * SZ_WINO;
constexpr size_t WS_KF = WS_WOUTO + 2 * SZ_SQ;
constexpr size_t SZ_KF = (size_t)1024 * DM * 2;
constexpr size_t WS_VWT = WS_KF + 8 * SZ_KF;
constexpr size_t WS_WST = WS_VWT + 8 * SZ_KF;
constexpr size_t SZ_WST = (size_t)S5NS * S5K1 * 2;
constexpr size_t WS_TG = WS_WST + 2 * 64 * SZ_WST;
constexpr size_t SZ_TG = (size_t)S5K1 * S5K2 * 2;
constexpr size_t WS_HB = WS_TG + 2 * 64 * SZ_TG;
constexpr size_t SZ_HB = (size_t)TT * DM * 2;
constexpr size_t WS_MISC = WS_HB + SZ_HB;
constexpr size_t MISC_ROPE = 0, MISC_AL = 65536  , MISC_LAM = 65536 + 131072  , MISC_PSS = 262144  ;
constexpr size_t WS_POOL = WS_MISC + MiB;
constexpr size_t PL_ACT = 0;
constexpr size_t PL_Z = 0;
constexpr size_t PL_UX = 144 * MiB;
constexpr size_t PL_KC = 144 * MiB;
constexpr size_t PL_SST = 216 * MiB;
constexpr size_t PL_GB = 264 * MiB;
constexpr size_t PL_CAT = 312 * MiB;
constexpr size_t PL_STASH = 408 * MiB;
constexpr size_t PL_CS = 0;
constexpr size_t PL_CP = 96 * MiB;
constexpr size_t PL_WQB = 0;
constexpr size_t PL_WKVT = 32 * MiB;
constexpr size_t PL_WOT = 96 * MiB;
constexpr size_t PL_MEMN = 128 * MiB;
constexpr size_t PL_KVB = 136 * MiB;
constexpr size_t POOL_BYTES = 440 * MiB;
constexpr size_t WS_X = WS_POOL + POOL_BYTES;
constexpr size_t WS_END = WS_X + (size_t)TT * DM;

constexpr int CW_BAR = 4096;
constexpr int CW_DBG = 1024;
constexpr int CW_QKB = 2048;
constexpr int CW_QUEUE = 2304;

constexpr int EXCH_OFF = 131072  , PSSB_OFF = 139264  , RING_BYTES = 155648, MISC_OFF = RING_BYTES + 320, LDS_BYTES = 159744;

struct Args { const float* in[N_IN]; float* out; unsigned char* ws; int ph_lo, ph_hi, li, pad; };
struct Frame {
    LAS unsigned char* lds; char* ldsg;
    volatile LAS unsigned* MISC;
    int tid, lane, wave, G, bid;
    const float* const* in; float* x; unsigned char* ws;
};
#define WSP(off) (F.ws + (off))
#define POOLP(off) (F.ws + WS_POOL + (off))

struct ZNone { __device__ __forceinline__ size_t aoff(int) const { return 0; } __device__ __forceinline__ size_t boff(int) const { return 0; } };
struct ZLin { size_t as, bs; __device__ __forceinline__ size_t aoff(int z) const { return (size_t)z * as; } __device__ __forceinline__ size_t boff(int z) const { return (size_t)z * bs; } };
struct ZKv { __device__ __forceinline__ size_t aoff(int z) const { return (size_t)z * (256 * 2048 * 2); } __device__ __forceinline__ size_t boff(int z) const { return (size_t)(z >> 1) * ((size_t)4096 * 2048 * 2); } };
struct ZKf { __device__ __forceinline__ size_t aoff(int z) const { return (size_t)(z >> 2) * ((size_t)256 * 4096 * 2) + (size_t)(z & 3) * 1024; }
             __device__ __forceinline__ size_t boff(int z) const { return (size_t)(z >> 3) * ((size_t)2048 * 2048 * 2) + (size_t)(z & 3) * 1024; } };
struct ZVw { __device__ __forceinline__ size_t aoff(int z) const { return (size_t)(z >> 3) * ((size_t)2048 * 2048 * 2) + (size_t)(z & 3) * 1024; }
             __device__ __forceinline__ size_t boff(int z) const { return (size_t)(z >> 2) * ((size_t)256 * 4096 * 2) + 4096 + (size_t)(z & 3) * 1024; } };
template <class ZM>
struct Sched : pg8::Enum {
    const char* A; const char* B; size_t atile, btile; int split; size_t bseq; ZM zm;
    __device__ __forceinline__ const char* a_base(const pg8::Unit& u) const { return A + (size_t)u.pm * atile + zm.aoff(u.z); }
    __device__ __forceinline__ const char* b_base(const pg8::Unit& u) const { return B + (size_t)u.pn * btile + zm.boff(u.z) + (u.pm >= split ? bseq : 0); }
};
template <class ZM>
__device__ __forceinline__ Sched<ZM> make_sched(const Frame& F, const void* A, int lda, const void* B, int ldb, int M, int N, int nZ, ZM zm) {
    Sched<ZM> S; S.init(M / 256, N / 256, nZ, F.G, F.bid); S.A = (const char*)A; S.B = (const char*)B; S.atile = (size_t)256 * lda * 2; S.btile = (size_t)256 * ldb * 2;
    S.split = 1 << 30; S.bseq = 0; S.zm = zm; return S;
}

typedef f32x4 Acc[2][2][4][2];
__device__ __forceinline__ float res_dec(unsigned hb  , float lob  ) {
    const int e = (int)((hb >> 7) & 0xFFu); const float sd = __uint_as_float((unsigned)(e > 15 ? e - 15 : 0) << 23);
    return fmaf(lob - 128.0f, sd, __uint_as_float(hb << 16));
}
__device__ __forceinline__ float res_enc_lo(float x, unsigned hb) {
    const int e = (int)((hb >> 7) & 0xFFu); const float se = e > 15 ? __uint_as_float((unsigned)(269 - e) << 23) : 0.f;
    return fminf(__builtin_rintf(fmaf(x - __uint_as_float(hb << 16), se, 128.0f)), 255.0f);
}
__device__ __forceinline__ unsigned pack4_u8(float a, float b, float c, float dd) { return (unsigned)a | ((unsigned)b << 8) | ((unsigned)c << 16) | ((unsigned)dd << 24); }
__device__ __forceinline__ void res_enc4(const f32x4 v, unsigned& w0, unsigned& w1, unsigned& lo) {
    w0 = cvt_pk_bf16(v[0], v[1]); w1 = cvt_pk_bf16(v[2], v[3]);
    lo = pack4_u8(res_enc_lo(v[0], w0 & 0xFFFFu), res_enc_lo(v[1], w0 >> 16), res_enc_lo(v[2], w1 & 0xFFFFu), res_enc_lo(v[3], w1 >> 16));
}
__device__ __forceinline__ f32x4 res_dec4(unsigned w0, unsigned w1, unsigned lo) {
    return (f32x4){res_dec(w0 & 0xFFFFu, (float)(lo & 0xFFu)), res_dec(w0 >> 16, (float)((lo >> 8) & 0xFFu)), res_dec(w1 & 0xFFFFu, (float)((lo >> 16) & 0xFFu)), res_dec(w1 >> 16, (float)(lo >> 24))};
}
__device__ __forceinline__ unsigned char* fresh_ws(unsigned char* ws) { asm volatile("" : "+s"(ws)); return ws; }
__device__ __forceinline__ void pss_prefetch(LAS unsigned char* lds, const unsigned char* ws, int pm, int par, int wid, int lane) {
    const unsigned char* src = ws + WS_MISC + MISC_PSS + (size_t)pm * 8192 + wid * 1024 + lane * 16;
    __builtin_amdgcn_global_load_lds((const unsigned*)src, (LAS unsigned*)(lds + PSSB_OFF + (par & 1) * 8192 + wid * 1024), 16, 0, 0);
}
__device__ __forceinline__ void row_rstd_lds(const LAS unsigned char* lds, int par, int rloc0, float (&rs)[2][4]) {
    const LAS unsigned char* b = lds + PSSB_OFF + (par & 1) * 8192;
#pragma unroll
    for (int ai = 0; ai < 2; ++ai)
#pragma unroll
        for (int m = 0; m < 4; ++m) { const f32x4 a = *(const LAS f32x4*)(b + (rloc0 + ai * 128 + m * 16) * 32), c = *(const LAS f32x4*)(b + (rloc0 + ai * 128 + m * 16) * 32 + 16);
            rs[ai][m] = 1.0f / sqrtf((((a.x + a.y) + (a.z + a.w)) + ((c.x + c.y) + (c.z + c.w))) * (1.f / DM) + EPS); }
}
__device__ __forceinline__ void row_rstd(const float* PSS, int row0, float (&rs)[2][4]) {
#pragma unroll
    for (int ai = 0; ai < 2; ++ai)
#pragma unroll
        for (int m = 0; m < 4; ++m) { const f32x4 a = *(const f32x4*)(PSS + (size_t)(row0 + ai * 128 + m * 16) * 8), b = *(const f32x4*)(PSS + (size_t)(row0 + ai * 128 + m * 16) * 8 + 4);
            rs[ai][m] = 1.0f / sqrtf((((a.x + a.y) + (a.z + a.w)) + ((b.x + b.y) + (b.z + b.w))) * (1.f / DM) + EPS); }
}
struct EpiSwiglu { static constexpr bool PERM = true, PREFETCH = true; unsigned char* ws; int ldc; LAS unsigned char* lds;
    __device__ __forceinline__ void prefetch(LAS unsigned char* l, const pg8::Unit& u, int par, int wid, int lane) const { pss_prefetch(l, ws, u.pm, par, wid, lane); }
    __device__ __forceinline__ void operator()(Acc& acc, const pg8::Unit& u, int wr, int wc, int fr, int fq, int par) const {
        const int row0 = u.pm * 256 + wr * 64 + fr, col0 = u.pn * 128 + wc * 32 + 8 * fq;
        unsigned char* w_ = fresh_ws(ws); bf16_t* O = (bf16_t*)(w_ + WS_POOL + PL_ACT);
        float rs[2][4]; row_rstd_lds(lds, par, wr * 64 + fr, rs);
#pragma unroll
        for (int ai = 0; ai < 2; ++ai)
#pragma unroll
            for (int m = 0; m < 4; ++m) { const f32x4 g0 = acc[ai][0][m][0] * rs[ai][m], g1 = acc[ai][0][m][1] * rs[ai][m], u0 = acc[ai][1][m][0] * rs[ai][m], u1 = acc[ai][1][m][1] * rs[ai][m];
                u32x4 w; w.x = cvt_pk_bf16(silu_f(g0[0]) * u0[0], silu_f(g0[1]) * u0[1]); w.y = cvt_pk_bf16(silu_f(g0[2]) * u0[2], silu_f(g0[3]) * u0[3]);
                w.z = cvt_pk_bf16(silu_f(g1[0]) * u1[0], silu_f(g1[1]) * u1[1]); w.w = cvt_pk_bf16(silu_f(g1[2]) * u1[2], silu_f(g1[3]) * u1[3]);
                *(u32x4*)(O + (size_t)(row0 + ai * 128 + m * 16) * ldc + col0) = w; }
    }
};
struct EpiResidNorm { static constexpr bool PERM = true, PREFETCH = false; float scale; unsigned char* ws; LAS float* red;
    __device__ __forceinline__ void operator()(Acc& acc, const pg8::Unit& u, int wr, int wc, int fr, int fq, int par) const {
        const int row0 = u.pm * 256 + wr * 64 + fr, col0 = u.pn * 256 + wc * 32 + 8 * fq, tid = (wr * 4 + wc) * 64 + fq * 16 + fr;
        unsigned char* w_ = fresh_ws(ws); bf16_t* XB = (bf16_t*)(w_ + WS_HB); float* PSS = (float*)(w_ + WS_MISC + MISC_PSS);
        u32x4* XL = (u32x4*)(w_ + WS_X + (size_t)(u.pm * 8 + u.pn) * 65536) + tid;
#pragma unroll
        for (int ai = 0; ai < 2; ++ai) {
            u32x4 hv[4][2], lv[4];
#pragma unroll
            for (int m = 0; m < 4; ++m) { const bf16_t* bp = XB + (size_t)(row0 + ai * 128 + m * 16) * DM + col0; hv[m][0] = *(const u32x4*)bp; hv[m][1] = *(const u32x4*)(bp + 128); lv[m] = XL[(ai * 4 + m) * 512]; }
#pragma unroll
            for (int m = 0; m < 4; ++m) { bf16_t* bp = XB + (size_t)(row0 + ai * 128 + m * 16) * DM + col0; float s = 0.f; u32x4 lo;
#pragma unroll
                for (int bj = 0; bj < 2; ++bj) { const f32x4 v0 = res_dec4(hv[m][bj].x, hv[m][bj].y, lv[m][bj * 2]) + acc[ai][bj][m][0] * scale, v1 = res_dec4(hv[m][bj].z, hv[m][bj].w, lv[m][bj * 2 + 1]) + acc[ai][bj][m][1] * scale;
                    unsigned a0, a1, a2, a3, l0, l1; res_enc4(v0, a0, a1, l0); res_enc4(v1, a2, a3, l1); *(u32x4*)(bp + bj * 128) = (u32x4){a0, a1, a2, a3}; lo[bj * 2] = l0; lo[bj * 2 + 1] = l1;
                    s += ((v0[0] * v0[0] + v0[1] * v0[1]) + (v0[2] * v0[2] + v0[3] * v0[3])) + ((v1[0] * v1[0] + v1[1] * v1[1]) + (v1[2] * v1[2] + v1[3] * v1[3])); }
                XL[(ai * 4 + m) * 512] = lo;
                s += __shfl_xor(s, 16); s += __shfl_xor(s, 32);
                if (fq == 0) red[(ai * 128 + wr * 64 + m * 16 + fr) * 4 + wc] = s; }
            asm volatile("" ::: "memory"); }
        asm volatile("s_waitcnt lgkmcnt(0)" ::: "memory"); __builtin_amdgcn_s_barrier(); asm volatile("" ::: "memory");
        if (tid < 256) { const f32x4 r4 = *(const LAS f32x4*)(red + tid * 4); PSS[(size_t)(u.pm * 256 + tid) * 8 + u.pn] = (r4.x + r4.y) + (r4.z + r4.w); }
    }
};
template <int MODE> struct EpiBf16 { static constexpr bool PERM = true, PREFETCH = (MODE == 1); bf16_t* O; int ldc; size_t zhi, zlo; int zshift; const float* aux; unsigned char* ws; LAS unsigned char* lds;
    __device__ __forceinline__ void prefetch(LAS unsigned char* l, const pg8::Unit& u, int par, int wid, int lane) const { pss_prefetch(l, ws, u.pm, par, wid, lane); }
    __device__ __forceinline__ void operator()(Acc& acc, const pg8::Unit& u, int wr, int wc, int fr, int fq, int par) const {
        bf16_t* base = O + (size_t)(u.z >> zshift) * zhi + (size_t)(u.z & ((1 << zshift) - 1)) * zlo;
        const int row0 = u.pm * 256 + wr * 64 + fr, col0 = u.pn * 256 + wc * 32 + 8 * fq;
        float rs[2][4]; if (MODE == 1) row_rstd_lds(lds, par, wr * 64 + fr, rs);
        f32x4 cs[2][2]; if (MODE == 2) {
#pragma unroll
            for (int bj = 0; bj < 2; ++bj)
#pragma unroll
                for (int n = 0; n < 2; ++n) cs[bj][n] = *(const f32x4*)(aux + (size_t)(u.z >> 3) * DM + col0 + bj * 128 + 4 * n); }
#pragma unroll
        for (int ai = 0; ai < 2; ++ai)
#pragma unroll
            for (int m = 0; m < 4; ++m) { bf16_t* rp = base + (size_t)(row0 + ai * 128 + m * 16) * ldc + col0;
#pragma unroll
                for (int bj = 0; bj < 2; ++bj) { f32x4 v0 = acc[ai][bj][m][0], v1 = acc[ai][bj][m][1];
                    if (MODE == 1) { v0 = v0 * rs[ai][m]; v1 = v1 * rs[ai][m]; }
                    if (MODE == 2) { v0 = v0 * cs[bj][0]; v1 = v1 * cs[bj][1]; }
                    u32x4 w; w.x = cvt_pk_bf16(v0[0], v0[1]); w.y = cvt_pk_bf16(v0[2], v0[3]); w.z = cvt_pk_bf16(v1[0], v1[1]); w.w = cvt_pk_bf16(v1[2], v1[3]);
                    *(u32x4*)(rp + bj * 128) = w; } }
    }
};
struct EpiWinEven { static constexpr bool PERM = true, PREFETCH = true; unsigned char* ws; LAS unsigned char* lds;
    __device__ __forceinline__ void prefetch(LAS unsigned char* l, const pg8::Unit& u, int par, int wid, int lane) const { pss_prefetch(l, ws, u.pm, par, wid, lane); }
    __device__ __forceinline__ void operator()(Acc& acc, const pg8::Unit& u, int wr, int wc, int fr, int fq, int par) const {
        const int row0 = u.pm * 256 + wr * 64 + fr, col0 = u.pn * 256 + wc * 32 + 8 * fq;
        unsigned char* w_ = fresh_ws(ws); bf16_t* UX = (bf16_t*)(w_ + WS_POOL + PL_UX); bf16_t* Z = (bf16_t*)(w_ + WS_POOL + PL_Z);
        float rs[2][4]; row_rstd_lds(lds, par, wr * 64 + fr, rs);
        const float qs = (u.pn >= 4 && u.pn < 8) ? 0.18033688f : 1.0f;
#pragma unroll
        for (int ai = 0; ai < 2; ++ai)
#pragma unroll
            for (int m = 0; m < 4; ++m) { const int row = row0 + ai * 128 + m * 16;
#pragma unroll
                for (int bj = 0; bj < 2; ++bj) { const float rq = rs[ai][m] * qs; const f32x4 v0 = acc[ai][bj][m][0] * rq, v1 = acc[ai][bj][m][1] * rq; const int col = col0 + bj * 128;
                    u32x4 w; w.x = cvt_pk_bf16(v0[0], v0[1]); w.y = cvt_pk_bf16(v0[2], v0[3]); w.z = cvt_pk_bf16(v1[0], v1[1]); w.w = cvt_pk_bf16(v1[2], v1[3]);
                    bf16_t* p;
                    if (u.pn < 4) { const int g = col >> 4, h0 = col & 15, c = row >> 5, i = row & 31; p = UX + ((size_t)(g * NCH + c) * S5K2 + i * 16 + h0); }
                    else p = Z + (size_t)row * ZLD + (col - 1024);
                    *(u32x4*)p = w; } }
    }
};
struct EpiF32 { static constexpr bool PERM = false, PREFETCH = false; float* O; int ldc; size_t zs;
    __device__ __forceinline__ void operator()(Acc& acc, const pg8::Unit& u, int wr, int wc, int fr, int fq, int par) const {
        float* base = O + (size_t)u.z * zs; const int row0 = u.pm * 256 + wr * 64 + fr, col0 = u.pn * 256 + wc * 32 + 4 * fq;
#pragma unroll
        for (int ai = 0; ai < 2; ++ai)
#pragma unroll
            for (int m = 0; m < 4; ++m) { float* rp = base + (size_t)(row0 + ai * 128 + m * 16) * ldc + col0;
#pragma unroll
                for (int bj = 0; bj < 2; ++bj)
#pragma unroll
                    for (int n = 0; n < 2; ++n) *(f32x4*)(rp + bj * 128 + n * 16) = acc[ai][bj][m][n]; }
    }
};
struct EpiS5Out { static constexpr bool PERM = true, PREFETCH = false; bf16_t* GB;
    __device__ __forceinline__ void operator()(Acc& acc, const pg8::Unit& u, int wr, int wc, int fr, int fq, int par) const {
        const int row0 = u.pm * 256 + wr * 64 + fr, col0 = u.pn * 256 + wc * 32 + 8 * fq;
#pragma unroll
        for (int ai = 0; ai < 2; ++ai)
#pragma unroll
            for (int m = 0; m < 4; ++m) { const int c = row0 + ai * 128 + m * 16;
#pragma unroll
                for (int bj = 0; bj < 2; ++bj) { const f32x4 v0 = acc[ai][bj][m][0], v1 = acc[ai][bj][m][1]; const int col = col0 + bj * 128, i = col >> 4, h0 = col & 15;
                    u32x4 w; w.x = cvt_pk_bf16(gelu_tanh_f(v0[0]), gelu_tanh_f(v0[1])); w.y = cvt_pk_bf16(gelu_tanh_f(v0[2]), gelu_tanh_f(v0[3]));
                    w.z = cvt_pk_bf16(gelu_tanh_f(v1[0]), gelu_tanh_f(v1[1])); w.w = cvt_pk_bf16(gelu_tanh_f(v1[2]), gelu_tanh_f(v1[3]));
                    *(u32x4*)(GB + (size_t)(c * LC + i) * S5W + u.z * 16 + h0) = w; } }
    }
};
struct EpiGlu { static constexpr bool PERM = true, PREFETCH = false; const bf16_t* GB; const float* bias; bf16_t* O;
    __device__ __forceinline__ void operator()(Acc& acc, const pg8::Unit& u, int wr, int wc, int fr, int fq, int par) const {
        const int row0 = u.pm * 256 + wr * 64 + fr, col0 = u.pn * 256 + wc * 32 + 8 * fq;
        f32x4 bv[2][2];
#pragma unroll
        for (int bj = 0; bj < 2; ++bj)
#pragma unroll
            for (int n = 0; n < 2; ++n) bv[bj][n] = *(const f32x4*)(bias + col0 + bj * 128 + 4 * n);
#pragma unroll
        for (int ai = 0; ai < 2; ++ai)
#pragma unroll
            for (int m = 0; m < 4; ++m) { const int row = row0 + ai * 128 + m * 16;
#pragma unroll
                for (int bj = 0; bj < 2; ++bj) { const f32x4 v0 = acc[ai][bj][m][0] + bv[bj][0], v1 = acc[ai][bj][m][1] + bv[bj][1]; const int col = col0 + bj * 128;
                    const u32x4 g = *(const u32x4*)(GB + (size_t)row * S5W + col);
                    u32x4 w; w.x = cvt_pk_bf16(bflo(g.x) * sigmoidf_fast(v0[0]), bfhi(g.x) * sigmoidf_fast(v0[1])); w.y = cvt_pk_bf16(bflo(g.y) * sigmoidf_fast(v0[2]), bfhi(g.y) * sigmoidf_fast(v0[3]));
                    w.z = cvt_pk_bf16(bflo(g.z) * sigmoidf_fast(v1[0]), bfhi(g.z) * sigmoidf_fast(v1[1])); w.w = cvt_pk_bf16(bflo(g.w) * sigmoidf_fast(v1[2]), bfhi(g.w) * sigmoidf_fast(v1[3]));
                    *(u32x4*)(O + (size_t)row * DM + col) = w; } }
    }
};

struct EpiCrossSm { static constexpr bool PERM = true, PREFETCH = true; unsigned char* ws; LAS f32x2* red; LAS unsigned char* lds;
    __device__ __forceinline__ void prefetch(LAS unsigned char* l, const pg8::Unit& u, int par, int wid, int lane) const { pss_prefetch(l, ws, u.pm, par, wid, lane); }
    __device__ __forceinline__ void operator()(Acc& acc, const pg8::Unit& u, int wr, int wc, int fr, int fq, int par) const {
        constexpr float C = 0.04419417382415922f * 1.4426950408889634f;
        const int row0 = u.pm * 256 + wr * 64 + fr, col0 = u.pn * 256 + wc * 32 + 8 * fq;
        unsigned char* w_ = fresh_ws(ws); bf16_t* O = (bf16_t*)(w_ + WS_POOL + PL_CP);
        float rs[2][4]; row_rstd_lds(lds, par, wr * 64 + fr, rs);
        float mw[2][4];
#pragma unroll
        for (int ai = 0; ai < 2; ++ai)
#pragma unroll
            for (int m = 0; m < 4; ++m) { const float k = rs[ai][m] * C; float mx = -3.0e38f;
#pragma unroll
                for (int bj = 0; bj < 2; ++bj)
#pragma unroll
                    for (int n = 0; n < 2; ++n) { f32x4 v = acc[ai][bj][m][n] * k; acc[ai][bj][m][n] = v; mx = fmaxf(fmaxf(mx, fmaxf(v[0], v[1])), fmaxf(v[2], v[3])); }
                mx = fmaxf(mx, __shfl_xor(mx, 16)); mx = fmaxf(mx, __shfl_xor(mx, 32)); float s = 0.f;
#pragma unroll
                for (int bj = 0; bj < 2; ++bj)
#pragma unroll
                    for (int n = 0; n < 2; ++n) { f32x4 v = acc[ai][bj][m][n]; v[0] = fast_exp2(v[0] - mx); v[1] = fast_exp2(v[1] - mx); v[2] = fast_exp2(v[2] - mx); v[3] = fast_exp2(v[3] - mx); acc[ai][bj][m][n] = v; s += (v[0] + v[1]) + (v[2] + v[3]); }
                s += __shfl_xor(s, 16); s += __shfl_xor(s, 32); mw[ai][m] = mx;
                if (fq == 0) red[(ai * 128 + wr * 64 + m * 16 + fr) * 4 + wc] = (f32x2){mx, s}; }
        asm volatile("s_waitcnt lgkmcnt(0)" ::: "memory"); __builtin_amdgcn_s_barrier(); asm volatile("" ::: "memory");
#pragma unroll
        for (int ai = 0; ai < 2; ++ai)
#pragma unroll
            for (int m = 0; m < 4; ++m) { const LAS f32x2* rr = red + (ai * 128 + wr * 64 + m * 16 + fr) * 4; const f32x2 r0 = rr[0], r1 = rr[1], r2 = rr[2], r3 = rr[3];
                const float M = fmaxf(fmaxf(r0.x, r1.x), fmaxf(r2.x, r3.x));
                const float tot = (r0.y * fast_exp2(r0.x - M) + r1.y * fast_exp2(r1.x - M)) + (r2.y * fast_exp2(r2.x - M) + r3.y * fast_exp2(r3.x - M));
                const float f = fast_exp2(mw[ai][m] - M) * fast_rcp(tot);
                bf16_t* rp = O + (size_t)(row0 + ai * 128 + m * 16) * 1024 + col0;
#pragma unroll
                for (int bj = 0; bj < 2; ++bj) { const f32x4 v0 = acc[ai][bj][m][0] * f, v1 = acc[ai][bj][m][1] * f;
                    u32x4 w; w.x = cvt_pk_bf16(v0[0], v0[1]); w.y = cvt_pk_bf16(v0[2], v0[3]); w.z = cvt_pk_bf16(v1[0], v1[1]); w.w = cvt_pk_bf16(v1[2], v1[3]);
                    *(u32x4*)(rp + bj * 128) = w; } }
    }
};

template <int MODE>
__device__ __forceinline__ void transpose_item(const float* W, int K, int N, bf16_t* WT, LAS float* scr, int item, int lane, const float* gain = nullptr) {
    const int nblk = N / 32, kb = item / nblk, nb = item % nblk, k0 = 64 * kb, n0 = 32 * nb;
#pragma unroll 8
    for (int i = 0; i < 32; ++i) { const int kk = 2 * i + (lane >> 5); scr[kk * 33 + (lane & 31)] = W[(size_t)(k0 + kk) * N + n0 + (lane & 31)]; }
    LDS_WAIT(); asm volatile("" ::: "memory");
    const int c = lane & 7;
    f32x4 g0 = (f32x4){1.f, 1.f, 1.f, 1.f}, g1 = g0; if (gain) { g0 = *(const f32x4*)(gain + k0 + 8 * c); g1 = *(const f32x4*)(gain + k0 + 8 * c + 4); }
    int r0;
    if (MODE == 1) { r0 = (n0 < DFF) ? (256 * (n0 / 128) + (n0 % 128)) : (256 * ((n0 - DFF) / 128) + 128 + ((n0 - DFF) % 128)); } else r0 = n0;
#pragma unroll
    for (int j = 0; j < 4; ++j) { const int n = (lane >> 3) + 8 * j; const LAS float* s = scr + (8 * c) * 33 + n;
        u32x4 o; o.x = cvt_pk_bf16(s[0 * 33] * g0.x, s[1 * 33] * g0.y); o.y = cvt_pk_bf16(s[2 * 33] * g0.z, s[3 * 33] * g0.w); o.z = cvt_pk_bf16(s[4 * 33] * g1.x, s[5 * 33] * g1.y); o.w = cvt_pk_bf16(s[6 * 33] * g1.z, s[7 * 33] * g1.w);
        *(u32x4*)(WT + (size_t)(r0 + n) * K + k0 + 8 * c) = o; }
    LDS_WAIT(); asm volatile("" ::: "memory");
}
__device__ __forceinline__ void convert_rows(const float* src, bf16_t* dst, size_t n8, size_t gtid, size_t gthreads) {
    for (size_t i = gtid; i < n8; i += gthreads) { const f32x4 a = *(const f32x4*)(src + i * 8), b = *(const f32x4*)(src + i * 8 + 4);
        u32x4 o; o.x = cvt_pk_bf16(a[0], a[1]); o.y = cvt_pk_bf16(a[2], a[3]); o.z = cvt_pk_bf16(b[0], b[1]); o.w = cvt_pk_bf16(b[2], b[3]); *(u32x4*)(dst + i * 8) = o; }
}

__device__ __forceinline__ void rms_row_to_bf16(const float* xrow, const float* g, bf16_t* orow, float* xcopy, int lane) {
    const f32x4* xr = (const f32x4*)xrow + lane;
    f32x4 v[8]; float s = 0.f;
#pragma unroll
    for (int j = 0; j < 8; ++j) { v[j] = xr[64 * j]; s += (v[j].x * v[j].x + v[j].y * v[j].y) + (v[j].z * v[j].z + v[j].w * v[j].w); }
    if (xcopy) {
#pragma unroll
        for (int j = 0; j < 8; ++j) ((f32x4*)xcopy + lane)[64 * j] = v[j]; }
    const float rstd = 1.0f / sqrtf(wave_sum(s) * (1.f / DM) + EPS);
    const f32x4* gr = (const f32x4*)g + lane;
    u32x2* o8 = (u32x2*)orow + lane;
#pragma unroll
    for (int j = 0; j < 8; ++j) { const f32x4 gg = gr[64 * j]; u32x2 w; w.x = cvt_pk_bf16(v[j].x * rstd * gg.x, v[j].y * rstd * gg.y); w.y = cvt_pk_bf16(v[j].z * rstd * gg.z, v[j].w * rstd * gg.w); o8[64 * j] = w; }
}
__device__ __forceinline__ void norm_phase(const Frame& F, const float* g) {
    const int gw = F.bid * NWAVES + F.wave, NGW = F.G * NWAVES; bf16_t* HB = (bf16_t*)WSP(WS_HB);
    for (int m = gw; m < TT; m += NGW) rms_row_to_bf16(F.x + (size_t)m * DM, g, HB + (size_t)m * DM, nullptr, F.lane);
}
__device__ __forceinline__ void final_norm_phase(const Frame& F, const float* g) {
    const float* PSS = (const float*)(WSP(WS_MISC) + MISC_PSS); const bf16_t* XB = (const bf16_t*)WSP(WS_HB);
    const int tid = F.tid, wid = tid >> 6, wr = wid >> 2, wc = wid & 3, fq = (tid >> 4) & 3, fr = tid & 15;
    for (int L = F.bid; L < (TT / 256) * 8; L += F.G) { const int pm = L >> 3, pn = L & 7;
        const u32x4* XL = (const u32x4*)(WSP(WS_X) + (size_t)L * 65536) + tid; const int row0 = pm * 256 + wr * 64 + fr, col0 = pn * 256 + wc * 32 + 8 * fq;
        float rs[2][4]; row_rstd(PSS, row0, rs);
        f32x4 gg[2][2];
#pragma unroll
        for (int bj = 0; bj < 2; ++bj) { gg[bj][0] = *(const f32x4*)(g + col0 + bj * 128); gg[bj][1] = *(const f32x4*)(g + col0 + bj * 128 + 4); }
#pragma unroll
        for (int ai = 0; ai < 2; ++ai)
#pragma unroll
            for (int m = 0; m < 4; ++m) { const size_t ro = (size_t)(row0 + ai * 128 + m * 16) * DM + col0; const u32x4 lo = XL[(ai * 4 + m) * 512];
#pragma unroll
                for (int bj = 0; bj < 2; ++bj) { const u32x4 h = *(const u32x4*)(XB + ro + bj * 128); float* op = F.x + ro + bj * 128;
                    *(f32x4*)op = res_dec4(h.x, h.y, lo[bj * 2]) * rs[ai][m] * gg[bj][0]; *(f32x4*)(op + 4) = res_dec4(h.z, h.w, lo[bj * 2 + 1]) * rs[ai][m] * gg[bj][1]; } }
    }
}

__device__ __forceinline__ void s5_precompute_group(const Frame& F, int e, int g) {
    LAS float* L = (LAS float*)F.lds;
    LAS float* apow = L;
    LAS float* bb = apow + 8448;
    LAS float* cc = bb + 4096;
    LAS float* km = cc + 4096;
    LAS float* dsk = km + 16384;
    const float* lre = F.in[I_LRE], *lim = F.in[I_LIM], *ldt = F.in[I_LDT], *bre = F.in[I_BRE], *bim = F.in[I_BIM], *cre = F.in[I_CRE], *cim = F.in[I_CIM], *dsk_g = F.in[I_S5D];
    const int tid = F.tid;
    for (int idx = tid; idx < 2 * 64 * 33; idx += NTHREADS) { const int k = idx % 33, p = (idx / 33) % 64, dir = idx / (33 * 64);
        const size_t pi = ((size_t)(e * 2 + dir) * S5G + g) * S5P + p; const float lr = fminf(lre[pi], -1e-4f), li = lim[pi], dt = expf(ldt[(e * 2 + dir) * S5G + g]);
        const float mag = expf(lr * dt * (float)k); float sn, cs; sincosf(li * dt * (float)k, &sn, &cs); apow[idx * 2] = mag * cs; apow[idx * 2 + 1] = mag * sn; }
    for (int idx = tid; idx < 2 * 64 * 16; idx += NTHREADS) { const int h = idx % 16, p = (idx / 16) % 64, dir = idx / 1024;
        const size_t pi = ((size_t)(e * 2 + dir) * S5G + g) * S5P + p; const float lr = fminf(lre[pi], -1e-4f), li = lim[pi], dt = expf(ldt[(e * 2 + dir) * S5G + g]);
        const float mag = expf(lr * dt); float sn, cs; sincosf(li * dt, &sn, &cs); const float ar = mag * cs, ai = mag * sn, nr = ar - 1.0f, den = lr * lr + li * li;
        const float fr = (nr * lr + ai * li) / den, fi = (ai * lr - nr * li) / den; const float br = bre[pi * 16 + h], bi = bim[pi * 16 + h];
        bb[idx * 2] = fr * br - fi * bi; bb[idx * 2 + 1] = fr * bi + fi * br; }
    for (int idx = tid; idx < 2 * 16 * 64; idx += NTHREADS) { const int p = idx % 64, h = (idx / 64) % 16, dir = idx / 1024;
        const size_t ci = (((size_t)(e * 2 + dir) * S5G + g) * S5H + h) * S5P + p; cc[idx * 2] = cre[ci]; cc[idx * 2 + 1] = cim[ci]; }
    if (tid < 16) dsk[tid] = dsk_g[e * S5W + g * 16 + tid];
    LDS_WAIT(); __syncthreads();
    for (int idx = tid; idx < 2 * 32 * 256; idx += NTHREADS) { const int hp = idx & 15, h = (idx >> 4) & 15, k = (idx >> 8) & 31, dir = idx >> 13; float s = 0.f;
        for (int p = 0; p < 64; ++p) { const float cr = cc[((dir * 16 + h) * 64 + p) * 2], ci = cc[((dir * 16 + h) * 64 + p) * 2 + 1], ar = apow[((dir * 64 + p) * 33 + k) * 2], ai = apow[((dir * 64 + p) * 33 + k) * 2 + 1];
            const float br = bb[((dir * 64 + p) * 16 + hp) * 2], bi = bb[((dir * 64 + p) * 16 + hp) * 2 + 1]; const float wr = cr * ar - ci * ai, wi = cr * ai + ci * ar; s += wr * br - wi * bi; }
        km[idx] = s; }
    LDS_WAIT(); __syncthreads();
    bf16_t* WST = (bf16_t*)WSP(WS_WST) + (size_t)(e * 64 + g) * (S5NS * S5K1);
    bf16_t* TG = (bf16_t*)WSP(WS_TG) + (size_t)(e * 64 + g) * (S5K1 * S5K2);
    for (int idx = tid; idx < S5NS * S5K1 / 2; idx += NTHREADS) { const int k2 = (idx % (S5K1 / 2)) * 2, n = idx / (S5K1 / 2); const int dir = n >> 7, p = (n >> 1) & 63, ri = n & 1; const int j = k2 >> 4, hp = k2 & 15;
        const int ex = dir == 0 ? (LC - 1 - j) : j; const float ar = apow[((dir * 64 + p) * 33 + ex) * 2], ai = apow[((dir * 64 + p) * 33 + ex) * 2 + 1];
        float v[2];
#pragma unroll
        for (int q = 0; q < 2; ++q) { const float br = bb[((dir * 64 + p) * 16 + hp + q) * 2], bi = bb[((dir * 64 + p) * 16 + hp + q) * 2 + 1]; v[q] = ri == 0 ? (ar * br - ai * bi) : (ar * bi + ai * br); }
        *(unsigned*)(WST + (size_t)n * S5K1 + k2) = cvt_pk_bf16(v[0], v[1]); }
    for (int idx = tid; idx < S5K1 * S5K2 / 2; idx += NTHREADS) { const int k2 = (idx % (S5K2 / 2)) * 2, n = idx / (S5K2 / 2); const int i = n >> 4, h = n & 15; float v[2];
        if (k2 < S5K1) { const int j = k2 >> 4, hp = k2 & 15;
#pragma unroll
            for (int q = 0; q < 2; ++q) { float s = 0.f; if (j <= i) s += km[((0 * 32 + (i - j)) * 16 + h) * 16 + hp + q]; if (j >= i) s += km[((1 * 32 + (j - i)) * 16 + h) * 16 + hp + q]; if (i == j && h == hp + q) s += dsk[h]; v[q] = s; }
        } else { const int nn = k2 - S5K1, dir = nn >> 7, p = (nn >> 1) & 63; const int ex = dir == 0 ? (i + 1) : (LC - i);
            const float ar = apow[((dir * 64 + p) * 33 + ex) * 2], ai = apow[((dir * 64 + p) * 33 + ex) * 2 + 1], cr = cc[((dir * 16 + h) * 64 + p) * 2], ci = cc[((dir * 16 + h) * 64 + p) * 2 + 1];
            v[0] = cr * ar - ci * ai; v[1] = -(cr * ai + ci * ar); }
        *(unsigned*)(TG + (size_t)n * S5K2 + k2) = cvt_pk_bf16(v[0], v[1]); }
    f32x2* AL = (f32x2*)(WSP(WS_MISC) + MISC_AL);
    if (tid < 128) { const int dir = tid >> 6, p = tid & 63; AL[((e * 2 + dir) * 64 + g) * 64 + p] = (f32x2){apow[((dir * 64 + p) * 33 + LC) * 2], apow[((dir * 64 + p) * 33 + LC) * 2 + 1]}; }
    __syncthreads();
}

__device__ __forceinline__ void s5_scan_phase(const Frame& F, int e) {
    const float* SST = (const float*)POOLP(PL_SST); bf16_t* UX = (bf16_t*)POOLP(PL_UX);
    LAS f32x2* tot = (LAS f32x2*)F.lds;
    const int p = F.lane, w = F.wave;
    for (int item = F.bid; item < 2 * 2 * 64; item += F.G) {
        const int g = item & 63, dir = (item >> 6) & 1, seq = item >> 7;
        const f32x2 aL = ((const f32x2*)(WSP(WS_MISC) + MISC_AL))[((e * 2 + dir) * 64 + g) * 64 + p];
        const int c0 = seq ? NCH_P : 0, cs = seq ? 32 : 16;
        const int step = dir == 0 ? 1 : -1;
        const float* sbase = SST + (size_t)g * 256 + dir * 128 + 2 * p;
        bf16_t* xbase = UX + (size_t)g * NCH * S5K2 + S5K1 + dir * 128 + 2 * p;
#pragma unroll 1
        for (int q = 0; q < 2; ++q) { const int s = 2 * w + q; int c = c0 + s * cs + (dir == 0 ? 0 : cs - 1); float xr = 0.f, xi = 0.f;
#pragma unroll 1
            for (int it = 0; it < cs; it += 8) { f32x2 sv[8];
#pragma unroll
                for (int k = 0; k < 8; ++k) sv[k] = *(const f32x2*)(sbase + (size_t)(c + k * step) * (64 * 256));
#pragma unroll
                for (int k = 0; k < 8; ++k) { const float nr = aL.x * xr - aL.y * xi + sv[k].x, ni = aL.x * xi + aL.y * xr + sv[k].y; xr = nr; xi = ni; }
                c += 8 * step; }
            tot[s * 64 + p] = (f32x2){xr, xi}; }
        LDS_WAIT(); __syncthreads();
        float pr = aL.x, pi = aL.y;
        for (int k = cs; k > 1; k >>= 1) { const float nr = pr * pr - pi * pi, ni = 2.f * pr * pi; pr = nr; pi = ni; }
#pragma unroll 1
        for (int q = 0; q < 2; ++q) { const int s = 2 * w + q; float xr = 0.f, xi = 0.f;
            if (dir == 0) { for (int j = 0; j < s; ++j) { const f32x2 t = tot[j * 64 + p]; const float nr = pr * xr - pi * xi + t.x, ni = pr * xi + pi * xr + t.y; xr = nr; xi = ni; } }
            else { for (int j = 15; j > s; --j) { const f32x2 t = tot[j * 64 + p]; const float nr = pr * xr - pi * xi + t.x, ni = pr * xi + pi * xr + t.y; xr = nr; xi = ni; } }
            int c = c0 + s * cs + (dir == 0 ? 0 : cs - 1);
#pragma unroll 1
            for (int it = 0; it < cs; it += 8) { f32x2 sv[8];
#pragma unroll
                for (int k = 0; k < 8; ++k) sv[k] = *(const f32x2*)(sbase + (size_t)(c + k * step) * (64 * 256));
#pragma unroll
                for (int k = 0; k < 8; ++k) { *(unsigned*)(xbase + (size_t)(c + k * step) * S5K2) = cvt_pk_bf16(xr, xi);
                    const float nr = aL.x * xr - aL.y * xi + sv[k].x, ni = aL.x * xi + aL.y * xr + sv[k].y; xr = nr; xi = ni; }
                c += 8 * step; } }
        __syncthreads();
    }
}

__device__ __forceinline__ void qk_prep_phase(const Frame& F, int o) {
    bf16_t* Z = (bf16_t*)POOLP(PL_Z); bf16_t* KC = (bf16_t*)POOLP(PL_KC); const float* rope = (const float*)(WSP(WS_MISC) + MISC_ROPE);
    const float* qg = F.in[I_QN] + o * 128, *kg = F.in[I_KN] + o * 128;
    const int sub = F.lane >> 4, j = F.lane & 15;
    const long nrows = (long)TT * 20, gq = ((long)F.bid * NWAVES + F.wave) * 4 + sub, nq = (long)F.G * NWAVES * 4;
    for (long r = gq; r < nrows; r += nq) {
        const int t = (int)(r / 20), hh = (int)(r % 20);
        bf16_t* p = Z + (size_t)t * ZLD + (hh < 16 ? hh * 128 : 2048 + (hh - 16) * 128) + j * 8;
        const u32x4 w = *(const u32x4*)p; float v[8] = {bflo(w.x), bfhi(w.x), bflo(w.y), bfhi(w.y), bflo(w.z), bfhi(w.z), bflo(w.w), bfhi(w.w)};
        float s = 0.f;
#pragma unroll
        for (int q = 0; q < 8; ++q) s += v[q] * v[q];
        s += __shfl_xor(s, 1); s += __shfl_xor(s, 2); s += __shfl_xor(s, 4); s += __shfl_xor(s, 8);
        const float rstd = 1.0f / sqrtf(s * (1.f / 128.f) + EPS); const float* gg = (hh < 16 ? qg : kg) + j * 8;
        const int tl = t < T_P ? t : t - T_P; const int pos = (j < 8) ? (tl >> 6) : (tl & 63);
        const float* rp = rope + ((size_t)pos * 32 + 8 * (j & 3)) * 2;
        float ov[8]; const float osc = hh < 16 ? 0.12751743f : 1.0f;
#pragma unroll
        for (int q = 0; q < 8; ++q) { const float x = v[q] * rstd * gg[q]; const float y = __shfl_xor(x, 4); const float cs = rp[2 * q], sn = rp[2 * q + 1];
            ov[q] = ((j & 4) ? (x * cs + y * sn) : (x * cs - y * sn)) * osc; }
        u32x4 ow; ow.x = cvt_pk_bf16(ov[0], ov[1]); ow.y = cvt_pk_bf16(ov[2], ov[3]); ow.z = cvt_pk_bf16(ov[4], ov[5]); ow.w = cvt_pk_bf16(ov[6], ov[7]);
        *(u32x4*)p = ow;
    }
}

__device__ __forceinline__ void cross_softmax_phase(const Frame& F) {
    const float* CS = (const float*)POOLP(PL_CS); bf16_t* CP = (bf16_t*)POOLP(PL_CP);
    const long nrows = (long)TT * 4, gw = (long)F.bid * NWAVES + F.wave, NGW = (long)F.G * NWAVES;
    constexpr float C = 0.04419417382415922f * 1.4426950408889634f;
    for (long r = gw; r < nrows; r += NGW) {
        const f32x4 v = *((const f32x4*)(CS + r * 256) + F.lane);
        float m = fmaxf(fmaxf(v.x, v.y), fmaxf(v.z, v.w));
#pragma unroll
        for (int o = 1; o < 64; o <<= 1) m = fmaxf(m, __shfl_xor(m, o));
        const float e0 = fast_exp2((v.x - m) * C), e1 = fast_exp2((v.y - m) * C), e2 = fast_exp2((v.z - m) * C), e3 = fast_exp2((v.w - m) * C);
        const float inv = fast_rcp(wave_sum((e0 + e1) + (e2 + e3)));
        u32x2 w; w.x = cvt_pk_bf16(e0 * inv, e1 * inv); w.y = cvt_pk_bf16(e2 * inv, e3 * inv);
        *((u32x2*)(CP + r * 256) + F.lane) = w;
    }
}

__device__ __forceinline__ void prologue_phase(const Frame& F) {
    LAS float* scr = (LAS float*)(F.lds + F.wave * 16384);
    const int gw = F.bid * NWAVES + F.wave, NGW = F.G * NWAVES;
    constexpr int IT_GU = (DM / 64) * (2 * DFF / 32), IT_D = (DFF / 64) * (DM / 32), IT_WINE = (DM / 64) * (EVEN_IN / 32), IT_SQ = (DM / 64) * (DM / 32), IT_GLU = (S5W / 64) * (S5W / 32),
                  IT_WINO = (DM / 64) * (ODD_IN / 32), IT_KV = (DM / 64) * (2 * DM / 32);
    constexpr int N_GU = 8 * IT_GU, N_D = 8 * IT_D, N_WINE = 2 * IT_WINE, N_WOUTE = 2 * IT_SQ, N_GLU = 2 * IT_GLU, N_WINO = 2 * IT_WINO, N_WOUTO = 2 * IT_SQ, N_KV = 4 * IT_KV, N_WO = 4 * IT_SQ;
    constexpr int NITEMS = N_GU + N_D + N_WINE + N_WOUTE + N_GLU + N_WINO + N_WOUTO + N_KV + N_WO;
    for (int it = gw; it < NITEMS; it += NGW) {
        int r = it;
        if (r < N_GU) { const int w = r / IT_GU, l = w >> 1, f = w & 1; transpose_item<1>(F.in[f ? I_F2GU : I_F1GU] + (size_t)l * DM * 2 * DFF, DM, 2 * DFF, (bf16_t*)WSP(WS_WGU + w * SZ_WGU), scr, r % IT_GU, F.lane, F.in[f ? I_F2N : I_F1N] + l * DM); continue; } r -= N_GU;
        if (r < N_D) { const int w = r / IT_D, l = w >> 1, f = w & 1; transpose_item<0>(F.in[f ? I_F2D : I_F1D] + (size_t)l * DFF * DM, DFF, DM, (bf16_t*)WSP(WS_WD + w * SZ_WD), scr, r % IT_D, F.lane); continue; } r -= N_D;
        if (r < N_WINE) { const int e = r / IT_WINE; transpose_item<0>(F.in[I_EWIN] + (size_t)e * DM * EVEN_IN, DM, EVEN_IN, (bf16_t*)WSP(WS_WINE + e * SZ_WINE), scr, r % IT_WINE, F.lane, F.in[I_MIXN] + (2 * e) * DM); continue; } r -= N_WINE;
        if (r < N_WOUTE) { const int e = r / IT_SQ; transpose_item<0>(F.in[I_EWOUT] + (size_t)e * DM * DM, DM, DM, (bf16_t*)WSP(WS_WOUTE + e * SZ_SQ), scr, r % IT_SQ, F.lane); continue; } r -= N_WOUTE;
        if (r < N_GLU) { const int e = r / IT_GLU; transpose_item<0>(F.in[I_GLUW] + (size_t)e * S5W * S5W, S5W, S5W, (bf16_t*)WSP(WS_GLU + e * SZ_GLU), scr, r % IT_GLU, F.lane); continue; } r -= N_GLU;
        if (r < N_WINO) { const int o = r / IT_WINO; transpose_item<0>(F.in[I_OWIN] + (size_t)o * DM * ODD_IN, DM, ODD_IN, (bf16_t*)WSP(WS_WINO + o * SZ_WINO), scr, r % IT_WINO, F.lane, F.in[I_MIXN] + (2 * o + 1) * DM); continue; } r -= N_WINO;
        if (r < N_WOUTO) { const int o = r / IT_SQ; transpose_item<0>(F.in[I_OWOUT] + (size_t)o * DM * DM, DM, DM, (bf16_t*)WSP(WS_WOUTO + o * SZ_SQ), scr, r % IT_SQ, F.lane); continue; } r -= N_WOUTO;
        if (r < N_KV) { const int l = r / IT_KV; transpose_item<0>(F.in[I_CWKV] + (size_t)l * DM * 2 * DM, DM, 2 * DM, (bf16_t*)POOLP(PL_WKVT) + (size_t)l * 2 * DM * DM, scr, r % IT_KV, F.lane); continue; } r -= N_KV;
        { const int l = r / IT_SQ; transpose_item<0>(F.in[I_CWO] + (size_t)l * DM * DM, DM, DM, (bf16_t*)POOLP(PL_WOT) + (size_t)l * DM * DM, scr, r % IT_SQ, F.lane); }
    }
    convert_rows(F.in[I_CWQ], (bf16_t*)POOLP(PL_WQB), (size_t)4 * DM * DM / 8, (size_t)F.bid * NTHREADS + F.tid, (size_t)F.G * NTHREADS);
    for (int m = gw; m < 4 * 2 * NMEM; m += NGW) { const int l = m / (2 * NMEM), s = (m / NMEM) & 1, j = m % NMEM;
        rms_row_to_bf16(F.in[s ? I_MS : I_MP] + (size_t)j * DM, F.in[I_MN] + l * DM, (bf16_t*)POOLP(PL_MEMN) + (size_t)m * DM, nullptr, F.lane); }
    for (int m = gw; m < TT; m += NGW) { const float* src = m < T_P ? F.in[I_XP] + (size_t)m * DM : F.in[I_XS] + (size_t)(m - T_P) * DM;
        const f32x4* xr = (const f32x4*)src + F.lane; u32x2* bo = (u32x2*)((bf16_t*)WSP(WS_HB) + (size_t)m * DM) + F.lane; float s = 0.f;
        const int rr = m & 255, ai = rr >> 7, wr = (rr >> 6) & 1, mm = (rr >> 4) & 3, fr = rr & 15, cc = 4 * F.lane, bj = cc >> 7, wc = (cc >> 5) & 3, fq = (cc >> 3) & 3, n = (cc >> 2) & 1;
        unsigned* xl = (unsigned*)(WSP(WS_X) + (size_t)(m >> 8) * 8 * 65536) + ((size_t)((ai * 4 + mm) * 512 + (wr * 4 + wc) * 64 + fq * 16 + fr)) * 4 + bj * 2 + n;
#pragma unroll
        for (int j = 0; j < 8; ++j) { const f32x4 v = xr[64 * j]; unsigned a0, a1, lo; res_enc4(v, a0, a1, lo); bo[64 * j] = (u32x2){a0, a1}; xl[(size_t)j * 16384] = lo; s += (v.x * v.x + v.y * v.y) + (v.z * v.z + v.w * v.w); }
        s = wave_sum(s);
        if (F.lane < 8) ((float*)(WSP(WS_MISC) + MISC_PSS))[(size_t)m * 8 + F.lane] = F.lane == 0 ? s : 0.f; }
    { float* rope = (float*)(WSP(WS_MISC) + MISC_ROPE); const int gt = F.bid * NTHREADS + F.tid;
      if (gt < 256 * 32) { const int pos = gt >> 5, i = gt & 31; const float inv = powf(10000.0f, -(float)(2 * i) / 64.0f); float sn, cs; sincosf((float)pos * inv, &sn, &cs); rope[gt * 2] = cs; rope[gt * 2 + 1] = sn; }
      if (gt < 2) { float s1 = 0.f, s2 = 0.f; for (int q = 0; q < 64; ++q) { s1 += F.in[I_LQ1][gt * 64 + q] * F.in[I_LK1][gt * 64 + q]; s2 += F.in[I_LQ2][gt * 64 + q] * F.in[I_LK2][gt * 64 + q]; }
          const float linit = 0.8f - 0.6f * expf(-0.3f * (float)(2 * gt)); ((float*)(WSP(WS_MISC) + MISC_LAM))[gt * 2] = expf(s1) - expf(s2) + linit; ((float*)(WSP(WS_MISC) + MISC_LAM))[gt * 2 + 1] = linit; } }
}
__device__ __forceinline__ void s5_precompute_phase(const Frame& F) {
    for (int w = F.G - 1 - F.bid; w < 2 * S5G; w += F.G) s5_precompute_group(F, w / S5G, w % S5G);
}

#ifndef GQA_SDEPTH
#define GQA_SDEPTH 1
#endif
#ifndef DIFF_SDEPTH
#define DIFF_SDEPTH 1
#endif
#ifndef ATT_SETPRIO
#define ATT_SETPRIO 0
#endif
#if ATT_SETPRIO
#define ATT_PRIO(x) __builtin_amdgcn_s_setprio(x)
#else
#define ATT_PRIO(x) do {} while (0)
#endif
#ifndef FIXREF_LIMIT_GQA
#define FIXREF_LIMIT_GQA 40.0f
#define FIXREF_LIMIT_DIFF 20.0f
#endif
namespace att {
constexpr int NW = 8, QBLK = 32, KVBLK = 64, DV = 128;
constexpr float THR = 8.f;
__device__ __forceinline__ int crow(int r, int hi) { return (r & 3) + 8 * (r >> 2) + 4 * hi; }
template <int DQK> __device__ __forceinline__ int kswz(int row, int colB) { if (DQK == 128) return row * 256 + (colB ^ ((row & 7) << 4)); else return row * 128 + (colB ^ (((row >> 1) & 7) << 4)); }
__device__ __forceinline__ int v_st(int k, int c) { const int kk = (k & ~0xC) | ((k & 4) << 1) | ((k & 8) >> 1); return ((kk >> 3) * 4 + (c >> 5)) * 512 + ((kk & 7) * 32 + (c & 31)) * 2; }
__device__ __forceinline__ int v_rd_base(int lane) { return ((lane & 3) << 3) | (((lane >> 2) & 3) << 6) | (((lane >> 4) & 1) << 5) | (((lane >> 5) & 1) << 8); }
constexpr int v_rd_off(int d0, int ks, int half) { return d0 * 512 + ks * 4096 + half * 2048; }
template <int OFF> __device__ __forceinline__ s16x4 tr_read(int vb) { s16x4 r; asm volatile("ds_read_b64_tr_b16 %0, %1 offset:%2" : "=&v"(r) : "v"(vb), "i"(OFF) : "memory"); return r; }
template <int D0> __device__ __forceinline__ void pv_one(f32x16& od, int vb, bf16x8 pa0, bf16x8 pa1, bf16x8 pa2, bf16x8 pa3) {
  const s16x4 l0 = tr_read<v_rd_off(D0, 0, 0)>(vb), h0 = tr_read<v_rd_off(D0, 0, 1)>(vb), l1 = tr_read<v_rd_off(D0, 1, 0)>(vb), h1 = tr_read<v_rd_off(D0, 1, 1)>(vb);
  const s16x4 l2 = tr_read<v_rd_off(D0, 2, 0)>(vb), h2 = tr_read<v_rd_off(D0, 2, 1)>(vb), l3 = tr_read<v_rd_off(D0, 3, 0)>(vb), h3 = tr_read<v_rd_off(D0, 3, 1)>(vb);
  asm volatile("s_waitcnt lgkmcnt(0)" ::: "memory"); SBAR();
#define PK(L, H) (bf16x8){L[0], L[1], L[2], L[3], H[0], H[1], H[2], H[3]}
  ATT_PRIO(1);
  od = __builtin_amdgcn_mfma_f32_32x32x16_bf16(pa0, PK(l0, h0), od, 0, 0, 0);
  od = __builtin_amdgcn_mfma_f32_32x32x16_bf16(pa1, PK(l1, h1), od, 0, 0, 0);
  od = __builtin_amdgcn_mfma_f32_32x32x16_bf16(pa2, PK(l2, h2), od, 0, 0, 0);
  od = __builtin_amdgcn_mfma_f32_32x32x16_bf16(pa3, PK(l3, h3), od, 0, 0, 0);
  ATT_PRIO(0);
#undef PK
}
__device__ __forceinline__ void pv_d0(f32x16* o, int vb, bf16x8 pa0, bf16x8 pa1, bf16x8 pa2, bf16x8 pa3) {
  pv_one<0>(o[0], vb, pa0, pa1, pa2, pa3); pv_one<1>(o[1], vb, pa0, pa1, pa2, pa3); pv_one<2>(o[2], vb, pa0, pa1, pa2, pa3); pv_one<3>(o[3], vb, pa0, pa1, pa2, pa3);
}
template <int DQK> struct Cst { static constexpr float SCALE = DQK == 128 ? 0.088388347648318440f : 0.125f; static constexpr float C = SCALE * 1.4426950408889634f; };

template <int DQK, bool FIXED>
__device__ __forceinline__ void partialSM(f32x16& p0, f32x16& p1, float& m_reg, float& mn, float& alpha) {
  if (FIXED) { mn = 0.f; alpha = 1.f;
#pragma unroll
    for (int r = 0; r < 16; ++r) p0[r] = __builtin_amdgcn_exp2f(p0[r]);
    return; }
  constexpr float THR2 = THR * 1.4426950408889634f;
  float pmax = p0[0];
#pragma unroll
  for (int r = 1; r < 16; ++r) pmax = fmaxf(pmax, p0[r]);
#pragma unroll
  for (int r = 0; r < 16; ++r) pmax = fmaxf(pmax, p1[r]);
  { auto rr = __builtin_amdgcn_permlane32_swap(__float_as_uint(pmax), __float_as_uint(pmax), false, false);
    pmax = fmaxf(__uint_as_float(rr[0]), __uint_as_float(rr[1])); }
  if (__builtin_expect(__all(pmax - m_reg <= THR2), 1)) { mn = m_reg; alpha = 1.f; }
  else { mn = fmaxf(m_reg, pmax); alpha = __builtin_amdgcn_exp2f(m_reg - mn); m_reg = mn; }
#pragma unroll
  for (int r = 0; r < 16; ++r) p0[r] -= mn;
#pragma unroll
  for (int r = 0; r < 16; ++r) p1[r] -= mn;
#pragma unroll
  for (int r = 0; r < 16; ++r) p0[r] = __builtin_amdgcn_exp2f(p0[r]);
}
__device__ __forceinline__ void finishSM(f32x16& p0, f32x16& p1, float alpha, float& l_reg, bf16x8& pa0, bf16x8& pa1, bf16x8& pa2, bf16x8& pa3) {
#pragma unroll
  for (int r = 0; r < 16; ++r) p1[r] = __builtin_amdgcn_exp2f(p1[r]);
  float ps = 0;
#pragma unroll
  for (int r = 0; r < 16; ++r) ps += p0[r];
#pragma unroll
  for (int r = 0; r < 16; ++r) ps += p1[r];
  { auto rr = __builtin_amdgcn_permlane32_swap(__float_as_uint(ps), __float_as_uint(ps), false, false);
    ps = __uint_as_float(rr[0]) + __uint_as_float(rr[1]); }
  l_reg = l_reg * alpha + ps;
#define PK4(P, BASE, OUT) do { unsigned a0 = cvt_pk_bf16(P[BASE + 0], P[BASE + 1]), a1 = cvt_pk_bf16(P[BASE + 2], P[BASE + 3]);   \
    unsigned b0 = cvt_pk_bf16(P[BASE + 4], P[BASE + 5]), b1 = cvt_pk_bf16(P[BASE + 6], P[BASE + 7]);                              \
    auto r0 = __builtin_amdgcn_permlane32_swap(a0, b0, false, false); auto r1 = __builtin_amdgcn_permlane32_swap(a1, b1, false, false); \
    u32x4 w = {r0[0], r1[0], r0[1], r1[1]}; OUT = *reinterpret_cast<bf16x8*>(&w); } while (0)
  PK4(p0, 0, pa0); PK4(p0, 8, pa1); PK4(p1, 0, pa2); PK4(p1, 8, pa3);
#undef PK4
}
template <int DQK, bool ALIBI>
__device__ __forceinline__ void qkt(f32x16& p0, f32x16& p1, const char* Ks, const bf16x8* qr, int r32, int hi, float dq, float sl) {
  if (ALIBI) {
    float dh = dq - (float)(4 * hi); asm volatile("" : "+v"(dh));
    const float d0u = __uint_as_float(__builtin_amdgcn_readfirstlane(__float_as_uint(dq)));
    if (d0u >= 64.f || d0u <= -32.f) {
      const float s = d0u > 0.f ? sl : -sl, base = -s * dh;
#pragma unroll
      for (int r = 0; r < 16; ++r) { const float c = (float)((r & 3) + 8 * (r >> 2)); p0[r] = fmaf(s, c, base); p1[r] = fmaf(s, c + 32.f, base); }
    } else {
#pragma unroll
      for (int r = 0; r < 16; ++r) { const float c = (float)((r & 3) + 8 * (r >> 2)); p0[r] = -sl * fabsf(dh - c); p1[r] = -sl * fabsf(dh - (c + 32.f)); }
    }
  } else { p0 = f32x16{}; p1 = f32x16{}; }
  ATT_PRIO(1);
#pragma unroll
  for (int d0 = 0; d0 < DQK / 16; ++d0) { const int cb = (d0 * 16 + hi * 8) * 2;
    const bf16x8 b0 = *reinterpret_cast<const bf16x8*>(Ks + kswz<DQK>(r32, cb));
    const bf16x8 b1 = *reinterpret_cast<const bf16x8*>(Ks + kswz<DQK>(32 + r32, cb));
    p0 = __builtin_amdgcn_mfma_f32_32x32x16_bf16(b0, qr[d0], p0, 0, 0, 0);
    p1 = __builtin_amdgcn_mfma_f32_32x32x16_bf16(b1, qr[d0], p1, 0, 0, 0); }
  ATT_PRIO(0);
}

template <int DQK, bool ALIBI, int SDEPTH, int LDKV, bool FIXED>
__device__ __forceinline__ void attn_pass(const bf16_t* __restrict__ Qw, const bf16_t* __restrict__ Kh, const bf16_t* __restrict__ Vh, int seq, char* lds, f32x16 (&o)[4], float qpos, float sl, int tid, const float mfix) {
  constexpr int SHM_V = KVBLK * DV * 2, SHM_K = KVBLK * DQK * 2;
  const int wid = tid >> 6, lane = tid & 63, r32 = lane & 31, hi = lane >> 5;
  char* V_lds = lds; char* K_lds = lds + 2 * SHM_V;
  float* ws = (float*)(lds + 2 * SHM_V + 2 * SHM_K) + wid * 64; float* li_l = ws; float* al_l = ws + 32;
  float m_reg = -1e30f, l_reg = 0; bf16x8 qr[DQK / 16];
#pragma unroll
  for (int d0 = 0; d0 < 4; ++d0) o[d0] = f32x16{};
#pragma unroll
  for (int d0 = 0; d0 < DQK / 16; ++d0) qr[d0] = *reinterpret_cast<const bf16x8*>(Qw + d0 * 16);
  const int sr = tid >> 4, sc = (tid & 15) * 8, vst0 = v_st(sr, sc), vst1 = v_st(32 + sr, sc);
  const int kr = DQK == 128 ? sr : (tid >> 3), kc = DQK == 128 ? sc : (tid & 7) * 8;
  const int vb0 = (int)(uintptr_t)V_lds + v_rd_base(lane);
  struct { bf16x8 vs0, vs1, ks0, ks1; } sr_[SDEPTH];
#define SLOAD(i, k0) do { sr_[i].vs0 = *(const bf16x8*)(Vh + (size_t)((k0) + sr) * LDKV + sc); sr_[i].vs1 = *(const bf16x8*)(Vh + (size_t)((k0) + 32 + sr) * LDKV + sc); \
    sr_[i].ks0 = *(const bf16x8*)(Kh + (size_t)((k0) + kr) * LDKV + kc); if (DQK == 128) sr_[i].ks1 = *(const bf16x8*)(Kh + (size_t)((k0) + 32 + kr) * LDKV + kc); } while (0)
#define SWRITE(b, i) do { *(bf16x8*)(V_lds + (b) * SHM_V + vst0) = sr_[i].vs0; *(bf16x8*)(V_lds + (b) * SHM_V + vst1) = sr_[i].vs1; \
    *(bf16x8*)(K_lds + (b) * SHM_K + kswz<DQK>(kr, kc * 2)) = sr_[i].ks0; if (DQK == 128) *(bf16x8*)(K_lds + (b) * SHM_K + kswz<DQK>(32 + kr, kc * 2)) = sr_[i].ks1; } while (0)
#define SWAIT() do { if (SDEPTH == 1) asm volatile("s_waitcnt vmcnt(0)" ::: "memory"); else if (DQK == 128) asm volatile("s_waitcnt vmcnt(4)" ::: "memory"); else asm volatile("s_waitcnt vmcnt(3)" ::: "memory"); } while (0)
#define RESC(a) do { if (!FIXED && __any((a) < 1.f)) { if (hi == 0) al_l[r32] = (a); asm volatile("s_waitcnt lgkmcnt(0)" ::: "memory"); \
    _Pragma("unroll") for (int d = 0; d < 4; ++d) _Pragma("unroll") for (int r = 0; r < 16; ++r) o[d][r] *= al_l[crow(r, hi)]; } } while (0)
  f32x16 pA0, pA1, pB0, pB1; float mnA, mnB, alA, alB; bf16x8 pa0, pa1, pa2, pa3; const int NT = seq / KVBLK;
  constexpr int SE = 0, SO = SDEPTH - 1;
  SLOAD(SE, 0); asm volatile("s_waitcnt vmcnt(0)" ::: "memory"); SWRITE(0, SE); __syncthreads();
  qkt<DQK, ALIBI>(pA0, pA1, K_lds, qr, r32, hi, qpos, sl); partialSM<DQK, FIXED>(pA0, pA1, m_reg, mnA, alA);
  SLOAD(SO, KVBLK); if (SDEPTH == 2) { if (2 < NT) SLOAD(SE, 2 * KVBLK); }
  SWAIT(); SWRITE(1, SO); __syncthreads();
  _Pragma("unroll 1") for (int j = 1; j + 1 < NT; j += 2) {
    SBAR(); qkt<DQK, ALIBI>(pB0, pB1, K_lds + SHM_K, qr, r32, hi, qpos - (float)(j * KVBLK), sl);
    finishSM(pA0, pA1, alA, l_reg, pa0, pa1, pa2, pa3); SBAR();
    SLOAD(SO, (j + SDEPTH) * KVBLK); SBAR();
    pv_d0(o, vb0, pa0, pa1, pa2, pa3); partialSM<DQK, FIXED>(pB0, pB1, m_reg, mnB, alB);
    __syncthreads(); SWAIT(); SWRITE(0, SE);
    RESC(alB); __syncthreads();
    SBAR(); qkt<DQK, ALIBI>(pA0, pA1, K_lds, qr, r32, hi, qpos - (float)((j + 1) * KVBLK), sl);
    finishSM(pB0, pB1, alB, l_reg, pa0, pa1, pa2, pa3); SBAR();
    if (SDEPTH == 1 || j + 3 < NT) SLOAD(SE, (j + 1 + SDEPTH) * KVBLK); SBAR();
    pv_d0(o, vb0 + SHM_V, pa0, pa1, pa2, pa3); partialSM<DQK, FIXED>(pA0, pA1, m_reg, mnA, alA);
    __syncthreads(); SWAIT(); SWRITE(1, SO);
    RESC(alA); __syncthreads();
  }
  SBAR(); qkt<DQK, ALIBI>(pB0, pB1, K_lds + SHM_K, qr, r32, hi, qpos - (float)((NT - 1) * KVBLK), sl);
  finishSM(pA0, pA1, alA, l_reg, pa0, pa1, pa2, pa3); SBAR();
  pv_d0(o, vb0, pa0, pa1, pa2, pa3); partialSM<DQK, FIXED>(pB0, pB1, m_reg, mnB, alB);
  __syncthreads(); RESC(alB);
  finishSM(pB0, pB1, alB, l_reg, pa0, pa1, pa2, pa3); SBAR();
  pv_d0(o, vb0 + SHM_V, pa0, pa1, pa2, pa3);
  if (hi == 0) li_l[r32] = l_reg; asm volatile("s_waitcnt lgkmcnt(0)" ::: "memory");
#pragma unroll
  for (int r = 0; r < 16; ++r) { const float rl = __builtin_amdgcn_rcpf(li_l[crow(r, hi)]);
#pragma unroll
    for (int d0 = 0; d0 < 4; ++d0) o[d0][r] *= rl; }
#undef SLOAD
#undef SWRITE
#undef SWAIT
#undef RESC
}
template <int DQK, bool ALIBI, int LDKV, bool FIXED>
__device__ __forceinline__ void attn_pass3(const bf16_t* __restrict__ Qw, const bf16_t* __restrict__ Kh, const bf16_t* __restrict__ Vh, int seq, char* lds, f32x16 (&o)[4], float qpos, float sl, int tid, const float mfix) {
  constexpr int SHM_V = KVBLK * DV * 2, SHM_K = KVBLK * DQK * 2;
  const int wid = tid >> 6, lane = tid & 63, r32 = lane & 31, hi = lane >> 5;
  char* V_lds = lds; char* K_lds = lds + 3 * SHM_V;
  float* ws = (float*)(lds + 3 * SHM_V + 3 * SHM_K) + wid * 64; float* li_l = ws; float* al_l = ws + 32;
  float m_reg = -1e30f, l_reg = 0; bf16x8 qr[DQK / 16];
#pragma unroll
  for (int d0 = 0; d0 < 4; ++d0) o[d0] = f32x16{};
#pragma unroll
  for (int d0 = 0; d0 < DQK / 16; ++d0) qr[d0] = *reinterpret_cast<const bf16x8*>(Qw + d0 * 16);
  const int sr = tid >> 4, sc = (tid & 15) * 8, vst0 = v_st(sr, sc), vst1 = v_st(32 + sr, sc);
  const int kr = DQK == 128 ? sr : (tid >> 3), kc = DQK == 128 ? sc : (tid & 7) * 8;
  const int vb0 = (int)(uintptr_t)V_lds + v_rd_base(lane);
  bf16x8 vs0, vs1, ks0, ks1;
#define SLOAD(k0) do { vs0 = *(const bf16x8*)(Vh + (size_t)((k0) + sr) * LDKV + sc); vs1 = *(const bf16x8*)(Vh + (size_t)((k0) + 32 + sr) * LDKV + sc); \
    ks0 = *(const bf16x8*)(Kh + (size_t)((k0) + kr) * LDKV + kc); if (DQK == 128) ks1 = *(const bf16x8*)(Kh + (size_t)((k0) + 32 + kr) * LDKV + kc); } while (0)
#define SWRITE(b) do { *(bf16x8*)(V_lds + (b) * SHM_V + vst0) = vs0; *(bf16x8*)(V_lds + (b) * SHM_V + vst1) = vs1; \
    *(bf16x8*)(K_lds + (b) * SHM_K + kswz<DQK>(kr, kc * 2)) = ks0; if (DQK == 128) *(bf16x8*)(K_lds + (b) * SHM_K + kswz<DQK>(32 + kr, kc * 2)) = ks1; } while (0)
#define RESC(a) do { if (!FIXED && __any((a) < 1.f)) { if (hi == 0) al_l[r32] = (a); asm volatile("s_waitcnt lgkmcnt(0)" ::: "memory"); \
    _Pragma("unroll") for (int d = 0; d < 4; ++d) _Pragma("unroll") for (int r = 0; r < 16; ++r) o[d][r] *= al_l[crow(r, hi)]; } } while (0)
  f32x16 pA0, pA1, pB0, pB1; float mnA, mnB, alA, alB; bf16x8 pa0, pa1, pa2, pa3; const int NT = seq / KVBLK;
  __syncthreads();
  SLOAD(0); asm volatile("s_waitcnt vmcnt(0)" ::: "memory"); SWRITE(0);
  SLOAD(KVBLK); asm volatile("s_waitcnt vmcnt(0)" ::: "memory"); SWRITE(1);
  if (2 < NT) SLOAD(2 * KVBLK);
  __syncthreads();
  qkt<DQK, ALIBI>(pA0, pA1, K_lds, qr, r32, hi, qpos, sl); partialSM<DQK, FIXED>(pA0, pA1, m_reg, mnA, alA);
  int s0 = 0, s1 = 1, s2 = 2;
#define ITER(PC0, PC1, mnC, alC, PP0, PP1, alP, t, DO_WRITE, DO_LOAD) do { \
    if (DO_WRITE) { asm volatile("s_waitcnt vmcnt(0)" ::: "memory"); SWRITE(s2); } \
    SBAR(); qkt<DQK, ALIBI>(PC0, PC1, K_lds + s1 * SHM_K, qr, r32, hi, qpos - (float)((t) * KVBLK), sl); \
    finishSM(PP0, PP1, alP, l_reg, pa0, pa1, pa2, pa3); SBAR(); \
    if (DO_LOAD) SLOAD(((t) + 2) * KVBLK); SBAR(); \
    pv_d0(o, vb0 + s0 * SHM_V, pa0, pa1, pa2, pa3); partialSM<DQK, FIXED>(PC0, PC1, m_reg, mnC, alC); \
    RESC(alC); __syncthreads(); \
    { const int t_ = s0; s0 = s1; s1 = s2; s2 = t_; } } while (0)
  _Pragma("unroll 1") for (int t = 1; t + 2 < NT; t += 2) {
    ITER(pB0, pB1, mnB, alB, pA0, pA1, alA, t, true, true);
    ITER(pA0, pA1, mnA, alA, pB0, pB1, alB, t + 1, true, (t + 3 < NT));
  }
  ITER(pB0, pB1, mnB, alB, pA0, pA1, alA, NT - 1, false, false);
  finishSM(pB0, pB1, alB, l_reg, pa0, pa1, pa2, pa3); SBAR();
  pv_d0(o, vb0 + s0 * SHM_V, pa0, pa1, pa2, pa3);
  if (hi == 0) li_l[r32] = l_reg; asm volatile("s_waitcnt lgkmcnt(0)" ::: "memory");
#pragma unroll
  for (int r = 0; r < 16; ++r) { const float rl = __builtin_amdgcn_rcpf(li_l[crow(r, hi)]);
#pragma unroll
    for (int d0 = 0; d0 < 4; ++d0) o[d0][r] *= rl; }
#undef ITER
#undef SLOAD
#undef SWRITE
#undef RESC
}
}

__device__ __forceinline__ void gqa_attn_phase(const Frame& F, int o) {
    const bf16_t* Z = (const bf16_t*)POOLP(PL_Z); bf16_t* CAT = (bf16_t*)POOLP(PL_CAT);
    constexpr int NU_S = 16 * (T_S / 256), NU = NU_S + 16 * (T_P / 256);
    float mfix; { const float* qg = F.in[I_QN] + o * 128, *kg = F.in[I_KN] + o * 128; float a = fmaxf(fabsf(qg[F.lane]), fabsf(qg[F.lane + 64])), b = fmaxf(fabsf(kg[F.lane]), fabsf(kg[F.lane + 64]));
#pragma unroll
        for (int s = 1; s < 64; s <<= 1) { a = fmaxf(a, __shfl_xor(a, s)); b = fmaxf(b, __shfl_xor(b, s)); }
        mfix = 128.0f * 1.01f * a * b * 0.0883883476f;
        if (!(mfix < FIXREF_LIMIT_GQA)) mfix = -1.0f; }
    for (int L = F.bid; L < NU; L += F.G) {
        int tid = threadIdx.x; asm volatile("" : "+v"(tid));
        const int lane = tid & 63, r32 = lane & 31, hi = lane >> 5, wid = tid >> 6;
        int seq, head, qb;
        if (L < NU_S) { const int x = L & 7, r = L >> 3, kvh = x & 3, half = x >> 2; seq = 1; head = kvh * 4 + (r & 3); qb = half * 32 + (r >> 2); }
        else { const int Lp = L - NU_S, x = Lp & 7, r = Lp >> 3, kvh = x & 3, half = x >> 2; seq = 0; head = kvh * 4 + (r & 3); qb = half * 16 + (r >> 2); }
        const int t0 = seq ? T_P : 0, slen = seq ? T_S : T_P, kvh = head >> 2;
        const bf16_t* Qw = Z + (size_t)(t0 + qb * 256 + wid * 32 + r32) * ZLD + head * 128 + hi * 8;
        const bf16_t* Kh = Z + (size_t)t0 * ZLD + 2048 + kvh * 128; const bf16_t* Vh = Z + (size_t)t0 * ZLD + 2560 + kvh * 128;
        f32x16 ov[4];
        if (mfix >= 0.f) att::attn_pass<128, false, GQA_SDEPTH, ZLD, true>(Qw, Kh, Vh, slen, F.ldsg, ov, 0.f, 0.f, tid, mfix);
        else att::attn_pass<128, false, GQA_SDEPTH, ZLD, false>(Qw, Kh, Vh, slen, F.ldsg, ov, 0.f, 0.f, tid, mfix);
        bf16_t* Ow = CAT + (size_t)(t0 + qb * 256 + wid * 32) * DM + head * 128;
#pragma unroll
        for (int r = 0; r < 16; ++r) { const int orow = att::crow(r, hi);
#pragma unroll
            for (int d0 = 0; d0 < 4; ++d0) Ow[(size_t)orow * DM + d0 * 32 + r32] = f2bf(ov[d0][r]); }
    }
}

__device__ __forceinline__ void qk_bound_pass(const Frame& F, int e) {
    const bf16_t* Z = (const bf16_t*)POOLP(PL_Z); unsigned* ctl = (unsigned*)WSP(WS_CTL) + CW_QKB + e * 64;
    const int gw = F.bid * NWAVES + F.wave, NGW = F.G * NWAVES, lane = F.lane;
    float mx[2][2] = {{0.f, 0.f}, {0.f, 0.f}};
    for (int t = gw; t < TT; t += NGW) {
        const bf16_t* row = Z + (size_t)t * ZLD + lane * 16;
#pragma unroll
        for (int qk = 0; qk < 2; ++qk) { const u32x4 a = *(const u32x4*)(row + qk * 1024), b = *(const u32x4*)(row + qk * 1024 + 8);
            float s = bflo(a.x) * bflo(a.x) + bfhi(a.x) * bfhi(a.x) + bflo(a.y) * bflo(a.y) + bfhi(a.y) * bfhi(a.y) + bflo(a.z) * bflo(a.z) + bfhi(a.z) * bfhi(a.z) + bflo(a.w) * bflo(a.w) + bfhi(a.w) * bfhi(a.w)
                    + bflo(b.x) * bflo(b.x) + bfhi(b.x) * bfhi(b.x) + bflo(b.y) * bflo(b.y) + bfhi(b.y) * bfhi(b.y) + bflo(b.z) * bflo(b.z) + bfhi(b.z) * bfhi(b.z) + bflo(b.w) * bflo(b.w) + bfhi(b.w) * bfhi(b.w);
            s += __shfl_xor(s, 1); s += __shfl_xor(s, 2);
            if (t < T_P) mx[0][qk] = fmaxf(mx[0][qk], s); else mx[1][qk] = fmaxf(mx[1][qk], s); }
    }
    LAS float* red = (LAS float*)F.lds;
    if ((lane & 3) == 0) {
#pragma unroll
        for (int sq = 0; sq < 2; ++sq)
#pragma unroll
            for (int qk = 0; qk < 2; ++qk) red[(F.wave * 4 + sq * 2 + qk) * 16 + (lane >> 2)] = mx[sq][qk]; }
    LDS_WAIT(); __syncthreads();
    if (F.tid < 64) { float m = 0.f;
#pragma unroll
        for (int w = 0; w < 8; ++w) m = fmaxf(m, red[w * 64 + F.tid]);
        atomicMax(ctl + F.tid, __float_as_uint(m)); }
    __syncthreads();
}

__device__ __forceinline__ void diff_attn_phase(const Frame& F, int e, int rep = 0) {
    const bf16_t* Z = (const bf16_t*)POOLP(PL_Z); bf16_t* CAT = (bf16_t*)POOLP(PL_CAT); float* ST = (float*)POOLP(PL_STASH);
    const float lam = ((const float*)(WSP(WS_MISC) + MISC_LAM))[e * 2], linit = ((const float*)(WSP(WS_MISC) + MISC_LAM))[e * 2 + 1];
    const float* sg = F.in[I_SUBLN] + e * 128;
    unsigned* ctl = (unsigned*)WSP(WS_CTL); const unsigned* qkb = ctl + CW_QKB + e * 64; unsigned* qctr = ctl + CW_QUEUE + e * 64 + rep * 256;
    constexpr int NU = 8 * (T_S / 256) + 8 * (T_P / 256);
    LAS int* uslot = (LAS int*)(F.lds + RING_BYTES + 64);
    for (;;) {
        __syncthreads();
        if (threadIdx.x == 0) *uslot = (int)__hip_atomic_fetch_add(qctr, 1u, RLX_AGENT);
        LDS_WAIT(); __syncthreads();
        const int u = __builtin_amdgcn_readfirstlane(*uslot);
        if (u >= NU) break;
        int tid = threadIdx.x; asm volatile("" : "+v"(tid));
        const int lane = tid & 63, r32 = lane & 31, hi = lane >> 5, wid = tid >> 6;
        f32x4* st = (f32x4*)ST + ((size_t)F.bid * NTHREADS + tid) * 16;
        const int head = 7 - u / 96, rr = u % 96, seq = rr < 64 ? 1 : 0, qb = seq ? rr : rr - 64;
        const int t0 = seq ? T_P : 0, slen = seq ? T_S : T_P;
        const float slope = exp2f(-(float)(head + 1)), sl = slope * 1.4426950408889634f;
        const bf16_t* Vh = Z + (size_t)t0 * ZLD + 2048 + head * 128;
        f32x16 o[4];
        for (int m = 0; m < 2; ++m) {
            const float q2 = __uint_as_float(__hip_atomic_load(qkb + (seq * 2 + 0) * 16 + head * 2 + m, RLX_AGENT)), k2 = __uint_as_float(__hip_atomic_load(qkb + (seq * 2 + 1) * 16 + head * 2 + m, RLX_AGENT));
            const float qk = sqrtf(q2 * k2) * 1.001f * 0.6931471805599453f;
            const float Bnd = 2.0f * qk + 32.0f;
            const float mfix = (qk < FIXREF_LIMIT_DIFF) ? qk : -1.0f;
            float Wf = Bnd / slope; if (!(Wf < (float)slen)) Wf = (float)slen;
            const int W = (int)Wf + 1;
            int tlo = (qb * 256 - W) >> 6; if (tlo < 0) tlo = 0;
            int thi = (qb * 256 + 256 + W + 63) >> 6; if (thi > slen / 64) thi = slen / 64;
            if ((thi - tlo) & 1) { if (thi < slen / 64) ++thi; else --tlo; }
            tlo = __builtin_amdgcn_readfirstlane(tlo); thi = __builtin_amdgcn_readfirstlane(thi);
            const float qpos = (float)(qb * 256 + wid * 32 + r32 - tlo * 64);
            const bf16_t* Qw = Z + (size_t)(t0 + qb * 256 + wid * 32 + r32) * ZLD + head * 128 + m * 64 + hi * 8;
            const bf16_t* Kh = Z + (size_t)(t0 + tlo * 64) * ZLD + 1024 + head * 128 + m * 64;
            if (mfix >= 0.f) att::attn_pass<64, true, DIFF_SDEPTH, ZLD, true>(Qw, Kh, Vh + (size_t)(tlo * 64) * ZLD, (thi - tlo) * 64, F.ldsg, o, qpos, sl, tid, mfix);
            else att::attn_pass<64, true, DIFF_SDEPTH, ZLD, false>(Qw, Kh, Vh + (size_t)(tlo * 64) * ZLD, (thi - tlo) * 64, F.ldsg, o, qpos, sl, tid, mfix);
            if (m == 0) {
#pragma unroll
                for (int d0 = 0; d0 < 4; ++d0)
#pragma unroll
                    for (int q = 0; q < 4; ++q) st[d0 * 4 + q] = (f32x4){o[d0][4 * q], o[d0][4 * q + 1], o[d0][4 * q + 2], o[d0][4 * q + 3]};
            }
        }
        float ss[16];
#pragma unroll
        for (int r = 0; r < 16; ++r) ss[r] = 0.f;
#pragma unroll
        for (int d0 = 0; d0 < 4; ++d0) {
#pragma unroll
            for (int q = 0; q < 4; ++q) { const f32x4 s4 = st[d0 * 4 + q];
#pragma unroll
                for (int i = 0; i < 4; ++i) { const int r = 4 * q + i; const float a = s4[i] - lam * o[d0][r]; o[d0][r] = a; ss[r] += a * a; } }
            asm volatile("" ::: "memory"); }
#pragma unroll
        for (int r = 0; r < 16; ++r) { float s = ss[r]; s += __shfl_xor(s, 1); s += __shfl_xor(s, 2); s += __shfl_xor(s, 4); s += __shfl_xor(s, 8); s += __shfl_xor(s, 16);
            ss[r] = (1.0f - linit) / sqrtf(s * (1.f / 128.f) + SUBLN_EPS); }
        bf16_t* Ow = CAT + (size_t)(t0 + qb * 256 + wid * 32) * DM + 1024 + head * 128;
#pragma unroll
        for (int d0 = 0; d0 < 4; ++d0) { const float gcol = sg[d0 * 32 + r32];
#pragma unroll
            for (int r = 0; r < 16; ++r) Ow[(size_t)att::crow(r, hi) * DM + d0 * 32 + r32] = f2bf(o[d0][r] * ss[r] * gcol); }
    }
}

constexpr int PH_BASE = 3, PH_PER = 16, PH_END = PH_BASE + 8 * PH_PER - 1;
__host__ __device__ inline bool phase_exists(int pid) {
    if (pid < PH_BASE) return true;
    const int hl = (pid - PH_BASE) / PH_PER, k = (pid - PH_BASE) % PH_PER, f = hl & 1, l = hl >> 1;
    if (k <= 1) return true;
    if (k == 14) return hl == 7;
    if (k == 15 || f == 1 || k == 2 || k == 10 || k == 12) return false;
    if ((l & 1) && (k == 6 || k == 7 || k == 8)) return false;
    return true;
}

__device__ __forceinline__ bool fresh_frame(Frame& F) { int t = threadIdx.x; asm volatile("" : "+v"(t)); F.tid = t; F.lane = t & 63; F.wave = __builtin_amdgcn_readfirstlane(t >> 6); return true; }
#ifndef GU_WGM
#define GU_WGM 4
#endif
__global__ void __launch_bounds__(NTHREADS, 2) fwd_kernel(Args args) {
    extern __shared__ __attribute__((aligned(16))) unsigned char lds[];
    Frame F;
    F.lds = (LAS unsigned char*)lds; F.ldsg = (char*)lds;
    F.MISC = (volatile LAS unsigned*)(F.lds + MISC_OFF);
    F.tid = threadIdx.x; F.lane = F.tid & 63; F.wave = __builtin_amdgcn_readfirstlane(F.tid >> 6);
    F.G = gridDim.x; F.bid = blockIdx.x; F.in = args.in; F.x = args.out; F.ws = args.ws;
    for (int u = F.tid; u < (LDS_BYTES - RING_BYTES) / 4; u += NTHREADS) ((LAS unsigned*)(F.lds + RING_BYTES))[u] = 0u;
    __syncthreads();
    XcdBarrier bar = xcd_barrier_post((unsigned*)(F.ws + WS_CTL) + CW_BAR + args.li * XCD_BAR_WORDS, F.MISC + 8);
    const int lo = args.ph_lo, hi = args.ph_hi;
#define PH(p) (lo <= (p) && (p) < hi && fresh_frame(F))
#define ENDPH(p) do { if ((p) + 1 < hi) xcd_barrier(bar); } while (0)
    float* const PSS = (float*)(F.ws + WS_MISC + MISC_PSS);
    const int rep = args.pad;
#ifdef PROBE_K
#define RSCALE(s) (rep == 0 ? (s) : 0.0f)
#else
#define RSCALE(s) (s)
#endif

    if (PH(0)) { prologue_phase(F); ENDPH(0); }
    if (PH(1)) {
        auto S = make_sched(F, POOLP(PL_MEMN), DM, POOLP(PL_WKVT), DM, 256, 2 * DM, 8, ZKv{});
        EpiBf16<0> E{(bf16_t*)POOLP(PL_KVB), 2 * DM, (size_t)256 * 2 * DM, 0, 0, nullptr, nullptr, nullptr};
        pg8::gemm_phase(F.lds, DM, DM, DM, S, E, F.tid);
        s5_precompute_phase(F); ENDPH(1);
    }
    if (PH(2)) {
        { auto S = make_sched(F, POOLP(PL_KVB), 2 * DM, POOLP(PL_WQB), DM, 256, DM, 32, ZKf{});
          EpiBf16<2> E{(bf16_t*)WSP(WS_KF), DM, (size_t)256 * DM, 0, 0, F.in[I_CN], nullptr, nullptr};
          pg8::gemm_phase(F.lds, 2 * DM, DM, 512, S, E, F.tid); }
        { auto S = make_sched(F, POOLP(PL_WOT), DM, POOLP(PL_KVB), 2 * DM, DM, 256, 32, ZVw{});
          EpiBf16<0> E{(bf16_t*)WSP(WS_VWT), 1024, (size_t)DM * 1024, 256, 2, nullptr, nullptr, nullptr};
          pg8::gemm_phase(F.lds, DM, 2 * DM, 512, S, E, F.tid); }
        ENDPH(2);
    }
    for (int hl = 0; hl < 8; ++hl) {
        const int l = hl >> 1, f = hl & 1, pb = PH_BASE + hl * PH_PER, eo = l >> 1;
        const bool even = (l & 1) == 0;
        if (PH(pb + 0)) {
            auto S = make_sched(F, WSP(WS_HB), DM, WSP(WS_WGU + (size_t)hl * SZ_WGU), DM, TT, 2 * DFF, 1, ZNone{}); S.wgm = GU_WGM;
            EpiSwiglu E{F.ws, DFF, F.lds};
            pg8::gemm_phase(F.lds, DM, DM, DM, S, E, F.tid);
            ENDPH(pb + 0);
        }
        if (PH(pb + 1)) {
            auto S = make_sched(F, POOLP(PL_ACT), DFF, WSP(WS_WD + (size_t)hl * SZ_WD), DFF, TT, DM, 1, ZNone{});
            { EpiResidNorm E{RSCALE(0.5f), F.ws, (LAS float*)(F.lds + EXCH_OFF)}; pg8::gemm_phase(F.lds, DFF, DFF, DFF, S, E, F.tid); }
            ENDPH(pb + 1);
        }
        if (f == 0) {
            if (even) {
                if (PH(pb + 3)) {
                    auto S = make_sched(F, WSP(WS_HB), DM, WSP(WS_WINE + (size_t)eo * SZ_WINE), DM, TT, EVEN_IN, 1, ZNone{});
                    EpiWinEven E{F.ws, F.lds};
                    pg8::gemm_phase(F.lds, DM, DM, DM, S, E, F.tid);
                    ENDPH(pb + 3);
                }
                if (PH(pb + 4)) {
                    auto S = make_sched(F, POOLP(PL_UX), S5K2, WSP(WS_WST + (size_t)eo * 64 * SZ_WST), S5K1, NCH, S5NS, S5G, ZLin{(size_t)NCH * S5K2 * 2, SZ_WST});
                    EpiF32 E{(float*)POOLP(PL_SST), S5G * S5NS, (size_t)S5NS};
                    pg8::gemm_phase(F.lds, S5K2, S5K1, S5K1, S, E, F.tid);
                    qk_bound_pass(F, eo); ENDPH(pb + 4);
                }
                if (PH(pb + 5)) { s5_scan_phase(F, eo); ENDPH(pb + 5); }
                if (PH(pb + 6)) {
                    auto S = make_sched(F, POOLP(PL_UX), S5K2, WSP(WS_TG + (size_t)eo * 64 * SZ_TG), S5K2, NCH, S5K1, S5G, ZLin{(size_t)NCH * S5K2 * 2, SZ_TG});
                    EpiS5Out E{(bf16_t*)POOLP(PL_GB)};
                    pg8::gemm_phase(F.lds, S5K2, S5K2, S5K2, S, E, F.tid); ENDPH(pb + 6);
                }
                if (PH(pb + 7)) {
                    auto S = make_sched(F, POOLP(PL_GB), S5W, WSP(WS_GLU + (size_t)eo * SZ_GLU), S5W, TT, S5W, 1, ZNone{});
                    EpiGlu E{(const bf16_t*)POOLP(PL_GB), F.in[I_GLUB] + eo * S5W, (bf16_t*)POOLP(PL_CAT)};
                    pg8::gemm_phase(F.lds, S5W, S5W, S5W, S, E, F.tid);
                    if (!PH(pb + 8)) ENDPH(pb + 7);
                }
                if (PH(pb + 8)) { diff_attn_phase(F, eo, rep); ENDPH(pb + 8); }
            } else {
                if (PH(pb + 3)) {
                    auto S = make_sched(F, WSP(WS_HB), DM, WSP(WS_WINO + (size_t)eo * SZ_WINO), DM, TT, ODD_IN, 1, ZNone{});
                    EpiBf16<1> E{(bf16_t*)POOLP(PL_Z), ZLD, 0, 0, 0, nullptr, F.ws, F.lds};
                    pg8::gemm_phase(F.lds, DM, DM, DM, S, E, F.tid); ENDPH(pb + 3);
                }
                if (PH(pb + 4)) { qk_prep_phase(F, eo); ENDPH(pb + 4); }
                if (PH(pb + 5)) { gqa_attn_phase(F, eo); ENDPH(pb + 5); }
            }
            if (PH(pb + 9)) {
                auto S = make_sched(F, POOLP(PL_CAT), DM, even ? WSP(WS_WOUTE + (size_t)eo * SZ_SQ) : WSP(WS_WOUTO + (size_t)eo * SZ_SQ), DM, TT, DM, 1, ZNone{});
                    { EpiResidNorm E{RSCALE(1.0f), F.ws, (LAS float*)(F.lds + EXCH_OFF)}; pg8::gemm_phase(F.lds, DM, DM, DM, S, E, F.tid); }
                ENDPH(pb + 9);
            }
            if (PH(pb + 11)) {
                auto S = make_sched(F, WSP(WS_HB), DM, WSP(WS_KF + (size_t)l * 2 * SZ_KF), DM, TT, 1024, 1, ZNone{}); S.split = T_P / 256; S.bseq = SZ_KF;
                EpiCrossSm E{F.ws, (LAS f32x2*)(F.lds + EXCH_OFF), F.lds};
                pg8::gemm_phase(F.lds, DM, DM, DM, S, E, F.tid);
                ENDPH(pb + 11);
            }
            if (PH(pb + 13)) {
                auto S = make_sched(F, POOLP(PL_CP), 1024, WSP(WS_VWT + (size_t)l * 2 * SZ_KF), 1024, TT, DM, 1, ZNone{}); S.split = T_P / 256; S.bseq = SZ_KF;
                EpiResidNorm E{RSCALE(1.0f), F.ws, (LAS float*)(F.lds + EXCH_OFF)};
                    pg8::gemm_phase(F.lds, 1024, 1024, 1024, S, E, F.tid); ENDPH(pb + 13);
            }
        }
        if (hl == 7 && PH(pb + 14)) { final_norm_phase(F, F.in[I_FINN]); ENDPH(pb + 14); }
    }
#undef PH
#undef ENDPH
}

#ifndef MK_PER_PHASE
#define MK_PER_PHASE 0
#endif
extern "C" void kernel_launch(void* const* d_in, const int* in_sizes, int n_in, void* d_out, int out_size, void* d_ws, size_t ws_size, hipStream_t stream) {
    static int grid = 0;
    if (grid == 0) {
        if (n_in != N_IN || out_size != TT * DM || ws_size < WS_END) { fprintf(stderr, "kernel_launch: unexpected shapes: n_in %d out %d ws %zu (need %zu)\n", n_in, out_size, ws_size, (size_t)WS_END); grid = -1; return; }
        int dev = 0, cus = 0, per_cu = 0;
        if (hipGetDevice(&dev) != hipSuccess || hipDeviceGetAttribute(&cus, hipDeviceAttributeMultiprocessorCount, dev) != hipSuccess) { grid = -1; return; }
        if (hipFuncSetAttribute((const void*)fwd_kernel, hipFuncAttributeMaxDynamicSharedMemorySize, LDS_BYTES) != hipSuccess) { fprintf(stderr, "kernel_launch: hipFuncSetAttribute failed\n"); grid = -1; return; }
        if (hipOccupancyMaxActiveBlocksPerMultiprocessor(&per_cu, (const void*)fwd_kernel, NTHREADS, LDS_BYTES) != hipSuccess || per_cu < 1) { fprintf(stderr, "kernel_launch: occupancy query says %d\n", per_cu); (void)hipGetLastError(); grid = -1; return; }
        grid = cus;
    }
    if (grid < 0) return;
#if MK_PER_PHASE
    (void)hipMemsetAsync((char*)d_ws + WS_CTL, 0, CTL_BYTES, stream);
#else
    (void)hipMemsetAsync((char*)d_ws + WS_CTL, 0, 32768, stream);
#endif
    Args a{};
    for (int i = 0; i < N_IN; ++i) a.in[i] = (const float*)d_in[i];
    a.out = (float*)d_out; a.ws = (unsigned char*)d_ws; a.pad = 0;
#if MK_PER_PHASE
    int li = 0;
    for (int p = 0; p < PH_END; ++p) { if (!phase_exists(p)) continue; a.ph_lo = p; a.ph_hi = p + 1; a.li = li++; a.pad = 0;
        hipLaunchKernelGGL(fwd_kernel, dim3(grid), dim3(NTHREADS), LDS_BYTES, stream, a);
#ifdef PROBE_K
        { const int kind = p < PH_BASE ? 100 + p : (p - PH_BASE) % PH_PER;
          if (kind == PROBE_K) for (int r = 1; r <= PROBE_REPS; ++r) { a.pad = r; hipLaunchKernelGGL(fwd_kernel, dim3(grid), dim3(NTHREADS), LDS_BYTES, stream, a); } }
#endif
    }
#else
    a.ph_lo = 0; a.ph_hi = PH_END; a.li = 0;
    hipLaunchKernelGGL(fwd_kernel, dim3(grid), dim3(NTHREADS), LDS_BYTES, stream, a);
#endif
    const hipError_t le = hipPeekAtLastError();
    if (le != hipSuccess) fprintf(stderr, "kernel_launch: launch failed: %s\n", hipGetErrorName(le));
}
```

```cpp
#include <hip/hip_runtime.h>
#include <cstdio>
#include <cstdint>

#define GAS __attribute__((address_space(1)))
#define LAS __attribute__((address_space(3)))
typedef unsigned short bf16_t;
typedef short bf16x8 __attribute__((ext_vector_type(8)));
typedef short s16x4 __attribute__((ext_vector_type(4)));
typedef float f32x2 __attribute__((ext_vector_type(2)));
typedef float f32x4 __attribute__((ext_vector_type(4)));
typedef float f32x8 __attribute__((ext_vector_type(8)));
typedef float f32x16 __attribute__((ext_vector_type(16)));
typedef unsigned u32x2 __attribute__((ext_vector_type(2)));
typedef unsigned u32x4 __attribute__((ext_vector_type(4)));
typedef GAS unsigned gu32;
#define RLX_AGENT __ATOMIC_RELAXED, __HIP_MEMORY_SCOPE_AGENT
#define LDS_WAIT() asm volatile("s_waitcnt lgkmcnt(0)" ::: "memory")
#define VM_WAIT() asm volatile("s_waitcnt vmcnt(0)" ::: "memory")
#define SBAR() __builtin_amdgcn_sched_barrier(0)

__device__ __forceinline__ unsigned cvt_pk_bf16(float lo, float hi) { unsigned r; asm volatile("v_cvt_pk_bf16_f32 %0, %1, %2" : "=v"(r) : "v"(lo), "v"(hi)); return r; }
__device__ __forceinline__ float bf2f(unsigned short b) { return __uint_as_float(((unsigned)b) << 16); }
__device__ __forceinline__ float bflo(unsigned w) { return __uint_as_float(w << 16); }
__device__ __forceinline__ float bfhi(unsigned w) { return __uint_as_float(w & 0xffff0000u); }
__device__ __forceinline__ unsigned short f2bf(float f) { unsigned u = __float_as_uint(f); return (unsigned short)((u + 0x7fffu + ((u >> 16) & 1u)) >> 16); }
__device__ __forceinline__ float fast_rcp(float x) { return __builtin_amdgcn_rcpf(x); }
__device__ __forceinline__ float fast_exp2(float x) { return __builtin_amdgcn_exp2f(x); }
__device__ __forceinline__ float sigmoidf_fast(float x) { return fast_rcp(1.0f + fast_exp2(-1.4426950408889634f * x)); }
__device__ __forceinline__ float silu_f(float x) { return x * sigmoidf_fast(x); }
__device__ __forceinline__ float gelu_tanh_f(float y) { const float z = y + 0.044715f * y * y * y; return y * fast_rcp(1.0f + fast_exp2(-2.3022081982f * z)); }
__device__ __forceinline__ float wave_sum(float v) {
#pragma unroll
    for (int o = 1; o < 64; o <<= 1) v += __shfl_xor(v, o);
    return v;
}

#define XB_TMO      128
#define XB_XCNT(j)  (256  + 64 * (j))
#define XB_XSUB(j)  (1280 + 64 * (j))
#define XB_XGEN(j)  (2304 + 64 * (j))
#define XB_TOP      3328
#define XB_TOPGEN   3392
#define XCD_BAR_WORDS 3456
#define XB_SPIN_CAP (1u << 22)

__device__ __forceinline__ unsigned xb_ld(unsigned* p)              { return __hip_atomic_load(p, __ATOMIC_RELAXED, __HIP_MEMORY_SCOPE_AGENT); }
__device__ __forceinline__ unsigned xb_add(unsigned* p, unsigned v) { return __hip_atomic_fetch_add(p, v, __ATOMIC_RELAXED, __HIP_MEMORY_SCOPE_AGENT); }
__device__ __forceinline__ unsigned xb_xcc_id() { return (unsigned)__builtin_amdgcn_s_getreg((3 << 11) | 20) & 0xFu; }
#define XB_SPIN(cond, bar) do { unsigned _sp = 0; while (cond) { __builtin_amdgcn_s_sleep(1); \
    if ((++_sp & 255u) == 0u) { if (xb_ld(&(bar)[XB_TMO])) break; if (_sp > XB_SPIN_CAP) { atomicAdd(&(bar)[XB_TMO], 1u); break; } } } } while (0)

struct XcdBarrier { unsigned* bar; unsigned x; volatile LAS unsigned* st; };

__device__ __forceinline__ XcdBarrier xcd_barrier_post(unsigned* bar, volatile LAS unsigned* st) {
    XcdBarrier b; b.bar = bar; b.x = xb_xcc_id(); b.st = st;
    if (threadIdx.x == 0) (void)xb_add(&bar[XB_XCNT(b.x)], 1u);
    return b;
}
__device__ __forceinline__ void xcd_barrier_complete(unsigned* bar, unsigned x, unsigned& nloc, unsigned& nx) {
    const unsigned G = gridDim.x * gridDim.y * gridDim.z;
    unsigned sum, cnt, mine, sp = 0u;
    for (;;) {
        sum = 0u; cnt = 0u; mine = 0u;
#pragma unroll
        for (unsigned j = 0; j < 16; ++j) { const unsigned c = xb_ld(&bar[XB_XCNT(j)]); sum += c; cnt += (c > 0u) ? 1u : 0u; mine = (j == x) ? c : mine; }
        if (sum == G) break;
        __builtin_amdgcn_s_sleep(1);
        if ((++sp & 255u) == 0u) { if (xb_ld(&bar[XB_TMO])) break; if (sp > XB_SPIN_CAP) { atomicAdd(&bar[XB_TMO], 1u); break; } }
    }
    nloc = mine > 0u ? mine : 1u; nx = cnt > 0u ? cnt : 1u;
}
__device__ __forceinline__ void xcd_barrier(const XcdBarrier& b) {
    asm volatile("s_waitcnt vmcnt(0)" ::: "memory");
    __syncthreads();
    if (threadIdx.x == 0) {
        unsigned* bar = b.bar;
        __builtin_amdgcn_s_waitcnt(0);
        unsigned nloc = b.st[0], nx = b.st[1];
        if (nloc == 0u) { xcd_barrier_complete(bar, b.x, nloc, nx); b.st[0] = nloc; b.st[1] = nx; }
        const unsigned old = xb_add(&bar[XB_XSUB(b.x)], 1u);
        const unsigned gen = old / nloc;
        if (old + 1u == (gen + 1u) * nloc) {
            __builtin_amdgcn_fence(__ATOMIC_RELEASE, "agent");
            asm volatile("s_waitcnt vmcnt(0)" ::: "memory");
            const unsigned og = xb_add(&bar[XB_TOP], 1u);
            const unsigned tg = og / nx;
            if (og + 1u == (tg + 1u) * nx) xb_add(&bar[XB_TOPGEN], 1u);
            else XB_SPIN(xb_ld(&bar[XB_TOPGEN]) == tg, bar);
            __builtin_amdgcn_fence(__ATOMIC_ACQUIRE, "agent");
            xb_add(&bar[XB_XGEN(b.x)], 1u);
            asm volatile("s_waitcnt vmcnt(0)" ::: "memory");
        } else {
            XB_SPIN(xb_ld(&bar[XB_XGEN(b.x)]) == gen, bar);
            __builtin_amdgcn_fence(__ATOMIC_ACQUIRE, "agent");
            asm volatile("s_waitcnt vmcnt(0)" ::: "memory");
        }
    }
    __syncthreads();
}

namespace pg8 {
constexpr int BM = 256, BK = 64, HALF = 128, HTB = HALF * BK * 2, STAGE_BYTES = 8 * HTB, NXCD = 8, WGM = 4;
__host__ __device__ __forceinline__ int lds_byte(int r, int c) { const int st = (r >> 4) * 2 + (c >> 5), rr = r & 15, cc = c & 31, ob = rr * 64 + cc * 2; return st * 1024 + (ob ^ (((ob >> 9) & 1) << 5)); }
__host__ __device__ __forceinline__ void stage_rc(int b, int& R, int& C) { const int st = b / 1024, sb = b % 1024, swz = sb ^ (((sb >> 9) & 1) << 5); R = (st >> 1) * 16 + swz / 64; C = (st & 1) * 32 + (swz % 64) / 2; }
__host__ __device__ __forceinline__ int perm32(int rho) { const int n = rho >> 4, i = rho & 15; return 8 * (i >> 2) + 4 * n + (i & 3); }

struct Unit { int pm, pn, z; };
struct Enum {
    int nM, nN, nZ, nwg, G, c, rev, wgm;
    __device__ __forceinline__ void init(int nM_, int nN_, int nZ_, int G_, int c_) { nM = nM_; nN = nN_; nZ = nZ_; nwg = nM * nN * nZ; G = G_; c = c_; rev = 0; wgm = WGM; }
    __device__ __forceinline__ bool next(int i, Unit& u) const {
        const long L = (long)i * G + c; if (L >= nwg) return false;
        int wgid = (int)L; { const int q = nwg / NXCD, r = nwg % NXCD, xcd = wgid % NXCD, off = wgid / NXCD; wgid = (xcd < r ? xcd * (q + 1) : r * (q + 1) + (xcd - r) * q) + off; }
        const int per = nM * nN; u.z = wgid / per; wgid -= u.z * per;
        const int nig = wgm * nN, gid = wgid / nig, fm = gid * wgm, gsz = (nM - fm) < wgm ? (nM - fm) : wgm;
        u.pm = fm + ((wgid % nig) % gsz); u.pn = (wgid % nig) / gsz; if (rev) u.pm = nM - 1 - u.pm; return true;
    }
};

template <class Epi, class Sched>
__device__ __forceinline__ void gemm_phase(LAS unsigned char* lds, const int lda, const int ldb, const int K, const Sched& S, const Epi& E, const int tid) {
    const int wid = __builtin_amdgcn_readfirstlane(tid >> 6), lane = tid & 63, wr = wid >> 2, wc = wid & 3, fr = lane & 15, fq = lane >> 4;
    const int nt = K / BK;
    unsigned voffA[2], voffB[2];
#pragma unroll
    for (int i = 0; i < 2; ++i) { int R, C; stage_rc(tid * 16 + i * 8192, R, C); const int Rb = Epi::PERM ? ((R & ~31) + perm32(R & 31)) : R;
        voffA[i] = (unsigned)(R * lda + C) * 2u; voffB[i] = (unsigned)(Rb * ldb + C) * 2u; }
    const size_t kstep = (size_t)(BK * 2);
    const size_t hstepA = (size_t)HALF * lda * 2, hstepB = (size_t)HALF * ldb * 2;
    const unsigned ldsw = (unsigned)wid * 1024u;
    const int aoff = lds_byte(wr * 64 + fr, fq * 8), boff = lds_byte(wc * 32 + fr, fq * 8);
#define PG8_SA(b, h) (((b) * 2 + (h)) * HTB)
#define PG8_SB(b, h) ((4 + (b) * 2 + (h)) * HTB)
#define PG8_STAGE(bufoff, gbase, voff) do { _Pragma("unroll") for (int _i = 0; _i < 2; ++_i) \
        __builtin_amdgcn_global_load_lds((const unsigned*)((const char*)(gbase) + (voff)[_i]), (LAS unsigned*)(lds + (bufoff) + ldsw + _i * 8192), 16, 0, 0); } while (0)
#define PG8_LDA(dst, b, h) do { _Pragma("unroll") for (int m = 0; m < 4; ++m) _Pragma("unroll") for (int k = 0; k < 2; ++k) dst[m][k] = *(const LAS bf16x8*)(lds + PG8_SA(b, h) + aoff + m * 2048 + k * 1024); } while (0)
#define PG8_LDB(dst, b, h) do { _Pragma("unroll") for (int n = 0; n < 2; ++n) _Pragma("unroll") for (int k = 0; k < 2; ++k) dst[n][k] = *(const LAS bf16x8*)(lds + PG8_SB(b, h) + boff + n * 2048 + k * 1024); } while (0)
#define PG8_MMA(ai, bj, At, Bt) do { __builtin_amdgcn_s_setprio(1); _Pragma("unroll") for (int m = 0; m < 4; ++m) _Pragma("unroll") for (int n = 0; n < 2; ++n) _Pragma("unroll") for (int k = 0; k < 2; ++k) \
        acc[ai][bj][m][n] = __builtin_amdgcn_mfma_f32_16x16x32_bf16(Bt[n][k], At[m][k], acc[ai][bj][m][n], 0, 0, 0); __builtin_amdgcn_s_setprio(0); } while (0)
#define PG8_WAIT_V(n) asm volatile("s_waitcnt vmcnt(" #n ")" ::: "memory")
#define PG8_WAIT_L(n) asm volatile("s_waitcnt lgkmcnt(" #n ")" ::: "memory")
#define PG8_BAR __builtin_amdgcn_s_barrier()
#define PG8_SCHED __builtin_amdgcn_sched_barrier(0)
    Unit cur, nxt; int ui = 0;
    if (!S.next(0, cur)) return;
    f32x4 acc[2][2][4][2];
#pragma unroll
    for (int a = 0; a < 2; ++a)
#pragma unroll
        for (int b = 0; b < 2; ++b)
#pragma unroll
            for (int m = 0; m < 4; ++m)
#pragma unroll
                for (int n = 0; n < 2; ++n) acc[a][b][m][n] = (f32x4){0.f, 0.f, 0.f, 0.f};
    bf16x8 At[4][2], B0[2][2], B1[2][2];
    const char* cA = S.a_base(cur); const char* cB = S.b_base(cur);
    {
        PG8_STAGE(PG8_SB(0, 0), cB, voffB); PG8_STAGE(PG8_SB(0, 1), cB + hstepB, voffB); PG8_STAGE(PG8_SA(0, 0), cA, voffA); PG8_STAGE(PG8_SA(0, 1), cA + hstepA, voffA);
        if (wr == 1) PG8_BAR;
        PG8_WAIT_V(2); PG8_BAR;
        PG8_STAGE(PG8_SB(1, 0), cB + kstep, voffB); PG8_STAGE(PG8_SA(1, 0), cA + kstep, voffA); PG8_STAGE(PG8_SB(1, 1), cB + hstepB + kstep, voffB);
        PG8_WAIT_V(6); PG8_BAR;
    }
    for (;;) {
        if constexpr (Epi::PREFETCH) E.prefetch(lds, cur, ui, wid, lane);
        const bool has_next = S.next(ui + 1, nxt);
        const char* nA = has_next ? S.a_base(nxt) : cA; const char* nB = has_next ? S.b_base(nxt) : cB;
        for (int t = 0; t < nt; t += 2) {
            const bool last = (t == nt - 2);
            const char* a1 = cA + (size_t)(t + 1) * kstep;
            const char* a2 = last ? nA : cA + (size_t)(t + 2) * kstep; const char* b2 = last ? nB : cB + (size_t)(t + 2) * kstep;
            const char* a3 = a2 + kstep; const char* b3 = b2 + kstep;
            PG8_LDB(B0, 0, 0); PG8_LDB(B1, 0, 1); PG8_SCHED; PG8_LDA(At, 0, 0); PG8_STAGE(PG8_SA(1, 1), a1 + hstepA, voffA);
            PG8_WAIT_V(8); PG8_WAIT_L(0); PG8_BAR; PG8_MMA(0, 0, At, B0); PG8_MMA(0, 1, At, B1); PG8_BAR; PG8_SCHED;
            PG8_LDA(At, 0, 1); PG8_STAGE(PG8_SB(0, 0), b2, voffB); PG8_STAGE(PG8_SB(0, 1), b2 + hstepB, voffB); PG8_STAGE(PG8_SA(0, 0), a2, voffA);
            PG8_WAIT_V(8); PG8_WAIT_L(0); PG8_BAR; PG8_MMA(1, 0, At, B0); PG8_MMA(1, 1, At, B1); PG8_BAR; PG8_SCHED;
            PG8_LDB(B0, 1, 0); PG8_LDB(B1, 1, 1); PG8_SCHED; PG8_LDA(At, 1, 0); PG8_STAGE(PG8_SA(0, 1), a2 + hstepA, voffA);
            PG8_WAIT_V(8); PG8_WAIT_L(0); PG8_BAR; PG8_MMA(0, 0, At, B0); PG8_MMA(0, 1, At, B1); PG8_BAR; PG8_SCHED;
            PG8_LDA(At, 1, 1); PG8_STAGE(PG8_SB(1, 0), b3, voffB); PG8_STAGE(PG8_SB(1, 1), b3 + hstepB, voffB); PG8_STAGE(PG8_SA(1, 0), a3, voffA);
            PG8_WAIT_V(8); PG8_WAIT_L(0); PG8_BAR; PG8_MMA(1, 0, At, B0); PG8_MMA(1, 1, At, B1); PG8_BAR; PG8_SCHED;
        }
        if (wr == 0) PG8_BAR;
        E(acc, cur, wr, wc, fr, fq, ui);
        if (!has_next) break;
#pragma unroll
        for (int a = 0; a < 2; ++a)
#pragma unroll
            for (int b = 0; b < 2; ++b)
#pragma unroll
                for (int m = 0; m < 4; ++m)
#pragma unroll
                    for (int n = 0; n < 2; ++n) acc[a][b][m][n] = (f32x4){0.f, 0.f, 0.f, 0.f};
        cur = nxt; cA = nA; cB = nB; ++ui;
        if (wr == 1) PG8_BAR;
    }
    PG8_WAIT_V(0);
    PG8_BAR;
#undef PG8_SA
#undef PG8_SB
#undef PG8_STAGE
#undef PG8_LDA
#undef PG8_LDB
#undef PG8_MMA
#undef PG8_WAIT_V
#undef PG8_WAIT_L
#undef PG8_BAR
#undef PG8_SCHED
}
}

constexpr int DM = 2048, T_P = 8192, T_S = 16384, TT = T_P + T_S, DEPTH = 4, NMEM = 256, DFF = 5632;
constexpr int S5W = 1024, S5G = 64, S5H = 16, S5P = 64, LC = 32, NCH = TT / LC, NCH_P = T_P / LC;
constexpr int S5K1 = LC * S5H  , S5NS = 4 * S5P  , S5K2 = S5K1 + S5NS  ;
constexpr int EVEN_IN = 4096, ODD_IN = 3072, ZLD = 3072;
constexpr float EPS = 1e-6f, SUBLN_EPS = 1e-5f;
constexpr int NWAVES = 8, NTHREADS = 512;

enum { I_XP = 0, I_XS, I_MP, I_MS, I_F1N, I_F1GU, I_F1D, I_MIXN, I_EWIN, I_EWOUT, I_LRE, I_LIM, I_LDT, I_BRE, I_BIM, I_CRE, I_CIM, I_S5D, I_GLUW, I_GLUB,
       I_LQ1, I_LK1, I_LQ2, I_LK2, I_SUBLN, I_OWIN, I_OWOUT, I_QN, I_KN, I_CN, I_MN, I_CWQ, I_CWKV, I_CWO, I_F2N, I_F2GU, I_F2D, I_FINN, N_IN };

constexpr size_t MiB = 1u << 20;
constexpr size_t WS_CTL = 0, CTL_BYTES = 2 * MiB;
constexpr size_t WS_WGU = 2 * MiB;
constexpr size_t SZ_WGU = (size_t)2 * DFF * DM * 2;
constexpr size_t WS_WD = WS_WGU + 8 * SZ_WGU;
constexpr size_t SZ_WD = (size_t)DM * DFF * 2;
constexpr size_t WS_WINE = WS_WD + 8 * SZ_WD;
constexpr size_t SZ_WINE = (size_t)EVEN_IN * DM * 2;
constexpr size_t WS_WOUTE = WS_WINE + 2 * SZ_WINE;
constexpr size_t SZ_SQ = (size_t)DM * DM * 2;
constexpr size_t WS_GLU = WS_WOUTE + 2 * SZ_SQ;
constexpr size_t SZ_GLU = (size_t)S5W * S5W * 2;
constexpr size_t WS_WINO = WS_GLU + 2 * SZ_GLU;
constexpr size_t SZ_WINO = (size_t)ODD_IN * DM * 2;
constexpr size_t WS_WOUTO = WS_WINO + 2 * SZ_WINO;
constexpr size_t WS_KF = WS_WOUTO + 2 * SZ_SQ;
constexpr size_t SZ_KF = (size_t)1024 * DM * 2;
constexpr size_t WS_VWT = WS_KF + 8 * SZ_KF;
constexpr size_t WS_WST = WS_VWT + 8 * SZ_KF;
constexpr size_t SZ_WST = (size_t)S5NS * S5K1 * 2;
constexpr size_t WS_TG = WS_WST + 2 * 64 * SZ_WST;
constexpr size_t SZ_TG = (size_t)S5K1 * S5K2 * 2;
constexpr size_t WS_HB = WS_TG + 2 * 64 * SZ_TG;
constexpr size_t SZ_HB = (size_t)TT * DM * 2;
constexpr size_t WS_MISC = WS_HB + SZ_HB;
constexpr size_t MISC_ROPE = 0, MISC_AL = 65536  , MISC_LAM = 65536 + 131072  , MISC_PSS = 262144  ;
constexpr size_t WS_POOL = WS_MISC + MiB;
constexpr size_t PL_ACT = 0;
constexpr size_t PL_Z = 0;
constexpr size_t PL_UX = 144 * MiB;
constexpr size_t PL_KC = 144 * MiB;
constexpr size_t PL_SST = 216 * MiB;
constexpr size_t PL_GB = 264 * MiB;
constexpr size_t PL_CAT = 312 * MiB;
constexpr size_t PL_STASH = 408 * MiB;
constexpr size_t PL_CS = 0;
constexpr size_t PL_CP = 96 * MiB;
constexpr size_t PL_WQB = 0;
constexpr size_t PL_WKVT = 32 * MiB;
constexpr size_t PL_WOT = 96 * MiB;
constexpr size_t PL_MEMN = 128 * MiB;
constexpr size_t PL_KVB = 136 * MiB;
constexpr size_t POOL_BYTES = 440 * MiB;
constexpr size_t WS_X = WS_POOL + POOL_BYTES;
constexpr size_t WS_END = WS_X + (size_t)TT * DM;

constexpr int CW_BAR = 4096;
constexpr int CW_DBG = 1024;
constexpr int CW_QKB = 2048;
constexpr int CW_QUEUE = 2304;

constexpr int EXCH_OFF = 131072  , PSSB_OFF = 139264  , RING_BYTES = 155648, MISC_OFF = RING_BYTES + 320, LDS_BYTES = 159744;

struct Args { const float* in[N_IN]; float* out; unsigned char* ws; int ph_lo, ph_hi, li, pad; };
struct Frame {
    LAS unsigned char* lds; char* ldsg;
    volatile LAS unsigned* MISC;
    int tid, lane, wave, G, bid;
    const float* const* in; float* x; unsigned char* ws;
};
#define WSP(off) (F.ws + (off))
#define POOLP(off) (F.ws + WS_POOL + (off))

struct ZNone { __device__ __forceinline__ size_t aoff(int) const { return 0; } __device__ __forceinline__ size_t boff(int) const { return 0; } };
struct ZLin { size_t as, bs; __device__ __forceinline__ size_t aoff(int z) const { return (size_t)z * as; } __device__ __forceinline__ size_t boff(int z) const { return (size_t)z * bs; } };
struct ZKv { __device__ __forceinline__ size_t aoff(int z) const { return (size_t)z * (256 * 2048 * 2); } __device__ __forceinline__ size_t boff(int z) const { return (size_t)(z >> 1) * ((size_t)4096 * 2048 * 2); } };
struct ZKf { __device__ __forceinline__ size_t aoff(int z) const { return (size_t)(z >> 2) * ((size_t)256 * 4096 * 2) + (size_t)(z & 3) * 1024; }
             __device__ __forceinline__ size_t boff(int z) const { return (size_t)(z >> 3) * ((size_t)2048 * 2048 * 2) + (size_t)(z & 3) * 1024; } };
struct ZVw { __device__ __forceinline__ size_t aoff(int z) const { return (size_t)(z >> 3) * ((size_t)2048 * 2048 * 2) + (size_t)(z & 3) * 1024; }
             __device__ __forceinline__ size_t boff(int z) const { return (size_t)(z >> 2) * ((size_t)256 * 4096 * 2) + 4096 + (size_t)(z & 3) * 1024; } };
template <class ZM>
struct Sched : pg8::Enum {
    const char* A; const char* B; size_t atile, btile; int split; size_t bseq; ZM zm;
    __device__ __forceinline__ const char* a_base(const pg8::Unit& u) const { return A + (size_t)u.pm * atile + zm.aoff(u.z); }
    __device__ __forceinline__ const char* b_base(const pg8::Unit& u) const { return B + (size_t)u.pn * btile + zm.boff(u.z) + (u.pm >= split ? bseq : 0); }
};
template <class ZM>
__device__ __forceinline__ Sched<ZM> make_sched(const Frame& F, const void* A, int lda, const void* B, int ldb, int M, int N, int nZ, ZM zm) {
    Sched<ZM> S; S.init(M / 256, N / 256, nZ, F.G, F.bid); S.A = (const char*)A; S.B = (const char*)B; S.atile = (size_t)256 * lda * 2; S.btile = (size_t)256 * ldb * 2;
    S.split = 1 << 30; S.bseq = 0; S.zm = zm; return S;
}

typedef f32x4 Acc[2][2][4][2];
__device__ __forceinline__ float res_dec(unsigned hb  , float lob  ) {
    const int e = (int)((hb >> 7) & 0xFFu); const float sd = __uint_as_float((unsigned)(e > 15 ? e - 15 : 0) << 23);
    return fmaf(lob - 128.0f, sd, __uint_as_float(hb << 16));
}
__device__ __forceinline__ float res_enc_lo(float x, unsigned hb) {
    const int e = (int)((hb >> 7) & 0xFFu); const float se = e > 15 ? __uint_as_float((unsigned)(269 - e) << 23) : 0.f;
    return fminf(__builtin_rintf(fmaf(x - __uint_as_float(hb << 16), se, 128.0f)), 255.0f);
}
__device__ __forceinline__ unsigned pack4_u8(float a, float b, float c, float dd) { return (unsigned)a | ((unsigned)b << 8) | ((unsigned)c << 16) | ((unsigned)dd << 24); }
__device__ __forceinline__ void res_enc4(const f32x4 v, unsigned& w0, unsigned& w1, unsigned& lo) {
    w0 = cvt_pk_bf16(v[0], v[1]); w1 = cvt_pk_bf16(v[2], v[3]);
    lo = pack4_u8(res_enc_lo(v[0], w0 & 0xFFFFu), res_enc_lo(v[1], w0 >> 16), res_enc_lo(v[2], w1 & 0xFFFFu), res_enc_lo(v[3], w1 >> 16));
}
__device__ __forceinline__ f32x4 res_dec4(unsigned w0, unsigned w1, unsigned lo) {
    return (f32x4){res_dec(w0 & 0xFFFFu, (float)(lo & 0xFFu)), res_dec(w0 >> 16, (float)((lo >> 8) & 0xFFu)), res_dec(w1 & 0xFFFFu, (float)((lo >> 16) & 0xFFu)), res_dec(w1 >> 16, (float)(lo >> 24))};
}
__device__ __forceinline__ unsigned char* fresh_ws(unsigned char* ws) { asm volatile("" : "+s"(ws)); return ws; }
__device__ __forceinline__ void pss_prefetch(LAS unsigned char* lds, const unsigned char* ws, int pm, int par, int wid, int lane) {
    const unsigned char* src = ws + WS_MISC + MISC_PSS + (size_t)pm * 8192 + wid * 1024 + lane * 16;
    __builtin_amdgcn_global_load_lds((const unsigned*)src, (LAS unsigned*)(lds + PSSB_OFF + (par & 1) * 8192 + wid * 1024), 16, 0, 0);
}
__device__ __forceinline__ void row_rstd_lds(const LAS unsigned char* lds, int par, int rloc0, float (&rs)[2][4]) {
    const LAS unsigned char* b = lds + PSSB_OFF + (par & 1) * 8192;
#pragma unroll
    for (int ai = 0; ai < 2; ++ai)
#pragma unroll
        for (int m = 0; m < 4; ++m) { const f32x4 a = *(const LAS f32x4*)(b + (rloc0 + ai * 128 + m * 16) * 32), c = *(const LAS f32x4*)(b + (rloc0 + ai * 128 + m * 16) * 32 + 16);
            rs[ai][m] = 1.0f / sqrtf((((a.x + a.y) + (a.z + a.w)) + ((c.x + c.y) + (c.z + c.w))) * (1.f / DM) + EPS); }
}
__device__ __forceinline__ void row_rstd(const float* PSS, int row0, float (&rs)[2][4]) {
#pragma unroll
    for (int ai = 0; ai < 2; ++ai)
#pragma unroll
        for (int m = 0; m < 4; ++m) { const f32x4 a = *(const f32x4*)(PSS + (size_t)(row0 + ai * 128 + m * 16) * 8), b = *(const f32x4*)(PSS + (size_t)(row0 + ai * 128 + m * 16) * 8 + 4);
            rs[ai][m] = 1.0f / sqrtf((((a.x + a.y) + (a.z + a.w)) + ((b.x + b.y) + (b.z + b.w))) * (1.f / DM) + EPS); }
}
struct EpiSwiglu { static constexpr bool PERM = true, PREFETCH = true; unsigned char* ws; int ldc; LAS unsigned char* lds;
    __device__ __forceinline__ void prefetch(LAS unsigned char* l, const pg8::Unit& u, int par, int wid, int lane) const { pss_prefetch(l, ws, u.pm, par, wid, lane); }
    __device__ __forceinline__ void operator()(Acc& acc, const pg8::Unit& u, int wr, int wc, int fr, int fq, int par) const {
        const int row0 = u.pm * 256 + wr * 64 + fr, col0 = u.pn * 128 + wc * 32 + 8 * fq;
        unsigned char* w_ = fresh_ws(ws); bf16_t* O = (bf16_t*)(w_ + WS_POOL + PL_ACT);
        float rs[2][4]; row_rstd_lds(lds, par, wr * 64 + fr, rs);
#pragma unroll
        for (int ai = 0; ai < 2; ++ai)
#pragma unroll
            for (int m = 0; m < 4; ++m) { const f32x4 g0 = acc[ai][0][m][0] * rs[ai][m], g1 = acc[ai][0][m][1] * rs[ai][m], u0 = acc[ai][1][m][0] * rs[ai][m], u1 = acc[ai][1][m][1] * rs[ai][m];
                u32x4 w; w.x = cvt_pk_bf16(silu_f(g0[0]) * u0[0], silu_f(g0[1]) * u0[1]); w.y = cvt_pk_bf16(silu_f(g0[2]) * u0[2], silu_f(g0[3]) * u0[3]);
                w.z = cvt_pk_bf16(silu_f(g1[0]) * u1[0], silu_f(g1[1]) * u1[1]); w.w = cvt_pk_bf16(silu_f(g1[2]) * u1[2], silu_f(g1[3]) * u1[3]);
                *(u32x4*)(O + (size_t)(row0 + ai * 128 + m * 16) * ldc + col0) = w; }
    }
};
struct EpiResidNorm { static constexpr bool PERM = true, PREFETCH = false; float scale; unsigned char* ws; LAS float* red;
    __device__ __forceinline__ void operator()(Acc& acc, const pg8::Unit& u, int wr, int wc, int fr, int fq, int par) const {
        const int row0 = u.pm * 256 + wr * 64 + fr, col0 = u.pn * 256 + wc * 32 + 8 * fq, tid = (wr * 4 + wc) * 64 + fq * 16 + fr;
        unsigned char* w_ = fresh_ws(ws); bf16_t* XB = (bf16_t*)(w_ + WS_HB); float* PSS = (float*)(w_ + WS_MISC + MISC_PSS);
        u32x4* XL = (u32x4*)(w_ + WS_X + (size_t)(u.pm * 8 + u.pn) * 65536) + tid;
#pragma unroll
        for (int ai = 0; ai < 2; ++ai) {
            u32x4 hv[4][2], lv[4];
#pragma unroll
            for (int m = 0; m < 4; ++m) { const bf16_t* bp = XB + (size_t)(row0 + ai * 128 + m * 16) * DM + col0; hv[m][0] = *(const u32x4*)bp; hv[m][1] = *(const u32x4*)(bp + 128); lv[m] = XL[(ai * 4 + m) * 512]; }
#pragma unroll
            for (int m = 0; m < 4; ++m) { bf16_t* bp = XB + (size_t)(row0 + ai * 128 + m * 16) * DM + col0; float s = 0.f; u32x4 lo;
#pragma unroll
                for (int bj = 0; bj < 2; ++bj) { const f32x4 v0 = res_dec4(hv[m][bj].x, hv[m][bj].y, lv[m][bj * 2]) + acc[ai][bj][m][0] * scale, v1 = res_dec4(hv[m][bj].z, hv[m][bj].w, lv[m][bj * 2 + 1]) + acc[ai][bj][m][1] * scale;
                    unsigned a0, a1, a2, a3, l0, l1; res_enc4(v0, a0, a1, l0); res_enc4(v1, a2, a3, l1); *(u32x4*)(bp + bj * 128) = (u32x4){a0, a1, a2, a3}; lo[bj * 2] = l0; lo[bj * 2 + 1] = l1;
                    s += ((v0[0] * v0[0] + v0[1] * v0[1]) + (v0[2] * v0[2] + v0[3] * v0[3])) + ((v1[0] * v1[0] + v1[1] * v1[1]) + (v1[2] * v1[2] + v1[3] * v1[3])); }
                XL[(ai * 4 + m) * 512] = lo;
                s += __shfl_xor(s, 16); s += __shfl_xor(s, 32);
                if (fq == 0) red[(ai * 128 + wr * 64 + m * 16 + fr) * 4 + wc] = s; }
            asm volatile("" ::: "memory"); }
        asm volatile("s_waitcnt lgkmcnt(0)" ::: "memory"); __builtin_amdgcn_s_barrier(); asm volatile("" ::: "memory");
        if (tid < 256) { const f32x4 r4 = *(const LAS f32x4*)(red + tid * 4); PSS[(size_t)(u.pm * 256 + tid) * 8 + u.pn] = (r4.x + r4.y) + (r4.z + r4.w); }
    }
};
template <int MODE> struct EpiBf16 { static constexpr bool PERM = true, PREFETCH = (MODE == 1); bf16_t* O; int ldc; size_t zhi, zlo; int zshift; const float* aux; unsigned char* ws; LAS unsigned char* lds;
    __device__ __forceinline__ void prefetch(LAS unsigned char* l, const pg8::Unit& u, int par, int wid, int lane) const { pss_prefetch(l, ws, u.pm, par, wid, lane); }
    __device__ __forceinline__ void operator()(Acc& acc, const pg8::Unit& u, int wr, int wc, int fr, int fq, int par) const {
        bf16_t* base = O + (size_t)(u.z >> zshift) * zhi + (size_t)(u.z & ((1 << zshift) - 1)) * zlo;
        const int row0 = u.pm * 256 + wr * 64 + fr, col0 = u.pn * 256 + wc * 32 + 8 * fq;
        float rs[2][4]; if (MODE == 1) row_rstd_lds(lds, par, wr * 64 + fr, rs);
        f32x4 cs[2][2]; if (MODE == 2) {
#pragma unroll
            for (int bj = 0; bj < 2; ++bj)
#pragma unroll
                for (int n = 0; n < 2; ++n) cs[bj][n] = *(const f32x4*)(aux + (size_t)(u.z >> 3) * DM + col0 + bj * 128 + 4 * n); }
#pragma unroll
        for (int ai = 0; ai < 2; ++ai)
#pragma unroll
            for (int m = 0; m < 4; ++m) { bf16_t* rp = base + (size_t)(row0 + ai * 128 + m * 16) * ldc + col0;
#pragma unroll
                for (int bj = 0; bj < 2; ++bj) { f32x4 v0 = acc[ai][bj][m][0], v1 = acc[ai][bj][m][1];
                    if (MODE == 1) { v0 = v0 * rs[ai][m]; v1 = v1 * rs[ai][m]; }
                    if (MODE == 2) { v0 = v0 * cs[bj][0]; v1 = v1 * cs[bj][1]; }
                    u32x4 w; w.x = cvt_pk_bf16(v0[0], v0[1]); w.y = cvt_pk_bf16(v0[2], v0[3]); w.z = cvt_pk_bf16(v1[0], v1[1]); w.w = cvt_pk_bf16(v1[2], v1[3]);
                    *(u32x4*)(rp + bj * 128) = w; } }
    }
};
struct EpiWinEven { static constexpr bool PERM = true, PREFETCH = true; unsigned char* ws; LAS unsigned char* lds;
    __device__ __forceinline__ void prefetch(LAS unsigned char* l, const pg8::Unit& u, int par, int wid, int lane) const { pss_prefetch(l, ws, u.pm, par, wid, lane); }
    __device__ __forceinline__ void operator()(Acc& acc, const pg8::Unit& u, int wr, int wc, int fr, int fq, int par) const {
        const int row0 = u.pm * 256 + wr * 64 + fr, col0 = u.pn * 256 + wc * 32 + 8 * fq;
        unsigned char* w_ = fresh_ws(ws); bf16_t* UX = (bf16_t*)(w_ + WS_POOL + PL_UX); bf16_t* Z = (bf16_t*)(w_ + WS_POOL + PL_Z);
        float rs[2][4]; row_rstd_lds(lds, par, wr * 64 + fr, rs);
        const float qs = (u.pn >= 4 && u.pn < 8) ? 0.18033688f : 1.0f;
#pragma unroll
        for (int ai = 0; ai < 2; ++ai)
#pragma unroll
            for (int m = 0; m < 4; ++m) { const int row = row0 + ai * 128 + m * 16;
#pragma unroll
                for (int bj = 0; bj < 2; ++bj) { const float rq = rs[ai][m] * qs; const f32x4 v0 = acc[ai][bj][m][0] * rq, v1 = acc[ai][bj][m][1] * rq; const int col = col0 + bj * 128;
                    u32x4 w; w.x = cvt_pk_bf16(v0[0], v0[1]); w.y = cvt_pk_bf16(v0[2], v0[3]); w.z = cvt_pk_bf16(v1[0], v1[1]); w.w = cvt_pk_bf16(v1[2], v1[3]);
                    bf16_t* p;
                    if (u.pn < 4) { const int g = col >> 4, h0 = col & 15, c = row >> 5, i = row & 31; p = UX + ((size_t)(g * NCH + c) * S5K2 + i * 16 + h0); }
                    else p = Z + (size_t)row * ZLD + (col - 1024);
                    *(u32x4*)p = w; } }
    }
};
struct EpiF32 { static constexpr bool PERM = false, PREFETCH = false; float* O; int ldc; size_t zs;
    __device__ __forceinline__ void operator()(Acc& acc, const pg8::Unit& u, int wr, int wc, int fr, int fq, int par) const {
        float* base = O + (size_t)u.z * zs; const int row0 = u.pm * 256 + wr * 64 + fr, col0 = u.pn * 256 + wc * 32 + 4 * fq;
#pragma unroll
        for (int ai = 0; ai < 2; ++ai)
#pragma unroll
            for (int m = 0; m < 4; ++m) { float* rp = base + (size_t)(row0 + ai * 128 + m * 16) * ldc + col0;
#pragma unroll
                for (int bj = 0; bj < 2; ++bj)
#pragma unroll
                    for (int n = 0; n < 2; ++n) *(f32x4*)(rp + bj * 128 + n * 16) = acc[ai][bj][m][n]; }
    }
};
struct EpiS5Out { static constexpr bool PERM = true, PREFETCH = false; bf16_t* GB;
    __device__ __forceinline__ void operator()(Acc& acc, const pg8::Unit& u, int wr, int wc, int fr, int fq, int par) const {
        const int row0 = u.pm * 256 + wr * 64 + fr, col0 = u.pn * 256 + wc * 32 + 8 * fq;
#pragma unroll
        for (int ai = 0; ai < 2; ++ai)
#pragma unroll
            for (int m = 0; m < 4; ++m) { const int c = row0 + ai * 128 + m * 16;
#pragma unroll
                for (int bj = 0; bj < 2; ++bj) { const f32x4 v0 = acc[ai][bj][m][0], v1 = acc[ai][bj][m][1]; const int col = col0 + bj * 128, i = col >> 4, h0 = col & 15;
                    u32x4 w; w.x = cvt_pk_bf16(gelu_tanh_f(v0[0]), gelu_tanh_f(v0[1])); w.y = cvt_pk_bf16(gelu_tanh_f(v0[2]), gelu_tanh_f(v0[3]));
                    w.z = cvt_pk_bf16(gelu_tanh_f(v1[0]), gelu_tanh_f(v1[1])); w.w = cvt_pk_bf16(gelu_tanh_f(v1[2]), gelu_tanh_f(v1[3]));
                    *(u32x4*)(GB + (size_t)(c * LC + i) * S5W + u.z * 16 + h0) = w; } }
    }
};
struct EpiGlu { static constexpr bool PERM = true, PREFETCH = false; const bf16_t* GB; const float* bias; bf16_t* O;
    __device__ __forceinline__ void operator()(Acc& acc, const pg8::Unit& u, int wr, int wc, int fr, int fq, int par) const {
        const int row0 = u.pm * 256 + wr * 64 + fr, col0 = u.pn * 256 + wc * 32 + 8 * fq;
        f32x4 bv[2][2];
#pragma unroll
        for (int bj = 0; bj < 2; ++bj)
#pragma unroll
            for (int n = 0; n < 2; ++n) bv[bj][n] = *(const f32x4*)(bias + col0 + bj * 128 + 4 * n);
#pragma unroll
        for (int ai = 0; ai < 2; ++ai)
#pragma unroll
            for (int m = 0; m < 4; ++m) { const int row = row0 + ai * 128 + m * 16;
#pragma unroll
                for (int bj = 0; bj < 2; ++bj) { const f32x4 v0 = acc[ai][bj][m][0] + bv[bj][0], v1 = acc[ai][bj][m][1] + bv[bj][1]; const int col = col0 + bj * 128;
                    const u32x4 g = *(const u32x4*)(GB + (size_t)row * S5W + col);
                    u32x4 w; w.x = cvt_pk_bf16(bflo(g.x) * sigmoidf_fast(v0[0]), bfhi(g.x) * sigmoidf_fast(v0[1])); w.y = cvt_pk_bf16(bflo(g.y) * sigmoidf_fast(v0[2]), bfhi(g.y) * sigmoidf_fast(v0[3]));
                    w.z = cvt_pk_bf16(bflo(g.z) * sigmoidf_fast(v1[0]), bfhi(g.z) * sigmoidf_fast(v1[1])); w.w = cvt_pk_bf16(bflo(g.w) * sigmoidf_fast(v1[2]), bfhi(g.w) * sigmoidf_fast(v1[3]));
                    *(u32x4*)(O + (size_t)row * DM + col) = w; } }
    }
};

struct EpiCrossSm { static constexpr bool PERM = true, PREFETCH = true; unsigned char* ws; LAS f32x2* red; LAS unsigned char* lds;
    __device__ __forceinline__ void prefetch(LAS unsigned char* l, const pg8::Unit& u, int par, int wid, int lane) const { pss_prefetch(l, ws, u.pm, par, wid, lane); }
    __device__ __forceinline__ void operator()(Acc& acc, const pg8::Unit& u, int wr, int wc, int fr, int fq, int par) const {
        constexpr float C = 0.04419417382415922f * 1.4426950408889634f;
        const int row0 = u.pm * 256 + wr * 64 + fr, col0 = u.pn * 256 + wc * 32 + 8 * fq;
        unsigned char* w_ = fresh_ws(ws); bf16_t* O = (bf16_t*)(w_ + WS_POOL + PL_CP);
        float rs[2][4]; row_rstd_lds(lds, par, wr * 64 + fr, rs);
        float mw[2][4];
#pragma unroll
        for (int ai = 0; ai < 2; ++ai)
#pragma unroll
            for (int m = 0; m < 4; ++m) { const float k = rs[ai][m] * C; float mx = -3.0e38f;
#pragma unroll
                for (int bj = 0; bj < 2; ++bj)
#pragma unroll
                    for (int n = 0; n < 2; ++n) { f32x4 v = acc[ai][bj][m][n] * k; acc[ai][bj][m][n] = v; mx = fmaxf(fmaxf(mx, fmaxf(v[0], v[1])), fmaxf(v[2], v[3])); }
                mx = fmaxf(mx, __shfl_xor(mx, 16)); mx = fmaxf(mx, __shfl_xor(mx, 32)); float s = 0.f;
#pragma unroll
                for (int bj = 0; bj < 2; ++bj)
#pragma unroll
                    for (int n = 0; n < 2; ++n) { f32x4 v = acc[ai][bj][m][n]; v[0] = fast_exp2(v[0] - mx); v[1] = fast_exp2(v[1] - mx); v[2] = fast_exp2(v[2] - mx); v[3] = fast_exp2(v[3] - mx); acc[ai][bj][m][n] = v; s += (v[0] + v[1]) + (v[2] + v[3]); }
                s += __shfl_xor(s, 16); s += __shfl_xor(s, 32); mw[ai][m] = mx;
                if (fq == 0) red[(ai * 128 + wr * 64 + m * 16 + fr) * 4 + wc] = (f32x2){mx, s}; }
        asm volatile("s_waitcnt lgkmcnt(0)" ::: "memory"); __builtin_amdgcn_s_barrier(); asm volatile("" ::: "memory");
#pragma unroll
        for (int ai = 0; ai < 2; ++ai)
#pragma unroll
            for (int m = 0; m < 4; ++m) { const LAS f32x2* rr = red + (ai * 128 + wr * 64 + m * 16 + fr) * 4; const f32x2 r0 = rr[0], r1 = rr[1], r2 = rr[2], r3 = rr[3];
                const float M = fmaxf(fmaxf(r0.x, r1.x), fmaxf(r2.x, r3.x));
                const float tot = (r0.y * fast_exp2(r0.x - M) + r1.y * fast_exp2(r1.x - M)) + (r2.y * fast_exp2(r2.x - M) + r3.y * fast_exp2(r3.x - M));
                const float f = fast_exp2(mw[ai][m] - M) * fast_rcp(tot);
                bf16_t* rp = O + (size_t)(row0 + ai * 128 + m * 16) * 1024 + col0;
#pragma unroll
                for (int bj = 0; bj < 2; ++bj) { const f32x4 v0 = acc[ai][bj][m][0] * f, v1 = acc[ai][bj][m][1] * f;
                    u32x4 w; w.x = cvt_pk_bf16(v0[0], v0[1]); w.y = cvt_pk_bf16(v0[2], v0[3]); w.z = cvt_pk_bf16(v1[0], v1[1]); w.w = cvt_pk_bf16(v1[2], v1[3]);
                    *(u32x4*)(rp + bj * 128) = w; } }
    }
};

template <int MODE>
__device__ __forceinline__ void transpose_item(const float* W, int K, int N, bf16_t* WT, LAS float* scr, int item, int lane, const float* gain = nullptr) {
    const int nblk = N / 32, kb = item / nblk, nb = item % nblk, k0 = 64 * kb, n0 = 32 * nb;
#pragma unroll 8
    for (int i = 0; i < 32; ++i) { const int kk = 2 * i + (lane >> 5); scr[kk * 33 + (lane & 31)] = W[(size_t)(k0 + kk) * N + n0 + (lane & 31)]; }
    LDS_WAIT(); asm volatile("" ::: "memory");
    const int c = lane & 7;
    f32x4 g0 = (f32x4){1.f, 1.f, 1.f, 1.f}, g1 = g0; if (gain) { g0 = *(const f32x4*)(gain + k0 + 8 * c); g1 = *(const f32x4*)(gain + k0 + 8 * c + 4); }
    int r0;
    if (MODE == 1) { r0 = (n0 < DFF) ? (256 * (n0 / 128) + (n0 % 128)) : (256 * ((n0 - DFF) / 128) + 128 + ((n0 - DFF) % 128)); } else r0 = n0;
#pragma unroll
    for (int j = 0; j < 4; ++j) { const int n = (lane >> 3) + 8 * j; const LAS float* s = scr + (8 * c) * 33 + n;
        u32x4 o; o.x = cvt_pk_bf16(s[0 * 33] * g0.x, s[1 * 33] * g0.y); o.y = cvt_pk_bf16(s[2 * 33] * g0.z, s[3 * 33] * g0.w); o.z = cvt_pk_bf16(s[4 * 33] * g1.x, s[5 * 33] * g1.y); o.w = cvt_pk_bf16(s[6 * 33] * g1.z, s[7 * 33] * g1.w);
        *(u32x4*)(WT + (size_t)(r0 + n) * K + k0 + 8 * c) = o; }
    LDS_WAIT(); asm volatile("" ::: "memory");
}
__device__ __forceinline__ void convert_rows(const float* src, bf16_t* dst, size_t n8, size_t gtid, size_t gthreads) {
    for (size_t i = gtid; i < n8; i += gthreads) { const f32x4 a = *(const f32x4*)(src + i * 8), b = *(const f32x4*)(src + i * 8 + 4);
        u32x4 o; o.x = cvt_pk_bf16(a[0], a[1]); o.y = cvt_pk_bf16(a[2], a[3]); o.z = cvt_pk_bf16(b[0], b[1]); o.w = cvt_pk_bf16(b[2], b[3]); *(u32x4*)(dst + i * 8) = o; }
}

__device__ __forceinline__ void rms_row_to_bf16(const float* xrow, const float* g, bf16_t* orow, float* xcopy, int lane) {
    const f32x4* xr = (const f32x4*)xrow + lane;
    f32x4 v[8]; float s = 0.f;
#pragma unroll
    for (int j = 0; j < 8; ++j) { v[j] = xr[64 * j]; s += (v[j].x * v[j].x + v[j].y * v[j].y) + (v[j].z * v[j].z + v[j].w * v[j].w); }
    if (xcopy) {
#pragma unroll
        for (int j = 0; j < 8; ++j) ((f32x4*)xcopy + lane)[64 * j] = v[j]; }
    const float rstd = 1.0f / sqrtf(wave_sum(s) * (1.f / DM) + EPS);
    const f32x4* gr = (const f32x4*)g + lane;
    u32x2* o8 = (u32x2*)orow + lane;
#pragma unroll
    for (int j = 0; j < 8; ++j) { const f32x4 gg = gr[64 * j]; u32x2 w; w.x = cvt_pk_bf16(v[j].x * rstd * gg.x, v[j].y * rstd * gg.y); w.y = cvt_pk_bf16(v[j].z * rstd * gg.z, v[j].w * rstd * gg.w); o8[64 * j] = w; }
}
__device__ __forceinline__ void norm_phase(const Frame& F, const float* g) {
    const int gw = F.bid * NWAVES + F.wave, NGW = F.G * NWAVES; bf16_t* HB = (bf16_t*)WSP(WS_HB);
    for (int m = gw; m < TT; m += NGW) rms_row_to_bf16(F.x + (size_t)m * DM, g, HB + (size_t)m * DM, nullptr, F.lane);
}
__device__ __forceinline__ void final_norm_phase(const Frame& F, const float* g) {
    const float* PSS = (const float*)(WSP(WS_MISC) + MISC_PSS); const bf16_t* XB = (const bf16_t*)WSP(WS_HB);
    const int tid = F.tid, wid = tid >> 6, wr = wid >> 2, wc = wid & 3, fq = (tid >> 4) & 3, fr = tid & 15;
    for (int L = F.bid; L < (TT / 256) * 8; L += F.G) { const int pm = L >> 3, pn = L & 7;
        const u32x4* XL = (const u32x4*)(WSP(WS_X) + (size_t)L * 65536) + tid; const int row0 = pm * 256 + wr * 64 + fr, col0 = pn * 256 + wc * 32 + 8 * fq;
        float rs[2][4]; row_rstd(PSS, row0, rs);
        f32x4 gg[2][2];
#pragma unroll
        for (int bj = 0; bj < 2; ++bj) { gg[bj][0] = *(const f32x4*)(g + col0 + bj * 128); gg[bj][1] = *(const f32x4*)(g + col0 + bj * 128 + 4); }
#pragma unroll
        for (int ai = 0; ai < 2; ++ai)
#pragma unroll
            for (int m = 0; m < 4; ++m) { const size_t ro = (size_t)(row0 + ai * 128 + m * 16) * DM + col0; const u32x4 lo = XL[(ai * 4 + m) * 512];
#pragma unroll
                for (int bj = 0; bj < 2; ++bj) { const u32x4 h = *(const u32x4*)(XB + ro + bj * 128); float* op = F.x + ro + bj * 128;
                    *(f32x4*)op = res_dec4(h.x, h.y, lo[bj * 2]) * rs[ai][m] * gg[bj][0]; *(f32x4*)(op + 4) = res_dec4(h.z, h.w, lo[bj * 2 + 1]) * rs[ai][m] * gg[bj][1]; } }
    }
}

__device__ __forceinline__ void s5_precompute_group(const Frame& F, int e, int g) {
    LAS float* L = (LAS float*)F.lds;
    LAS float* apow = L;
    LAS float* bb = apow + 8448;
    LAS float* cc = bb + 4096;
    LAS float* km = cc + 4096;
    LAS float* dsk = km + 16384;
    const float* lre = F.in[I_LRE], *lim = F.in[I_LIM], *ldt = F.in[I_LDT], *bre = F.in[I_BRE], *bim = F.in[I_BIM], *cre = F.in[I_CRE], *cim = F.in[I_CIM], *dsk_g = F.in[I_S5D];
    const int tid = F.tid;
    for (int idx = tid; idx < 2 * 64 * 33; idx += NTHREADS) { const int k = idx % 33, p = (idx / 33) % 64, dir = idx / (33 * 64);
        const size_t pi = ((size_t)(e * 2 + dir) * S5G + g) * S5P + p; const float lr = fminf(lre[pi], -1e-4f), li = lim[pi], dt = expf(ldt[(e * 2 + dir) * S5G + g]);
        const float mag = expf(lr * dt * (float)k); float sn, cs; sincosf(li * dt * (float)k, &sn, &cs); apow[idx * 2] = mag * cs; apow[idx * 2 + 1] = mag * sn; }
    for (int idx = tid; idx < 2 * 64 * 16; idx += NTHREADS) { const int h = idx % 16, p = (idx / 16) % 64, dir = idx / 1024;
        const size_t pi = ((size_t)(e * 2 + dir) * S5G + g) * S5P + p; const float lr = fminf(lre[pi], -1e-4f), li = lim[pi], dt = expf(ldt[(e * 2 + dir) * S5G + g]);
        const float mag = expf(lr * dt); float sn, cs; sincosf(li * dt, &sn, &cs); const float ar = mag * cs, ai = mag * sn, nr = ar - 1.0f, den = lr * lr + li * li;
        const float fr = (nr * lr + ai * li) / den, fi = (ai * lr - nr * li) / den; const float br = bre[pi * 16 + h], bi = bim[pi * 16 + h];
        bb[idx * 2] = fr * br - fi * bi; bb[idx * 2 + 1] = fr * bi + fi * br; }
    for (int idx = tid; idx < 2 * 16 * 64; idx += NTHREADS) { const int p = idx % 64, h = (idx / 64) % 16, dir = idx / 1024;
        const size_t ci = (((size_t)(e * 2 + dir) * S5G + g) * S5H + h) * S5P + p; cc[idx * 2] = cre[ci]; cc[idx * 2 + 1] = cim[ci]; }
    if (tid < 16) dsk[tid] = dsk_g[e * S5W + g * 16 + tid];
    LDS_WAIT(); __syncthreads();
    for (int idx = tid; idx < 2 * 32 * 256; idx += NTHREADS) { const int hp = idx & 15, h = (idx >> 4) & 15, k = (idx >> 8) & 31, dir = idx >> 13; float s = 0.f;
        for (int p = 0; p < 64; ++p) { const float cr = cc[((dir * 16 + h) * 64 + p) * 2], ci = cc[((dir * 16 + h) * 64 + p) * 2 + 1], ar = apow[((dir * 64 + p) * 33 + k) * 2], ai = apow[((dir * 64 + p) * 33 + k) * 2 + 1];
            const float br = bb[((dir * 64 + p) * 16 + hp) * 2], bi = bb[((dir * 64 + p) * 16 + hp) * 2 + 1]; const float wr = cr * ar - ci * ai, wi = cr * ai + ci * ar; s += wr * br - wi * bi; }
        km[idx] = s; }
    LDS_WAIT(); __syncthreads();
    bf16_t* WST = (bf16_t*)WSP(WS_WST) + (size_t)(e * 64 + g) * (S5NS * S5K1);
    bf16_t* TG = (bf16_t*)WSP(WS_TG) + (size_t)(e * 64 + g) * (S5K1 * S5K2);
    for (int idx = tid; idx < S5NS * S5K1 / 2; idx += NTHREADS) { const int k2 = (idx % (S5K1 / 2)) * 2, n = idx / (S5K1 / 2); const int dir = n >> 7, p = (n >> 1) & 63, ri = n & 1; const int j = k2 >> 4, hp = k2 & 15;
        const int ex = dir == 0 ? (LC - 1 - j) : j; const float ar = apow[((dir * 64 + p) * 33 + ex) * 2], ai = apow[((dir * 64 + p) * 33 + ex) * 2 + 1];
        float v[2];
#pragma unroll
        for (int q = 0; q < 2; ++q) { const float br = bb[((dir * 64 + p) * 16 + hp + q) * 2], bi = bb[((dir * 64 + p) * 16 + hp + q) * 2 + 1]; v[q] = ri == 0 ? (ar * br - ai * bi) : (ar * bi + ai * br); }
        *(unsigned*)(WST + (size_t)n * S5K1 + k2) = cvt_pk_bf16(v[0], v[1]); }
    for (int idx = tid; idx < S5K1 * S5K2 / 2; idx += NTHREADS) { const int k2 = (idx % (S5K2 / 2)) * 2, n = idx / (S5K2 / 2); const int i = n >> 4, h = n & 15; float v[2];
        if (k2 < S5K1) { const int j = k2 >> 4, hp = k2 & 15;
#pragma unroll
            for (int q = 0; q < 2; ++q) { float s = 0.f; if (j <= i) s += km[((0 * 32 + (i - j)) * 16 + h) * 16 + hp + q]; if (j >= i) s += km[((1 * 32 + (j - i)) * 16 + h) * 16 + hp + q]; if (i == j && h == hp + q) s += dsk[h]; v[q] = s; }
        } else { const int nn = k2 - S5K1, dir = nn >> 7, p = (nn >> 1) & 63; const int ex = dir == 0 ? (i + 1) : (LC - i);
            const float ar = apow[((dir * 64 + p) * 33 + ex) * 2], ai = apow[((dir * 64 + p) * 33 + ex) * 2 + 1], cr = cc[((dir * 16 + h) * 64 + p) * 2], ci = cc[((dir * 16 + h) * 64 + p) * 2 + 1];
            v[0] = cr * ar - ci * ai; v[1] = -(cr * ai + ci * ar); }
        *(unsigned*)(TG + (size_t)n * S5K2 + k2) = cvt_pk_bf16(v[0], v[1]); }
    f32x2* AL = (f32x2*)(WSP(WS_MISC) + MISC_AL);
    if (tid < 128) { const int dir = tid >> 6, p = tid & 63; AL[((e * 2 + dir) * 64 + g) * 64 + p] = (f32x2){apow[((dir * 64 + p) * 33 + LC) * 2], apow[((dir * 64 + p) * 33 + LC) * 2 + 1]}; }
    __syncthreads();
}

__device__ __forceinline__ void s5_scan_phase(const Frame& F, int e) {
    const float* SST = (const float*)POOLP(PL_SST); bf16_t* UX = (bf16_t*)POOLP(PL_UX);
    LAS f32x2* tot = (LAS f32x2*)F.lds;
    const int p = F.lane, w = F.wave;
    for (int item = F.bid; item < 2 * 2 * 64; item += F.G) {
        const int g = item & 63, dir = (item >> 6) & 1, seq = item >> 7;
        const f32x2 aL = ((const f32x2*)(WSP(WS_MISC) + MISC_AL))[((e * 2 + dir) * 64 + g) * 64 + p];
        const int c0 = seq ? NCH_P : 0, cs = seq ? 32 : 16;
        const int step = dir == 0 ? 1 : -1;
        const float* sbase = SST + (size_t)g * 256 + dir * 128 + 2 * p;
        bf16_t* xbase = UX + (size_t)g * NCH * S5K2 + S5K1 + dir * 128 + 2 * p;
#pragma unroll 1
        for (int q = 0; q < 2; ++q) { const int s = 2 * w + q; int c = c0 + s * cs + (dir == 0 ? 0 : cs - 1); float xr = 0.f, xi = 0.f;
#pragma unroll 1
            for (int it = 0; it < cs; it += 8) { f32x2 sv[8];
#pragma unroll
                for (int k = 0; k < 8; ++k) sv[k] = *(const f32x2*)(sbase + (size_t)(c + k * step) * (64 * 256));
#pragma unroll
                for (int k = 0; k < 8; ++k) { const float nr = aL.x * xr - aL.y * xi + sv[k].x, ni = aL.x * xi + aL.y * xr + sv[k].y; xr = nr; xi = ni; }
                c += 8 * step; }
            tot[s * 64 + p] = (f32x2){xr, xi}; }
        LDS_WAIT(); __syncthreads();
        float pr = aL.x, pi = aL.y;
        for (int k = cs; k > 1; k >>= 1) { const float nr = pr * pr - pi * pi, ni = 2.f * pr * pi; pr = nr; pi = ni; }
#pragma unroll 1
        for (int q = 0; q < 2; ++q) { const int s = 2 * w + q; float xr = 0.f, xi = 0.f;
            if (dir == 0) { for (int j = 0; j < s; ++j) { const f32x2 t = tot[j * 64 + p]; const float nr = pr * xr - pi * xi + t.x, ni = pr * xi + pi * xr + t.y; xr = nr; xi = ni; } }
            else { for (int j = 15; j > s; --j) { const f32x2 t = tot[j * 64 + p]; const float nr = pr * xr - pi * xi + t.x, ni = pr * xi + pi * xr + t.y; xr = nr; xi = ni; } }
            int c = c0 + s * cs + (dir == 0 ? 0 : cs - 1);
#pragma unroll 1
            for (int it = 0; it < cs; it += 8) { f32x2 sv[8];
#pragma unroll
                for (int k = 0; k < 8; ++k) sv[k] = *(const f32x2*)(sbase + (size_t)(c + k * step) * (64 * 256));
#pragma unroll
                for (int k = 0; k < 8; ++k) { *(unsigned*)(xbase + (size_t)(c + k * step) * S5K2) = cvt_pk_bf16(xr, xi);
                    const float nr = aL.x * xr - aL.y * xi + sv[k].x, ni = aL.x * xi + aL.y * xr + sv[k].y; xr = nr; xi = ni; }
                c += 8 * step; } }
        __syncthreads();
    }
}

__device__ __forceinline__ void qk_prep_phase(const Frame& F, int o) {
    bf16_t* Z = (bf16_t*)POOLP(PL_Z); bf16_t* KC = (bf16_t*)POOLP(PL_KC); const float* rope = (const float*)(WSP(WS_MISC) + MISC_ROPE);
    const float* qg = F.in[I_QN] + o * 128, *kg = F.in[I_KN] + o * 128;
    const int sub = F.lane >> 4, j = F.lane & 15;
    const long nrows = (long)TT * 20, gq = ((long)F.bid * NWAVES + F.wave) * 4 + sub, nq = (long)F.G * NWAVES * 4;
    for (long r = gq; r < nrows; r += nq) {
        const int t = (int)(r / 20), hh = (int)(r % 20);
        bf16_t* p = Z + (size_t)t * ZLD + (hh < 16 ? hh * 128 : 2048 + (hh - 16) * 128) + j * 8;
        const u32x4 w = *(const u32x4*)p; float v[8] = {bflo(w.x), bfhi(w.x), bflo(w.y), bfhi(w.y), bflo(w.z), bfhi(w.z), bflo(w.w), bfhi(w.w)};
        float s = 0.f;
#pragma unroll
        for (int q = 0; q < 8; ++q) s += v[q] * v[q];
        s += __shfl_xor(s, 1); s += __shfl_xor(s, 2); s += __shfl_xor(s, 4); s += __shfl_xor(s, 8);
        const float rstd = 1.0f / sqrtf(s * (1.f / 128.f) + EPS); const float* gg = (hh < 16 ? qg : kg) + j * 8;
        const int tl = t < T_P ? t : t - T_P; const int pos = (j < 8) ? (tl >> 6) : (tl & 63);
        const float* rp = rope + ((size_t)pos * 32 + 8 * (j & 3)) * 2;
        float ov[8]; const float osc = hh < 16 ? 0.12751743f : 1.0f;
#pragma unroll
        for (int q = 0; q < 8; ++q) { const float x = v[q] * rstd * gg[q]; const float y = __shfl_xor(x, 4); const float cs = rp[2 * q], sn = rp[2 * q + 1];
            ov[q] = ((j & 4) ? (x * cs + y * sn) : (x * cs - y * sn)) * osc; }
        u32x4 ow; ow.x = cvt_pk_bf16(ov[0], ov[1]); ow.y = cvt_pk_bf16(ov[2], ov[3]); ow.z = cvt_pk_bf16(ov[4], ov[5]); ow.w = cvt_pk_bf16(ov[6], ov[7]);
        *(u32x4*)p = ow;
    }
}

__device__ __forceinline__ void cross_softmax_phase(const Frame& F) {
    const float* CS = (const float*)POOLP(PL_CS); bf16_t* CP = (bf16_t*)POOLP(PL_CP);
    const long nrows = (long)TT * 4, gw = (long)F.bid * NWAVES + F.wave, NGW = (long)F.G * NWAVES;
    constexpr float C = 0.04419417382415922f * 1.4426950408889634f;
    for (long r = gw; r < nrows; r += NGW) {
        const f32x4 v = *((const f32x4*)(CS + r * 256) + F.lane);
        float m = fmaxf(fmaxf(v.x, v.y), fmaxf(v.z, v.w));
#pragma unroll
        for (int o = 1; o < 64; o <<= 1) m = fmaxf(m, __shfl_xor(m, o));
        const float e0 = fast_exp2((v.x - m) * C), e1 = fast_exp2((v.y - m) * C), e2 = fast_exp2((v.z - m) * C), e3 = fast_exp2((v.w - m) * C);
        const float inv = fast_rcp(wave_sum((e0 + e1) + (e2 + e3)));
        u32x2 w; w.x = cvt_pk_bf16(e0 * inv, e1 * inv); w.y = cvt_pk_bf16(e2 * inv, e3 * inv);
        *((u32x2*)(CP + r * 256) + F.lane) = w;
    }
}

__device__ __forceinline__ void prologue_phase(const Frame& F) {
    LAS float* scr = (LAS float*)(F.lds + F.wave * 16384);
    const int gw = F.bid * NWAVES + F.wave, NGW = F.G * NWAVES;
    constexpr int IT_GU = (DM / 64) * (2 * DFF / 32), IT_D = (DFF / 64) * (DM / 32), IT_WINE = (DM / 64) * (EVEN_IN / 32), IT_SQ = (DM / 64) * (DM / 32), IT_GLU = (S5W / 64) * (S5W / 32),
                  IT_WINO = (DM / 64) * (ODD_IN / 32), IT_KV = (DM / 64) * (2 * DM / 32);
    constexpr int N_GU = 8 * IT_GU, N_D = 8 * IT_D, N_WINE = 2 * IT_WINE, N_WOUTE = 2 * IT_SQ, N_GLU = 2 * IT_GLU, N_WINO = 2 * IT_WINO, N_WOUTO = 2 * IT_SQ, N_KV = 4 * IT_KV, N_WO = 4 * IT_SQ;
    constexpr int NITEMS = N_GU + N_D + N_WINE + N_WOUTE + N_GLU + N_WINO + N_WOUTO + N_KV + N_WO;
    for (int it = gw; it < NITEMS; it += NGW) {
        int r = it;
        if (r < N_GU) { const int w = r / IT_GU, l = w >> 1, f = w & 1; transpose_item<1>(F.in[f ? I_F2GU : I_F1GU] + (size_t)l * DM * 2 * DFF, DM, 2 * DFF, (bf16_t*)WSP(WS_WGU + w * SZ_WGU), scr, r % IT_GU, F.lane, F.in[f ? I_F2N : I_F1N] + l * DM); continue; } r -= N_GU;
        if (r < N_D) { const int w = r / IT_D, l = w >> 1, f = w & 1; transpose_item<0>(F.in[f ? I_F2D : I_F1D] + (size_t)l * DFF * DM, DFF, DM, (bf16_t*)WSP(WS_WD + w * SZ_WD), scr, r % IT_D, F.lane); continue; } r -= N_D;
        if (r < N_WINE) { const int e = r / IT_WINE; transpose_item<0>(F.in[I_EWIN] + (size_t)e * DM * EVEN_IN, DM, EVEN_IN, (bf16_t*)WSP(WS_WINE + e * SZ_WINE), scr, r % IT_WINE, F.lane, F.in[I_MIXN] + (2 * e) * DM); continue; } r -= N_WINE;
        if (r < N_WOUTE) { const int e = r / IT_SQ; transpose_item<0>(F.in[I_EWOUT] + (size_t)e * DM * DM, DM, DM, (bf16_t*)WSP(WS_WOUTE + e * SZ_SQ), scr, r % IT_SQ, F.lane); continue; } r -= N_WOUTE;
        if (r < N_GLU) { const int e = r / IT_GLU; transpose_item<0>(F.in[I_GLUW] + (size_t)e * S5W * S5W, S5W, S5W, (bf16_t*)WSP(WS_GLU + e * SZ_GLU), scr, r % IT_GLU, F.lane); continue; } r -= N_GLU;
        if (r < N_WINO) { const int o = r / IT_WINO; transpose_item<0>(F.in[I_OWIN] + (size_t)o * DM * ODD_IN, DM, ODD_IN, (bf16_t*)WSP(WS_WINO + o * SZ_WINO), scr, r % IT_WINO, F.lane, F.in[I_MIXN] + (2 * o + 1) * DM); continue; } r -= N_WINO;
        if (r < N_WOUTO) { const int o = r / IT_SQ; transpose_item<0>(F.in[I_OWOUT] + (size_t)o * DM * DM, DM, DM, (bf16_t*)WSP(WS_WOUTO + o * SZ_SQ), scr, r % IT_SQ, F.lane); continue; } r -= N_WOUTO;
        if (r < N_KV) { const int l = r / IT_KV; transpose_item<0>(F.in[I_CWKV] + (size_t)l * DM * 2 * DM, DM, 2 * DM, (bf16_t*)POOLP(PL_WKVT) + (size_t)l * 2 * DM * DM, scr, r % IT_KV, F.lane); continue; } r -= N_KV;
        { const int l = r / IT_SQ; transpose_item<0>(F.in[I_CWO] + (size_t)l * DM * DM, DM, DM, (bf16_t*)POOLP(PL_WOT) + (size_t)l * DM * DM, scr, r % IT_SQ, F.lane); }
    }
    convert_rows(F.in[I_CWQ], (bf16_t*)POOLP(PL_WQB), (size_t)4 * DM * DM / 8, (size_t)F.bid * NTHREADS + F.tid, (size_t)F.G * NTHREADS);
    for (int m = gw; m < 4 * 2 * NMEM; m += NGW) { const int l = m / (2 * NMEM), s = (m / NMEM) & 1, j = m % NMEM;
        rms_row_to_bf16(F.in[s ? I_MS : I_MP] + (size_t)j * DM, F.in[I_MN] + l * DM, (bf16_t*)POOLP(PL_MEMN) + (size_t)m * DM, nullptr, F.lane); }
    for (int m = gw; m < TT; m += NGW) { const float* src = m < T_P ? F.in[I_XP] + (size_t)m * DM : F.in[I_XS] + (size_t)(m - T_P) * DM;
        const f32x4* xr = (const f32x4*)src + F.lane; u32x2* bo = (u32x2*)((bf16_t*)WSP(WS_HB) + (size_t)m * DM) + F.lane; float s = 0.f;
        const int rr = m & 255, ai = rr >> 7, wr = (rr >> 6) & 1, mm = (rr >> 4) & 3, fr = rr & 15, cc = 4 * F.lane, bj = cc >> 7, wc = (cc >> 5) & 3, fq = (cc >> 3) & 3, n = (cc >> 2) & 1;
        unsigned* xl = (unsigned*)(WSP(WS_X) + (size_t)(m >> 8) * 8 * 65536) + ((size_t)((ai * 4 + mm) * 512 + (wr * 4 + wc) * 64 + fq * 16 + fr)) * 4 + bj * 2 + n;
#pragma unroll
        for (int j = 0; j < 8; ++j) { const f32x4 v = xr[64 * j]; unsigned a0, a1, lo; res_enc4(v, a0, a1, lo); bo[64 * j] = (u32x2){a0, a1}; xl[(size_t)j * 16384] = lo; s += (v.x * v.x + v.y * v.y) + (v.z * v.z + v.w * v.w); }
        s = wave_sum(s);
        if (F.lane < 8) ((float*)(WSP(WS_MISC) + MISC_PSS))[(size_t)m * 8 + F.lane] = F.lane == 0 ? s : 0.f; }
    { float* rope = (float*)(WSP(WS_MISC) + MISC_ROPE); const int gt = F.bid * NTHREADS + F.tid;
      if (gt < 256 * 32) { const int pos = gt >> 5, i = gt & 31; const float inv = powf(10000.0f, -(float)(2 * i) / 64.0f); float sn, cs; sincosf((float)pos * inv, &sn, &cs); rope[gt * 2] = cs; rope[gt * 2 + 1] = sn; }
      if (gt < 2) { float s1 = 0.f, s2 = 0.f; for (int q = 0; q < 64; ++q) { s1 += F.in[I_LQ1][gt * 64 + q] * F.in[I_LK1][gt * 64 + q]; s2 += F.in[I_LQ2][gt * 64 + q] * F.in[I_LK2][gt * 64 + q]; }
          const float linit = 0.8f - 0.6f * expf(-0.3f * (float)(2 * gt)); ((float*)(WSP(WS_MISC) + MISC_LAM))[gt * 2] = expf(s1) - expf(s2) + linit; ((float*)(WSP(WS_MISC) + MISC_LAM))[gt * 2 + 1] = linit; } }
}
__device__ __forceinline__ void s5_precompute_phase(const Frame& F) {
    for (int w = F.G - 1 - F.bid; w < 2 * S5G; w += F.G) s5_precompute_group(F, w / S5G, w % S5G);
}

#ifndef GQA_SDEPTH
#define GQA_SDEPTH 1
#endif
#ifndef DIFF_SDEPTH
#define DIFF_SDEPTH 1
#endif
#ifndef ATT_SETPRIO
#define ATT_SETPRIO 0
#endif
#if ATT_SETPRIO
#define ATT_PRIO(x) __builtin_amdgcn_s_setprio(x)
#else
#define ATT_PRIO(x) do {} while (0)
#endif
#ifndef FIXREF_LIMIT_GQA
#define FIXREF_LIMIT_GQA 40.0f
#define FIXREF_LIMIT_DIFF 20.0f
#endif
namespace att {
constexpr int NW = 8, QBLK = 32, KVBLK = 64, DV = 128;
constexpr float THR = 8.f;
__device__ __forceinline__ int crow(int r, int hi) { return (r & 3) + 8 * (r >> 2) + 4 * hi; }
template <int DQK> __device__ __forceinline__ int kswz(int row, int colB) { if (DQK == 128) return row * 256 + (colB ^ ((row & 7) << 4)); else return row * 128 + (colB ^ (((row >> 1) & 7) << 4)); }
__device__ __forceinline__ int v_st(int k, int c) { const int kk = k; return ((kk >> 3) * 4 + (c >> 5)) * 512 + ((kk & 7) * 32 + (c & 31)) * 2; }
__device__ __forceinline__ int v_rd_base(int lane) { return ((lane & 3) << 3) | (((lane >> 2) & 3) << 6) | (((lane >> 4) & 1) << 5) | (((lane >> 5) & 1) << 8); }
constexpr int v_rd_off(int d0, int ks, int half) { return d0 * 512 + ks * 4096 + half * 2048; }
template <int OFF> __device__ __forceinline__ s16x4 tr_read(int vb) { s16x4 r; asm volatile("ds_read_b64_tr_b16 %0, %1 offset:%2" : "=&v"(r) : "v"(vb), "i"(OFF) : "memory"); return r; }
template <int D0> __device__ __forceinline__ void pv_one(f32x16& od, int vb, bf16x8 pa0, bf16x8 pa1, bf16x8 pa2, bf16x8 pa3) {
  const s16x4 l0 = tr_read<v_rd_off(D0, 0, 0)>(vb), h0 = tr_read<v_rd_off(D0, 0, 1)>(vb), l1 = tr_read<v_rd_off(D0, 1, 0)>(vb), h1 = tr_read<v_rd_off(D0, 1, 1)>(vb);
  const s16x4 l2 = tr_read<v_rd_off(D0, 2, 0)>(vb), h2 = tr_read<v_rd_off(D0, 2, 1)>(vb), l3 = tr_read<v_rd_off(D0, 3, 0)>(vb), h3 = tr_read<v_rd_off(D0, 3, 1)>(vb);
  asm volatile("s_waitcnt lgkmcnt(0)" ::: "memory"); SBAR();
#define PK(L, H) (bf16x8){L[0], L[1], L[2], L[3], H[0], H[1], H[2], H[3]}
  ATT_PRIO(1);
  od = __builtin_amdgcn_mfma_f32_32x32x16_bf16(pa0, PK(l0, h0), od, 0, 0, 0);
  od = __builtin_amdgcn_mfma_f32_32x32x16_bf16(pa1, PK(l1, h1), od, 0, 0, 0);
  od = __builtin_amdgcn_mfma_f32_32x32x16_bf16(pa2, PK(l2, h2), od, 0, 0, 0);
  od = __builtin_amdgcn_mfma_f32_32x32x16_bf16(pa3, PK(l3, h3), od, 0, 0, 0);
  ATT_PRIO(0);
#undef PK
}
__device__ __forceinline__ void pv_d0(f32x16* o, int vb, bf16x8 pa0, bf16x8 pa1, bf16x8 pa2, bf16x8 pa3) {
  pv_one<0>(o[0], vb, pa0, pa1, pa2, pa3); pv_one<1>(o[1], vb, pa0, pa1, pa2, pa3); pv_one<2>(o[2], vb, pa0, pa1, pa2, pa3); pv_one<3>(o[3], vb, pa0, pa1, pa2, pa3);
}
template <int DQK> struct Cst { static constexpr float SCALE = DQK == 128 ? 0.088388347648318440f : 0.125f; static constexpr float C = SCALE * 1.4426950408889634f; };

template <int DQK, bool FIXED>
__device__ __forceinline__ void partialSM(f32x16& p0, f32x16& p1, float& m_reg, float& mn, float& alpha) {
  if (FIXED) { mn = 0.f; alpha = 1.f;
#pragma unroll
    for (int r = 0; r < 16; ++r) p0[r] = __builtin_amdgcn_exp2f(p0[r]);
    return; }
  constexpr float THR2 = THR * 1.4426950408889634f;
  float pmax = p0[0];
#pragma unroll
  for (int r = 1; r < 16; ++r) pmax = fmaxf(pmax, p0[r]);
#pragma unroll
  for (int r = 0; r < 16; ++r) pmax = fmaxf(pmax, p1[r]);
  { auto rr = __builtin_amdgcn_permlane32_swap(__float_as_uint(pmax), __float_as_uint(pmax), false, false);
    pmax = fmaxf(__uint_as_float(rr[0]), __uint_as_float(rr[1])); }
  if (__builtin_expect(__all(pmax - m_reg <= THR2), 1)) { mn = m_reg; alpha = 1.f; }
  else { mn = fmaxf(m_reg, pmax); alpha = __builtin_amdgcn_exp2f(m_reg - mn); m_reg = mn; }
#pragma unroll
  for (int r = 0; r < 16; ++r) p0[r] -= mn;
#pragma unroll
  for (int r = 0; r < 16; ++r) p1[r] -= mn;
#pragma unroll
  for (int r = 0; r < 16; ++r) p0[r] = __builtin_amdgcn_exp2f(p0[r]);
}
__device__ __forceinline__ void finishSM(f32x16& p0, f32x16& p1, float alpha, float& l_reg, bf16x8& pa0, bf16x8& pa1, bf16x8& pa2, bf16x8& pa3) {
#pragma unroll
  for (int r = 0; r < 16; ++r) p1[r] = __builtin_amdgcn_exp2f(p1[r]);
  float ps = 0;
#pragma unroll
  for (int r = 0; r < 16; ++r) ps += p0[r];
#pragma unroll
  for (int r = 0; r < 16; ++r) ps += p1[r];
  { auto rr = __builtin_amdgcn_permlane32_swap(__float_as_uint(ps), __float_as_uint(ps), false, false);
    ps = __uint_as_float(rr[0]) + __uint_as_float(rr[1]); }
  l_reg = l_reg * alpha + ps;
#define PK4(P, BASE, OUT) do { u32x4 w = {cvt_pk_bf16(P[BASE + 0], P[BASE + 1]), cvt_pk_bf16(P[BASE + 2], P[BASE + 3]), cvt_pk_bf16(P[BASE + 4], P[BASE + 5]), cvt_pk_bf16(P[BASE + 6], P[BASE + 7])}; \
    OUT = *reinterpret_cast<bf16x8*>(&w); } while (0)
  PK4(p0, 0, pa0); PK4(p0, 8, pa1); PK4(p1, 0, pa2); PK4(p1, 8, pa3);
#undef PK4
}
template <int DQK, bool ALIBI>
__device__ __forceinline__ void qkt(f32x16& p0, f32x16& p1, const char* Ks, const bf16x8* qr, int r32, int hi, float dq, float sl) {
  if (ALIBI) {
    float dh = dq - (float)(4 * hi); asm volatile("" : "+v"(dh));
    const float d0u = __uint_as_float(__builtin_amdgcn_readfirstlane(__float_as_uint(dq)));
    if (d0u >= 64.f || d0u <= -32.f) {
      const float s = d0u > 0.f ? sl : -sl, base = -s * dh;
#pragma unroll
      for (int r = 0; r < 16; ++r) { const float c = (float)((r & 3) + 8 * (r >> 2)); p0[r] = fmaf(s, c, base); p1[r] = fmaf(s, c + 32.f, base); }
    } else {
#pragma unroll
      for (int r = 0; r < 16; ++r) { const float c = (float)((r & 3) + 8 * (r >> 2)); p0[r] = -sl * fabsf(dh - c); p1[r] = -sl * fabsf(dh - (c + 32.f)); }
    }
  } else { p0 = f32x16{}; p1 = f32x16{}; }
  ATT_PRIO(1);
  bf16x8 nb0 = *reinterpret_cast<const bf16x8*>(Ks + kswz<DQK>(r32, hi * 16)), nb1 = *reinterpret_cast<const bf16x8*>(Ks + kswz<DQK>(32 + r32, hi * 16));
#pragma unroll
  for (int d0 = 0; d0 < DQK / 16; ++d0) { const bf16x8 b0 = nb0, b1 = nb1;
    if (d0 + 1 < DQK / 16) { const int cb = ((d0 + 1) * 16 + hi * 8) * 2; nb0 = *reinterpret_cast<const bf16x8*>(Ks + kswz<DQK>(r32, cb)); nb1 = *reinterpret_cast<const bf16x8*>(Ks + kswz<DQK>(32 + r32, cb)); }
    p0 = __builtin_amdgcn_mfma_f32_32x32x16_bf16(b0, qr[d0], p0, 0, 0, 0);
    p1 = __builtin_amdgcn_mfma_f32_32x32x16_bf16(b1, qr[d0], p1, 0, 0, 0); }
  ATT_PRIO(0);
}

template <int DQK, bool ALIBI, int SDEPTH, int LDKV, bool FIXED>
__device__ __forceinline__ void attn_pass(const bf16_t* __restrict__ Qw, const bf16_t* __restrict__ Kh, const bf16_t* __restrict__ Vh, int seq, char* lds, f32x16 (&o)[4], float qpos, float sl, int tid, const float mfix) {
  constexpr int SHM_V = KVBLK * DV * 2, SHM_K = KVBLK * DQK * 2;
  const int wid = tid >> 6, lane = tid & 63, r32 = lane & 31, hi = lane >> 5;
  char* V_lds = lds; char* K_lds = lds + 2 * SHM_V;
  float* ws = (float*)(lds + 2 * SHM_V + 2 * SHM_K) + wid * 64; float* li_l = ws; float* al_l = ws + 32;
  float m_reg = -1e30f, l_reg = 0; bf16x8 qr[DQK / 16];
#pragma unroll
  for (int d0 = 0; d0 < 4; ++d0) o[d0] = f32x16{};
#pragma unroll
  for (int d0 = 0; d0 < DQK / 16; ++d0) qr[d0] = *reinterpret_cast<const bf16x8*>(Qw + d0 * 16);
  const int sr = tid >> 4, sc = (tid & 15) * 8, vst0 = v_st(sr, sc), vst1 = v_st(32 + sr, sc);
  const int kr = DQK == 128 ? sr : (tid >> 3), kc = DQK == 128 ? sc : (tid & 7) * 8;
  const int vb0 = (int)(uintptr_t)V_lds + v_rd_base(lane);
  struct { bf16x8 vs0, vs1, ks0, ks1; } sr_[SDEPTH];
#define SLOAD(i, k0) do { sr_[i].vs0 = *(const bf16x8*)(Vh + (size_t)((k0) + sr) * LDKV + sc); sr_[i].vs1 = *(const bf16x8*)(Vh + (size_t)((k0) + 32 + sr) * LDKV + sc); \
    sr_[i].ks0 = *(const bf16x8*)(Kh + (size_t)((k0) + kr) * LDKV + kc); if (DQK == 128) sr_[i].ks1 = *(const bf16x8*)(Kh + (size_t)((k0) + 32 + kr) * LDKV + kc); } while (0)
#define SWRITE(b, i) do { *(bf16x8*)(V_lds + (b) * SHM_V + vst0) = sr_[i].vs0; *(bf16x8*)(V_lds + (b) * SHM_V + vst1) = sr_[i].vs1; \
    *(bf16x8*)(K_lds + (b) * SHM_K + kswz<DQK>(kr, kc * 2)) = sr_[i].ks0; if (DQK == 128) *(bf16x8*)(K_lds + (b) * SHM_K + kswz<DQK>(32 + kr, kc * 2)) = sr_[i].ks1; } while (0)
#define SWAIT() do { if (SDEPTH == 1) asm volatile("s_waitcnt vmcnt(0)" ::: "memory"); else if (DQK == 128) asm volatile("s_waitcnt vmcnt(4)" ::: "memory"); else asm volatile("s_waitcnt vmcnt(3)" ::: "memory"); } while (0)
#define RESC(a) do { if (!FIXED && __any((a) < 1.f)) { if (hi == 0) al_l[r32] = (a); asm volatile("s_waitcnt lgkmcnt(0)" ::: "memory"); \
    _Pragma("unroll") for (int d = 0; d < 4; ++d) _Pragma("unroll") for (int r = 0; r < 16; ++r) o[d][r] *= al_l[crow(r, hi)]; } } while (0)
  f32x16 pA0, pA1, pB0, pB1; float mnA, mnB, alA, alB; bf16x8 pa0, pa1, pa2, pa3; const int NT = seq / KVBLK;
  constexpr int SE = 0, SO = SDEPTH - 1;
  SLOAD(SE, 0); asm volatile("s_waitcnt vmcnt(0)" ::: "memory"); SWRITE(0, SE); __syncthreads();
  qkt<DQK, ALIBI>(pA0, pA1, K_lds, qr, r32, hi, qpos, sl); partialSM<DQK, FIXED>(pA0, pA1, m_reg, mnA, alA);
  SLOAD(SO, KVBLK); if (SDEPTH == 2) { if (2 < NT) SLOAD(SE, 2 * KVBLK); }
  SWAIT(); SWRITE(1, SO); __syncthreads();
  _Pragma("unroll 1") for (int j = 1; j + 1 < NT; j += 2) {
    SBAR(); qkt<DQK, ALIBI>(pB0, pB1, K_lds + SHM_K, qr, r32, hi, qpos - (float)(j * KVBLK), sl);
    finishSM(pA0, pA1, alA, l_reg, pa0, pa1, pa2, pa3); SBAR();
    SLOAD(SO, (j + SDEPTH) * KVBLK); SBAR();
    pv_d0(o, vb0, pa0, pa1, pa2, pa3); partialSM<DQK, FIXED>(pB0, pB1, m_reg, mnB, alB);
    __syncthreads(); SWAIT(); SWRITE(0, SE);
    RESC(alB); __syncthreads();
    SBAR(); qkt<DQK, ALIBI>(pA0, pA1, K_lds, qr, r32, hi, qpos - (float)((j + 1) * KVBLK), sl);
    finishSM(pB0, pB1, alB, l_reg, pa0, pa1, pa2, pa3); SBAR();
    if (SDEPTH == 1 || j + 3 < NT) SLOAD(SE, (j + 1 + SDEPTH) * KVBLK); SBAR();
    pv_d0(o, vb0 + SHM_V, pa0, pa1, pa2, pa3); partialSM<DQK, FIXED>(pA0, pA1, m_reg, mnA, alA);
    __syncthreads(); SWAIT(); SWRITE(1, SO);
    RESC(alA); __syncthreads();
  }
  SBAR(); qkt<DQK, ALIBI>(pB0, pB1, K_lds + SHM_K, qr, r32, hi, qpos - (float)((NT - 1) * KVBLK), sl);
  finishSM(pA0, pA1, alA, l_reg, pa0, pa1, pa2, pa3); SBAR();
  pv_d0(o, vb0, pa0, pa1, pa2, pa3); partialSM<DQK, FIXED>(pB0, pB1, m_reg, mnB, alB);
  __syncthreads(); RESC(alB);
  finishSM(pB0, pB1, alB, l_reg, pa0, pa1, pa2, pa3); SBAR();
  pv_d0(o, vb0 + SHM_V, pa0, pa1, pa2, pa3);
  if (hi == 0) li_l[r32] = l_reg; asm volatile("s_waitcnt lgkmcnt(0)" ::: "memory");
#pragma unroll
  for (int r = 0; r < 16; ++r) { const float rl = __builtin_amdgcn_rcpf(li_l[crow(r, hi)]);
#pragma unroll
    for (int d0 = 0; d0 < 4; ++d0) o[d0][r] *= rl; }
#undef SLOAD
#undef SWRITE
#undef SWAIT
#undef RESC
}
template <int DQK, bool ALIBI, int LDKV, bool FIXED>
__device__ __forceinline__ void attn_pass3(const bf16_t* __restrict__ Qw, const bf16_t* __restrict__ Kh, const bf16_t* __restrict__ Vh, int seq, char* lds, f32x16 (&o)[4], float qpos, float sl, int tid, const float mfix) {
  constexpr int SHM_V = KVBLK * DV * 2, SHM_K = KVBLK * DQK * 2;
  const int wid = tid >> 6, lane = tid & 63, r32 = lane & 31, hi = lane >> 5;
  char* V_lds = lds; char* K_lds = lds + 3 * SHM_V;
  float* ws = (float*)(lds + 3 * SHM_V + 3 * SHM_K) + wid * 64; float* li_l = ws; float* al_l = ws + 32;
  float m_reg = -1e30f, l_reg = 0; bf16x8 qr[DQK / 16];
#pragma unroll
  for (int d0 = 0; d0 < 4; ++d0) o[d0] = f32x16{};
#pragma unroll
  for (int d0 = 0; d0 < DQK / 16; ++d0) qr[d0] = *reinterpret_cast<const bf16x8*>(Qw + d0 * 16);
  const int sr = tid >> 4, sc = (tid & 15) * 8, vst0 = v_st(sr, sc), vst1 = v_st(32 + sr, sc);
  const int kr = DQK == 128 ? sr : (tid >> 3), kc = DQK == 128 ? sc : (tid & 7) * 8;
  const int vb0 = (int)(uintptr_t)V_lds + v_rd_base(lane);
  bf16x8 vs0, vs1, ks0, ks1;
#define SLOAD(k0) do { vs0 = *(const bf16x8*)(Vh + (size_t)((k0) + sr) * LDKV + sc); vs1 = *(const bf16x8*)(Vh + (size_t)((k0) + 32 + sr) * LDKV + sc); \
    ks0 = *(const bf16x8*)(Kh + (size_t)((k0) + kr) * LDKV + kc); if (DQK == 128) ks1 = *(const bf16x8*)(Kh + (size_t)((k0) + 32 + kr) * LDKV + kc); } while (0)
#define SWRITE(b) do { *(bf16x8*)(V_lds + (b) * SHM_V + vst0) = vs0; *(bf16x8*)(V_lds + (b) * SHM_V + vst1) = vs1; \
    *(bf16x8*)(K_lds + (b) * SHM_K + kswz<DQK>(kr, kc * 2)) = ks0; if (DQK == 128) *(bf16x8*)(K_lds + (b) * SHM_K + kswz<DQK>(32 + kr, kc * 2)) = ks1; } while (0)
#define RESC(a) do { if (!FIXED && __any((a) < 1.f)) { if (hi == 0) al_l[r32] = (a); asm volatile("s_waitcnt lgkmcnt(0)" ::: "memory"); \
    _Pragma("unroll") for (int d = 0; d < 4; ++d) _Pragma("unroll") for (int r = 0; r < 16; ++r) o[d][r] *= al_l[crow(r, hi)]; } } while (0)
  f32x16 pA0, pA1, pB0, pB1; float mnA, mnB, alA, alB; bf16x8 pa0, pa1, pa2, pa3; const int NT = seq / KVBLK;
  __syncthreads();
  SLOAD(0); asm volatile("s_waitcnt vmcnt(0)" ::: "memory"); SWRITE(0);
  SLOAD(KVBLK); asm volatile("s_waitcnt vmcnt(0)" ::: "memory"); SWRITE(1);
  if (2 < NT) SLOAD(2 * KVBLK);
  __syncthreads();
  qkt<DQK, ALIBI>(pA0, pA1, K_lds, qr, r32, hi, qpos, sl); partialSM<DQK, FIXED>(pA0, pA1, m_reg, mnA, alA);
  int s0 = 0, s1 = 1, s2 = 2;
#define ITER(PC0, PC1, mnC, alC, PP0, PP1, alP, t, DO_WRITE, DO_LOAD) do { \
    if (DO_WRITE) { asm volatile("s_waitcnt vmcnt(0)" ::: "memory"); SWRITE(s2); } \
    SBAR(); qkt<DQK, ALIBI>(PC0, PC1, K_lds + s1 * SHM_K, qr, r32, hi, qpos - (float)((t) * KVBLK), sl); \
    finishSM(PP0, PP1, alP, l_reg, pa0, pa1, pa2, pa3); SBAR(); \
    if (DO_LOAD) SLOAD(((t) + 2) * KVBLK); SBAR(); \
    pv_d0(o, vb0 + s0 * SHM_V, pa0, pa1, pa2, pa3); partialSM<DQK, FIXED>(PC0, PC1, m_reg, mnC, alC); \
    RESC(alC); __syncthreads(); \
    { const int t_ = s0; s0 = s1; s1 = s2; s2 = t_; } } while (0)
  _Pragma("unroll 1") for (int t = 1; t + 2 < NT; t += 2) {
    ITER(pB0, pB1, mnB, alB, pA0, pA1, alA, t, true, true);
    ITER(pA0, pA1, mnA, alA, pB0, pB1, alB, t + 1, true, (t + 3 < NT));
  }
  ITER(pB0, pB1, mnB, alB, pA0, pA1, alA, NT - 1, false, false);
  finishSM(pB0, pB1, alB, l_reg, pa0, pa1, pa2, pa3); SBAR();
  pv_d0(o, vb0 + s0 * SHM_V, pa0, pa1, pa2, pa3);
  if (hi == 0) li_l[r32] = l_reg; asm volatile("s_waitcnt lgkmcnt(0)" ::: "memory");
#pragma unroll
  for (int r = 0; r < 16; ++r) { const float rl = __builtin_amdgcn_rcpf(li_l[crow(r, hi)]);
#pragma unroll
    for (int d0 = 0; d0 < 4; ++d0) o[d0][r] *= rl; }
#undef ITER
#undef SLOAD
#undef SWRITE
#undef RESC
}
}

__device__ __forceinline__ void gqa_attn_phase(const Frame& F, int o) {
    const bf16_t* Z = (const bf16_t*)POOLP(PL_Z); bf16_t* CAT = (bf16_t*)POOLP(PL_CAT);
    constexpr int NU_S = 16 * (T_S / 256), NU = NU_S + 16 * (T_P / 256);
    float mfix; { const float* qg = F.in[I_QN] + o * 128, *kg = F.in[I_KN] + o * 128; float a = fmaxf(fabsf(qg[F.lane]), fabsf(qg[F.lane + 64])), b = fmaxf(fabsf(kg[F.lane]), fabsf(kg[F.lane + 64]));
#pragma unroll
        for (int s = 1; s < 64; s <<= 1) { a = fmaxf(a, __shfl_xor(a, s)); b = fmaxf(b, __shfl_xor(b, s)); }
        mfix = 128.0f * 1.01f * a * b * 0.0883883476f;
        if (!(mfix < FIXREF_LIMIT_GQA)) mfix = -1.0f; }
    for (int L = F.bid; L < NU; L += F.G) {
        int tid = threadIdx.x; asm volatile("" : "+v"(tid));
        const int lane = tid & 63, r32 = lane & 31, hi = lane >> 5, wid = tid >> 6;
        int seq, head, qb;
        if (L < NU_S) { const int x = L & 7, r = L >> 3, kvh = x & 3, half = x >> 2; seq = 1; head = kvh * 4 + (r & 3); qb = half * 32 + (r >> 2); }
        else { const int Lp = L - NU_S, x = Lp & 7, r = Lp >> 3, kvh = x & 3, half = x >> 2; seq = 0; head = kvh * 4 + (r & 3); qb = half * 16 + (r >> 2); }
        const int t0 = seq ? T_P : 0, slen = seq ? T_S : T_P, kvh = head >> 2;
        const bf16_t* Qw = Z + (size_t)(t0 + qb * 256 + wid * 32 + r32) * ZLD + head * 128 + hi * 8;
        const bf16_t* Kh = Z + (size_t)t0 * ZLD + 2048 + kvh * 128; const bf16_t* Vh = Z + (size_t)t0 * ZLD + 2560 + kvh * 128;
        f32x16 ov[4];
        if (mfix >= 0.f) att::attn_pass<128, false, GQA_SDEPTH, ZLD, true>(Qw, Kh, Vh, slen, F.ldsg, ov, 0.f, 0.f, tid, mfix);
        else att::attn_pass<128, false, GQA_SDEPTH, ZLD, false>(Qw, Kh, Vh, slen, F.ldsg, ov, 0.f, 0.f, tid, mfix);
        bf16_t* Ow = CAT + (size_t)(t0 + qb * 256 + wid * 32) * DM + head * 128;
#pragma unroll
        for (int r = 0; r < 16; ++r) { const int orow = att::crow(r, hi);
#pragma unroll
            for (int d0 = 0; d0 < 4; ++d0) Ow[(size_t)orow * DM + d0 * 32 + r32] = f2bf(ov[d0][r]); }
    }
}

__device__ __forceinline__ void qk_bound_pass(const Frame& F, int e) {
    const bf16_t* Z = (const bf16_t*)POOLP(PL_Z); unsigned* ctl = (unsigned*)WSP(WS_CTL) + CW_QKB + e * 64;
    const int gw = F.bid * NWAVES + F.wave, NGW = F.G * NWAVES, lane = F.lane;
    float mx[2][2] = {{0.f, 0.f}, {0.f, 0.f}};
    for (int t = gw; t < TT; t += NGW) {
        const bf16_t* row = Z + (size_t)t * ZLD + lane * 16;
#pragma unroll
        for (int qk = 0; qk < 2; ++qk) { const u32x4 a = *(const u32x4*)(row + qk * 1024), b = *(const u32x4*)(row + qk * 1024 + 8);
            float s = bflo(a.x) * bflo(a.x) + bfhi(a.x) * bfhi(a.x) + bflo(a.y) * bflo(a.y) + bfhi(a.y) * bfhi(a.y) + bflo(a.z) * bflo(a.z) + bfhi(a.z) * bfhi(a.z) + bflo(a.w) * bflo(a.w) + bfhi(a.w) * bfhi(a.w)
                    + bflo(b.x) * bflo(b.x) + bfhi(b.x) * bfhi(b.x) + bflo(b.y) * bflo(b.y) + bfhi(b.y) * bfhi(b.y) + bflo(b.z) * bflo(b.z) + bfhi(b.z) * bfhi(b.z) + bflo(b.w) * bflo(b.w) + bfhi(b.w) * bfhi(b.w);
            s += __shfl_xor(s, 1); s += __shfl_xor(s, 2);
            if (t < T_P) mx[0][qk] = fmaxf(mx[0][qk], s); else mx[1][qk] = fmaxf(mx[1][qk], s); }
    }
    LAS float* red = (LAS float*)F.lds;
    if ((lane & 3) == 0) {
#pragma unroll
        for (int sq = 0; sq < 2; ++sq)
#pragma unroll
            for (int qk = 0; qk < 2; ++qk) red[(F.wave * 4 + sq * 2 + qk) * 16 + (lane >> 2)] = mx[sq][qk]; }
    LDS_WAIT(); __syncthreads();
    if (F.tid < 64) { float m = 0.f;
#pragma unroll
        for (int w = 0; w < 8; ++w) m = fmaxf(m, red[w * 64 + F.tid]);
        atomicMax(ctl + F.tid, __float_as_uint(m)); }
    __syncthreads();
}

__device__ __forceinline__ void diff_attn_phase(const Frame& F, int e, int rep = 0) {
    const bf16_t* Z = (const bf16_t*)POOLP(PL_Z); bf16_t* CAT = (bf16_t*)POOLP(PL_CAT); float* ST = (float*)POOLP(PL_STASH);
    const float lam = ((const float*)(WSP(WS_MISC) + MISC_LAM))[e * 2], linit = ((const float*)(WSP(WS_MISC) + MISC_LAM))[e * 2 + 1];
    const float* sg = F.in[I_SUBLN] + e * 128;
    unsigned* ctl = (unsigned*)WSP(WS_CTL); const unsigned* qkb = ctl + CW_QKB + e * 64; unsigned* qctr = ctl + CW_QUEUE + e * 64 + rep * 256;
    constexpr int NU = 8 * (T_S / 256) + 8 * (T_P / 256);
    LAS int* uslot = (LAS int*)(F.lds + RING_BYTES + 64);
    for (;;) {
        __syncthreads();
        if (threadIdx.x == 0) *uslot = (int)__hip_atomic_fetch_add(qctr, 1u, RLX_AGENT);
        LDS_WAIT(); __syncthreads();
        const int u = __builtin_amdgcn_readfirstlane(*uslot);
        if (u >= NU) break;
        int tid = threadIdx.x; asm volatile("" : "+v"(tid));
        const int lane = tid & 63, r32 = lane & 31, hi = lane >> 5, wid = tid >> 6;
        f32x4* st = (f32x4*)ST + ((size_t)F.bid * NTHREADS + tid) * 16;
        const int head = 7 - u / 96, rr = u % 96, seq = rr < 64 ? 1 : 0, qb = seq ? rr : rr - 64;
        const int t0 = seq ? T_P : 0, slen = seq ? T_S : T_P;
        const float slope = exp2f(-(float)(head + 1)), sl = slope * 1.4426950408889634f;
        const bf16_t* Vh = Z + (size_t)t0 * ZLD + 2048 + head * 128;
        f32x16 o[4];
        for (int m = 0; m < 2; ++m) {
            const float q2 = __uint_as_float(__hip_atomic_load(qkb + (seq * 2 + 0) * 16 + head * 2 + m, RLX_AGENT)), k2 = __uint_as_float(__hip_atomic_load(qkb + (seq * 2 + 1) * 16 + head * 2 + m, RLX_AGENT));
            const float qk = sqrtf(q2 * k2) * 1.001f * 0.6931471805599453f;
            const float Bnd = 2.0f * qk + 32.0f;
            const float mfix = (qk < FIXREF_LIMIT_DIFF) ? qk : -1.0f;
            float Wf = Bnd / slope; if (!(Wf < (float)slen)) Wf = (float)slen;
            const int W = (int)Wf + 1;
            int tlo = (qb * 256 - W) >> 6; if (tlo < 0) tlo = 0;
            int thi = (qb * 256 + 256 + W + 63) >> 6; if (thi > slen / 64) thi = slen / 64;
            if ((thi - tlo) & 1) { if (thi < slen / 64) ++thi; else --tlo; }
            tlo = __builtin_amdgcn_readfirstlane(tlo); thi = __builtin_amdgcn_readfirstlane(thi);
            const float qpos = (float)(qb * 256 + wid * 32 + r32 - tlo * 64);
            const bf16_t* Qw = Z + (size_t)(t0 + qb * 256 + wid * 32 + r32) * ZLD + head * 128 + m * 64 + hi * 8;
            const bf16_t* Kh = Z + (size_t)(t0 + tlo * 64) * ZLD + 1024 + head * 128 + m * 64;
            if (mfix >= 0.f) att::attn_pass<64, true, DIFF_SDEPTH, ZLD, true>(Qw, Kh, Vh + (size_t)(tlo * 64) * ZLD, (thi - tlo) * 64, F.ldsg, o, qpos, sl, tid, mfix);
            else att::attn_pass<64, true, DIFF_SDEPTH, ZLD, false>(Qw, Kh, Vh + (size_t)(tlo * 64) * ZLD, (thi - tlo) * 64, F.ldsg, o, qpos, sl, tid, mfix);
            if (m == 0) {
#pragma unroll
                for (int d0 = 0; d0 < 4; ++d0)
#pragma unroll
                    for (int q = 0; q < 4; ++q) st[d0 * 4 + q] = (f32x4){o[d0][4 * q], o[d0][4 * q + 1], o[d0][4 * q + 2], o[d0][4 * q + 3]};
            }
        }
        float ss[16];
#pragma unroll
        for (int r = 0; r < 16; ++r) ss[r] = 0.f;
#pragma unroll
        for (int d0 = 0; d0 < 4; ++d0) {
#pragma unroll
            for (int q = 0; q < 4; ++q) { const f32x4 s4 = st[d0 * 4 + q];
#pragma unroll
                for (int i = 0; i < 4; ++i) { const int r = 4 * q + i; const float a = s4[i] - lam * o[d0][r]; o[d0][r] = a; ss[r] += a * a; } }
            asm volatile("" ::: "memory"); }
#pragma unroll
        for (int r = 0; r < 16; ++r) { float s = ss[r]; s += __shfl_xor(s, 1); s += __shfl_xor(s, 2); s += __shfl_xor(s, 4); s += __shfl_xor(s, 8); s += __shfl_xor(s, 16);
            ss[r] = (1.0f - linit) / sqrtf(s * (1.f / 128.f) + SUBLN_EPS); }
        bf16_t* Ow = CAT + (size_t)(t0 + qb * 256 + wid * 32) * DM + 1024 + head * 128;
#pragma unroll
        for (int d0 = 0; d0 < 4; ++d0) { const float gcol = sg[d0 * 32 + r32];
#pragma unroll
            for (int r = 0; r < 16; ++r) Ow[(size_t)att::crow(r, hi) * DM + d0 * 32 + r32] = f2bf(o[d0][r] * ss[r] * gcol); }
    }
}

constexpr int PH_BASE = 3, PH_PER = 16, PH_END = PH_BASE + 8 * PH_PER - 1;
__host__ __device__ inline bool phase_exists(int pid) {
    if (pid < PH_BASE) return true;
    const int hl = (pid - PH_BASE) / PH_PER, k = (pid - PH_BASE) % PH_PER, f = hl & 1, l = hl >> 1;
    if (k <= 1) return true;
    if (k == 14) return hl == 7;
    if (k == 15 || f == 1 || k == 2 || k == 10 || k == 12) return false;
    if ((l & 1) && (k == 6 || k == 7 || k == 8)) return false;
    return true;
}

__device__ __forceinline__ bool fresh_frame(Frame& F) { int t = threadIdx.x; asm volatile("" : "+v"(t)); F.tid = t; F.lane = t & 63; F.wave = __builtin_amdgcn_readfirstlane(t >> 6); return true; }
#ifndef GU_WGM
#define GU_WGM 4
#endif
#ifndef DOWN_WGM
#define DOWN_WGM 2
#endif
#ifndef RES_WGM
#define RES_WGM 4
#endif
__global__ void __launch_bounds__(NTHREADS, 2) fwd_kernel(Args args) {
    extern __shared__ __attribute__((aligned(16))) unsigned char lds[];
    Frame F;
    F.lds = (LAS unsigned char*)lds; F.ldsg = (char*)lds;
    F.MISC = (volatile LAS unsigned*)(F.lds + MISC_OFF);
    F.tid = threadIdx.x; F.lane = F.tid & 63; F.wave = __builtin_amdgcn_readfirstlane(F.tid >> 6);
    F.G = gridDim.x; F.bid = blockIdx.x; F.in = args.in; F.x = args.out; F.ws = args.ws;
    for (int u = F.tid; u < (LDS_BYTES - RING_BYTES) / 4; u += NTHREADS) ((LAS unsigned*)(F.lds + RING_BYTES))[u] = 0u;
    __syncthreads();
    XcdBarrier bar = xcd_barrier_post((unsigned*)(F.ws + WS_CTL) + CW_BAR + args.li * XCD_BAR_WORDS, F.MISC + 8);
    const int lo = args.ph_lo, hi = args.ph_hi;
#define PH(p) (lo <= (p) && (p) < hi && fresh_frame(F))
#define ENDPH(p) do { if ((p) + 1 < hi) xcd_barrier(bar); } while (0)
    float* const PSS = (float*)(F.ws + WS_MISC + MISC_PSS);
    const int rep = args.pad;
#ifdef PROBE_K
#define RSCALE(s) (rep == 0 ? (s) : 0.0f)
#else
#define RSCALE(s) (s)
#endif

    if (PH(0)) { prologue_phase(F); ENDPH(0); }
    if (PH(1)) {
        auto S = make_sched(F, POOLP(PL_MEMN), DM, POOLP(PL_WKVT), DM, 256, 2 * DM, 8, ZKv{});
        EpiBf16<0> E{(bf16_t*)POOLP(PL_KVB), 2 * DM, (size_t)256 * 2 * DM, 0, 0, nullptr, nullptr, nullptr};
        pg8::gemm_phase(F.lds, DM, DM, DM, S, E, F.tid);
        s5_precompute_phase(F); ENDPH(1);
    }
    if (PH(2)) {
        { auto S = make_sched(F, POOLP(PL_KVB), 2 * DM, POOLP(PL_WQB), DM, 256, DM, 32, ZKf{});
          EpiBf16<2> E{(bf16_t*)WSP(WS_KF), DM, (size_t)256 * DM, 0, 0, F.in[I_CN], nullptr, nullptr};
          pg8::gemm_phase(F.lds, 2 * DM, DM, 512, S, E, F.tid); }
        { auto S = make_sched(F, POOLP(PL_WOT), DM, POOLP(PL_KVB), 2 * DM, DM, 256, 32, ZVw{});
          EpiBf16<0> E{(bf16_t*)WSP(WS_VWT), 1024, (size_t)DM * 1024, 256, 2, nullptr, nullptr, nullptr};
          pg8::gemm_phase(F.lds, DM, 2 * DM, 512, S, E, F.tid); }
        ENDPH(2);
    }
    for (int hl = 0; hl < 8; ++hl) {
        const int l = hl >> 1, f = hl & 1, pb = PH_BASE + hl * PH_PER, eo = l >> 1;
        const bool even = (l & 1) == 0;
        if (PH(pb + 0)) {
            auto S = make_sched(F, WSP(WS_HB), DM, WSP(WS_WGU + (size_t)hl * SZ_WGU), DM, TT, 2 * DFF, 1, ZNone{}); S.wgm = GU_WGM;
            EpiSwiglu E{F.ws, DFF, F.lds};
            pg8::gemm_phase(F.lds, DM, DM, DM, S, E, F.tid);
            ENDPH(pb + 0);
        }
        if (PH(pb + 1)) {
            auto S = make_sched(F, POOLP(PL_ACT), DFF, WSP(WS_WD + (size_t)hl * SZ_WD), DFF, TT, DM, 1, ZNone{}); S.wgm = DOWN_WGM;
            { EpiResidNorm E{RSCALE(0.5f), F.ws, (LAS float*)(F.lds + EXCH_OFF)}; pg8::gemm_phase(F.lds, DFF, DFF, DFF, S, E, F.tid); }
            ENDPH(pb + 1);
        }
        if (f == 0) {
            if (even) {
                if (PH(pb + 3)) {
                    auto S = make_sched(F, WSP(WS_HB), DM, WSP(WS_WINE + (size_t)eo * SZ_WINE), DM, TT, EVEN_IN, 1, ZNone{});
                    EpiWinEven E{F.ws, F.lds};
                    pg8::gemm_phase(F.lds, DM, DM, DM, S, E, F.tid);
                    ENDPH(pb + 3);
                }
                if (PH(pb + 4)) {
                    auto S = make_sched(F, POOLP(PL_UX), S5K2, WSP(WS_WST + (size_t)eo * 64 * SZ_WST), S5K1, NCH, S5NS, S5G, ZLin{(size_t)NCH * S5K2 * 2, SZ_WST});
                    EpiF32 E{(float*)POOLP(PL_SST), S5G * S5NS, (size_t)S5NS};
                    pg8::gemm_phase(F.lds, S5K2, S5K1, S5K1, S, E, F.tid);
                    qk_bound_pass(F, eo); ENDPH(pb + 4);
                }
                if (PH(pb + 5)) { s5_scan_phase(F, eo); ENDPH(pb + 5); }
                if (PH(pb + 6)) {
                    auto S = make_sched(F, POOLP(PL_UX), S5K2, WSP(WS_TG + (size_t)eo * 64 * SZ_TG), S5K2, NCH, S5K1, S5G, ZLin{(size_t)NCH * S5K2 * 2, SZ_TG});
                    EpiS5Out E{(bf16_t*)POOLP(PL_GB)};
                    pg8::gemm_phase(F.lds, S5K2, S5K2, S5K2, S, E, F.tid); ENDPH(pb + 6);
                }
                if (PH(pb + 7)) {
                    auto S = make_sched(F, POOLP(PL_GB), S5W, WSP(WS_GLU + (size_t)eo * SZ_GLU), S5W, TT, S5W, 1, ZNone{});
                    EpiGlu E{(const bf16_t*)POOLP(PL_GB), F.in[I_GLUB] + eo * S5W, (bf16_t*)POOLP(PL_CAT)};
                    pg8::gemm_phase(F.lds, S5W, S5W, S5W, S, E, F.tid);
                    if (!PH(pb + 8)) ENDPH(pb + 7);
                }
                if (PH(pb + 8)) { diff_attn_phase(F, eo, rep); ENDPH(pb + 8); }
            } else {
                if (PH(pb + 3)) {
                    auto S = make_sched(F, WSP(WS_HB), DM, WSP(WS_WINO + (size_t)eo * SZ_WINO), DM, TT, ODD_IN, 1, ZNone{});
                    EpiBf16<1> E{(bf16_t*)POOLP(PL_Z), ZLD, 0, 0, 0, nullptr, F.ws, F.lds};
                    pg8::gemm_phase(F.lds, DM, DM, DM, S, E, F.tid); ENDPH(pb + 3);
                }
                if (PH(pb + 4)) { qk_prep_phase(F, eo); ENDPH(pb + 4); }
                if (PH(pb + 5)) { gqa_attn_phase(F, eo); ENDPH(pb + 5); }
            }
            if (PH(pb + 9)) {
                auto S = make_sched(F, POOLP(PL_CAT), DM, even ? WSP(WS_WOUTE + (size_t)eo * SZ_SQ) : WSP(WS_WOUTO + (size_t)eo * SZ_SQ), DM, TT, DM, 1, ZNone{});
                    { EpiResidNorm E{RSCALE(1.0f), F.ws, (LAS float*)(F.lds + EXCH_OFF)}; pg8::gemm_phase(F.lds, DM, DM, DM, S, E, F.tid); }
                ENDPH(pb + 9);
            }
            if (PH(pb + 11)) {
                auto S = make_sched(F, WSP(WS_HB), DM, WSP(WS_KF + (size_t)l * 2 * SZ_KF), DM, TT, 1024, 1, ZNone{}); S.split = T_P / 256; S.bseq = SZ_KF;
                EpiCrossSm E{F.ws, (LAS f32x2*)(F.lds + EXCH_OFF), F.lds};
                pg8::gemm_phase(F.lds, DM, DM, DM, S, E, F.tid);
                ENDPH(pb + 11);
            }
            if (PH(pb + 13)) {
                auto S = make_sched(F, POOLP(PL_CP), 1024, WSP(WS_VWT + (size_t)l * 2 * SZ_KF), 1024, TT, DM, 1, ZNone{}); S.split = T_P / 256; S.bseq = SZ_KF; S.wgm = RES_WGM;
                EpiResidNorm E{RSCALE(1.0f), F.ws, (LAS float*)(F.lds + EXCH_OFF)};
                    pg8::gemm_phase(F.lds, 1024, 1024, 1024, S, E, F.tid); ENDPH(pb + 13);
            }
        }
        if (hl == 7 && PH(pb + 14)) { final_norm_phase(F, F.in[I_FINN]); ENDPH(pb + 14); }
    }
#undef PH
#undef ENDPH
}

#ifndef MK_PER_PHASE
#define MK_PER_PHASE 0
#endif
extern "C" void kernel_launch(void* const* d_in, const int* in_sizes, int n_in, void* d_out, int out_size, void* d_ws, size_t ws_size, hipStream_t stream) {
    static int grid = 0;
    if (grid == 0) {
        if (n_in != N_IN || out_size != TT * DM || ws_size < WS_END) { fprintf(stderr, "kernel_launch: unexpected shapes: n_in %d out %d ws %zu (need %zu)\n", n_in, out_size, ws_size, (size_t)WS_END); grid = -1; return; }
        int dev = 0, cus = 0, per_cu = 0;
        if (hipGetDevice(&dev) != hipSuccess || hipDeviceGetAttribute(&cus, hipDeviceAttributeMultiprocessorCount, dev) != hipSuccess) { grid = -1; return; }
        if (hipFuncSetAttribute((const void*)fwd_kernel, hipFuncAttributeMaxDynamicSharedMemorySize, LDS_BYTES) != hipSuccess) { fprintf(stderr, "kernel_launch: hipFuncSetAttribute failed\n"); grid = -1; return; }
        if (hipOccupancyMaxActiveBlocksPerMultiprocessor(&per_cu, (const void*)fwd_kernel, NTHREADS, LDS_BYTES) != hipSuccess || per_cu < 1) { fprintf(stderr, "kernel_launch: occupancy query says %d\n", per_cu); (void)hipGetLastError(); grid = -1; return; }
        grid = cus;
    }
    if (grid < 0) return;
#if MK_PER_PHASE
    (void)hipMemsetAsync((char*)d_ws + WS_CTL, 0, CTL_BYTES, stream);
#else
    (void)hipMemsetAsync((char*)d_ws + WS_CTL, 0, 32768, stream);
#endif
    Args a{};
    for (int i = 0; i < N_IN; ++i) a.in[i] = (const float*)d_in[i];
    a.out = (float*)d_out; a.ws = (unsigned char*)d_ws; a.pad = 0;
#if MK_PER_PHASE
    int li = 0;
    for (int p = 0; p < PH_END; ++p) { if (!phase_exists(p)) continue; a.ph_lo = p; a.ph_hi = p + 1; a.li = li++; a.pad = 0;
        hipLaunchKernelGGL(fwd_kernel, dim3(grid), dim3(NTHREADS), LDS_BYTES, stream, a);
#ifdef PROBE_K
        { const int kind = p < PH_BASE ? 100 + p : (p - PH_BASE) % PH_PER;
          if (kind == PROBE_K) for (int r = 1; r <= PROBE_REPS; ++r) { a.pad = r; hipLaunchKernelGGL(fwd_kernel, dim3(grid), dim3(NTHREADS), LDS_BYTES, stream, a); } }
#endif
    }
#else
    a.ph_lo = 0; a.ph_hi = PH_END; a.li = 0;
    hipLaunchKernelGGL(fwd_kernel, dim3(grid), dim3(NTHREADS), LDS_BYTES, stream, a);
#endif
    const hipError_t le = hipPeekAtLastError();
    if (le != hipSuccess) fprintf(stderr, "kernel_launch: launch failed: %s\n", hipGetErrorName(le));
}
```

```cpp
#include <hip/hip_runtime.h>
#include <cstdio>
#include <cstdint>

#define GAS __attribute__((address_space(1)))
#define LAS __attribute__((address_space(3)))
typedef unsigned short bf16_t;
typedef short bf16x8 __attribute__((ext_vector_type(8)));
typedef short s16x4 __attribute__((ext_vector_type(4)));
typedef float f32x2 __attribute__((ext_vector_type(2)));
typedef float f32x4 __attribute__((ext_vector_type(4)));
typedef float f32x8 __attribute__((ext_vector_type(8)));
typedef float f32x16 __attribute__((ext_vector_type(16)));
typedef unsigned u32x2 __attribute__((ext_vector_type(2)));
typedef unsigned u32x4 __attribute__((ext_vector_type(4)));
typedef GAS unsigned gu32;
#define RLX_AGENT __ATOMIC_RELAXED, __HIP_MEMORY_SCOPE_AGENT
#define LDS_WAIT() asm volatile("s_waitcnt lgkmcnt(0)" ::: "memory")
#define VM_WAIT() asm volatile("s_waitcnt vmcnt(0)" ::: "memory")
#define SBAR() __builtin_amdgcn_sched_barrier(0)

__device__ __forceinline__ unsigned cvt_pk_bf16(float lo, float hi) { unsigned r; asm volatile("v_cvt_pk_bf16_f32 %0, %1, %2" : "=v"(r) : "v"(lo), "v"(hi)); return r; }
__device__ __forceinline__ float bf2f(unsigned short b) { return __uint_as_float(((unsigned)b) << 16); }
__device__ __forceinline__ float bflo(unsigned w) { return __uint_as_float(w << 16); }
__device__ __forceinline__ float bfhi(unsigned w) { return __uint_as_float(w & 0xffff0000u); }
__device__ __forceinline__ unsigned short f2bf(float f) { unsigned u = __float_as_uint(f); return (unsigned short)((u + 0x7fffu + ((u >> 16) & 1u)) >> 16); }
__device__ __forceinline__ float fast_rcp(float x) { return __builtin_amdgcn_rcpf(x); }
__device__ __forceinline__ float fast_exp2(float x) { return __builtin_amdgcn_exp2f(x); }
__device__ __forceinline__ float sigmoidf_fast(float x) { return fast_rcp(1.0f + fast_exp2(-1.4426950408889634f * x)); }
__device__ __forceinline__ float silu_f(float x) { return x * sigmoidf_fast(x); }
__device__ __forceinline__ float gelu_tanh_f(float y) { const float z = y + 0.044715f * y * y * y; return y * fast_rcp(1.0f + fast_exp2(-2.3022081982f * z)); }
__device__ __forceinline__ float wave_sum(float v) {
#pragma unroll
    for (int o = 1; o < 64; o <<= 1) v += __shfl_xor(v, o);
    return v;
}

#define XB_TMO      128
#define XB_XCNT(j)  (256  + 64 * (j))
#define XB_XSUB(j)  (1280 + 64 * (j))
#define XB_XGEN(j)  (2304 + 64 * (j))
#define XB_TOP      3328
#define XB_TOPGEN   3392
#define XCD_BAR_WORDS 3456
#define XB_SPIN_CAP (1u << 22)

__device__ __forceinline__ unsigned xb_ld(unsigned* p)              { return __hip_atomic_load(p, __ATOMIC_RELAXED, __HIP_MEMORY_SCOPE_AGENT); }
__device__ __forceinline__ unsigned xb_add(unsigned* p, unsigned v) { return __hip_atomic_fetch_add(p, v, __ATOMIC_RELAXED, __HIP_MEMORY_SCOPE_AGENT); }
__device__ __forceinline__ unsigned xb_xcc_id() { return (unsigned)__builtin_amdgcn_s_getreg((3 << 11) | 20) & 0xFu; }
#define XB_SPIN(cond, bar) do { unsigned _sp = 0; while (cond) { __builtin_amdgcn_s_sleep(1); \
    if ((++_sp & 255u) == 0u) { if (xb_ld(&(bar)[XB_TMO])) break; if (_sp > XB_SPIN_CAP) { atomicAdd(&(bar)[XB_TMO], 1u); break; } } } } while (0)

struct XcdBarrier { unsigned* bar; unsigned x; volatile LAS unsigned* st; };

__device__ __forceinline__ XcdBarrier xcd_barrier_post(unsigned* bar, volatile LAS unsigned* st) {
    XcdBarrier b; b.bar = bar; b.x = xb_xcc_id(); b.st = st;
    if (threadIdx.x == 0) (void)xb_add(&bar[XB_XCNT(b.x)], 1u);
    return b;
}
__device__ __forceinline__ void xcd_barrier_complete(unsigned* bar, unsigned x, unsigned& nloc, unsigned& nx) {
    const unsigned G = gridDim.x * gridDim.y * gridDim.z;
    unsigned sum, cnt, mine, sp = 0u;
    for (;;) {
        sum = 0u; cnt = 0u; mine = 0u;
#pragma unroll
        for (unsigned j = 0; j < 16; ++j) { const unsigned c = xb_ld(&bar[XB_XCNT(j)]); sum += c; cnt += (c > 0u) ? 1u : 0u; mine = (j == x) ? c : mine; }
        if (sum == G) break;
        __builtin_amdgcn_s_sleep(1);
        if ((++sp & 255u) == 0u) { if (xb_ld(&bar[XB_TMO])) break; if (sp > XB_SPIN_CAP) { atomicAdd(&bar[XB_TMO], 1u); break; } }
    }
    nloc = mine > 0u ? mine : 1u; nx = cnt > 0u ? cnt : 1u;
}
__device__ __forceinline__ void xcd_barrier(const XcdBarrier& b) {
    asm volatile("s_waitcnt vmcnt(0)" ::: "memory");
    __syncthreads();
    if (threadIdx.x == 0) {
        unsigned* bar = b.bar;
        __builtin_amdgcn_s_waitcnt(0);
        unsigned nloc = b.st[0], nx = b.st[1];
        if (nloc == 0u) { xcd_barrier_complete(bar, b.x, nloc, nx); b.st[0] = nloc; b.st[1] = nx; }
        const unsigned old = xb_add(&bar[XB_XSUB(b.x)], 1u);
        const unsigned gen = old / nloc;
        if (old + 1u == (gen + 1u) * nloc) {
            __builtin_amdgcn_fence(__ATOMIC_RELEASE, "agent");
            asm volatile("s_waitcnt vmcnt(0)" ::: "memory");
            const unsigned og = xb_add(&bar[XB_TOP], 1u);
            const unsigned tg = og / nx;
            if (og + 1u == (tg + 1u) * nx) xb_add(&bar[XB_TOPGEN], 1u);
            else XB_SPIN(xb_ld(&bar[XB_TOPGEN]) == tg, bar);
            __builtin_amdgcn_fence(__ATOMIC_ACQUIRE, "agent");
            xb_add(&bar[XB_XGEN(b.x)], 1u);
            asm volatile("s_waitcnt vmcnt(0)" ::: "memory");
        } else {
            XB_SPIN(xb_ld(&bar[XB_XGEN(b.x)]) == gen, bar);
            __builtin_amdgcn_fence(__ATOMIC_ACQUIRE, "agent");
            asm volatile("s_waitcnt vmcnt(0)" ::: "memory");
        }
    }
    __syncthreads();
}

namespace pg8 {
constexpr int BM = 256, BK = 64, HALF = 128, HTB = HALF * BK * 2, STAGE_BYTES = 8 * HTB, NXCD = 8, WGM = 4;
__host__ __device__ __forceinline__ int lds_byte(int r, int c) { const int st = (r >> 4) * 2 + (c >> 5), rr = r & 15, cc = c & 31, ob = rr * 64 + cc * 2; return st * 1024 + (ob ^ (((ob >> 9) & 1) << 5)); }
__host__ __device__ __forceinline__ void stage_rc(int b, int& R, int& C) { const int st = b / 1024, sb = b % 1024, swz = sb ^ (((sb >> 9) & 1) << 5); R = (st >> 1) * 16 + swz / 64; C = (st & 1) * 32 + (swz % 64) / 2; }
__host__ __device__ __forceinline__ int perm32(int rho) { const int n = rho >> 4, i = rho & 15; return 8 * (i >> 2) + 4 * n + (i & 3); }

struct Unit { int pm, pn, z; };
struct Enum {
    int nM, nN, nZ, nwg, G, c, rev, wgm;
    __device__ __forceinline__ void init(int nM_, int nN_, int nZ_, int G_, int c_) { nM = nM_; nN = nN_; nZ = nZ_; nwg = nM * nN * nZ; G = G_; c = c_; rev = 0; wgm = WGM; }
    __device__ __forceinline__ bool next(int i, Unit& u) const {
        const long L = (long)i * G + c; if (L >= nwg) return false;
        int wgid = (int)L; { const int q = nwg / NXCD, r = nwg % NXCD, xcd = wgid % NXCD, off = wgid / NXCD; wgid = (xcd < r ? xcd * (q + 1) : r * (q + 1) + (xcd - r) * q) + off; }
        const int per = nM * nN; u.z = wgid / per; wgid -= u.z * per;
        const int nig = wgm * nN, gid = wgid / nig, fm = gid * wgm, gsz = (nM - fm) < wgm ? (nM - fm) : wgm;
        u.pm = fm + ((wgid % nig) % gsz); u.pn = (wgid % nig) / gsz; if (rev) u.pm = nM - 1 - u.pm; return true;
    }
};

template <class Epi, class Sched>
__device__ __forceinline__ void gemm_phase(LAS unsigned char* lds, const int lda, const int ldb, const int K, const Sched& S, const Epi& E, const int tid) {
    const int wid = __builtin_amdgcn_readfirstlane(tid >> 6), lane = tid & 63, wr = wid >> 2, wc = wid & 3, fr = lane & 15, fq = lane >> 4;
    const int nt = K / BK;
    unsigned voffA[2], voffB[2];
#pragma unroll
    for (int i = 0; i < 2; ++i) { int R, C; stage_rc(tid * 16 + i * 8192, R, C); const int Rb = Epi::PERM ? ((R & ~31) + perm32(R & 31)) : R;
        voffA[i] = (unsigned)(R * lda + C) * 2u; voffB[i] = (unsigned)(Rb * ldb + C) * 2u; }
    const size_t kstep = (size_t)(BK * 2);
    const size_t hstepA = (size_t)HALF * lda * 2, hstepB = (size_t)HALF * ldb * 2;
    const unsigned ldsw = (unsigned)wid * 1024u;
    const int aoff = lds_byte(wr * 64 + fr, fq * 8), boff = lds_byte(wc * 32 + fr, fq * 8);
#define PG8_SA(b, h) (((b) * 2 + (h)) * HTB)
#define PG8_SB(b, h) ((4 + (b) * 2 + (h)) * HTB)
#define PG8_STAGE(bufoff, gbase, voff) do { _Pragma("unroll") for (int _i = 0; _i < 2; ++_i) \
        __builtin_amdgcn_global_load_lds((const unsigned*)((const char*)(gbase) + (voff)[_i]), (LAS unsigned*)(lds + (bufoff) + ldsw + _i * 8192), 16, 0, 0); } while (0)
#define PG8_LDA(dst, b, h) do { _Pragma("unroll") for (int m = 0; m < 4; ++m) _Pragma("unroll") for (int k = 0; k < 2; ++k) dst[m][k] = *(const LAS bf16x8*)(lds + PG8_SA(b, h) + aoff + m * 2048 + k * 1024); } while (0)
#define PG8_LDB(dst, b, h) do { _Pragma("unroll") for (int n = 0; n < 2; ++n) _Pragma("unroll") for (int k = 0; k < 2; ++k) dst[n][k] = *(const LAS bf16x8*)(lds + PG8_SB(b, h) + boff + n * 2048 + k * 1024); } while (0)
#define PG8_MMA(ai, bj, At, Bt) do { __builtin_amdgcn_s_setprio(1); _Pragma("unroll") for (int m = 0; m < 4; ++m) _Pragma("unroll") for (int n = 0; n < 2; ++n) _Pragma("unroll") for (int k = 0; k < 2; ++k) \
        acc[ai][bj][m][n] = __builtin_amdgcn_mfma_f32_16x16x32_bf16(Bt[n][k], At[m][k], acc[ai][bj][m][n], 0, 0, 0); __builtin_amdgcn_s_setprio(0); } while (0)
#define PG8_WAIT_V(n) asm volatile("s_waitcnt vmcnt(" #n ")" ::: "memory")
#define PG8_WAIT_L(n) asm volatile("s_waitcnt lgkmcnt(" #n ")" ::: "memory")
#define PG8_BAR __builtin_amdgcn_s_barrier()
#define PG8_SCHED __builtin_amdgcn_sched_barrier(0)
    Unit cur, nxt; int ui = 0;
    if (!S.next(0, cur)) return;
    f32x4 acc[2][2][4][2];
#pragma unroll
    for (int a = 0; a < 2; ++a)
#pragma unroll
        for (int b = 0; b < 2; ++b)
#pragma unroll
            for (int m = 0; m < 4; ++m)
#pragma unroll
                for (int n = 0; n < 2; ++n) acc[a][b][m][n] = (f32x4){0.f, 0.f, 0.f, 0.f};
    bf16x8 At[4][2], B0[2][2], B1[2][2];
    const char* cA = S.a_base(cur); const char* cB = S.b_base(cur);
    {
        PG8_STAGE(PG8_SB(0, 0), cB, voffB); PG8_STAGE(PG8_SB(0, 1), cB + hstepB, voffB); PG8_STAGE(PG8_SA(0, 0), cA, voffA); PG8_STAGE(PG8_SA(0, 1), cA + hstepA, voffA);
        if (wr == 1) PG8_BAR;
        PG8_WAIT_V(2); PG8_BAR;
        PG8_STAGE(PG8_SB(1, 0), cB + kstep, voffB); PG8_STAGE(PG8_SA(1, 0), cA + kstep, voffA); PG8_STAGE(PG8_SB(1, 1), cB + hstepB + kstep, voffB);
        PG8_WAIT_V(6); PG8_BAR;
    }
    for (;;) {
        if constexpr (Epi::PREFETCH) E.prefetch(lds, cur, ui, wid, lane);
        const bool has_next = S.next(ui + 1, nxt);
        const char* nA = has_next ? S.a_base(nxt) : cA; const char* nB = has_next ? S.b_base(nxt) : cB;
        for (int t = 0; t < nt; t += 2) {
            const bool last = (t == nt - 2);
            const char* a1 = cA + (size_t)(t + 1) * kstep;
            const char* a2 = last ? nA : cA + (size_t)(t + 2) * kstep; const char* b2 = last ? nB : cB + (size_t)(t + 2) * kstep;
            const char* a3 = a2 + kstep; const char* b3 = b2 + kstep;
            PG8_LDB(B0, 0, 0); PG8_LDB(B1, 0, 1); PG8_SCHED; PG8_LDA(At, 0, 0); PG8_STAGE(PG8_SA(1, 1), a1 + hstepA, voffA);
            PG8_WAIT_V(8); PG8_WAIT_L(0); PG8_BAR; PG8_MMA(0, 0, At, B0); PG8_MMA(0, 1, At, B1); PG8_BAR; PG8_SCHED;
            PG8_LDA(At, 0, 1); PG8_STAGE(PG8_SB(0, 0), b2, voffB); PG8_STAGE(PG8_SB(0, 1), b2 + hstepB, voffB); PG8_STAGE(PG8_SA(0, 0), a2, voffA);
            PG8_WAIT_V(8); PG8_WAIT_L(0); PG8_BAR; PG8_MMA(1, 0, At, B0); PG8_MMA(1, 1, At, B1); PG8_BAR; PG8_SCHED;
            PG8_LDB(B0, 1, 0); PG8_LDB(B1, 1, 1); PG8_SCHED; PG8_LDA(At, 1, 0); PG8_STAGE(PG8_SA(0, 1), a2 + hstepA, voffA);
            PG8_WAIT_V(8); PG8_WAIT_L(0); PG8_BAR; PG8_MMA(0, 0, At, B0); PG8_MMA(0, 1, At, B1); PG8_BAR; PG8_SCHED;
            PG8_LDA(At, 1, 1); PG8_STAGE(PG8_SB(1, 0), b3, voffB); PG8_STAGE(PG8_SB(1, 1), b3 + hstepB, voffB); PG8_STAGE(PG8_SA(1, 0), a3, voffA);
            PG8_WAIT_V(8); PG8_WAIT_L(0); PG8_BAR; PG8_MMA(1, 0, At, B0); PG8_MMA(1, 1, At, B1); PG8_BAR; PG8_SCHED;
        }
        if (wr == 0) PG8_BAR;
        E(acc, cur, wr, wc, fr, fq, ui);
        if (!has_next) break;
#pragma unroll
        for (int a = 0; a < 2; ++a)
#pragma unroll
            for (int b = 0; b < 2; ++b)
#pragma unroll
                for (int m = 0; m < 4; ++m)
#pragma unroll
                    for (int n = 0; n < 2; ++n) acc[a][b][m][n] = (f32x4){0.f, 0.f, 0.f, 0.f};
        cur = nxt; cA = nA; cB = nB; ++ui;
        if (wr == 1) PG8_BAR;
    }
    PG8_WAIT_V(0);
    PG8_BAR;
#undef PG8_SA
#undef PG8_SB
#undef PG8_STAGE
#undef PG8_LDA
#undef PG8_LDB
#undef PG8_MMA
#undef PG8_WAIT_V
#undef PG8_WAIT_L
#undef PG8_BAR
#undef PG8_SCHED
}
}

constexpr int DM = 2048, T_P = 8192, T_S = 16384, TT = T_P + T_S, DEPTH = 4, NMEM = 256, DFF = 5632;
constexpr int S5W = 1024, S5G = 64, S5H = 16, S5P = 64, LC = 32, NCH = TT / LC, NCH_P = T_P / LC;
constexpr int S5K1 = LC * S5H  , S5NS = 4 * S5P  , S5K2 = S5K1 + S5NS  ;
constexpr int EVEN_IN = 4096, ODD_IN = 3072, ZLD = 3072;
constexpr float EPS = 1e-6f, SUBLN_EPS = 1e-5f;
constexpr int NWAVES = 8, NTHREADS = 512;

enum { I_XP = 0, I_XS, I_MP, I_MS, I_F1N, I_F1GU, I_F1D, I_MIXN, I_EWIN, I_EWOUT, I_LRE, I_LIM, I_LDT, I_BRE, I_BIM, I_CRE, I_CIM, I_S5D, I_GLUW, I_GLUB,
       I_LQ1, I_LK1, I_LQ2, I_LK2, I_SUBLN, I_OWIN, I_OWOUT, I_QN, I_KN, I_CN, I_MN, I_CWQ, I_CWKV, I_CWO, I_F2N, I_F2GU, I_F2D, I_FINN, N_IN };

constexpr size_t MiB = 1u << 20;
constexpr size_t WS_CTL = 0, CTL_BYTES = 2 * MiB;
constexpr size_t WS_WGU = 2 * MiB;
constexpr size_t SZ_WGU = (size_t)2 * DFF * DM * 2;
constexpr size_t WS_WD = WS_WGU + 8 * SZ_WGU;
constexpr size_t SZ_WD = (size_t)DM * DFF * 2;
constexpr size_t WS_WINE = WS_WD + 8 * SZ_WD;
constexpr size_t SZ_WINE = (size_t)EVEN_IN * DM * 2;
constexpr size_t WS_WOUTE = WS_WINE + 2 * SZ_WINE;
constexpr size_t SZ_SQ = (size_t)DM * DM * 2;
constexpr size_t WS_GLU = WS_WOUTE + 2 * SZ_SQ;
constexpr size_t SZ_GLU = (size_t)S5W * S5W * 2;
constexpr size_t WS_WINO = WS_GLU + 2 * SZ_GLU;
constexpr size_t SZ_WINO = (size_t)ODD_IN * DM * 2;
constexpr size_t WS_WOUTO = WS_WINO + 2 * SZ_WINO;
constexpr size_t WS_KF = WS_WOUTO + 2 * SZ_SQ;
constexpr size_t SZ_KF = (size_t)1024 * DM * 2;
constexpr size_t WS_VWT = WS_KF + 8 * SZ_KF;
constexpr size_t WS_WST = WS_VWT + 8 * SZ_KF;
constexpr size_t SZ_WST = (size_t)S5NS * S5K1 * 2;
constexpr size_t WS_TG = WS_WST + 2 * 64 * SZ_WST;
constexpr size_t SZ_TG = (size_t)S5K1 * S5K2 * 2;
constexpr size_t WS_HB = WS_TG + 2 * 64 * SZ_TG;
constexpr size_t SZ_HB = (size_t)TT * DM * 2;
constexpr size_t WS_MISC = WS_HB + SZ_HB;
constexpr size_t MISC_ROPE = 0, MISC_AL = 65536  , MISC_LAM = 65536 + 131072  , MISC_PSS = 262144  ;
constexpr size_t WS_POOL = WS_MISC + MiB;
constexpr size_t PL_ACT = 0;
constexpr size_t PL_Z = 0;
constexpr size_t PL_UX = 144 * MiB;
constexpr size_t PL_KC = 144 * MiB;
constexpr size_t PL_SST = 216 * MiB;
constexpr size_t PL_GB = 264 * MiB;
constexpr size_t PL_CAT = 312 * MiB;
constexpr size_t PL_STASH = 408 * MiB;
constexpr size_t PL_CS = 0;
constexpr size_t PL_CP = 96 * MiB;
constexpr size_t PL_WQB = 0;
constexpr size_t PL_WKVT = 32 * MiB;
constexpr size_t PL_WOT = 96 * MiB;
constexpr size_t PL_MEMN = 128 * MiB;
constexpr size_t PL_KVB = 136 * MiB;
constexpr size_t POOL_BYTES = 440 * MiB;
constexpr size_t WS_X = WS_POOL + POOL_BYTES;
constexpr size_t WS_END = WS_X + (size_t)TT * DM;

constexpr int CW_BAR = 4096;
constexpr int CW_DBG = 1024;
constexpr int CW_QKB = 2048;
constexpr int CW_QUEUE = 2304;

constexpr int EXCH_OFF = 131072  , PSSB_OFF = 139264  , RING_BYTES = 155648, MISC_OFF = RING_BYTES + 320, LDS_BYTES = 159744;

struct Args { const float* in[N_IN]; float* out; unsigned char* ws; int ph_lo, ph_hi, li, pad; };
struct Frame {
    LAS unsigned char* lds; char* ldsg;
    volatile LAS unsigned* MISC;
    int tid, lane, wave, G, bid;
    const float* const* in; float* x; unsigned char* ws;
};
#define WSP(off) (F.ws + (off))
#define POOLP(off) (F.ws + WS_POOL + (off))

struct ZNone { __device__ __forceinline__ size_t aoff(int) const { return 0; } __device__ __forceinline__ size_t boff(int) const { return 0; } };
struct ZLin { size_t as, bs; __device__ __forceinline__ size_t aoff(int z) const { return (size_t)z * as; } __device__ __forceinline__ size_t boff(int z) const { return (size_t)z * bs; } };
struct ZKv { __device__ __forceinline__ size_t aoff(int z) const { return (size_t)z * (256 * 2048 * 2); } __device__ __forceinline__ size_t boff(int z) const { return (size_t)(z >> 1) * ((size_t)4096 * 2048 * 2); } };
struct ZKf { __device__ __forceinline__ size_t aoff(int z) const { return (size_t)(z >> 2) * ((size_t)256 * 4096 * 2) + (size_t)(z & 3) * 1024; }
             __device__ __forceinline__ size_t boff(int z) const { return (size_t)(z >> 3) * ((size_t)2048 * 2048 * 2) + (size_t)(z & 3) * 1024; } };
struct ZVw { __device__ __forceinline__ size_t aoff(int z) const { return (size_t)(z >> 3) * ((size_t)2048 * 2048 * 2) + (size_t)(z & 3) * 1024; }
             __device__ __forceinline__ size_t boff(int z) const { return (size_t)(z >> 2) * ((size_t)256 * 4096 * 2) + 4096 + (size_t)(z & 3) * 1024; } };
template <class ZM>
struct Sched : pg8::Enum {
    const char* A; const char* B; size_t atile, btile; int split; size_t bseq; ZM zm;
    __device__ __forceinline__ const char* a_base(const pg8::Unit& u) const { return A + (size_t)u.pm * atile + zm.aoff(u.z); }
    __device__ __forceinline__ const char* b_base(const pg8::Unit& u) const { return B + (size_t)u.pn * btile + zm.boff(u.z) + (u.pm >= split ? bseq : 0); }
};
template <class ZM>
__device__ __forceinline__ Sched<ZM> make_sched(const Frame& F, const void* A, int lda, const void* B, int ldb, int M, int N, int nZ, ZM zm) {
    Sched<ZM> S; S.init(M / 256, N / 256, nZ, F.G, F.bid); S.A = (const char*)A; S.B = (const char*)B; S.atile = (size_t)256 * lda * 2; S.btile = (size_t)256 * ldb * 2;
    S.split = 1 << 30; S.bseq = 0; S.zm = zm; return S;
}

typedef f32x4 Acc[2][2][4][2];
__device__ __forceinline__ float res_dec(unsigned hb  , float lob  ) {
    const int e = (int)((hb >> 7) & 0xFFu); const float sd = __uint_as_float((unsigned)(e > 15 ? e - 15 : 0) << 23);
    return fmaf(lob - 128.0f, sd, __uint_as_float(hb << 16));
}
__device__ __forceinline__ float res_enc_lo(float x, unsigned hb) {
    const int e = (int)((hb >> 7) & 0xFFu); const float se = e > 15 ? __uint_as_float((unsigned)(269 - e) << 23) : 0.f;
    return fminf(__builtin_rintf(fmaf(x - __uint_as_float(hb << 16), se, 128.0f)), 255.0f);
}
__device__ __forceinline__ unsigned pack4_u8(float a, float b, float c, float dd) { return (unsigned)a | ((unsigned)b << 8) | ((unsigned)c << 16) | ((unsigned)dd << 24); }
__device__ __forceinline__ void res_enc4(const f32x4 v, unsigned& w0, unsigned& w1, unsigned& lo) {
    w0 = cvt_pk_bf16(v[0], v[1]); w1 = cvt_pk_bf16(v[2], v[3]);
    lo = pack4_u8(res_enc_lo(v[0], w0 & 0xFFFFu), res_enc_lo(v[1], w0 >> 16), res_enc_lo(v[2], w1 & 0xFFFFu), res_enc_lo(v[3], w1 >> 16));
}
__device__ __forceinline__ f32x4 res_dec4(unsigned w0, unsigned w1, unsigned lo) {
    return (f32x4){res_dec(w0 & 0xFFFFu, (float)(lo & 0xFFu)), res_dec(w0 >> 16, (float)((lo >> 8) & 0xFFu)), res_dec(w1 & 0xFFFFu, (float)((lo >> 16) & 0xFFu)), res_dec(w1 >> 16, (float)(lo >> 24))};
}
__device__ __forceinline__ unsigned char* fresh_ws(unsigned char* ws) { asm volatile("" : "+s"(ws)); return ws; }
__device__ __forceinline__ void pss_prefetch(LAS unsigned char* lds, const unsigned char* ws, int pm, int par, int wid, int lane) {
    const unsigned char* src = ws + WS_MISC + MISC_PSS + (size_t)pm * 8192 + wid * 1024 + lane * 16;
    __builtin_amdgcn_global_load_lds((const unsigned*)src, (LAS unsigned*)(lds + PSSB_OFF + (par & 1) * 8192 + wid * 1024), 16, 0, 0);
}
__device__ __forceinline__ void row_rstd_lds(const LAS unsigned char* lds, int par, int rloc0, float (&rs)[2][4]) {
    const LAS unsigned char* b = lds + PSSB_OFF + (par & 1) * 8192;
#pragma unroll
    for (int ai = 0; ai < 2; ++ai)
#pragma unroll
        for (int m = 0; m < 4; ++m) { const f32x4 a = *(const LAS f32x4*)(b + (rloc0 + ai * 128 + m * 16) * 32), c = *(const LAS f32x4*)(b + (rloc0 + ai * 128 + m * 16) * 32 + 16);
            rs[ai][m] = 1.0f / sqrtf((((a.x + a.y) + (a.z + a.w)) + ((c.x + c.y) + (c.z + c.w))) * (1.f / DM) + EPS); }
}
__device__ __forceinline__ void row_rstd(const float* PSS, int row0, float (&rs)[2][4]) {
#pragma unroll
    for (int ai = 0; ai < 2; ++ai)
#pragma unroll
        for (int m = 0; m < 4; ++m) { const f32x4 a = *(const f32x4*)(PSS + (size_t)(row0 + ai * 128 + m * 16) * 8), b = *(const f32x4*)(PSS + (size_t)(row0 + ai * 128 + m * 16) * 8 + 4);
            rs[ai][m] = 1.0f / sqrtf((((a.x + a.y) + (a.z + a.w)) + ((b.x + b.y) + (b.z + b.w))) * (1.f / DM) + EPS); }
}
struct EpiSwiglu { static constexpr bool PERM = true, PREFETCH = true; unsigned char* ws; int ldc; LAS unsigned char* lds;
    __device__ __forceinline__ void prefetch(LAS unsigned char* l, const pg8::Unit& u, int par, int wid, int lane) const { pss_prefetch(l, ws, u.pm, par, wid, lane); }
    __device__ __forceinline__ void operator()(Acc& acc, const pg8::Unit& u, int wr, int wc, int fr, int fq, int par) const {
        const int row0 = u.pm * 256 + wr * 64 + fr, col0 = u.pn * 128 + wc * 32 + 8 * fq;
        unsigned char* w_ = fresh_ws(ws); bf16_t* O = (bf16_t*)(w_ + WS_POOL + PL_ACT);
        float rs[2][4]; row_rstd_lds(lds, par, wr * 64 + fr, rs);
#pragma unroll
        for (int ai = 0; ai < 2; ++ai)
#pragma unroll
            for (int m = 0; m < 4; ++m) { const f32x4 g0 = acc[ai][0][m][0] * rs[ai][m], g1 = acc[ai][0][m][1] * rs[ai][m], u0 = acc[ai][1][m][0] * rs[ai][m], u1 = acc[ai][1][m][1] * rs[ai][m];
                u32x4 w; w.x = cvt_pk_bf16(silu_f(g0[0]) * u0[0], silu_f(g0[1]) * u0[1]); w.y = cvt_pk_bf16(silu_f(g0[2]) * u0[2], silu_f(g0[3]) * u0[3]);
                w.z = cvt_pk_bf16(silu_f(g1[0]) * u1[0], silu_f(g1[1]) * u1[1]); w.w = cvt_pk_bf16(silu_f(g1[2]) * u1[2], silu_f(g1[3]) * u1[3]);
                *(u32x4*)(O + (size_t)(row0 + ai * 128 + m * 16) * ldc + col0) = w; }
    }
};
struct EpiResidNorm { static constexpr bool PERM = true, PREFETCH = false; float scale; unsigned char* ws; LAS float* red;
    __device__ __forceinline__ void operator()(Acc& acc, const pg8::Unit& u, int wr, int wc, int fr, int fq, int par) const {
        const int row0 = u.pm * 256 + wr * 64 + fr, col0 = u.pn * 256 + wc * 32 + 8 * fq, tid = (wr * 4 + wc) * 64 + fq * 16 + fr;
        unsigned char* w_ = fresh_ws(ws); bf16_t* XB = (bf16_t*)(w_ + WS_HB); float* PSS = (float*)(w_ + WS_MISC + MISC_PSS);
        u32x4* XL = (u32x4*)(w_ + WS_X + (size_t)(u.pm * 8 + u.pn) * 65536) + tid;
#pragma unroll
        for (int ai = 0; ai < 2; ++ai) {
            u32x4 hv[4][2], lv[4];
#pragma unroll
            for (int m = 0; m < 4; ++m) { const bf16_t* bp = XB + (size_t)(row0 + ai * 128 + m * 16) * DM + col0; hv[m][0] = *(const u32x4*)bp; hv[m][1] = *(const u32x4*)(bp + 128); lv[m] = XL[(ai * 4 + m) * 512]; }
#pragma unroll
            for (int m = 0; m < 4; ++m) { bf16_t* bp = XB + (size_t)(row0 + ai * 128 + m * 16) * DM + col0; float s = 0.f; u32x4 lo;
#pragma unroll
                for (int bj = 0; bj < 2; ++bj) { const f32x4 v0 = res_dec4(hv[m][bj].x, hv[m][bj].y, lv[m][bj * 2]) + acc[ai][bj][m][0] * scale, v1 = res_dec4(hv[m][bj].z, hv[m][bj].w, lv[m][bj * 2 + 1]) + acc[ai][bj][m][1] * scale;
                    unsigned a0, a1, a2, a3, l0, l1; res_enc4(v0, a0, a1, l0); res_enc4(v1, a2, a3, l1); *(u32x4*)(bp + bj * 128) = (u32x4){a0, a1, a2, a3}; lo[bj * 2] = l0; lo[bj * 2 + 1] = l1;
                    s += ((v0[0] * v0[0] + v0[1] * v0[1]) + (v0[2] * v0[2] + v0[3] * v0[3])) + ((v1[0] * v1[0] + v1[1] * v1[1]) + (v1[2] * v1[2] + v1[3] * v1[3])); }
                XL[(ai * 4 + m) * 512] = lo;
                s += __shfl_xor(s, 16); s += __shfl_xor(s, 32);
                if (fq == 0) red[(ai * 128 + wr * 64 + m * 16 + fr) * 4 + wc] = s; }
            asm volatile("" ::: "memory"); }
        asm volatile("s_waitcnt lgkmcnt(0)" ::: "memory"); __builtin_amdgcn_s_barrier(); asm volatile("" ::: "memory");
        if (tid < 256) { const f32x4 r4 = *(const LAS f32x4*)(red + tid * 4); PSS[(size_t)(u.pm * 256 + tid) * 8 + u.pn] = (r4.x + r4.y) + (r4.z + r4.w); }
    }
};
template <int MODE> struct EpiBf16 { static constexpr bool PERM = true, PREFETCH = (MODE == 1); bf16_t* O; int ldc; size_t zhi, zlo; int zshift; const float* aux; unsigned char* ws; LAS unsigned char* lds;
    __device__ __forceinline__ void prefetch(LAS unsigned char* l, const pg8::Unit& u, int par, int wid, int lane) const { pss_prefetch(l, ws, u.pm, par, wid, lane); }
    __device__ __forceinline__ void operator()(Acc& acc, const pg8::Unit& u, int wr, int wc, int fr, int fq, int par) const {
        bf16_t* base = O + (size_t)(u.z >> zshift) * zhi + (size_t)(u.z & ((1 << zshift) - 1)) * zlo;
        const int row0 = u.pm * 256 + wr * 64 + fr, col0 = u.pn * 256 + wc * 32 + 8 * fq;
        float rs[2][4]; if (MODE == 1) row_rstd_lds(lds, par, wr * 64 + fr, rs);
        f32x4 cs[2][2]; if (MODE == 2) {
#pragma unroll
            for (int bj = 0; bj < 2; ++bj)
#pragma unroll
                for (int n = 0; n < 2; ++n) cs[bj][n] = *(const f32x4*)(aux + (size_t)(u.z >> 3) * DM + col0 + bj * 128 + 4 * n); }
#pragma unroll
        for (int ai = 0; ai < 2; ++ai)
#pragma unroll
            for (int m = 0; m < 4; ++m) { bf16_t* rp = base + (size_t)(row0 + ai * 128 + m * 16) * ldc + col0;
#pragma unroll
                for (int bj = 0; bj < 2; ++bj) { f32x4 v0 = acc[ai][bj][m][0], v1 = acc[ai][bj][m][1];
                    if (MODE == 1) { v0 = v0 * rs[ai][m]; v1 = v1 * rs[ai][m]; }
                    if (MODE == 2) { v0 = v0 * cs[bj][0]; v1 = v1 * cs[bj][1]; }
                    u32x4 w; w.x = cvt_pk_bf16(v0[0], v0[1]); w.y = cvt_pk_bf16(v0[2], v0[3]); w.z = cvt_pk_bf16(v1[0], v1[1]); w.w = cvt_pk_bf16(v1[2], v1[3]);
                    *(u32x4*)(rp + bj * 128) = w; } }
    }
};
struct EpiWinEven { static constexpr bool PERM = true, PREFETCH = true; unsigned char* ws; LAS unsigned char* lds;
    __device__ __forceinline__ void prefetch(LAS unsigned char* l, const pg8::Unit& u, int par, int wid, int lane) const { pss_prefetch(l, ws, u.pm, par, wid, lane); }
    __device__ __forceinline__ void operator()(Acc& acc, const pg8::Unit& u, int wr, int wc, int fr, int fq, int par) const {
        const int row0 = u.pm * 256 + wr * 64 + fr, col0 = u.pn * 256 + wc * 32 + 8 * fq;
        unsigned char* w_ = fresh_ws(ws); bf16_t* UX = (bf16_t*)(w_ + WS_POOL + PL_UX); bf16_t* Z = (bf16_t*)(w_ + WS_POOL + PL_Z);
        float rs[2][4]; row_rstd_lds(lds, par, wr * 64 + fr, rs);
        const float qs = (u.pn >= 4 && u.pn < 8) ? 0.18033688f : 1.0f;
#pragma unroll
        for (int ai = 0; ai < 2; ++ai)
#pragma unroll
            for (int m = 0; m < 4; ++m) { const int row = row0 + ai * 128 + m * 16;
#pragma unroll
                for (int bj = 0; bj < 2; ++bj) { const float rq = rs[ai][m] * qs; const f32x4 v0 = acc[ai][bj][m][0] * rq, v1 = acc[ai][bj][m][1] * rq; const int col = col0 + bj * 128;
                    u32x4 w; w.x = cvt_pk_bf16(v0[0], v0[1]); w.y = cvt_pk_bf16(v0[2], v0[3]); w.z = cvt_pk_bf16(v1[0], v1[1]); w.w = cvt_pk_bf16(v1[2], v1[3]);
                    bf16_t* p;
                    if (u.pn < 4) { const int g = col >> 4, h0 = col & 15, c = row >> 5, i = row & 31; p = UX + ((size_t)(g * NCH + c) * S5K2 + i * 16 + h0); }
                    else p = Z + (size_t)row * ZLD + (col - 1024);
                    *(u32x4*)p = w; } }
    }
};
struct EpiF32 { static constexpr bool PERM = false, PREFETCH = false; float* O; int ldc; size_t zs;
    __device__ __forceinline__ void operator()(Acc& acc, const pg8::Unit& u, int wr, int wc, int fr, int fq, int par) const {
        float* base = O + (size_t)u.z * zs; const int row0 = u.pm * 256 + wr * 64 + fr, col0 = u.pn * 256 + wc * 32 + 4 * fq;
#pragma unroll
        for (int ai = 0; ai < 2; ++ai)
#pragma unroll
            for (int m = 0; m < 4; ++m) { float* rp = base + (size_t)(row0 + ai * 128 + m * 16) * ldc + col0;
#pragma unroll
                for (int bj = 0; bj < 2; ++bj)
#pragma unroll
                    for (int n = 0; n < 2; ++n) *(f32x4*)(rp + bj * 128 + n * 16) = acc[ai][bj][m][n]; }
    }
};
struct EpiS5Out { static constexpr bool PERM = true, PREFETCH = false; bf16_t* GB;
    __device__ __forceinline__ void operator()(Acc& acc, const pg8::Unit& u, int wr, int wc, int fr, int fq, int par) const {
        const int row0 = u.pm * 256 + wr * 64 + fr, col0 = u.pn * 256 + wc * 32 + 8 * fq;
#pragma unroll
        for (int ai = 0; ai < 2; ++ai)
#pragma unroll
            for (int m = 0; m < 4; ++m) { const int c = row0 + ai * 128 + m * 16;
#pragma unroll
                for (int bj = 0; bj < 2; ++bj) { const f32x4 v0 = acc[ai][bj][m][0], v1 = acc[ai][bj][m][1]; const int col = col0 + bj * 128, i = col >> 4, h0 = col & 15;
                    u32x4 w; w.x = cvt_pk_bf16(gelu_tanh_f(v0[0]), gelu_tanh_f(v0[1])); w.y = cvt_pk_bf16(gelu_tanh_f(v0[2]), gelu_tanh_f(v0[3]));
                    w.z = cvt_pk_bf16(gelu_tanh_f(v1[0]), gelu_tanh_f(v1[1])); w.w = cvt_pk_bf16(gelu_tanh_f(v1[2]), gelu_tanh_f(v1[3]));
                    *(u32x4*)(GB + (size_t)(c * LC + i) * S5W + u.z * 16 + h0) = w; } }
    }
};
struct EpiGlu { static constexpr bool PERM = true, PREFETCH = false; const bf16_t* GB; const float* bias; bf16_t* O;
    __device__ __forceinline__ void operator()(Acc& acc, const pg8::Unit& u, int wr, int wc, int fr, int fq, int par) const {
        const int row0 = u.pm * 256 + wr * 64 + fr, col0 = u.pn * 256 + wc * 32 + 8 * fq;
        f32x4 bv[2][2];
#pragma unroll
        for (int bj = 0; bj < 2; ++bj)
#pragma unroll
            for (int n = 0; n < 2; ++n) bv[bj][n] = *(const f32x4*)(bias + col0 + bj * 128 + 4 * n);
#pragma unroll
        for (int ai = 0; ai < 2; ++ai)
#pragma unroll
            for (int m = 0; m < 4; ++m) { const int row = row0 + ai * 128 + m * 16;
#pragma unroll
                for (int bj = 0; bj < 2; ++bj) { const f32x4 v0 = acc[ai][bj][m][0] + bv[bj][0], v1 = acc[ai][bj][m][1] + bv[bj][1]; const int col = col0 + bj * 128;
                    const u32x4 g = *(const u32x4*)(GB + (size_t)row * S5W + col);
                    u32x4 w; w.x = cvt_pk_bf16(bflo(g.x) * sigmoidf_fast(v0[0]), bfhi(g.x) * sigmoidf_fast(v0[1])); w.y = cvt_pk_bf16(bflo(g.y) * sigmoidf_fast(v0[2]), bfhi(g.y) * sigmoidf_fast(v0[3]));
                    w.z = cvt_pk_bf16(bflo(g.z) * sigmoidf_fast(v1[0]), bfhi(g.z) * sigmoidf_fast(v1[1])); w.w = cvt_pk_bf16(bflo(g.w) * sigmoidf_fast(v1[2]), bfhi(g.w) * sigmoidf_fast(v1[3]));
                    *(u32x4*)(O + (size_t)row * DM + col) = w; } }
    }
};

struct EpiCrossSm { static constexpr bool PERM = true, PREFETCH = true; unsigned char* ws; LAS f32x2* red; LAS unsigned char* lds;
    __device__ __forceinline__ void prefetch(LAS unsigned char* l, const pg8::Unit& u, int par, int wid, int lane) const { pss_prefetch(l, ws, u.pm, par, wid, lane); }
    __device__ __forceinline__ void operator()(Acc& acc, const pg8::Unit& u, int wr, int wc, int fr, int fq, int par) const {
        constexpr float C = 0.04419417382415922f * 1.4426950408889634f;
        const int row0 = u.pm * 256 + wr * 64 + fr, col0 = u.pn * 256 + wc * 32 + 8 * fq;
        unsigned char* w_ = fresh_ws(ws); bf16_t* O = (bf16_t*)(w_ + WS_POOL + PL_CP);
        float rs[2][4]; row_rstd_lds(lds, par, wr * 64 + fr, rs);
        float mw[2][4];
#pragma unroll
        for (int ai = 0; ai < 2; ++ai)
#pragma unroll
            for (int m = 0; m < 4; ++m) { const float k = rs[ai][m] * C; float mx = -3.0e38f;
#pragma unroll
                for (int bj = 0; bj < 2; ++bj)
#pragma unroll
                    for (int n = 0; n < 2; ++n) { f32x4 v = acc[ai][bj][m][n] * k; acc[ai][bj][m][n] = v; mx = fmaxf(fmaxf(mx, fmaxf(v[0], v[1])), fmaxf(v[2], v[3])); }
                mx = fmaxf(mx, __shfl_xor(mx, 16)); mx = fmaxf(mx, __shfl_xor(mx, 32)); float s = 0.f;
#pragma unroll
                for (int bj = 0; bj < 2; ++bj)
#pragma unroll
                    for (int n = 0; n < 2; ++n) { f32x4 v = acc[ai][bj][m][n]; v[0] = fast_exp2(v[0] - mx); v[1] = fast_exp2(v[1] - mx); v[2] = fast_exp2(v[2] - mx); v[3] = fast_exp2(v[3] - mx); acc[ai][bj][m][n] = v; s += (v[0] + v[1]) + (v[2] + v[3]); }
                s += __shfl_xor(s, 16); s += __shfl_xor(s, 32); mw[ai][m] = mx;
                if (fq == 0) red[(ai * 128 + wr * 64 + m * 16 + fr) * 4 + wc] = (f32x2){mx, s}; }
        asm volatile("s_waitcnt lgkmcnt(0)" ::: "memory"); __builtin_amdgcn_s_barrier(); asm volatile("" ::: "memory");
#pragma unroll
        for (int ai = 0; ai < 2; ++ai)
#pragma unroll
            for (int m = 0; m < 4; ++m) { const LAS f32x2* rr = red + (ai * 128 + wr * 64 + m * 16 + fr) * 4; const f32x2 r0 = rr[0], r1 = rr[1], r2 = rr[2], r3 = rr[3];
                const float M = fmaxf(fmaxf(r0.x, r1.x), fmaxf(r2.x, r3.x));
                const float tot = (r0.y * fast_exp2(r0.x - M) + r1.y * fast_exp2(r1.x - M)) + (r2.y * fast_exp2(r2.x - M) + r3.y * fast_exp2(r3.x - M));
                const float f = fast_exp2(mw[ai][m] - M) * fast_rcp(tot);
                bf16_t* rp = O + (size_t)(row0 + ai * 128 + m * 16) * 1024 + col0;
#pragma unroll
                for (int bj = 0; bj < 2; ++bj) { const f32x4 v0 = acc[ai][bj][m][0] * f, v1 = acc[ai][bj][m][1] * f;
                    u32x4 w; w.x = cvt_pk_bf16(v0[0], v0[1]); w.y = cvt_pk_bf16(v0[2], v0[3]); w.z = cvt_pk_bf16(v1[0], v1[1]); w.w = cvt_pk_bf16(v1[2], v1[3]);
                    *(u32x4*)(rp + bj * 128) = w; } }
    }
};

template <int MODE>
__device__ __forceinline__ void transpose_item(const float* W, int K, int N, bf16_t* WT, LAS float* scr, int item, int lane, const float* gain = nullptr) {
    const int nblk = N / 32, kb = item / nblk, nb = item % nblk, k0 = 64 * kb, n0 = 32 * nb;
#pragma unroll 8
    for (int i = 0; i < 32; ++i) { const int kk = 2 * i + (lane >> 5); scr[kk * 33 + (lane & 31)] = W[(size_t)(k0 + kk) * N + n0 + (lane & 31)]; }
    LDS_WAIT(); asm volatile("" ::: "memory");
    const int c = lane & 7;
    f32x4 g0 = (f32x4){1.f, 1.f, 1.f, 1.f}, g1 = g0; if (gain) { g0 = *(const f32x4*)(gain + k0 + 8 * c); g1 = *(const f32x4*)(gain + k0 + 8 * c + 4); }
    int r0;
    if (MODE == 1) { r0 = (n0 < DFF) ? (256 * (n0 / 128) + (n0 % 128)) : (256 * ((n0 - DFF) / 128) + 128 + ((n0 - DFF) % 128)); } else r0 = n0;
#pragma unroll
    for (int j = 0; j < 4; ++j) { const int n = (lane >> 3) + 8 * j; const LAS float* s = scr + (8 * c) * 33 + n;
        u32x4 o; o.x = cvt_pk_bf16(s[0 * 33] * g0.x, s[1 * 33] * g0.y); o.y = cvt_pk_bf16(s[2 * 33] * g0.z, s[3 * 33] * g0.w); o.z = cvt_pk_bf16(s[4 * 33] * g1.x, s[5 * 33] * g1.y); o.w = cvt_pk_bf16(s[6 * 33] * g1.z, s[7 * 33] * g1.w);
        *(u32x4*)(WT + (size_t)(r0 + n) * K + k0 + 8 * c) = o; }
    LDS_WAIT(); asm volatile("" ::: "memory");
}
__device__ __forceinline__ void convert_rows(const float* src, bf16_t* dst, size_t n8, size_t gtid, size_t gthreads) {
    for (size_t i = gtid; i < n8; i += gthreads) { const f32x4 a = *(const f32x4*)(src + i * 8), b = *(const f32x4*)(src + i * 8 + 4);
        u32x4 o; o.x = cvt_pk_bf16(a[0], a[1]); o.y = cvt_pk_bf16(a[2], a[3]); o.z = cvt_pk_bf16(b[0], b[1]); o.w = cvt_pk_bf16(b[2], b[3]); *(u32x4*)(dst + i * 8) = o; }
}

__device__ __forceinline__ void rms_row_to_bf16(const float* xrow, const float* g, bf16_t* orow, float* xcopy, int lane) {
    const f32x4* xr = (const f32x4*)xrow + lane;
    f32x4 v[8]; float s = 0.f;
#pragma unroll
    for (int j = 0; j < 8; ++j) { v[j] = xr[64 * j]; s += (v[j].x * v[j].x + v[j].y * v[j].y) + (v[j].z * v[j].z + v[j].w * v[j].w); }
    if (xcopy) {
#pragma unroll
        for (int j = 0; j < 8; ++j) ((f32x4*)xcopy + lane)[64 * j] = v[j]; }
    const float rstd = 1.0f / sqrtf(wave_sum(s) * (1.f / DM) + EPS);
    const f32x4* gr = (const f32x4*)g + lane;
    u32x2* o8 = (u32x2*)orow + lane;
#pragma unroll
    for (int j = 0; j < 8; ++j) { const f32x4 gg = gr[64 * j]; u32x2 w; w.x = cvt_pk_bf16(v[j].x * rstd * gg.x, v[j].y * rstd * gg.y); w.y = cvt_pk_bf16(v[j].z * rstd * gg.z, v[j].w * rstd * gg.w); o8[64 * j] = w; }
}
__device__ __forceinline__ void norm_phase(const Frame& F, const float* g) {
    const int gw = F.bid * NWAVES + F.wave, NGW = F.G * NWAVES; bf16_t* HB = (bf16_t*)WSP(WS_HB);
    for (int m = gw; m < TT; m += NGW) rms_row_to_bf16(F.x + (size_t)m * DM, g, HB + (size_t)m * DM, nullptr, F.lane);
}
__device__ __forceinline__ void final_norm_phase(const Frame& F, const float* g) {
    const float* PSS = (const float*)(WSP(WS_MISC) + MISC_PSS); const bf16_t* XB = (const bf16_t*)WSP(WS_HB);
    const int tid = F.tid, wid = tid >> 6, wr = wid >> 2, wc = wid & 3, fq = (tid >> 4) & 3, fr = tid & 15;
    for (int L = F.bid; L < (TT / 256) * 8; L += F.G) { const int pm = L >> 3, pn = L & 7;
        const u32x4* XL = (const u32x4*)(WSP(WS_X) + (size_t)L * 65536) + tid; const int row0 = pm * 256 + wr * 64 + fr, col0 = pn * 256 + wc * 32 + 8 * fq;
        float rs[2][4]; row_rstd(PSS, row0, rs);
        f32x4 gg[2][2];
#pragma unroll
        for (int bj = 0; bj < 2; ++bj) { gg[bj][0] = *(const f32x4*)(g + col0 + bj * 128); gg[bj][1] = *(const f32x4*)(g + col0 + bj * 128 + 4); }
#pragma unroll
        for (int ai = 0; ai < 2; ++ai)
#pragma unroll
            for (int m = 0; m < 4; ++m) { const size_t ro = (size_t)(row0 + ai * 128 + m * 16) * DM + col0; const u32x4 lo = XL[(ai * 4 + m) * 512];
#pragma unroll
                for (int bj = 0; bj < 2; ++bj) { const u32x4 h = *(const u32x4*)(XB + ro + bj * 128); float* op = F.x + ro + bj * 128;
                    *(f32x4*)op = res_dec4(h.x, h.y, lo[bj * 2]) * rs[ai][m] * gg[bj][0]; *(f32x4*)(op + 4) = res_dec4(h.z, h.w, lo[bj * 2 + 1]) * rs[ai][m] * gg[bj][1]; } }
    }
}

__device__ __forceinline__ void s5_precompute_group(const Frame& F, int e, int g) {
    LAS float* L = (LAS float*)F.lds;
    LAS float* apow = L;
    LAS float* bb = apow + 8448;
    LAS float* cc = bb + 4096;
    LAS float* km = cc + 4096;
    LAS float* dsk = km + 16384;
    const float* lre = F.in[I_LRE], *lim = F.in[I_LIM], *ldt = F.in[I_LDT], *bre = F.in[I_BRE], *bim = F.in[I_BIM], *cre = F.in[I_CRE], *cim = F.in[I_CIM], *dsk_g = F.in[I_S5D];
    const int tid = F.tid;
    for (int idx = tid; idx < 2 * 64 * 33; idx += NTHREADS) { const int k = idx % 33, p = (idx / 33) % 64, dir = idx / (33 * 64);
        const size_t pi = ((size_t)(e * 2 + dir) * S5G + g) * S5P + p; const float lr = fminf(lre[pi], -1e-4f), li = lim[pi], dt = expf(ldt[(e * 2 + dir) * S5G + g]);
        const float mag = expf(lr * dt * (float)k); float sn, cs; sincosf(li * dt * (float)k, &sn, &cs); apow[idx * 2] = mag * cs; apow[idx * 2 + 1] = mag * sn; }
    for (int idx = tid; idx < 2 * 64 * 16; idx += NTHREADS) { const int h = idx % 16, p = (idx / 16) % 64, dir = idx / 1024;
        const size_t pi = ((size_t)(e * 2 + dir) * S5G + g) * S5P + p; const float lr = fminf(lre[pi], -1e-4f), li = lim[pi], dt = expf(ldt[(e * 2 + dir) * S5G + g]);
        const float mag = expf(lr * dt); float sn, cs; sincosf(li * dt, &sn, &cs); const float ar = mag * cs, ai = mag * sn, nr = ar - 1.0f, den = lr * lr + li * li;
        const float fr = (nr * lr + ai * li) / den, fi = (ai * lr - nr * li) / den; const float br = bre[pi * 16 + h], bi = bim[pi * 16 + h];
        bb[idx * 2] = fr * br - fi * bi; bb[idx * 2 + 1] = fr * bi + fi * br; }
    for (int idx = tid; idx < 2 * 16 * 64; idx += NTHREADS) { const int p = idx % 64, h = (idx / 64) % 16, dir = idx / 1024;
        const size_t ci = (((size_t)(e * 2 + dir) * S5G + g) * S5H + h) * S5P + p; cc[idx * 2] = cre[ci]; cc[idx * 2 + 1] = cim[ci]; }
    if (tid < 16) dsk[tid] = dsk_g[e * S5W + g * 16 + tid];
    LDS_WAIT(); __syncthreads();
    for (int idx = tid; idx < 2 * 32 * 256; idx += NTHREADS) { const int hp = idx & 15, h = (idx >> 4) & 15, k = (idx >> 8) & 31, dir = idx >> 13; float s = 0.f;
        for (int p = 0; p < 64; ++p) { const float cr = cc[((dir * 16 + h) * 64 + p) * 2], ci = cc[((dir * 16 + h) * 64 + p) * 2 + 1], ar = apow[((dir * 64 + p) * 33 + k) * 2], ai = apow[((dir * 64 + p) * 33 + k) * 2 + 1];
            const float br = bb[((dir * 64 + p) * 16 + hp) * 2], bi = bb[((dir * 64 + p) * 16 + hp) * 2 + 1]; const float wr = cr * ar - ci * ai, wi = cr * ai + ci * ar; s += wr * br - wi * bi; }
        km[idx] = s; }
    LDS_WAIT(); __syncthreads();
    bf16_t* WST = (bf16_t*)WSP(WS_WST) + (size_t)(e * 64 + g) * (S5NS * S5K1);
    bf16_t* TG = (bf16_t*)WSP(WS_TG) + (size_t)(e * 64 + g) * (S5K1 * S5K2);
    for (int idx = tid; idx < S5NS * S5K1 / 2; idx += NTHREADS) { const int k2 = (idx % (S5K1 / 2)) * 2, n = idx / (S5K1 / 2); const int dir = n >> 7, p = (n >> 1) & 63, ri = n & 1; const int j = k2 >> 4, hp = k2 & 15;
        const int ex = dir == 0 ? (LC - 1 - j) : j; const float ar = apow[((dir * 64 + p) * 33 + ex) * 2], ai = apow[((dir * 64 + p) * 33 + ex) * 2 + 1];
        float v[2];
#pragma unroll
        for (int q = 0; q < 2; ++q) { const float br = bb[((dir * 64 + p) * 16 + hp + q) * 2], bi = bb[((dir * 64 + p) * 16 + hp + q) * 2 + 1]; v[q] = ri == 0 ? (ar * br - ai * bi) : (ar * bi + ai * br); }
        *(unsigned*)(WST + (size_t)n * S5K1 + k2) = cvt_pk_bf16(v[0], v[1]); }
    for (int idx = tid; idx < S5K1 * S5K2 / 2; idx += NTHREADS) { const int k2 = (idx % (S5K2 / 2)) * 2, n = idx / (S5K2 / 2); const int i = n >> 4, h = n & 15; float v[2];
        if (k2 < S5K1) { const int j = k2 >> 4, hp = k2 & 15;
#pragma unroll
            for (int q = 0; q < 2; ++q) { float s = 0.f; if (j <= i) s += km[((0 * 32 + (i - j)) * 16 + h) * 16 + hp + q]; if (j >= i) s += km[((1 * 32 + (j - i)) * 16 + h) * 16 + hp + q]; if (i == j && h == hp + q) s += dsk[h]; v[q] = s; }
        } else { const int nn = k2 - S5K1, dir = nn >> 7, p = (nn >> 1) & 63; const int ex = dir == 0 ? (i + 1) : (LC - i);
            const float ar = apow[((dir * 64 + p) * 33 + ex) * 2], ai = apow[((dir * 64 + p) * 33 + ex) * 2 + 1], cr = cc[((dir * 16 + h) * 64 + p) * 2], ci = cc[((dir * 16 + h) * 64 + p) * 2 + 1];
            v[0] = cr * ar - ci * ai; v[1] = -(cr * ai + ci * ar); }
        *(unsigned*)(TG + (size_t)n * S5K2 + k2) = cvt_pk_bf16(v[0], v[1]); }
    f32x2* AL = (f32x2*)(WSP(WS_MISC) + MISC_AL);
    if (tid < 128) { const int dir = tid >> 6, p = tid & 63; AL[((e * 2 + dir) * 64 + g) * 64 + p] = (f32x2){apow[((dir * 64 + p) * 33 + LC) * 2], apow[((dir * 64 + p) * 33 + LC) * 2 + 1]}; }
    __syncthreads();
}

__device__ __forceinline__ void s5_scan_phase(const Frame& F, int e) {
    const float* SST = (const float*)POOLP(PL_SST); bf16_t* UX = (bf16_t*)POOLP(PL_UX);
    LAS f32x2* tot = (LAS f32x2*)F.lds;
    const int p = F.lane, w = F.wave;
    for (int item = F.bid; item < 2 * 2 * 64; item += F.G) {
        const int g = item & 63, dir = (item >> 6) & 1, seq = item >> 7;
        const f32x2 aL = ((const f32x2*)(WSP(WS_MISC) + MISC_AL))[((e * 2 + dir) * 64 + g) * 64 + p];
        const int c0 = seq ? NCH_P : 0, cs = seq ? 32 : 16;
        const int step = dir == 0 ? 1 : -1;
        const float* sbase = SST + (size_t)g * 256 + dir * 128 + 2 * p;
        bf16_t* xbase = UX + (size_t)g * NCH * S5K2 + S5K1 + dir * 128 + 2 * p;
#pragma unroll 1
        for (int q = 0; q < 2; ++q) { const int s = 2 * w + q; int c = c0 + s * cs + (dir == 0 ? 0 : cs - 1); float xr = 0.f, xi = 0.f;
#pragma unroll 1
            for (int it = 0; it < cs; it += 8) { f32x2 sv[8];
#pragma unroll
                for (int k = 0; k < 8; ++k) sv[k] = *(const f32x2*)(sbase + (size_t)(c + k * step) * (64 * 256));
#pragma unroll
                for (int k = 0; k < 8; ++k) { const float nr = aL.x * xr - aL.y * xi + sv[k].x, ni = aL.x * xi + aL.y * xr + sv[k].y; xr = nr; xi = ni; }
                c += 8 * step; }
            tot[s * 64 + p] = (f32x2){xr, xi}; }
        LDS_WAIT(); __syncthreads();
        float pr = aL.x, pi = aL.y;
        for (int k = cs; k > 1; k >>= 1) { const float nr = pr * pr - pi * pi, ni = 2.f * pr * pi; pr = nr; pi = ni; }
#pragma unroll 1
        for (int q = 0; q < 2; ++q) { const int s = 2 * w + q; float xr = 0.f, xi = 0.f;
            if (dir == 0) { for (int j = 0; j < s; ++j) { const f32x2 t = tot[j * 64 + p]; const float nr = pr * xr - pi * xi + t.x, ni = pr * xi + pi * xr + t.y; xr = nr; xi = ni; } }
            else { for (int j = 15; j > s; --j) { const f32x2 t = tot[j * 64 + p]; const float nr = pr * xr - pi * xi + t.x, ni = pr * xi + pi * xr + t.y; xr = nr; xi = ni; } }
            int c = c0 + s * cs + (dir == 0 ? 0 : cs - 1);
#pragma unroll 1
            for (int it = 0; it < cs; it += 8) { f32x2 sv[8];
#pragma unroll
                for (int k = 0; k < 8; ++k) sv[k] = *(const f32x2*)(sbase + (size_t)(c + k * step) * (64 * 256));
#pragma unroll
                for (int k = 0; k < 8; ++k) { *(unsigned*)(xbase + (size_t)(c + k * step) * S5K2) = cvt_pk_bf16(xr, xi);
                    const float nr = aL.x * xr - aL.y * xi + sv[k].x, ni = aL.x * xi + aL.y * xr + sv[k].y; xr = nr; xi = ni; }
                c += 8 * step; } }
        __syncthreads();
    }
}

__device__ __forceinline__ void qk_prep_phase(const Frame& F, int o) {
    bf16_t* Z = (bf16_t*)POOLP(PL_Z); bf16_t* KC = (bf16_t*)POOLP(PL_KC); const float* rope = (const float*)(WSP(WS_MISC) + MISC_ROPE);
    const float* qg = F.in[I_QN] + o * 128, *kg = F.in[I_KN] + o * 128;
    const int sub = F.lane >> 4, j = F.lane & 15;
    const long nrows = (long)TT * 20, gq = ((long)F.bid * NWAVES + F.wave) * 4 + sub, nq = (long)F.G * NWAVES * 4;
    for (long r = gq; r < nrows; r += nq) {
        const int t = (int)(r / 20), hh = (int)(r % 20);
        bf16_t* p = Z + (size_t)t * ZLD + (hh < 16 ? hh * 128 : 2048 + (hh - 16) * 128) + j * 8;
        const u32x4 w = *(const u32x4*)p; float v[8] = {bflo(w.x), bfhi(w.x), bflo(w.y), bfhi(w.y), bflo(w.z), bfhi(w.z), bflo(w.w), bfhi(w.w)};
        float s = 0.f;
#pragma unroll
        for (int q = 0; q < 8; ++q) s += v[q] * v[q];
        s += __shfl_xor(s, 1); s += __shfl_xor(s, 2); s += __shfl_xor(s, 4); s += __shfl_xor(s, 8);
        const float rstd = 1.0f / sqrtf(s * (1.f / 128.f) + EPS); const float* gg = (hh < 16 ? qg : kg) + j * 8;
        const int tl = t < T_P ? t : t - T_P; const int pos = (j < 8) ? (tl >> 6) : (tl & 63);
        const float* rp = rope + ((size_t)pos * 32 + 8 * (j & 3)) * 2;
        float ov[8]; const float osc = hh < 16 ? 0.12751743f : 1.0f;
#pragma unroll
        for (int q = 0; q < 8; ++q) { const float x = v[q] * rstd * gg[q]; const float y = __shfl_xor(x, 4); const float cs = rp[2 * q], sn = rp[2 * q + 1];
            ov[q] = ((j & 4) ? (x * cs + y * sn) : (x * cs - y * sn)) * osc; }
        u32x4 ow; ow.x = cvt_pk_bf16(ov[0], ov[1]); ow.y = cvt_pk_bf16(ov[2], ov[3]); ow.z = cvt_pk_bf16(ov[4], ov[5]); ow.w = cvt_pk_bf16(ov[6], ov[7]);
        *(u32x4*)p = ow;
    }
}

__device__ __forceinline__ void cross_softmax_phase(const Frame& F) {
    const float* CS = (const float*)POOLP(PL_CS); bf16_t* CP = (bf16_t*)POOLP(PL_CP);
    const long nrows = (long)TT * 4, gw = (long)F.bid * NWAVES + F.wave, NGW = (long)F.G * NWAVES;
    constexpr float C = 0.04419417382415922f * 1.4426950408889634f;
    for (long r = gw; r < nrows; r += NGW) {
        const f32x4 v = *((const f32x4*)(CS + r * 256) + F.lane);
        float m = fmaxf(fmaxf(v.x, v.y), fmaxf(v.z, v.w));
#pragma unroll
        for (int o = 1; o < 64; o <<= 1) m = fmaxf(m, __shfl_xor(m, o));
        const float e0 = fast_exp2((v.x - m) * C), e1 = fast_exp2((v.y - m) * C), e2 = fast_exp2((v.z - m) * C), e3 = fast_exp2((v.w - m) * C);
        const float inv = fast_rcp(wave_sum((e0 + e1) + (e2 + e3)));
        u32x2 w; w.x = cvt_pk_bf16(e0 * inv, e1 * inv); w.y = cvt_pk_bf16(e2 * inv, e3 * inv);
        *((u32x2*)(CP + r * 256) + F.lane) = w;
    }
}

__device__ __forceinline__ void prologue_phase(const Frame& F) {
    LAS float* scr = (LAS float*)(F.lds + F.wave * 16384);
    const int gw = F.bid * NWAVES + F.wave, NGW = F.G * NWAVES;
    constexpr int IT_GU = (DM / 64) * (2 * DFF / 32), IT_D = (DFF / 64) * (DM / 32), IT_WINE = (DM / 64) * (EVEN_IN / 32), IT_SQ = (DM / 64) * (DM / 32), IT_GLU = (S5W / 64) * (S5W / 32),
                  IT_WINO = (DM / 64) * (ODD_IN / 32), IT_KV = (DM / 64) * (2 * DM / 32);
    constexpr int N_GU = 8 * IT_GU, N_D = 8 * IT_D, N_WINE = 2 * IT_WINE, N_WOUTE = 2 * IT_SQ, N_GLU = 2 * IT_GLU, N_WINO = 2 * IT_WINO, N_WOUTO = 2 * IT_SQ, N_KV = 4 * IT_KV, N_WO = 4 * IT_SQ;
    constexpr int NITEMS = N_GU + N_D + N_WINE + N_WOUTE + N_GLU + N_WINO + N_WOUTO + N_KV + N_WO;
    for (int it = gw; it < NITEMS; it += NGW) {
        int r = it;
        if (r < N_GU) { const int w = r / IT_GU, l = w >> 1, f = w & 1; transpose_item<1>(F.in[f ? I_F2GU : I_F1GU] + (size_t)l * DM * 2 * DFF, DM, 2 * DFF, (bf16_t*)WSP(WS_WGU + w * SZ_WGU), scr, r % IT_GU, F.lane, F.in[f ? I_F2N : I_F1N] + l * DM); continue; } r -= N_GU;
        if (r < N_D) { const int w = r / IT_D, l = w >> 1, f = w & 1; transpose_item<0>(F.in[f ? I_F2D : I_F1D] + (size_t)l * DFF * DM, DFF, DM, (bf16_t*)WSP(WS_WD + w * SZ_WD), scr, r % IT_D, F.lane); continue; } r -= N_D;
        if (r < N_WINE) { const int e = r / IT_WINE; transpose_item<0>(F.in[I_EWIN] + (size_t)e * DM * EVEN_IN, DM, EVEN_IN, (bf16_t*)WSP(WS_WINE + e * SZ_WINE), scr, r % IT_WINE, F.lane, F.in[I_MIXN] + (2 * e) * DM); continue; } r -= N_WINE;
        if (r < N_WOUTE) { const int e = r / IT_SQ; transpose_item<0>(F.in[I_EWOUT] + (size_t)e * DM * DM, DM, DM, (bf16_t*)WSP(WS_WOUTE + e * SZ_SQ), scr, r % IT_SQ, F.lane); continue; } r -= N_WOUTE;
        if (r < N_GLU) { const int e = r / IT_GLU; transpose_item<0>(F.in[I_GLUW] + (size_t)e * S5W * S5W, S5W, S5W, (bf16_t*)WSP(WS_GLU + e * SZ_GLU), scr, r % IT_GLU, F.lane); continue; } r -= N_GLU;
        if (r < N_WINO) { const int o = r / IT_WINO; transpose_item<0>(F.in[I_OWIN] + (size_t)o * DM * ODD_IN, DM, ODD_IN, (bf16_t*)WSP(WS_WINO + o * SZ_WINO), scr, r % IT_WINO, F.lane, F.in[I_MIXN] + (2 * o + 1) * DM); continue; } r -= N_WINO;
        if (r < N_WOUTO) { const int o = r / IT_SQ; transpose_item<0>(F.in[I_OWOUT] + (size_t)o * DM * DM, DM, DM, (bf16_t*)WSP(WS_WOUTO + o * SZ_SQ), scr, r % IT_SQ, F.lane); continue; } r -= N_WOUTO;
        if (r < N_KV) { const int l = r / IT_KV; transpose_item<0>(F.in[I_CWKV] + (size_t)l * DM * 2 * DM, DM, 2 * DM, (bf16_t*)POOLP(PL_WKVT) + (size_t)l * 2 * DM * DM, scr, r % IT_KV, F.lane); continue; } r -= N_KV;
        { const int l = r / IT_SQ; transpose_item<0>(F.in[I_CWO] + (size_t)l * DM * DM, DM, DM, (bf16_t*)POOLP(PL_WOT) + (size_t)l * DM * DM, scr, r % IT_SQ, F.lane); }
    }
    convert_rows(F.in[I_CWQ], (bf16_t*)POOLP(PL_WQB), (size_t)4 * DM * DM / 8, (size_t)F.bid * NTHREADS + F.tid, (size_t)F.G * NTHREADS);
    for (int m = gw; m < 4 * 2 * NMEM; m += NGW) { const int l = m / (2 * NMEM), s = (m / NMEM) & 1, j = m % NMEM;
        rms_row_to_bf16(F.in[s ? I_MS : I_MP] + (size_t)j * DM, F.in[I_MN] + l * DM, (bf16_t*)POOLP(PL_MEMN) + (size_t)m * DM, nullptr, F.lane); }
    for (int m = gw; m < TT; m += NGW) { const float* src = m < T_P ? F.in[I_XP] + (size_t)m * DM : F.in[I_XS] + (size_t)(m - T_P) * DM;
        const f32x4* xr = (const f32x4*)src + F.lane; u32x2* bo = (u32x2*)((bf16_t*)WSP(WS_HB) + (size_t)m * DM) + F.lane; float s = 0.f;
        const int rr = m & 255, ai = rr >> 7, wr = (rr >> 6) & 1, mm = (rr >> 4) & 3, fr = rr & 15, cc = 4 * F.lane, bj = cc >> 7, wc = (cc >> 5) & 3, fq = (cc >> 3) & 3, n = (cc >> 2) & 1;
        unsigned* xl = (unsigned*)(WSP(WS_X) + (size_t)(m >> 8) * 8 * 65536) + ((size_t)((ai * 4 + mm) * 512 + (wr * 4 + wc) * 64 + fq * 16 + fr)) * 4 + bj * 2 + n;
#pragma unroll
        for (int j = 0; j < 8; ++j) { const f32x4 v = xr[64 * j]; unsigned a0, a1, lo; res_enc4(v, a0, a1, lo); bo[64 * j] = (u32x2){a0, a1}; xl[(size_t)j * 16384] = lo; s += (v.x * v.x + v.y * v.y) + (v.z * v.z + v.w * v.w); }
        s = wave_sum(s);
        if (F.lane < 8) ((float*)(WSP(WS_MISC) + MISC_PSS))[(size_t)m * 8 + F.lane] = F.lane == 0 ? s : 0.f; }
    { float* rope = (float*)(WSP(WS_MISC) + MISC_ROPE); const int gt = F.bid * NTHREADS + F.tid;
      if (gt < 256 * 32) { const int pos = gt >> 5, i = gt & 31; const float inv = powf(10000.0f, -(float)(2 * i) / 64.0f); float sn, cs; sincosf((float)pos * inv, &sn, &cs); rope[gt * 2] = cs; rope[gt * 2 + 1] = sn; }
      if (gt < 2) { float s1 = 0.f, s2 = 0.f; for (int q = 0; q < 64; ++q) { s1 += F.in[I_LQ1][gt * 64 + q] * F.in[I_LK1][gt * 64 + q]; s2 += F.in[I_LQ2][gt * 64 + q] * F.in[I_LK2][gt * 64 + q]; }
          const float linit = 0.8f - 0.6f * expf(-0.3f * (float)(2 * gt)); ((float*)(WSP(WS_MISC) + MISC_LAM))[gt * 2] = expf(s1) - expf(s2) + linit; ((float*)(WSP(WS_MISC) + MISC_LAM))[gt * 2 + 1] = linit; } }
}
__device__ __forceinline__ void s5_precompute_phase(const Frame& F) {
    for (int w = F.G - 1 - F.bid; w < 2 * S5G; w += F.G) s5_precompute_group(F, w / S5G, w % S5G);
}

#ifndef GQA_SDEPTH
#define GQA_SDEPTH 1
#endif
#ifndef DIFF_SDEPTH
#define DIFF_SDEPTH 1
#endif
#ifndef ATT_SETPRIO
#define ATT_SETPRIO 0
#endif
#if ATT_SETPRIO
#define ATT_PRIO(x) __builtin_amdgcn_s_setprio(x)
#else
#define ATT_PRIO(x) do {} while (0)
#endif
#ifndef FIXREF_LIMIT_GQA
#define FIXREF_LIMIT_GQA 40.0f
#define FIXREF_LIMIT_DIFF 20.0f
#endif
namespace att {
constexpr int NW = 8, QBLK = 32, KVBLK = 64, DV = 128;
constexpr float THR = 8.f;
__device__ __forceinline__ int crow(int r, int hi) { return (r & 3) + 8 * (r >> 2) + 4 * hi; }
template <int DQK> __device__ __forceinline__ int kswz(int row, int colB) { if (DQK == 128) return row * 256 + (colB ^ ((row & 7) << 4)); else return row * 128 + (colB ^ (((row >> 1) & 7) << 4)); }
__device__ __forceinline__ int v_st(int k, int c) { const int kk = k; return ((kk >> 3) * 4 + (c >> 5)) * 512 + ((kk & 7) * 32 + (c & 31)) * 2; }
__device__ __forceinline__ int v_rd_base(int lane) { return ((lane & 3) << 3) | (((lane >> 2) & 3) << 6) | (((lane >> 4) & 1) << 5) | (((lane >> 5) & 1) << 8); }
constexpr int v_rd_off(int d0, int ks, int half) { return d0 * 512 + ks * 4096 + half * 2048; }
template <int OFF> __device__ __forceinline__ s16x4 tr_read(int vb) { s16x4 r; asm volatile("ds_read_b64_tr_b16 %0, %1 offset:%2" : "=&v"(r) : "v"(vb), "i"(OFF) : "memory"); return r; }
template <int D0> __device__ __forceinline__ void pv_one(f32x16& od, int vb, bf16x8 pa0, bf16x8 pa1, bf16x8 pa2, bf16x8 pa3) {
  const s16x4 l0 = tr_read<v_rd_off(D0, 0, 0)>(vb), h0 = tr_read<v_rd_off(D0, 0, 1)>(vb), l1 = tr_read<v_rd_off(D0, 1, 0)>(vb), h1 = tr_read<v_rd_off(D0, 1, 1)>(vb);
  const s16x4 l2 = tr_read<v_rd_off(D0, 2, 0)>(vb), h2 = tr_read<v_rd_off(D0, 2, 1)>(vb), l3 = tr_read<v_rd_off(D0, 3, 0)>(vb), h3 = tr_read<v_rd_off(D0, 3, 1)>(vb);
  asm volatile("s_waitcnt lgkmcnt(0)" ::: "memory"); SBAR();
#define PK(L, H) (bf16x8){L[0], L[1], L[2], L[3], H[0], H[1], H[2], H[3]}
  ATT_PRIO(1);
  od = __builtin_amdgcn_mfma_f32_32x32x16_bf16(pa0, PK(l0, h0), od, 0, 0, 0);
  od = __builtin_amdgcn_mfma_f32_32x32x16_bf16(pa1, PK(l1, h1), od, 0, 0, 0);
  od = __builtin_amdgcn_mfma_f32_32x32x16_bf16(pa2, PK(l2, h2), od, 0, 0, 0);
  od = __builtin_amdgcn_mfma_f32_32x32x16_bf16(pa3, PK(l3, h3), od, 0, 0, 0);
  ATT_PRIO(0);
#undef PK
}
__device__ __forceinline__ void pv_d0(f32x16* o, int vb, bf16x8 pa0, bf16x8 pa1, bf16x8 pa2, bf16x8 pa3) {
  pv_one<0>(o[0], vb, pa0, pa1, pa2, pa3); pv_one<1>(o[1], vb, pa0, pa1, pa2, pa3); pv_one<2>(o[2], vb, pa0, pa1, pa2, pa3); pv_one<3>(o[3], vb, pa0, pa1, pa2, pa3);
}
template <int DQK> struct Cst { static constexpr float SCALE = DQK == 128 ? 0.088388347648318440f : 0.125f; static constexpr float C = SCALE * 1.4426950408889634f; };

template <int DQK, bool FIXED>
__device__ __forceinline__ void partialSM(f32x16& p0, f32x16& p1, float& m_reg, float& mn, float& alpha) {
  if (FIXED) { mn = 0.f; alpha = 1.f;
#pragma unroll
    for (int r = 0; r < 16; ++r) p0[r] = __builtin_amdgcn_exp2f(p0[r]);
    return; }
  constexpr float THR2 = THR * 1.4426950408889634f;
  float pmax = p0[0];
#pragma unroll
  for (int r = 1; r < 16; ++r) pmax = fmaxf(pmax, p0[r]);
#pragma unroll
  for (int r = 0; r < 16; ++r) pmax = fmaxf(pmax, p1[r]);
  { auto rr = __builtin_amdgcn_permlane32_swap(__float_as_uint(pmax), __float_as_uint(pmax), false, false);
    pmax = fmaxf(__uint_as_float(rr[0]), __uint_as_float(rr[1])); }
  if (__builtin_expect(__all(pmax - m_reg <= THR2), 1)) { mn = m_reg; alpha = 1.f; }
  else { mn = fmaxf(m_reg, pmax); alpha = __builtin_amdgcn_exp2f(m_reg - mn); m_reg = mn; }
#pragma unroll
  for (int r = 0; r < 16; ++r) p0[r] -= mn;
#pragma unroll
  for (int r = 0; r < 16; ++r) p1[r] -= mn;
#pragma unroll
  for (int r = 0; r < 16; ++r) p0[r] = __builtin_amdgcn_exp2f(p0[r]);
}
__device__ __forceinline__ void finishSM(f32x16& p0, f32x16& p1, float alpha, float& l_reg, bf16x8& pa0, bf16x8& pa1, bf16x8& pa2, bf16x8& pa3) {
#pragma unroll
  for (int r = 0; r < 16; ++r) p1[r] = __builtin_amdgcn_exp2f(p1[r]);
  float ps = 0;
#pragma unroll
  for (int r = 0; r < 16; ++r) ps += p0[r];
#pragma unroll
  for (int r = 0; r < 16; ++r) ps += p1[r];
  { auto rr = __builtin_amdgcn_permlane32_swap(__float_as_uint(ps), __float_as_uint(ps), false, false);
    ps = __uint_as_float(rr[0]) + __uint_as_float(rr[1]); }
  l_reg = l_reg * alpha + ps;
#define PK4(P, BASE, OUT) do { u32x4 w = {cvt_pk_bf16(P[BASE + 0], P[BASE + 1]), cvt_pk_bf16(P[BASE + 2], P[BASE + 3]), cvt_pk_bf16(P[BASE + 4], P[BASE + 5]), cvt_pk_bf16(P[BASE + 6], P[BASE + 7])}; \
    OUT = *reinterpret_cast<bf16x8*>(&w); } while (0)
  PK4(p0, 0, pa0); PK4(p0, 8, pa1); PK4(p1, 0, pa2); PK4(p1, 8, pa3);
#undef PK4
}
template <int DQK, bool ALIBI>
__device__ __forceinline__ void qkt(f32x16& p0, f32x16& p1, const char* Ks, const bf16x8* qr, int r32, int hi, float dq, float sl) {
  if (ALIBI) {
    float dh = dq - (float)(4 * hi); asm volatile("" : "+v"(dh));
    const float d0u = __uint_as_float(__builtin_amdgcn_readfirstlane(__float_as_uint(dq)));
    if (d0u >= 64.f || d0u <= -32.f) {
      const float s = d0u > 0.f ? sl : -sl, base = -s * dh;
#pragma unroll
      for (int r = 0; r < 16; ++r) { const float c = (float)((r & 3) + 8 * (r >> 2)); p0[r] = fmaf(s, c, base); p1[r] = fmaf(s, c + 32.f, base); }
    } else {
#pragma unroll
      for (int r = 0; r < 16; ++r) { const float c = (float)((r & 3) + 8 * (r >> 2)); p0[r] = -sl * fabsf(dh - c); p1[r] = -sl * fabsf(dh - (c + 32.f)); }
    }
  } else { p0 = f32x16{}; p1 = f32x16{}; }
  ATT_PRIO(1);
  bf16x8 nb0 = *reinterpret_cast<const bf16x8*>(Ks + kswz<DQK>(r32, hi * 16)), nb1 = *reinterpret_cast<const bf16x8*>(Ks + kswz<DQK>(32 + r32, hi * 16));
#pragma unroll
  for (int d0 = 0; d0 < DQK / 16; ++d0) { const bf16x8 b0 = nb0, b1 = nb1;
    if (d0 + 1 < DQK / 16) { const int cb = ((d0 + 1) * 16 + hi * 8) * 2; nb0 = *reinterpret_cast<const bf16x8*>(Ks + kswz<DQK>(r32, cb)); nb1 = *reinterpret_cast<const bf16x8*>(Ks + kswz<DQK>(32 + r32, cb)); }
    p0 = __builtin_amdgcn_mfma_f32_32x32x16_bf16(b0, qr[d0], p0, 0, 0, 0);
    p1 = __builtin_amdgcn_mfma_f32_32x32x16_bf16(b1, qr[d0], p1, 0, 0, 0); }
  ATT_PRIO(0);
}

template <int DQK, bool ALIBI, int SDEPTH, int LDKV, bool FIXED>
__device__ __forceinline__ void attn_pass(const bf16_t* __restrict__ Qw, const bf16_t* __restrict__ Kh, const bf16_t* __restrict__ Vh, int seq, char* lds, f32x16 (&o)[4], float qpos, float sl, int tid, const float mfix) {
  constexpr int SHM_V = KVBLK * DV * 2, SHM_K = KVBLK * DQK * 2;
  const int wid = tid >> 6, lane = tid & 63, r32 = lane & 31, hi = lane >> 5;
  char* V_lds = lds; char* K_lds = lds + 2 * SHM_V;
  float* ws = (float*)(lds + 2 * SHM_V + 2 * SHM_K) + wid * 64; float* li_l = ws; float* al_l = ws + 32;
  float m_reg = -1e30f, l_reg = 0; bf16x8 qr[DQK / 16];
#pragma unroll
  for (int d0 = 0; d0 < 4; ++d0) o[d0] = f32x16{};
#pragma unroll
  for (int d0 = 0; d0 < DQK / 16; ++d0) qr[d0] = *reinterpret_cast<const bf16x8*>(Qw + d0 * 16);
  const int sr = tid >> 4, sc = (tid & 15) * 8, vst0 = v_st(sr, sc), vst1 = v_st(32 + sr, sc);
  const int kr = DQK == 128 ? sr : (tid >> 3), kc = DQK == 128 ? sc : (tid & 7) * 8;
  const int vb0 = (int)(uintptr_t)V_lds + v_rd_base(lane);
  struct { bf16x8 vs0, vs1, ks0, ks1; } sr_[SDEPTH];
#define SLOAD(i, k0) do { sr_[i].vs0 = *(const bf16x8*)(Vh + (size_t)((k0) + sr) * LDKV + sc); sr_[i].vs1 = *(const bf16x8*)(Vh + (size_t)((k0) + 32 + sr) * LDKV + sc); \
    sr_[i].ks0 = *(const bf16x8*)(Kh + (size_t)((k0) + kr) * LDKV + kc); if (DQK == 128) sr_[i].ks1 = *(const bf16x8*)(Kh + (size_t)((k0) + 32 + kr) * LDKV + kc); } while (0)
#define SWRITE(b, i) do { *(bf16x8*)(V_lds + (b) * SHM_V + vst0) = sr_[i].vs0; *(bf16x8*)(V_lds + (b) * SHM_V + vst1) = sr_[i].vs1; \
    *(bf16x8*)(K_lds + (b) * SHM_K + kswz<DQK>(kr, kc * 2)) = sr_[i].ks0; if (DQK == 128) *(bf16x8*)(K_lds + (b) * SHM_K + kswz<DQK>(32 + kr, kc * 2)) = sr_[i].ks1; } while (0)
#define SWAIT() do { if (SDEPTH == 1) asm volatile("s_waitcnt vmcnt(0)" ::: "memory"); else if (DQK == 128) asm volatile("s_waitcnt vmcnt(4)" ::: "memory"); else asm volatile("s_waitcnt vmcnt(3)" ::: "memory"); } while (0)
#define RESC(a) do { if (!FIXED && __any((a) < 1.f)) { if (hi == 0) al_l[r32] = (a); asm volatile("s_waitcnt lgkmcnt(0)" ::: "memory"); \
    _Pragma("unroll") for (int d = 0; d < 4; ++d) _Pragma("unroll") for (int r = 0; r < 16; ++r) o[d][r] *= al_l[crow(r, hi)]; } } while (0)
  f32x16 pA0, pA1, pB0, pB1; float mnA, mnB, alA, alB; bf16x8 pa0, pa1, pa2, pa3; const int NT = seq / KVBLK;
  constexpr int SE = 0, SO = SDEPTH - 1;
  SLOAD(SE, 0); asm volatile("s_waitcnt vmcnt(0)" ::: "memory"); SWRITE(0, SE); __syncthreads();
  qkt<DQK, ALIBI>(pA0, pA1, K_lds, qr, r32, hi, qpos, sl); partialSM<DQK, FIXED>(pA0, pA1, m_reg, mnA, alA);
  SLOAD(SO, KVBLK); if (SDEPTH == 2) { if (2 < NT) SLOAD(SE, 2 * KVBLK); }
  SWAIT(); SWRITE(1, SO); __syncthreads();
  _Pragma("unroll 1") for (int j = 1; j + 1 < NT; j += 2) {
    SBAR(); qkt<DQK, ALIBI>(pB0, pB1, K_lds + SHM_K, qr, r32, hi, qpos - (float)(j * KVBLK), sl);
    finishSM(pA0, pA1, alA, l_reg, pa0, pa1, pa2, pa3); SBAR();
    SLOAD(SO, (j + SDEPTH) * KVBLK); SBAR();
    pv_d0(o, vb0, pa0, pa1, pa2, pa3); partialSM<DQK, FIXED>(pB0, pB1, m_reg, mnB, alB);
    __syncthreads(); SWAIT(); SWRITE(0, SE);
    RESC(alB); __syncthreads();
    SBAR(); qkt<DQK, ALIBI>(pA0, pA1, K_lds, qr, r32, hi, qpos - (float)((j + 1) * KVBLK), sl);
    finishSM(pB0, pB1, alB, l_reg, pa0, pa1, pa2, pa3); SBAR();
    if (SDEPTH == 1 || j + 3 < NT) SLOAD(SE, (j + 1 + SDEPTH) * KVBLK); SBAR();
    pv_d0(o, vb0 + SHM_V, pa0, pa1, pa2, pa3); partialSM<DQK, FIXED>(pA0, pA1, m_reg, mnA, alA);
    __syncthreads(); SWAIT(); SWRITE(1, SO);
    RESC(alA); __syncthreads();
  }
  SBAR(); qkt<DQK, ALIBI>(pB0, pB1, K_lds + SHM_K, qr, r32, hi, qpos - (float)((NT - 1) * KVBLK), sl);
  finishSM(pA0, pA1, alA, l_reg, pa0, pa1, pa2, pa3); SBAR();
  pv_d0(o, vb0, pa0, pa1, pa2, pa3); partialSM<DQK, FIXED>(pB0, pB1, m_reg, mnB, alB);
  __syncthreads(); RESC(alB);
  finishSM(pB0, pB1, alB, l_reg, pa0, pa1, pa2, pa3); SBAR();
  pv_d0(o, vb0 + SHM_V, pa0, pa1, pa2, pa3);
  if (hi == 0) li_l[r32] = l_reg; asm volatile("s_waitcnt lgkmcnt(0)" ::: "memory");
#pragma unroll
  for (int r = 0; r < 16; ++r) { const float rl = __builtin_amdgcn_rcpf(li_l[crow(r, hi)]);
#pragma unroll
    for (int d0 = 0; d0 < 4; ++d0) o[d0][r] *= rl; }
#undef SLOAD
#undef SWRITE
#undef SWAIT
#undef RESC
}
template <int DQK, bool ALIBI, int LDKV, bool FIXED>
__device__ __forceinline__ void attn_pass3(const bf16_t* __restrict__ Qw, const bf16_t* __restrict__ Kh, const bf16_t* __restrict__ Vh, int seq, char* lds, f32x16 (&o)[4], float qpos, float sl, int tid, const float mfix) {
  constexpr int SHM_V = KVBLK * DV * 2, SHM_K = KVBLK * DQK * 2;
  const int wid = tid >> 6, lane = tid & 63, r32 = lane & 31, hi = lane >> 5;
  char* V_lds = lds; char* K_lds = lds + 3 * SHM_V;
  float* ws = (float*)(lds + 3 * SHM_V + 3 * SHM_K) + wid * 64; float* li_l = ws; float* al_l = ws + 32;
  float m_reg = -1e30f, l_reg = 0; bf16x8 qr[DQK / 16];
#pragma unroll
  for (int d0 = 0; d0 < 4; ++d0) o[d0] = f32x16{};
#pragma unroll
  for (int d0 = 0; d0 < DQK / 16; ++d0) qr[d0] = *reinterpret_cast<const bf16x8*>(Qw + d0 * 16);
  const int sr = tid >> 4, sc = (tid & 15) * 8, vst0 = v_st(sr, sc), vst1 = v_st(32 + sr, sc);
  const int kr = DQK == 128 ? sr : (tid >> 3), kc = DQK == 128 ? sc : (tid & 7) * 8;
  const int vb0 = (int)(uintptr_t)V_lds + v_rd_base(lane);
  bf16x8 vs0, vs1, ks0, ks1;
#define SLOAD(k0) do { vs0 = *(const bf16x8*)(Vh + (size_t)((k0) + sr) * LDKV + sc); vs1 = *(const bf16x8*)(Vh + (size_t)((k0) + 32 + sr) * LDKV + sc); \
    ks0 = *(const bf16x8*)(Kh + (size_t)((k0) + kr) * LDKV + kc); if (DQK == 128) ks1 = *(const bf16x8*)(Kh + (size_t)((k0) + 32 + kr) * LDKV + kc); } while (0)
#define SWRITE(b) do { *(bf16x8*)(V_lds + (b) * SHM_V + vst0) = vs0; *(bf16x8*)(V_lds + (b) * SHM_V + vst1) = vs1; \
    *(bf16x8*)(K_lds + (b) * SHM_K + kswz<DQK>(kr, kc * 2)) = ks0; if (DQK == 128) *(bf16x8*)(K_lds + (b) * SHM_K + kswz<DQK>(32 + kr, kc * 2)) = ks1; } while (0)
#define RESC(a) do { if (!FIXED && __any((a) < 1.f)) { if (hi == 0) al_l[r32] = (a); asm volatile("s_waitcnt lgkmcnt(0)" ::: "memory"); \
    _Pragma("unroll") for (int d = 0; d < 4; ++d) _Pragma("unroll") for (int r = 0; r < 16; ++r) o[d][r] *= al_l[crow(r, hi)]; } } while (0)
  f32x16 pA0, pA1, pB0, pB1; float mnA, mnB, alA, alB; bf16x8 pa0, pa1, pa2, pa3; const int NT = seq / KVBLK;
  __syncthreads();
  SLOAD(0); asm volatile("s_waitcnt vmcnt(0)" ::: "memory"); SWRITE(0);
  SLOAD(KVBLK); asm volatile("s_waitcnt vmcnt(0)" ::: "memory"); SWRITE(1);
  if (2 < NT) SLOAD(2 * KVBLK);
  __syncthreads();
  qkt<DQK, ALIBI>(pA0, pA1, K_lds, qr, r32, hi, qpos, sl); partialSM<DQK, FIXED>(pA0, pA1, m_reg, mnA, alA);
  int s0 = 0, s1 = 1, s2 = 2;
#define ITER(PC0, PC1, mnC, alC, PP0, PP1, alP, t, DO_WRITE, DO_LOAD) do { \
    if (DO_WRITE) { asm volatile("s_waitcnt vmcnt(0)" ::: "memory"); SWRITE(s2); } \
    SBAR(); qkt<DQK, ALIBI>(PC0, PC1, K_lds + s1 * SHM_K, qr, r32, hi, qpos - (float)((t) * KVBLK), sl); \
    finishSM(PP0, PP1, alP, l_reg, pa0, pa1, pa2, pa3); SBAR(); \
    if (DO_LOAD) SLOAD(((t) + 2) * KVBLK); SBAR(); \
    pv_d0(o, vb0 + s0 * SHM_V, pa0, pa1, pa2, pa3); partialSM<DQK, FIXED>(PC0, PC1, m_reg, mnC, alC); \
    RESC(alC); __syncthreads(); \
    { const int t_ = s0; s0 = s1; s1 = s2; s2 = t_; } } while (0)
  _Pragma("unroll 1") for (int t = 1; t + 2 < NT; t += 2) {
    ITER(pB0, pB1, mnB, alB, pA0, pA1, alA, t, true, true);
    ITER(pA0, pA1, mnA, alA, pB0, pB1, alB, t + 1, true, (t + 3 < NT));
  }
  ITER(pB0, pB1, mnB, alB, pA0, pA1, alA, NT - 1, false, false);
  finishSM(pB0, pB1, alB, l_reg, pa0, pa1, pa2, pa3); SBAR();
  pv_d0(o, vb0 + s0 * SHM_V, pa0, pa1, pa2, pa3);
  if (hi == 0) li_l[r32] = l_reg; asm volatile("s_waitcnt lgkmcnt(0)" ::: "memory");
#pragma unroll
  for (int r = 0; r < 16; ++r) { const float rl = __builtin_amdgcn_rcpf(li_l[crow(r, hi)]);
#pragma unroll
    for (int d0 = 0; d0 < 4; ++d0) o[d0][r] *= rl; }
#undef ITER
#undef SLOAD
#undef SWRITE
#undef RESC
}
}

__device__ __forceinline__ void gqa_attn_phase(const Frame& F, int o) {
    const bf16_t* Z = (const bf16_t*)POOLP(PL_Z); bf16_t* CAT = (bf16_t*)POOLP(PL_CAT);
    constexpr int NU_S = 16 * (T_S / 256), NU = NU_S + 16 * (T_P / 256);
    float mfix; { const float* qg = F.in[I_QN] + o * 128, *kg = F.in[I_KN] + o * 128; float a = fmaxf(fabsf(qg[F.lane]), fabsf(qg[F.lane + 64])), b = fmaxf(fabsf(kg[F.lane]), fabsf(kg[F.lane + 64]));
#pragma unroll
        for (int s = 1; s < 64; s <<= 1) { a = fmaxf(a, __shfl_xor(a, s)); b = fmaxf(b, __shfl_xor(b, s)); }
        mfix = 128.0f * 1.01f * a * b * 0.0883883476f;
        if (!(mfix < FIXREF_LIMIT_GQA)) mfix = -1.0f; }
    for (int L = F.bid; L < NU; L += F.G) {
        int tid = threadIdx.x; asm volatile("" : "+v"(tid));
        const int lane = tid & 63, r32 = lane & 31, hi = lane >> 5, wid = tid >> 6;
        int seq, head, qb;
        if (L < NU_S) { const int x = L & 7, r = L >> 3, kvh = x & 3, half = x >> 2; seq = 1; head = kvh * 4 + (r & 3); qb = half * 32 + (r >> 2); }
        else { const int Lp = L - NU_S, x = Lp & 7, r = Lp >> 3, kvh = x & 3, half = x >> 2; seq = 0; head = kvh * 4 + (r & 3); qb = half * 16 + (r >> 2); }
        const int t0 = seq ? T_P : 0, slen = seq ? T_S : T_P, kvh = head >> 2;
        const bf16_t* Qw = Z + (size_t)(t0 + qb * 256 + wid * 32 + r32) * ZLD + head * 128 + hi * 8;
        const bf16_t* Kh = Z + (size_t)t0 * ZLD + 2048 + kvh * 128; const bf16_t* Vh = Z + (size_t)t0 * ZLD + 2560 + kvh * 128;
        f32x16 ov[4];
        if (mfix >= 0.f) att::attn_pass<128, false, GQA_SDEPTH, ZLD, true>(Qw, Kh, Vh, slen, F.ldsg, ov, 0.f, 0.f, tid, mfix);
        else att::attn_pass<128, false, GQA_SDEPTH, ZLD, false>(Qw, Kh, Vh, slen, F.ldsg, ov, 0.f, 0.f, tid, mfix);
        bf16_t* Ow = CAT + (size_t)(t0 + qb * 256 + wid * 32) * DM + head * 128;
#pragma unroll
        for (int r = 0; r < 16; ++r) { const int orow = att::crow(r, hi);
#pragma unroll
            for (int d0 = 0; d0 < 4; ++d0) Ow[(size_t)orow * DM + d0 * 32 + r32] = f2bf(ov[d0][r]); }
    }
}

__device__ __forceinline__ void qk_bound_pass(const Frame& F, int e) {
    const bf16_t* Z = (const bf16_t*)POOLP(PL_Z); unsigned* ctl = (unsigned*)WSP(WS_CTL) + CW_QKB + e * 64;
    const int gw = F.bid * NWAVES + F.wave, NGW = F.G * NWAVES, lane = F.lane;
    float mx[2][2] = {{0.f, 0.f}, {0.f, 0.f}};
    for (int t = gw; t < TT; t += NGW) {
        const bf16_t* row = Z + (size_t)t * ZLD + lane * 16;
#pragma unroll
        for (int qk = 0; qk < 2; ++qk) { const u32x4 a = *(const u32x4*)(row + qk * 1024), b = *(const u32x4*)(row + qk * 1024 + 8);
            float s = bflo(a.x) * bflo(a.x) + bfhi(a.x) * bfhi(a.x) + bflo(a.y) * bflo(a.y) + bfhi(a.y) * bfhi(a.y) + bflo(a.z) * bflo(a.z) + bfhi(a.z) * bfhi(a.z) + bflo(a.w) * bflo(a.w) + bfhi(a.w) * bfhi(a.w)
                    + bflo(b.x) * bflo(b.x) + bfhi(b.x) * bfhi(b.x) + bflo(b.y) * bflo(b.y) + bfhi(b.y) * bfhi(b.y) + bflo(b.z) * bflo(b.z) + bfhi(b.z) * bfhi(b.z) + bflo(b.w) * bflo(b.w) + bfhi(b.w) * bfhi(b.w);
            s += __shfl_xor(s, 1); s += __shfl_xor(s, 2);
            if (t < T_P) mx[0][qk] = fmaxf(mx[0][qk], s); else mx[1][qk] = fmaxf(mx[1][qk], s); }
    }
    LAS float* red = (LAS float*)F.lds;
    if ((lane & 3) == 0) {
#pragma unroll
        for (int sq = 0; sq < 2; ++sq)
#pragma unroll
            for (int qk = 0; qk < 2; ++qk) red[(F.wave * 4 + sq * 2 + qk) * 16 + (lane >> 2)] = mx[sq][qk]; }
    LDS_WAIT(); __syncthreads();
    if (F.tid < 64) { float m = 0.f;
#pragma unroll
        for (int w = 0; w < 8; ++w) m = fmaxf(m, red[w * 64 + F.tid]);
        atomicMax(ctl + F.tid, __float_as_uint(m)); }
    __syncthreads();
}

__device__ __forceinline__ void diff_attn_phase(const Frame& F, int e, int rep = 0) {
    const bf16_t* Z = (const bf16_t*)POOLP(PL_Z); bf16_t* CAT = (bf16_t*)POOLP(PL_CAT); float* ST = (float*)POOLP(PL_STASH);
    const float lam = ((const float*)(WSP(WS_MISC) + MISC_LAM))[e * 2], linit = ((const float*)(WSP(WS_MISC) + MISC_LAM))[e * 2 + 1];
    const float* sg = F.in[I_SUBLN] + e * 128;
    unsigned* ctl = (unsigned*)WSP(WS_CTL); const unsigned* qkb = ctl + CW_QKB + e * 64; unsigned* qctr = ctl + CW_QUEUE + e * 64 + rep * 256;
    constexpr int NU = 8 * (T_S / 256) + 8 * (T_P / 256);
    LAS int* uslot = (LAS int*)(F.lds + RING_BYTES + 64);
    for (;;) {
        __syncthreads();
        if (threadIdx.x == 0) *uslot = (int)__hip_atomic_fetch_add(qctr, 1u, RLX_AGENT);
        LDS_WAIT(); __syncthreads();
        const int u = __builtin_amdgcn_readfirstlane(*uslot);
        if (u >= NU) break;
        int tid = threadIdx.x; asm volatile("" : "+v"(tid));
        const int lane = tid & 63, r32 = lane & 31, hi = lane >> 5, wid = tid >> 6;
        f32x4* st = (f32x4*)ST + ((size_t)F.bid * NTHREADS + tid) * 16;
        const int head = 7 - u / 96, rr = u % 96, seq = rr < 64 ? 1 : 0, qb = seq ? rr : rr - 64;
        const int t0 = seq ? T_P : 0, slen = seq ? T_S : T_P;
        const float slope = exp2f(-(float)(head + 1)), sl = slope * 1.4426950408889634f;
        const bf16_t* Vh = Z + (size_t)t0 * ZLD + 2048 + head * 128;
        f32x16 o[4];
        for (int m = 0; m < 2; ++m) {
            const float q2 = __uint_as_float(__hip_atomic_load(qkb + (seq * 2 + 0) * 16 + head * 2 + m, RLX_AGENT)), k2 = __uint_as_float(__hip_atomic_load(qkb + (seq * 2 + 1) * 16 + head * 2 + m, RLX_AGENT));
            const float qk = sqrtf(q2 * k2) * 1.001f * 0.6931471805599453f;
            const float Bnd = 2.0f * qk + 24.0f;
            const float mfix = (qk < FIXREF_LIMIT_DIFF) ? qk : -1.0f;
            float Wf = Bnd / slope; if (!(Wf < (float)slen)) Wf = (float)slen;
            const int W = (int)Wf + 1;
            int tlo = (qb * 256 - W) >> 6; if (tlo < 0) tlo = 0;
            int thi = (qb * 256 + 256 + W + 63) >> 6; if (thi > slen / 64) thi = slen / 64;
            if ((thi - tlo) & 1) { if (thi < slen / 64) ++thi; else --tlo; }
            tlo = __builtin_amdgcn_readfirstlane(tlo); thi = __builtin_amdgcn_readfirstlane(thi);
            const float qpos = (float)(qb * 256 + wid * 32 + r32 - tlo * 64);
            const bf16_t* Qw = Z + (size_t)(t0 + qb * 256 + wid * 32 + r32) * ZLD + head * 128 + m * 64 + hi * 8;
            const bf16_t* Kh = Z + (size_t)(t0 + tlo * 64) * ZLD + 1024 + head * 128 + m * 64;
            if (mfix >= 0.f) att::attn_pass<64, true, DIFF_SDEPTH, ZLD, true>(Qw, Kh, Vh + (size_t)(tlo * 64) * ZLD, (thi - tlo) * 64, F.ldsg, o, qpos, sl, tid, mfix);
            else att::attn_pass<64, true, DIFF_SDEPTH, ZLD, false>(Qw, Kh, Vh + (size_t)(tlo * 64) * ZLD, (thi - tlo) * 64, F.ldsg, o, qpos, sl, tid, mfix);
            if (m == 0) {
#pragma unroll
                for (int d0 = 0; d0 < 4; ++d0)
#pragma unroll
                    for (int q = 0; q < 4; ++q) st[d0 * 4 + q] = (f32x4){o[d0][4 * q], o[d0][4 * q + 1], o[d0][4 * q + 2], o[d0][4 * q + 3]};
            }
        }
        float ss[16];
#pragma unroll
        for (int r = 0; r < 16; ++r) ss[r] = 0.f;
#pragma unroll
        for (int d0 = 0; d0 < 4; ++d0) {
#pragma unroll
            for (int q = 0; q < 4; ++q) { const f32x4 s4 = st[d0 * 4 + q];
#pragma unroll
                for (int i = 0; i < 4; ++i) { const int r = 4 * q + i; const float a = s4[i] - lam * o[d0][r]; o[d0][r] = a; ss[r] += a * a; } }
            asm volatile("" ::: "memory"); }
#pragma unroll
        for (int r = 0; r < 16; ++r) { float s = ss[r]; s += __shfl_xor(s, 1); s += __shfl_xor(s, 2); s += __shfl_xor(s, 4); s += __shfl_xor(s, 8); s += __shfl_xor(s, 16);
            ss[r] = (1.0f - linit) / sqrtf(s * (1.f / 128.f) + SUBLN_EPS); }
        bf16_t* Ow = CAT + (size_t)(t0 + qb * 256 + wid * 32) * DM + 1024 + head * 128;
#pragma unroll
        for (int d0 = 0; d0 < 4; ++d0) { const float gcol = sg[d0 * 32 + r32];
#pragma unroll
            for (int r = 0; r < 16; ++r) Ow[(size_t)att::crow(r, hi) * DM + d0 * 32 + r32] = f2bf(o[d0][r] * ss[r] * gcol); }
    }
}

constexpr int PH_BASE = 3, PH_PER = 16, PH_END = PH_BASE + 8 * PH_PER - 1;
__host__ __device__ inline bool phase_exists(int pid) {
    if (pid < PH_BASE) return true;
    const int hl = (pid - PH_BASE) / PH_PER, k = (pid - PH_BASE) % PH_PER, f = hl & 1, l = hl >> 1;
    if (k <= 1) return true;
    if (k == 14) return hl == 7;
    if (k == 15 || f == 1 || k == 2 || k == 10 || k == 12) return false;
    if ((l & 1) && (k == 6 || k == 7 || k == 8)) return false;
    return true;
}

__device__ __forceinline__ bool fresh_frame(Frame& F) { int t = threadIdx.x; asm volatile("" : "+v"(t)); F.tid = t; F.lane = t & 63; F.wave = __builtin_amdgcn_readfirstlane(t >> 6); return true; }
#ifndef GU_WGM
#define GU_WGM 4
#endif
#ifndef DOWN_WGM
#define DOWN_WGM 2
#endif
#ifndef RES_WGM
#define RES_WGM 4
#endif
__global__ void __launch_bounds__(NTHREADS, 2) fwd_kernel(Args args) {
    extern __shared__ __attribute__((aligned(16))) unsigned char lds[];
    Frame F;
    F.lds = (LAS unsigned char*)lds; F.ldsg = (char*)lds;
    F.MISC = (volatile LAS unsigned*)(F.lds + MISC_OFF);
    F.tid = threadIdx.x; F.lane = F.tid & 63; F.wave = __builtin_amdgcn_readfirstlane(F.tid >> 6);
    F.G = gridDim.x; F.bid = blockIdx.x; F.in = args.in; F.x = args.out; F.ws = args.ws;
    for (int u = F.tid; u < (LDS_BYTES - RING_BYTES) / 4; u += NTHREADS) ((LAS unsigned*)(F.lds + RING_BYTES))[u] = 0u;
    __syncthreads();
    XcdBarrier bar = xcd_barrier_post((unsigned*)(F.ws + WS_CTL) + CW_BAR + args.li * XCD_BAR_WORDS, F.MISC + 8);
    const int lo = args.ph_lo, hi = args.ph_hi;
#define PH(p) (lo <= (p) && (p) < hi && fresh_frame(F))
#define ENDPH(p) do { if ((p) + 1 < hi) xcd_barrier(bar); } while (0)
    float* const PSS = (float*)(F.ws + WS_MISC + MISC_PSS);
    const int rep = args.pad;
#ifdef PROBE_K
#define RSCALE(s) (rep == 0 ? (s) : 0.0f)
#else
#define RSCALE(s) (s)
#endif

    if (PH(0)) { prologue_phase(F); ENDPH(0); }
    if (PH(1)) {
        auto S = make_sched(F, POOLP(PL_MEMN), DM, POOLP(PL_WKVT), DM, 256, 2 * DM, 8, ZKv{});
        EpiBf16<0> E{(bf16_t*)POOLP(PL_KVB), 2 * DM, (size_t)256 * 2 * DM, 0, 0, nullptr, nullptr, nullptr};
        pg8::gemm_phase(F.lds, DM, DM, DM, S, E, F.tid);
        s5_precompute_phase(F); ENDPH(1);
    }
    if (PH(2)) {
        { auto S = make_sched(F, POOLP(PL_KVB), 2 * DM, POOLP(PL_WQB), DM, 256, DM, 32, ZKf{});
          EpiBf16<2> E{(bf16_t*)WSP(WS_KF), DM, (size_t)256 * DM, 0, 0, F.in[I_CN], nullptr, nullptr};
          pg8::gemm_phase(F.lds, 2 * DM, DM, 512, S, E, F.tid); }
        { auto S = make_sched(F, POOLP(PL_WOT), DM, POOLP(PL_KVB), 2 * DM, DM, 256, 32, ZVw{});
          EpiBf16<0> E{(bf16_t*)WSP(WS_VWT), 1024, (size_t)DM * 1024, 256, 2, nullptr, nullptr, nullptr};
          pg8::gemm_phase(F.lds, DM, 2 * DM, 512, S, E, F.tid); }
        ENDPH(2);
    }
    for (int hl = 0; hl < 8; ++hl) {
        const int l = hl >> 1, f = hl & 1, pb = PH_BASE + hl * PH_PER, eo = l >> 1;
        const bool even = (l & 1) == 0;
        if (PH(pb + 0)) {
            auto S = make_sched(F, WSP(WS_HB), DM, WSP(WS_WGU + (size_t)hl * SZ_WGU), DM, TT, 2 * DFF, 1, ZNone{}); S.wgm = GU_WGM;
            EpiSwiglu E{F.ws, DFF, F.lds};
            pg8::gemm_phase(F.lds, DM, DM, DM, S, E, F.tid);
            ENDPH(pb + 0);
        }
        if (PH(pb + 1)) {
            auto S = make_sched(F, POOLP(PL_ACT), DFF, WSP(WS_WD + (size_t)hl * SZ_WD), DFF, TT, DM, 1, ZNone{}); S.wgm = DOWN_WGM;
            { EpiResidNorm E{RSCALE(0.5f), F.ws, (LAS float*)(F.lds + EXCH_OFF)}; pg8::gemm_phase(F.lds, DFF, DFF, DFF, S, E, F.tid); }
            ENDPH(pb + 1);
        }
        if (f == 0) {
            if (even) {
                if (PH(pb + 3)) {
                    auto S = make_sched(F, WSP(WS_HB), DM, WSP(WS_WINE + (size_t)eo * SZ_WINE), DM, TT, EVEN_IN, 1, ZNone{});
                    EpiWinEven E{F.ws, F.lds};
                    pg8::gemm_phase(F.lds, DM, DM, DM, S, E, F.tid);
                    ENDPH(pb + 3);
                }
                if (PH(pb + 4)) {
                    auto S = make_sched(F, POOLP(PL_UX), S5K2, WSP(WS_WST + (size_t)eo * 64 * SZ_WST), S5K1, NCH, S5NS, S5G, ZLin{(size_t)NCH * S5K2 * 2, SZ_WST});
                    EpiF32 E{(float*)POOLP(PL_SST), S5G * S5NS, (size_t)S5NS};
                    pg8::gemm_phase(F.lds, S5K2, S5K1, S5K1, S, E, F.tid);
                    qk_bound_pass(F, eo); ENDPH(pb + 4);
                }
                if (PH(pb + 5)) { s5_scan_phase(F, eo); ENDPH(pb + 5); }
                if (PH(pb + 6)) {
                    auto S = make_sched(F, POOLP(PL_UX), S5K2, WSP(WS_TG + (size_t)eo * 64 * SZ_TG), S5K2, NCH, S5K1, S5G, ZLin{(size_t)NCH * S5K2 * 2, SZ_TG});
                    EpiS5Out E{(bf16_t*)POOLP(PL_GB)};
                    pg8::gemm_phase(F.lds, S5K2, S5K2, S5K2, S, E, F.tid); ENDPH(pb + 6);
                }
                if (PH(pb + 7)) {
                    auto S = make_sched(F, POOLP(PL_GB), S5W, WSP(WS_GLU + (size_t)eo * SZ_GLU), S5W, TT, S5W, 1, ZNone{});
                    EpiGlu E{(const bf16_t*)POOLP(PL_GB), F.in[I_GLUB] + eo * S5W, (bf16_t*)POOLP(PL_CAT)};
                    pg8::gemm_phase(F.lds, S5W, S5W, S5W, S, E, F.tid);
                    if (!PH(pb + 8)) ENDPH(pb + 7);
                }
                if (PH(pb + 8)) { diff_attn_phase(F, eo, rep); ENDPH(pb + 8); }
            } else {
                if (PH(pb + 3)) {
                    auto S = make_sched(F, WSP(WS_HB), DM, WSP(WS_WINO + (size_t)eo * SZ_WINO), DM, TT, ODD_IN, 1, ZNone{});
                    EpiBf16<1> E{(bf16_t*)POOLP(PL_Z), ZLD, 0, 0, 0, nullptr, F.ws, F.lds};
                    pg8::gemm_phase(F.lds, DM, DM, DM, S, E, F.tid); ENDPH(pb + 3);
                }
                if (PH(pb + 4)) { qk_prep_phase(F, eo); ENDPH(pb + 4); }
                if (PH(pb + 5)) { gqa_attn_phase(F, eo); ENDPH(pb + 5); }
            }
            if (PH(pb + 9)) {
                auto S = make_sched(F, POOLP(PL_CAT), DM, even ? WSP(WS_WOUTE + (size_t)eo * SZ_SQ) : WSP(WS_WOUTO + (size_t)eo * SZ_SQ), DM, TT, DM, 1, ZNone{});
                    { EpiResidNorm E{RSCALE(1.0f), F.ws, (LAS float*)(F.lds + EXCH_OFF)}; pg8::gemm_phase(F.lds, DM, DM, DM, S, E, F.tid); }
                ENDPH(pb + 9);
            }
            if (PH(pb + 11)) {
                auto S = make_sched(F, WSP(WS_HB), DM, WSP(WS_KF + (size_t)l * 2 * SZ_KF), DM, TT, 1024, 1, ZNone{}); S.split = T_P / 256; S.bseq = SZ_KF;
                EpiCrossSm E{F.ws, (LAS f32x2*)(F.lds + EXCH_OFF), F.lds};
                pg8::gemm_phase(F.lds, DM, DM, DM, S, E, F.tid);
                ENDPH(pb + 11);
            }
            if (PH(pb + 13)) {
                auto S = make_sched(F, POOLP(PL_CP), 1024, WSP(WS_VWT + (size_t)l * 2 * SZ_KF), 1024, TT, DM, 1, ZNone{}); S.split = T_P / 256; S.bseq = SZ_KF; S.wgm = RES_WGM;
                EpiResidNorm E{RSCALE(1.0f), F.ws, (LAS float*)(F.lds + EXCH_OFF)};
                    pg8::gemm_phase(F.lds, 1024, 1024, 1024, S, E, F.tid); ENDPH(pb + 13);
            }
        }
        if (hl == 7 && PH(pb + 14)) { final_norm_phase(F, F.in[I_FINN]); ENDPH(pb + 14); }
    }
#undef PH
#undef ENDPH
}

#ifndef MK_PER_PHASE
#define MK_PER_PHASE 0
#endif
extern "C" void kernel_launch(void* const* d_in, const int* in_sizes, int n_in, void* d_out, int out_size, void* d_ws, size_t ws_size, hipStream_t stream) {
    static int grid = 0;
    if (grid == 0) {
        if (n_in != N_IN || out_size != TT * DM || ws_size < WS_END) { fprintf(stderr, "kernel_launch: unexpected shapes: n_in %d out %d ws %zu (need %zu)\n", n_in, out_size, ws_size, (size_t)WS_END); grid = -1; return; }
        int dev = 0, cus = 0, per_cu = 0;
        if (hipGetDevice(&dev) != hipSuccess || hipDeviceGetAttribute(&cus, hipDeviceAttributeMultiprocessorCount, dev) != hipSuccess) { grid = -1; return; }
        if (hipFuncSetAttribute((const void*)fwd_kernel, hipFuncAttributeMaxDynamicSharedMemorySize, LDS_BYTES) != hipSuccess) { fprintf(stderr, "kernel_launch: hipFuncSetAttribute failed\n"); grid = -1; return; }
        if (hipOccupancyMaxActiveBlocksPerMultiprocessor(&per_cu, (const void*)fwd_kernel, NTHREADS, LDS_BYTES) != hipSuccess || per_cu < 1) { fprintf(stderr, "kernel_launch: occupancy query says %d\n", per_cu); (void)hipGetLastError(); grid = -1; return; }
        grid = cus;
    }
    if (grid < 0) return;
#if MK_PER_PHASE
    (void)hipMemsetAsync((char*)d_ws + WS_CTL, 0, CTL_BYTES, stream);
#else
    (void)hipMemsetAsync((char*)d_ws + WS_CTL, 0, 32768, stream);
#endif
    Args a{};
    for (int i = 0; i < N_IN; ++i) a.in[i] = (const float*)d_in[i];
    a.out = (float*)d_out; a.ws = (unsigned char*)d_ws; a.pad = 0;
#if MK_PER_PHASE
    int li = 0;
    for (int p = 0; p < PH_END; ++p) { if (!phase_exists(p)) continue; a.ph_lo = p; a.ph_hi = p + 1; a.li = li++; a.pad = 0;
        hipLaunchKernelGGL(fwd_kernel, dim3(grid), dim3(NTHREADS), LDS_BYTES, stream, a);
#ifdef PROBE_K
        { const int kind = p < PH_BASE ? 100 + p : (p - PH_BASE) % PH_PER;
          if (kind == PROBE_K) for (int r = 1; r <= PROBE_REPS; ++r) { a.pad = r; hipLaunchKernelGGL(fwd_kernel, dim3(grid), dim3(NTHREADS), LDS_BYTES, stream, a); } }
#endif
    }
#else
    a.ph_lo = 0; a.ph_hi = PH_END; a.li = 0;
    hipLaunchKernelGGL(fwd_kernel, dim3(grid), dim3(NTHREADS), LDS_BYTES, stream, a);
#endif
    const hipError_t le = hipPeekAtLastError();
    if (le != hipSuccess) fprintf(stderr, "kernel_launch: launch failed: %s\n", hipGetErrorName(le));
}
```
